# Optimizing an MI355X kernel written in HIP

```python
import math
import jax, jax.numpy as jnp
from jax import lax
import numpy as np

D_MODEL = 1024
BATCH = 2
SEQ = 8192
DEPTH = 2

N_MIXERS = 2
DIFF_HEADS = 8
DIFF_HEAD_DIM = D_MODEL // DIFF_HEADS // 2
MOBA_HEADS = 16
MOBA_HEAD_DIM = D_MODEL // MOBA_HEADS
MOBA_BLOCK = 256
MOBA_TOPK = 3
D_FF = 4 * D_MODEL
Q_BLOCK = 128
MOBA_Q_CHUNK = 32
RMS_EPS = 1e-6
NEG_INF = -1e30
N_DIFF_LAYERS = (DEPTH + N_MIXERS - 1) // N_MIXERS

kernel_name = "diffattn_moba_interleaved_hybrid"


def alibi_slopes(n_heads):
    return np.array([2.0 ** (-8.0 * (h + 1) / n_heads) for h in range(n_heads)], dtype=np.float32)


def lambda_init_fn(layer_idx):
    return 0.8 - 0.6 * math.exp(-0.3 * layer_idx)


def rmsnorm(x, g):
    xf = x.astype(jnp.float32)
    y = xf * lax.rsqrt(jnp.mean(xf * xf, axis=-1, keepdims=True) + RMS_EPS) * g.astype(jnp.float32)
    return y.astype(x.dtype)


def squared_relu_mlp(h, w1, w2):
    return jnp.square(jax.nn.relu(h @ w1)) @ w2


def diff_attention(h, w_in, w_out, lam_params, subln_w, lam_init):
    B, T, _ = h.shape
    H, d = DIFF_HEADS, DIFF_HEAD_DIM
    q, k, v = jnp.split(h @ w_in, 3, axis=-1)
    q = q.reshape(B, T, H, 2, d).transpose(3, 0, 2, 1, 4)
    kf = k.reshape(B, T, H, 2, d).transpose(3, 0, 2, 1, 4).astype(jnp.float32)
    v = v.reshape(B, T, H, 2 * d).transpose(0, 2, 1, 3)
    lf = lam_params.astype(jnp.float32)
    lam = jnp.exp(jnp.sum(lf[0] * lf[1])) - jnp.exp(jnp.sum(lf[2] * lf[3])) + lam_init
    slopes = jnp.asarray(alibi_slopes(H))
    kpos = jnp.arange(T)
    scale = d ** -0.5

    def block(i):
        t0 = i * Q_BLOCK
        qb = lax.dynamic_slice_in_dim(q, t0, Q_BLOCK, axis=3).astype(jnp.float32)
        s = jnp.einsum('mbhqd,mbhkd->mbhqk', qb, kf) * scale
        dist = (t0 + jnp.arange(Q_BLOCK))[:, None] - kpos[None, :]
        bias = -slopes[:, None, None] * dist.astype(jnp.float32)
        s = jnp.where(dist >= 0, s + bias, NEG_INF)
        p = jax.nn.softmax(s, axis=-1)
        a = p[0] - lam * p[1]
        return jnp.einsum('bhqk,bhke->bhqe', a.astype(v.dtype), v)

    o = lax.map(block, jnp.arange(T // Q_BLOCK))
    o = o.transpose(1, 0, 3, 2, 4).reshape(B, T, H, 2 * d)
    o = rmsnorm(o, subln_w) * (1.0 - lam_init)
    return o.reshape(B, T, H * 2 * d) @ w_out


def moba_attention(h, w_in, w_out):
    B, T, _ = h.shape
    H, dh, BLK, QC = MOBA_HEADS, MOBA_HEAD_DIM, MOBA_BLOCK, MOBA_Q_CHUNK
    q, k, v = jnp.split(h @ w_in, 3, axis=-1)
    q = q.reshape(B, T, H, dh).transpose(0, 2, 1, 3)
    k = k.reshape(B, T, H, dh).transpose(0, 2, 1, 3)
    v = v.reshape(B, T, H, dh).transpose(0, 2, 1, 3)
    NB = -(-T // BLK)
    pad = NB * BLK - T
    kp = jnp.pad(k, ((0, 0), (0, 0), (0, pad), (0, 0)))
    vp = jnp.pad(v, ((0, 0), (0, 0), (0, pad), (0, 0)))
    kb = kp.reshape(B, H, NB, BLK, dh)
    vb = vp.reshape(B, H, NB, BLK, dh)
    kmean = jnp.mean(kb.astype(jnp.float32), axis=3)
    K_SEL = min(MOBA_TOPK, NB)
    slopes = jnp.asarray(alibi_slopes(H))
    scale = dh ** -0.5
    bi = jnp.arange(B)[:, None, None, None]
    hi = jnp.arange(H)[None, :, None, None]

    def chunk(c):
        t0 = c * QC
        j = t0 // BLK
        qc = lax.dynamic_slice_in_dim(q, t0, QC, axis=2).astype(jnp.float32)
        qpos = t0 + jnp.arange(QC)
        gate = jnp.einsum('bhqd,bhnd->bhqn', qc, kmean)
        gate = jnp.where(jnp.arange(NB) < j, gate, NEG_INF)
        _, idx = lax.top_k(gate, K_SEL)
        valid = jnp.arange(K_SEL) < j
        s0 = j * BLK
        k_own = lax.dynamic_slice_in_dim(kp, s0, BLK, axis=2).astype(jnp.float32)
        v_own = lax.dynamic_slice_in_dim(vp, s0, BLK, axis=2)
        d_own = (qpos[:, None] - (s0 + jnp.arange(BLK))[None, :]).astype(jnp.float32)
        sc_own = jnp.einsum('bhqd,bhkd->bhqk', qc, k_own) * scale - slopes[:, None, None] * d_own
        sc_own = jnp.where(d_own >= 0, sc_own, NEG_INF)
        k_sel = kb[bi, hi, idx]
        v_sel = vb[bi, hi, idx]
        sel_pos = idx[..., None] * BLK + jnp.arange(BLK)
        d_sel = (qpos[None, None, :, None, None] - sel_pos).astype(jnp.float32)
        sc_sel = (jnp.einsum('bhqd,bhqkld->bhqkl', qc, k_sel.astype(jnp.float32)) * scale
                  - slopes[None, :, None, None, None] * d_sel)
        sc_sel = jnp.where(valid[:, None], sc_sel, NEG_INF)
        sc = jnp.concatenate([sc_own, sc_sel.reshape(B, H, QC, K_SEL * BLK)], axis=-1)
        p = jax.nn.softmax(sc, axis=-1)
        p_own = p[..., :BLK].astype(v.dtype)
        p_sel = p[..., BLK:].reshape(B, H, QC, K_SEL, BLK).astype(v.dtype)
        return (jnp.einsum('bhqk,bhkd->bhqd', p_own, v_own)
                + jnp.einsum('bhqkl,bhqkld->bhqd', p_sel, v_sel))

    o = lax.map(chunk, jnp.arange(T // QC))
    o = o.transpose(1, 0, 3, 2, 4).reshape(B, T, H * dh)
    return o @ w_out


def setup_inputs(seed: int = 0) -> dict:
    key = jax.random.key(seed)
    ks = jax.random.split(key, 10)
    f32 = jnp.float32
    x = jax.random.normal(ks[0], (BATCH, SEQ, D_MODEL), f32)
    attn_norm = 1.0 + 0.02 * jax.random.normal(ks[1], (DEPTH, D_MODEL), f32)
    w_in = jax.random.normal(ks[2], (DEPTH, D_MODEL, 3 * D_MODEL), f32) * D_MODEL ** -0.5
    w_out = jax.random.normal(ks[3], (DEPTH, D_MODEL, D_MODEL), f32) * D_MODEL ** -0.5
    diff_lambda = 0.1 * jax.random.normal(ks[4], (N_DIFF_LAYERS, 4, DIFF_HEAD_DIM), f32)
    diff_subln = 1.0 + 0.02 * jax.random.normal(ks[5], (N_DIFF_LAYERS, 2 * DIFF_HEAD_DIM), f32)
    mlp_norm = 1.0 + 0.02 * jax.random.normal(ks[6], (DEPTH, D_MODEL), f32)
    w_ff1 = jax.random.normal(ks[7], (DEPTH, D_MODEL, D_FF), f32) * D_MODEL ** -0.5
    w_ff2 = jax.random.normal(ks[8], (DEPTH, D_FF, D_MODEL), f32) * D_FF ** -0.5
    final_norm = 1.0 + 0.02 * jax.random.normal(ks[9], (D_MODEL,), f32)
    return {"x": x, "attn_norm": attn_norm, "w_in": w_in, "w_out": w_out,
            "diff_lambda": diff_lambda, "diff_subln": diff_subln, "mlp_norm": mlp_norm,
            "w_ff1": w_ff1, "w_ff2": w_ff2, "final_norm": final_norm}


def reference(x, attn_norm, w_in, w_out, diff_lambda, diff_subln, mlp_norm, w_ff1, w_ff2, final_norm):
    h = x
    for i in range(DEPTH):
        hn = rmsnorm(h, attn_norm[i])
        if i % N_MIXERS == 0:
            li = i // N_MIXERS
            m = diff_attention(hn, w_in[i], w_out[i], diff_lambda[li], diff_subln[li], lambda_init_fn(i))
        else:
            m = moba_attention(hn, w_in[i], w_out[i])
        h = h + m
        h = h + squared_relu_mlp(rmsnorm(h, mlp_norm[i]), w_ff1[i], w_ff2[i])
    return rmsnorm(h, final_norm)
```

```cpp
#include <hip/hip_runtime.h>
#include <cstdint>
#include <cstdio>

typedef unsigned short bf16;
constexpr int BATCH = 2, T = 8192, D = 1024, M = BATCH * T, FF = 4096, NQKV = 3 * D;
constexpr float RMS_EPS = 1e-6f;
constexpr float LOG2E = 1.4426950408889634f;
constexpr float QSCALE = 0.125f * LOG2E;
constexpr float NEG_BIG = -1e30f;

constexpr size_t MiB = 1u << 20;
constexpr size_t WS_CTL = 0;
constexpr size_t WS_WIN = 1 * MiB;
constexpr size_t WS_WOUT = 13 * MiB;
constexpr size_t WS_WFF1 = 17 * MiB;
constexpr size_t WS_WFF2 = 33 * MiB;
constexpr size_t WS_SSQ = 49 * MiB;
constexpr size_t WS_KMEAN = 49 * MiB + 512 * 1024;
constexpr size_t WS_HB = 50 * MiB;
constexpr size_t WS_Q = 82 * MiB, WS_K = 114 * MiB, WS_V = 146 * MiB, WS_O = 178 * MiB;
constexpr size_t WS_ACT = 82 * MiB;
constexpr size_t WS_END = 210 * MiB;

__device__ __forceinline__ unsigned f2bf(float f) { unsigned u = __builtin_bit_cast(unsigned, f); return (u + 0x7fffu + ((u >> 16) & 1u)) >> 16; }
__device__ __forceinline__ float bf2f(unsigned h) { return __builtin_bit_cast(float, h << 16); }

__global__ __launch_bounds__(256) void prep_w(const float* __restrict__ W, int K, int N, bf16* __restrict__ Wt, const float* __restrict__ gk, int gmod, float cmul, int qcols, float qscale) {
    __shared__ float tile[32][33];
    const int tx = threadIdx.x & 31, ty = threadIdx.x >> 5;
    const int n0 = blockIdx.x * 32, k0 = blockIdx.y * 32;
#pragma unroll
    for (int i = 0; i < 4; ++i) {
        const int k = k0 + ty + 8 * i, n = n0 + tx;
        float v = W[(size_t)k * N + n];
        if (gk) v *= gk[k % gmod];
        v *= cmul;
        if (n < qcols) v *= qscale;
        tile[ty + 8 * i][tx] = v;
    }
    __syncthreads();
#pragma unroll
    for (int i = 0; i < 4; ++i) {
        const int n = n0 + ty + 8 * i, k = k0 + tx;
        Wt[(size_t)n * K + k] = (bf16)f2bf(tile[tx][ty + 8 * i]);
    }
}

__device__ __forceinline__ float wave_sum(float v) {
#pragma unroll
    for (int o = 1; o < 64; o <<= 1) v += __shfl_xor(v, o);
    return v;
}

__global__ __launch_bounds__(256) void prep_x(const float* __restrict__ x, float* __restrict__ out, bf16* __restrict__ HB, float* __restrict__ SSQ) {
    const int row = blockIdx.x, t = threadIdx.x;
    const float4 v = *(const float4*)(x + (size_t)row * D + 4 * t);
    *(float4*)(out + (size_t)row * D + 4 * t) = v;
    uint2 o; o.x = f2bf(v.x) | (f2bf(v.y) << 16); o.y = f2bf(v.z) | (f2bf(v.w) << 16);
    *(uint2*)(HB + (size_t)row * D + 4 * t) = o;
    const float s = wave_sum(v.x * v.x + v.y * v.y + v.z * v.z + v.w * v.w);
    if ((t & 63) == 0) SSQ[row * 4 + (t >> 6)] = s;
}
__global__ __launch_bounds__(256) void row_ssq(const float* __restrict__ h, bf16* __restrict__ HB, float* __restrict__ SSQ) {
    const int row = blockIdx.x, t = threadIdx.x;
    const float4 v = *(const float4*)(h + (size_t)row * D + 4 * t);
    uint2 o; o.x = f2bf(v.x) | (f2bf(v.y) << 16); o.y = f2bf(v.z) | (f2bf(v.w) << 16);
    *(uint2*)(HB + (size_t)row * D + 4 * t) = o;
    const float s = wave_sum(v.x * v.x + v.y * v.y + v.z * v.z + v.w * v.w);
    if ((t & 63) == 0) SSQ[row * 4 + (t >> 6)] = s;
}
__device__ __forceinline__ float row_rstd(const float* SSQ, int row) {
    const float4 s = *(const float4*)(SSQ + row * 4);
    return 1.0f / sqrtf(((s.x + s.y) + (s.z + s.w)) * (1.0f / D) + RMS_EPS);
}

template <int EPI>
__global__ __launch_bounds__(256) void gemm_simple(const bf16* __restrict__ A, const bf16* __restrict__ Bt, int N, int K, const float* __restrict__ SSQ, bf16* __restrict__ Ob, float* __restrict__ Of) {
    __shared__ float As[16][68], Bs[16][68];
    const int tid = threadIdx.x, tx = tid & 15, ty = tid >> 4;
    const int m0 = blockIdx.y * 64, n0 = blockIdx.x * 64;
    const int lr = tid >> 2, lk = (tid & 3) * 4;
    float acc[4][4];
#pragma unroll
    for (int i = 0; i < 4; ++i)
#pragma unroll
        for (int j = 0; j < 4; ++j) acc[i][j] = 0.f;
    for (int k0 = 0; k0 < K; k0 += 16) {
        const uint2 a = *(const uint2*)(A + (size_t)(m0 + lr) * K + k0 + lk);
        const uint2 b = *(const uint2*)(Bt + (size_t)(n0 + lr) * K + k0 + lk);
        As[lk + 0][lr] = bf2f(a.x & 0xffffu); As[lk + 1][lr] = bf2f(a.x >> 16); As[lk + 2][lr] = bf2f(a.y & 0xffffu); As[lk + 3][lr] = bf2f(a.y >> 16);
        Bs[lk + 0][lr] = bf2f(b.x & 0xffffu); Bs[lk + 1][lr] = bf2f(b.x >> 16); Bs[lk + 2][lr] = bf2f(b.y & 0xffffu); Bs[lk + 3][lr] = bf2f(b.y >> 16);
        __syncthreads();
#pragma unroll
        for (int k = 0; k < 16; ++k) {
            const float4 av = *(const float4*)&As[k][ty * 4];
            const float4 bv = *(const float4*)&Bs[k][tx * 4];
            const float aa[4] = {av.x, av.y, av.z, av.w}, bb[4] = {bv.x, bv.y, bv.z, bv.w};
#pragma unroll
            for (int i = 0; i < 4; ++i)
#pragma unroll
                for (int j = 0; j < 4; ++j) acc[i][j] = fmaf(aa[i], bb[j], acc[i][j]);
        }
        __syncthreads();
    }
#pragma unroll
    for (int i = 0; i < 4; ++i) {
        const int row = m0 + ty * 4 + i, col = n0 + tx * 4;
        if (EPI == 0) {
            const float rs = row_rstd(SSQ, row);
            const int t = col / D, c = col % D;
            bf16* dst = Ob + (size_t)t * ((size_t)M * D) + (size_t)row * D + c;
            uint2 o; o.x = f2bf(acc[i][0] * rs) | (f2bf(acc[i][1] * rs) << 16); o.y = f2bf(acc[i][2] * rs) | (f2bf(acc[i][3] * rs) << 16);
            *(uint2*)dst = o;
        } else if (EPI == 1) {
            float4* p = (float4*)(Of + (size_t)row * N + col);
            float4 h = *p; h.x += acc[i][0]; h.y += acc[i][1]; h.z += acc[i][2]; h.w += acc[i][3]; *p = h;
        } else {
            const float rs = row_rstd(SSQ, row);
            float v[4];
#pragma unroll
            for (int j = 0; j < 4; ++j) { const float r = fmaxf(acc[i][j] * rs, 0.f); v[j] = r * r; }
            uint2 o; o.x = f2bf(v[0]) | (f2bf(v[1]) << 16); o.y = f2bf(v[2]) | (f2bf(v[3]) << 16);
            *(uint2*)(Ob + (size_t)row * N + col) = o;
        }
    }
}

__global__ __launch_bounds__(256) void diff_attn_simple(const bf16* __restrict__ Q, const bf16* __restrict__ K, const bf16* __restrict__ V, bf16* __restrict__ O, const float* __restrict__ lamp) {
    __shared__ float Ks[64][65];
    __shared__ float Vs[64][129];
    const int tid = threadIdx.x, qi = tid >> 2, part = tid & 3;
    const int q0 = blockIdx.x * 64, h = blockIdx.y, b = blockIdx.z;
    const int t = q0 + qi;
    const size_t rowbase = (size_t)b * T;
    float lam;
    {
        const int l = tid & 63;
        const float a = wave_sum(lamp[l] * lamp[64 + l]), c = wave_sum(lamp[128 + l] * lamp[192 + l]);
        lam = expf(a) - expf(c) + 0.2f;
    }
    const float slope2 = exp2f(-(float)(h + 1)) * LOG2E;
    float ores[32];
    float o0[32], l0 = 0.f;
#pragma unroll 1
    for (int m = 0; m < 2; ++m) {
        float q[16];
        {
            const bf16* qp = Q + (rowbase + t) * D + h * 128 + m * 64 + part * 16;
#pragma unroll
            for (int i = 0; i < 16; ++i) q[i] = bf2f(qp[i]);
        }
        float mrun = NEG_BIG, l = 0.f, o[32];
#pragma unroll
        for (int e = 0; e < 32; ++e) o[e] = 0.f;
        const int nkt = q0 / 64 + 1;
        for (int kt = 0; kt < nkt; ++kt) {
            const int kb = kt * 64;
            __syncthreads();
            {
                const int key = tid >> 2, seg = tid & 3;
                const bf16* kp = K + (rowbase + kb + key) * D + h * 128 + m * 64 + seg * 16;
#pragma unroll
                for (int i = 0; i < 16; ++i) Ks[key][seg * 16 + i] = bf2f(kp[i]);
                const bf16* vp = V + (rowbase + kb + key) * D + h * 128 + seg * 32;
#pragma unroll
                for (int i = 0; i < 32; ++i) Vs[key][seg * 32 + i] = bf2f(vp[i]);
            }
            __syncthreads();
            for (int key = 0; key < 64; ++key) {
                float s = 0.f;
#pragma unroll
                for (int i = 0; i < 16; ++i) s = fmaf(q[i], Ks[key][part * 16 + i], s);
                s += __shfl_xor(s, 1); s += __shfl_xor(s, 2);
                const int kpos = kb + key;
                s += slope2 * (float)(kpos - t);
                if (kpos > t) s = -INFINITY;
                const float mn = fmaxf(mrun, s);
                const float alpha = exp2f(mrun - mn), p = exp2f(s - mn);
                mrun = mn; l = l * alpha + p;
#pragma unroll
                for (int e = 0; e < 32; ++e) o[e] = fmaf(p, Vs[key][part * 32 + e], o[e] * alpha);
            }
        }
        if (m == 0) {
#pragma unroll
            for (int e = 0; e < 32; ++e) o0[e] = o[e];
            l0 = l;
        } else {
            const float i0 = 1.0f / l0, i1 = lam / l;
#pragma unroll
            for (int e = 0; e < 32; ++e) ores[e] = o0[e] * i0 - o[e] * i1;
        }
    }
    float ss = 0.f;
#pragma unroll
    for (int e = 0; e < 32; ++e) ss = fmaf(ores[e], ores[e], ss);
    ss += __shfl_xor(ss, 1); ss += __shfl_xor(ss, 2);
    const float rs = 1.0f / sqrtf(ss * (1.0f / 128.0f) + RMS_EPS);
    bf16* op = O + (rowbase + t) * D + h * 128 + part * 32;
#pragma unroll
    for (int e = 0; e < 32; ++e) op[e] = (bf16)f2bf(ores[e] * rs);
}

__global__ __launch_bounds__(64) void kmean_simple(const bf16* __restrict__ K, float* __restrict__ KM) {
    const int n = blockIdx.x, h = blockIdx.y, b = blockIdx.z, d = threadIdx.x;
    float s = 0.f;
    for (int i = 0; i < 256; ++i) s += bf2f(K[((size_t)b * T + n * 256 + i) * D + h * 64 + d]);
    KM[(((size_t)b * 16 + h) * 32 + n) * 64 + d] = s * (1.0f / 256.0f);
}
__global__ __launch_bounds__(256) void moba_simple(const bf16* __restrict__ Q, const bf16* __restrict__ K, const bf16* __restrict__ V, bf16* __restrict__ O, const float* __restrict__ KM) {
    const int tid = threadIdx.x, qi = tid >> 2, part = tid & 3;
    const int q0 = blockIdx.x * 64, h = blockIdx.y, b = blockIdx.z;
    const int t = q0 + qi, j = q0 / 256;
    const size_t rowbase = (size_t)b * T;
    const float slope2 = exp2f(-0.5f * (float)(h + 1)) * LOG2E;
    float q[16];
    {
        const bf16* qp = Q + (rowbase + t) * D + h * 64 + part * 16;
#pragma unroll
        for (int i = 0; i < 16; ++i) q[i] = bf2f(qp[i]);
    }
    float b0 = -INFINITY, b1 = -INFINITY, b2 = -INFINITY; int i0 = 0, i1 = 0, i2 = 0;
    for (int n = 0; n < j; ++n) {
        const float* km = KM + (((size_t)b * 16 + h) * 32 + n) * 64 + part * 16;
        float g = 0.f;
#pragma unroll
        for (int i = 0; i < 16; ++i) g = fmaf(q[i], km[i], g);
        g += __shfl_xor(g, 1); g += __shfl_xor(g, 2);
        if (g > b0) { b2 = b1; i2 = i1; b1 = b0; i1 = i0; b0 = g; i0 = n; }
        else if (g > b1) { b2 = b1; i2 = i1; b1 = g; i1 = n; }
        else if (g > b2) { b2 = g; i2 = n; }
    }
    const int nsel = j < 3 ? j : 3;
    float mrun = NEG_BIG, l = 0.f, o[16];
#pragma unroll
    for (int e = 0; e < 16; ++e) o[e] = 0.f;
    for (int seg = 0; seg <= nsel; ++seg) {
        const int blk = seg == 0 ? j : (seg == 1 ? i0 : (seg == 2 ? i1 : i2));
        const int kb = blk * 256;
        for (int key = 0; key < 256; ++key) {
            const int kpos = kb + key;
            const bf16* kp = K + (rowbase + kpos) * D + h * 64 + part * 16;
            float s = 0.f;
#pragma unroll
            for (int i = 0; i < 16; ++i) s = fmaf(q[i], bf2f(kp[i]), s);
            s += __shfl_xor(s, 1); s += __shfl_xor(s, 2);
            s += slope2 * (float)(kpos - t);
            if (kpos > t) s = -INFINITY;
            const float mn = fmaxf(mrun, s);
            const float alpha = exp2f(mrun - mn), p = exp2f(s - mn);
            mrun = mn; l = l * alpha + p;
            const bf16* vp = V + (rowbase + kpos) * D + h * 64 + part * 16;
#pragma unroll
            for (int e = 0; e < 16; ++e) o[e] = fmaf(p, bf2f(vp[e]), o[e] * alpha);
        }
    }
    const float il = 1.0f / l;
    bf16* op = O + (rowbase + t) * D + h * 64 + part * 16;
#pragma unroll
    for (int e = 0; e < 16; ++e) op[e] = (bf16)f2bf(o[e] * il);
}

__global__ __launch_bounds__(256) void final_norm_k(float* __restrict__ out, const float* __restrict__ g) {
    __shared__ float red[4];
    const int row = blockIdx.x, t = threadIdx.x;
    float4 v = *(const float4*)(out + (size_t)row * D + 4 * t);
    const float s = wave_sum(v.x * v.x + v.y * v.y + v.z * v.z + v.w * v.w);
    if ((t & 63) == 0) red[t >> 6] = s;
    __syncthreads();
    const float rs = 1.0f / sqrtf(((red[0] + red[1]) + (red[2] + red[3])) * (1.0f / D) + RMS_EPS);
    const float4 gv = *(const float4*)(g + 4 * t);
    v.x *= rs * gv.x; v.y *= rs * gv.y; v.z *= rs * gv.z; v.w *= rs * gv.w;
    *(float4*)(out + (size_t)row * D + 4 * t) = v;
}

extern "C" void kernel_launch(void* const* d_in, const int* in_sizes, int n_in, void* d_out, int out_size, void* d_ws, size_t ws_size, hipStream_t stream) {
    if (n_in != 10 || out_size != M * D || ws_size < WS_END) { fprintf(stderr, "kernel_launch: unexpected shapes (n_in %d out %d ws %zu)\n", n_in, out_size, ws_size); return; }
    const float* x = (const float*)d_in[0];
    const float* attn_norm = (const float*)d_in[1];
    const float* w_in = (const float*)d_in[2];
    const float* w_out = (const float*)d_in[3];
    const float* diff_lambda = (const float*)d_in[4];
    const float* diff_subln = (const float*)d_in[5];
    const float* mlp_norm = (const float*)d_in[6];
    const float* w_ff1 = (const float*)d_in[7];
    const float* w_ff2 = (const float*)d_in[8];
    const float* final_norm = (const float*)d_in[9];
    float* out = (float*)d_out;
    unsigned char* ws = (unsigned char*)d_ws;
    bf16* WIN = (bf16*)(ws + WS_WIN); bf16* WOUT = (bf16*)(ws + WS_WOUT); bf16* WFF1 = (bf16*)(ws + WS_WFF1); bf16* WFF2 = (bf16*)(ws + WS_WFF2);
    float* SSQ = (float*)(ws + WS_SSQ); float* KM = (float*)(ws + WS_KMEAN);
    bf16* HB = (bf16*)(ws + WS_HB); bf16* Qb = (bf16*)(ws + WS_Q); bf16* Kb = (bf16*)(ws + WS_K); bf16* Vb = (bf16*)(ws + WS_V); bf16* Ob = (bf16*)(ws + WS_O);
    bf16* ACT = (bf16*)(ws + WS_ACT);

    for (int l = 0; l < 2; ++l) {
        prep_w<<<dim3(NQKV / 32, D / 32), 256, 0, stream>>>(w_in + (size_t)l * D * NQKV, D, NQKV, WIN + (size_t)l * NQKV * D, attn_norm + l * D, D, 1.0f, D, QSCALE);
        if (l == 0) prep_w<<<dim3(D / 32, D / 32), 256, 0, stream>>>(w_out, D, D, WOUT, diff_subln, 128, 0.8f, 0, 1.0f);
        else prep_w<<<dim3(D / 32, D / 32), 256, 0, stream>>>(w_out + (size_t)D * D, D, D, WOUT + (size_t)D * D, nullptr, 1, 1.0f, 0, 1.0f);
        prep_w<<<dim3(FF / 32, D / 32), 256, 0, stream>>>(w_ff1 + (size_t)l * D * FF, D, FF, WFF1 + (size_t)l * FF * D, mlp_norm + l * D, D, 1.0f, 0, 1.0f);
        prep_w<<<dim3(D / 32, FF / 32), 256, 0, stream>>>(w_ff2 + (size_t)l * FF * D, FF, D, WFF2 + (size_t)l * D * FF, nullptr, 1, 1.0f, 0, 1.0f);
    }
    prep_x<<<M, 256, 0, stream>>>(x, out, HB, SSQ);
    for (int l = 0; l < 2; ++l) {
        gemm_simple<0><<<dim3(NQKV / 64, M / 64), 256, 0, stream>>>(HB, WIN + (size_t)l * NQKV * D, NQKV, D, SSQ, Qb, nullptr);
        if (l == 0) diff_attn_simple<<<dim3(T / 64, 8, BATCH), 256, 0, stream>>>(Qb, Kb, Vb, Ob, diff_lambda);
        else {
            kmean_simple<<<dim3(32, 16, BATCH), 64, 0, stream>>>(Kb, KM);
            moba_simple<<<dim3(T / 64, 16, BATCH), 256, 0, stream>>>(Qb, Kb, Vb, Ob, KM);
        }
        gemm_simple<1><<<dim3(D / 64, M / 64), 256, 0, stream>>>(Ob, WOUT + (size_t)l * D * D, D, D, nullptr, nullptr, out);
        row_ssq<<<M, 256, 0, stream>>>(out, HB, SSQ);
        gemm_simple<2><<<dim3(FF / 64, M / 64), 256, 0, stream>>>(HB, WFF1 + (size_t)l * FF * D, FF, D, SSQ, ACT, nullptr);
        gemm_simple<1><<<dim3(D / 64, M / 64), 256, 0, stream>>>(ACT, WFF2 + (size_t)l * D * FF, D, FF, nullptr, nullptr, out);
        row_ssq<<<M, 256, 0, stream>>>(out, HB, SSQ);
    }
    final_norm_k<<<M, 256, 0, stream>>>(out, final_norm);
}
```

```cpp
#include <hip/hip_runtime.h>
#include <cstdio>
#include <cstdint>

constexpr int BATCH = 2, T = 8192, D = 1024, M = BATCH * T, FF = 4096, NQKV = 3 * D;
constexpr float RMS_EPS = 1e-6f;
constexpr float LOG2E = 1.4426950408889634f;
constexpr float QSCALE = 0.125f * LOG2E;
constexpr float NEG_BIG = -1e30f;

constexpr size_t MiB = 1u << 20;
constexpr size_t WS_CTL = 0, CTL_ZERO_BYTES = 1 * MiB;
constexpr size_t WS_WIN = 1 * MiB;
constexpr size_t WS_WOUT = 13 * MiB;
constexpr size_t WS_WFF1 = 17 * MiB;
constexpr size_t WS_WFF2 = 33 * MiB;
constexpr size_t WS_SSQ = 49 * MiB;
constexpr size_t WS_KMEAN = 50 * MiB;
constexpr size_t WS_HB = 51 * MiB;
constexpr size_t WS_Q = 83 * MiB, WS_K = 115 * MiB, WS_V = 147 * MiB, WS_O = 179 * MiB;
constexpr size_t WS_ACT = 83 * MiB;
constexpr size_t WS_END = 211 * MiB;
constexpr int CW_TMO = 0, CW_CODE = 1, CW_BAR = 4096;
namespace pg8 {
#define PG8_LAS __attribute__((address_space(3)))
typedef unsigned short bf16_t;
typedef short bf16x8 __attribute__((ext_vector_type(8)));
typedef float f32x4 __attribute__((ext_vector_type(4)));
typedef unsigned u32x4 __attribute__((ext_vector_type(4)));
constexpr int BM = 256, BK = 64, HALF = 128, HTB = HALF * BK * 2  , STAGE_BYTES = 8 * HTB, NXCD = 8, WGM = 8;

__host__ __device__ __forceinline__ int lds_byte(int r, int c) { const int st = (r >> 4) * 2 + (c >> 5), rr = r & 15, cc = c & 31, ob = rr * 64 + cc * 2; return st * 1024 + (ob ^ (((ob >> 9) & 1) << 5)); }
__host__ __device__ __forceinline__ void stage_rc(int b, int& R, int& C) { const int st = b / 1024, sb = b % 1024, swz = sb ^ (((sb >> 9) & 1) << 5); R = (st >> 1) * 16 + swz / 64; C = (st & 1) * 32 + (swz % 64) / 2; }
__host__ __device__ __forceinline__ int perm32(int rho) { const int n = rho >> 4, i = rho & 15; return 8 * (i >> 2) + 4 * n + (i & 3); }

struct Unit { int pm, pn; };
struct Gemm { const bf16_t* A; const bf16_t* Bt; int M, N, K; };

struct StaticOrder {
    int nM, nN, nwg, G, c;
    __host__ __device__ void init(int M, int N, int G_, int c_) { nM = M / BM; nN = N / BM; nwg = nM * nN; G = G_; c = c_; }
    __host__ __device__ bool next(int i, Unit& u) const {
        const long L = (long)i * G + c; if (L >= nwg) return false;
        int wgid = (int)L; { const int q = nwg / NXCD, r = nwg % NXCD, xcd = wgid % NXCD, off = wgid / NXCD; wgid = (xcd < r ? xcd * (q + 1) : r * (q + 1) + (xcd - r) * q) + off; }
        const int nig = WGM * nN, gid = wgid / nig, fm = gid * WGM, gsz = (nM - fm) < WGM ? (nM - fm) : WGM;
        u.pm = fm + ((wgid % nig) % gsz); u.pn = (wgid % nig) / gsz; return true;
    }
    __device__ __forceinline__ void a_ready(const Unit&) const {}
    __device__ __forceinline__ void done(const Unit&) const {}
};


__device__ __forceinline__ unsigned cvt_pk_bf16(float lo, float hi) { unsigned r; asm volatile("v_cvt_pk_bf16_f32 %0, %1, %2" : "=v"(r) : "v"(lo), "v"(hi)); return r; }
__device__ __forceinline__ float row_rstd16(const float* SSQ, int row) {
    const f32x4* p = (const f32x4*)(SSQ + (size_t)row * 16);
    const f32x4 a = p[0], b = p[1], c = p[2], d = p[3];
    const float s = ((a[0] + a[1]) + (a[2] + a[3])) + ((b[0] + b[1]) + (b[2] + b[3])) + ((c[0] + c[1]) + (c[2] + c[3])) + ((d[0] + d[1]) + (d[2] + d[3]));
    return 1.0f / sqrtf(s * (1.0f / 1024.0f) + 1e-6f);
}
template <int ACT> struct EpiScaleBf16 {
    static constexpr bool PERM = true, AFTER_DRAIN = false;
    bf16_t* O; int ldc; const float* SSQ; int split_cols; size_t split_stride;
    __device__ __forceinline__ void operator()(const f32x4 (&acc)[2][2][4][2], const Unit& u, int wr, int wc, int fr, int fq) const {
        const int row0 = u.pm * BM + wr * 64 + fr; int colt = u.pn * BM; bf16_t* base = O;
        if (split_cols) { const int t = colt / split_cols; base += (size_t)t * split_stride; colt -= t * split_cols; }
        const int col0 = colt + wc * 32 + 8 * fq;
        const int lane = fq * 16 + fr; float myrs[2];
#pragma unroll
        for (int ai = 0; ai < 2; ++ai) myrs[ai] = row_rstd16(SSQ, u.pm * BM + wr * 64 + ai * HALF + lane);
        asm volatile("" : "+v"(myrs[0]), "+v"(myrs[1]));
#pragma unroll
        for (int ai = 0; ai < 2; ++ai)
#pragma unroll
            for (int m = 0; m < 4; ++m) { const int row = row0 + ai * HALF + m * 16; const float rs = __shfl(myrs[ai], m * 16 + fr); bf16_t* rowp = base + (size_t)row * ldc + col0;
#pragma unroll
                for (int bj = 0; bj < 2; ++bj) { f32x4 v0 = acc[ai][bj][m][0] * rs, v1 = acc[ai][bj][m][1] * rs;
                    if (ACT == 1) {
#pragma unroll
                        for (int e = 0; e < 4; ++e) { const float a = __builtin_fmaxf(v0[e], 0.f), b = __builtin_fmaxf(v1[e], 0.f); v0[e] = a * a; v1[e] = b * b; } }
                    u32x4 w; w.x = cvt_pk_bf16(v0[0], v0[1]); w.y = cvt_pk_bf16(v0[2], v0[3]); w.z = cvt_pk_bf16(v1[0], v1[1]); w.w = cvt_pk_bf16(v1[2], v1[3]);
                    *(u32x4*)(rowp + bj * HALF) = w; } }
    }
};
struct EpiRes {
    static constexpr bool PERM = false, AFTER_DRAIN = false;
    float* out; bf16_t* HB; float* SSQ; int ldc;
    __device__ __forceinline__ void operator()(const f32x4 (&acc)[2][2][4][2], const Unit& u, int wr, int wc, int fr, int fq) const {
        typedef unsigned u32x2v __attribute__((ext_vector_type(2)));
        const int col0 = u.pn * BM + wc * 32 + 4 * fq;
#pragma unroll
        for (int ai = 0; ai < 2; ++ai)
#pragma unroll
            for (int m = 0; m < 4; ++m) { const int row = u.pm * BM + ai * HALF + wr * 64 + m * 16 + fr; const size_t off = (size_t)row * ldc + col0; float s = 0.f;
#pragma unroll
                for (int bj = 0; bj < 2; ++bj)
#pragma unroll
                    for (int n = 0; n < 2; ++n) { const size_t o2 = off + bj * HALF + n * 16; const f32x4 h = *(const f32x4*)(out + o2) + acc[ai][bj][m][n]; *(f32x4*)(out + o2) = h;
                        u32x2v w; w.x = cvt_pk_bf16(h[0], h[1]); w.y = cvt_pk_bf16(h[2], h[3]); *(u32x2v*)(HB + o2) = w;
                        s += (h[0] * h[0] + h[1] * h[1]) + (h[2] * h[2] + h[3] * h[3]); }
                s += __shfl_xor(s, 16); s += __shfl_xor(s, 32);
                if (fq == 0) SSQ[(size_t)row * 16 + u.pn * 4 + wc] = s;
                if (m & 1) asm volatile("" ::: "memory"); }
    }
};
template <class Epi, class Sched, bool ALIGN_EPI = false, bool SP2 = false>
__device__ __forceinline__ void gemm_phase(PG8_LAS unsigned char* lds, const Gemm g, const Sched& S, const Epi& E) {
    int tid_ = threadIdx.x; asm volatile("" : "+v"(tid_));
    const int tid = tid_, wid = __builtin_amdgcn_readfirstlane(tid >> 6), lane = tid & 63, wr = wid >> 2, wc = wid & 3, fr = lane & 15, fq = lane >> 4;
    const int K = g.K, nt = K / BK;
    unsigned voffA[2], voffB[2];
#pragma unroll
    for (int i = 0; i < 2; ++i) { int R, C; stage_rc(tid * 16 + i * 8192, R, C); const int Rb = Epi::PERM ? ((R & ~31) + perm32(R & 31)) : R;
        voffA[i] = (unsigned)(R * K + C) * 2u; voffB[i] = (unsigned)(Rb * K + C) * 2u; }
    const size_t kstep = (size_t)(BK * 2);
    const size_t hstep = (size_t)HALF * K * 2;
    const size_t tstep = 2 * hstep;
    const unsigned ldsw = (unsigned)wid * 1024u;
    const int aoff = lds_byte(wr * 64 + fr, fq * 8), boff = lds_byte(wc * 32 + fr, fq * 8);
#define PG8_SA(b, h) (((b) * 2 + (h)) * HTB)
#define PG8_SB(b, h) ((4 + (b) * 2 + (h)) * HTB)
#define PG8_STAGE(bufoff, gbase, voff) do { _Pragma("unroll") for (int _i = 0; _i < 2; ++_i) \
        __builtin_amdgcn_global_load_lds((const unsigned*)((const char*)(gbase) + (voff)[_i]), (PG8_LAS unsigned*)(lds + (bufoff) + ldsw + _i * 8192), 16, 0, 0); } while (0)
#define PG8_LDA(dst, b, h) do { _Pragma("unroll") for (int m = 0; m < 4; ++m) _Pragma("unroll") for (int k = 0; k < 2; ++k) dst[m][k] = *(const PG8_LAS bf16x8*)(lds + PG8_SA(b, h) + aoff + m * 2048 + k * 1024); } while (0)
#define PG8_LDB(dst, b, h) do { _Pragma("unroll") for (int n = 0; n < 2; ++n) _Pragma("unroll") for (int k = 0; k < 2; ++k) dst[n][k] = *(const PG8_LAS bf16x8*)(lds + PG8_SB(b, h) + boff + n * 2048 + k * 1024); } while (0)
#define PG8_MMA(ai, bj, At, Bt) do { __builtin_amdgcn_s_setprio(1); _Pragma("unroll") for (int m = 0; m < 4; ++m) _Pragma("unroll") for (int n = 0; n < 2; ++n) _Pragma("unroll") for (int k = 0; k < 2; ++k) \
        acc[ai][bj][m][n] = __builtin_amdgcn_mfma_f32_16x16x32_bf16(Bt[n][k], At[m][k], acc[ai][bj][m][n], 0, 0, 0); __builtin_amdgcn_s_setprio(0); } while (0)
#define PG8_WAIT_V(n) asm volatile("s_waitcnt vmcnt(" #n ")" ::: "memory")
#define PG8_WAIT_L(n) asm volatile("s_waitcnt lgkmcnt(" #n ")" ::: "memory")
#define PG8_BAR __builtin_amdgcn_s_barrier()
#define PG8_SCHED __builtin_amdgcn_sched_barrier(0)
    Unit cur, nxt; int ui = 0;
    if (!S.next(0, cur)) return;
    f32x4 acc[2][2][4][2];
#pragma unroll
    for (int a = 0; a < 2; ++a)
#pragma unroll
        for (int b = 0; b < 2; ++b)
#pragma unroll
            for (int m = 0; m < 4; ++m)
#pragma unroll
                for (int n = 0; n < 2; ++n) acc[a][b][m][n] = (f32x4){0.f, 0.f, 0.f, 0.f};
    bf16x8 At[4][2], B0[2][2], B1[2][2];
    const char* cA = (const char*)g.A + (size_t)cur.pm * tstep; const char* cB = (const char*)g.Bt + (size_t)cur.pn * tstep;
    S.a_ready(cur);
    if constexpr (SP2) {
        PG8_STAGE(PG8_SB(0, 0), cB, voffB); PG8_STAGE(PG8_SB(0, 1), cB + hstep, voffB); PG8_STAGE(PG8_SA(0, 0), cA, voffA); PG8_STAGE(PG8_SA(0, 1), cA + hstep, voffA);
        if (wr == 1) PG8_BAR;
        PG8_WAIT_V(2); PG8_BAR;
        PG8_STAGE(PG8_SB(1, 0), cB + kstep, voffB); PG8_STAGE(PG8_SA(1, 0), cA + kstep, voffA); PG8_STAGE(PG8_SB(1, 1), cB + hstep + kstep, voffB);
        PG8_WAIT_V(6); PG8_BAR;
    } else {
        PG8_STAGE(PG8_SB(0, 0), cB, voffB); PG8_STAGE(PG8_SA(0, 0), cA, voffA); PG8_STAGE(PG8_SB(0, 1), cB + hstep, voffB); PG8_STAGE(PG8_SA(0, 1), cA + hstep, voffA);
        if (wr == 1) PG8_BAR;
        PG8_WAIT_V(4); PG8_BAR;
        PG8_STAGE(PG8_SB(1, 0), cB + kstep, voffB); PG8_STAGE(PG8_SA(1, 0), cA + kstep, voffA); PG8_STAGE(PG8_SB(1, 1), cB + hstep + kstep, voffB);
        PG8_WAIT_V(6); PG8_BAR;
    }
    for (;;) {
        const bool has_next = S.next(ui + 1, nxt);
        const char* nA = has_next ? (const char*)g.A + (size_t)nxt.pm * tstep : cA; const char* nB = has_next ? (const char*)g.Bt + (size_t)nxt.pn * tstep : cB;
        for (int t = 0; t < nt; t += 2) {
            const bool last = (t == nt - 2);
            const char* a1 = cA + (size_t)(t + 1) * kstep;
            const char* a2 = last ? nA : cA + (size_t)(t + 2) * kstep; const char* b2 = last ? nB : cB + (size_t)(t + 2) * kstep;
            const char* a3 = a2 + kstep; const char* b3 = b2 + kstep;
            if (last && has_next) S.a_ready(nxt);
            if constexpr (SP2) {
            PG8_LDB(B0, 0, 0); PG8_LDB(B1, 0, 1); PG8_SCHED; PG8_LDA(At, 0, 0); PG8_STAGE(PG8_SA(1, 1), a1 + hstep, voffA);
            PG8_WAIT_V(8); PG8_WAIT_L(0); PG8_BAR; PG8_MMA(0, 0, At, B0); PG8_MMA(0, 1, At, B1); PG8_BAR; PG8_SCHED;
            PG8_LDA(At, 0, 1); PG8_STAGE(PG8_SB(0, 0), b2, voffB); PG8_STAGE(PG8_SB(0, 1), b2 + hstep, voffB); PG8_STAGE(PG8_SA(0, 0), a2, voffA);
            PG8_WAIT_V(8); PG8_WAIT_L(0); PG8_BAR; PG8_MMA(1, 0, At, B0); PG8_MMA(1, 1, At, B1); PG8_BAR; PG8_SCHED;
            PG8_LDB(B0, 1, 0); PG8_LDB(B1, 1, 1); PG8_SCHED; PG8_LDA(At, 1, 0); PG8_STAGE(PG8_SA(0, 1), a2 + hstep, voffA);
            PG8_WAIT_V(8); PG8_WAIT_L(0); PG8_BAR; PG8_MMA(0, 0, At, B0); PG8_MMA(0, 1, At, B1); PG8_BAR; PG8_SCHED;
            PG8_LDA(At, 1, 1); PG8_STAGE(PG8_SB(1, 0), b3, voffB); PG8_STAGE(PG8_SB(1, 1), b3 + hstep, voffB); PG8_STAGE(PG8_SA(1, 0), a3, voffA);
            PG8_WAIT_V(8); PG8_WAIT_L(0); PG8_BAR; PG8_MMA(1, 0, At, B0); PG8_MMA(1, 1, At, B1); PG8_BAR; PG8_SCHED;
            } else {
            PG8_LDB(B0, 0, 0); PG8_SCHED; PG8_LDA(At, 0, 0); PG8_STAGE(PG8_SA(1, 1), a1 + hstep, voffA);
            PG8_WAIT_L(8); PG8_BAR; PG8_WAIT_L(0); PG8_MMA(0, 0, At, B0); PG8_BAR; PG8_SCHED;
            PG8_LDB(B1, 0, 1); PG8_STAGE(PG8_SB(0, 0), b2, voffB);
            PG8_BAR; PG8_WAIT_L(0); PG8_MMA(0, 1, At, B1); PG8_BAR;
            PG8_LDA(At, 0, 1); PG8_STAGE(PG8_SA(0, 0), a2, voffA);
            PG8_BAR; PG8_WAIT_L(0); PG8_MMA(1, 0, At, B0); PG8_BAR; PG8_SCHED;
            PG8_STAGE(PG8_SB(0, 1), b2 + hstep, voffB);
            PG8_WAIT_V(6); PG8_BAR; PG8_MMA(1, 1, At, B1); PG8_BAR;
            PG8_LDB(B0, 1, 0); PG8_SCHED; PG8_LDA(At, 1, 0); PG8_STAGE(PG8_SA(0, 1), a2 + hstep, voffA);
            PG8_WAIT_L(8); PG8_BAR; PG8_WAIT_L(0); PG8_MMA(0, 0, At, B0); PG8_BAR; PG8_SCHED;
            PG8_LDB(B1, 1, 1); PG8_STAGE(PG8_SB(1, 0), b3, voffB);
            PG8_BAR; PG8_WAIT_L(0); PG8_MMA(0, 1, At, B1); PG8_BAR;
            PG8_LDA(At, 1, 1); PG8_STAGE(PG8_SA(1, 0), a3, voffA);
            PG8_BAR; PG8_WAIT_L(0); PG8_MMA(1, 0, At, B0); PG8_BAR; PG8_SCHED;
            PG8_STAGE(PG8_SB(1, 1), b3 + hstep, voffB);
            PG8_WAIT_V(6); PG8_BAR; PG8_MMA(1, 1, At, B1); PG8_BAR;
            }
        }
        if constexpr (ALIGN_EPI) { if (wr == 0) PG8_BAR; }
        if constexpr (!Epi::AFTER_DRAIN) { E(acc, cur, wr, wc, fr, fq); S.done(cur); }
        if (!has_next) break;
#pragma unroll
        for (int a = 0; a < 2; ++a)
#pragma unroll
            for (int b = 0; b < 2; ++b)
#pragma unroll
                for (int m = 0; m < 4; ++m)
#pragma unroll
                    for (int n = 0; n < 2; ++n) acc[a][b][m][n] = (f32x4){0.f, 0.f, 0.f, 0.f};
        cur = nxt; cA = nA; cB = nB; ++ui;
        if constexpr (ALIGN_EPI) { if (wr == 1) PG8_BAR; }
    }
    PG8_WAIT_V(0);
    if constexpr (!ALIGN_EPI) { if (wr == 0) PG8_BAR; }
    PG8_BAR;
    if constexpr (Epi::AFTER_DRAIN) { E.fused(acc, cur, wr, wc, fr, fq, lds, wid, lane); S.done(cur); }
#undef PG8_SA
#undef PG8_SB
#undef PG8_STAGE
#undef PG8_LDA
#undef PG8_LDB
#undef PG8_MMA
#undef PG8_WAIT_V
#undef PG8_WAIT_L
#undef PG8_BAR
#undef PG8_SCHED
}
}

#ifndef PG8_SP2
#define PG8_SP2 true
#endif
#ifndef PG8_ALIGN
#define PG8_ALIGN true
#endif
#define GAS __attribute__((address_space(1)))
#define LAS __attribute__((address_space(3)))
typedef unsigned short bf16;
typedef unsigned v4u __attribute__((ext_vector_type(4)));
typedef float f32x4 __attribute__((ext_vector_type(4)));
typedef short bf16x8 __attribute__((ext_vector_type(8)));
typedef GAS unsigned gu32;
typedef GAS unsigned long long gu64;
#define RLX_AGENT __ATOMIC_RELAXED, __HIP_MEMORY_SCOPE_AGENT
#define LDS_WAIT() asm volatile("s_waitcnt lgkmcnt(0)" ::: "memory")
#define VM_WAIT() asm volatile("s_waitcnt vmcnt(0)" ::: "memory")
__device__ __forceinline__ unsigned long long rt() { return __builtin_amdgcn_s_memrealtime(); }
__device__ __forceinline__ unsigned f2bf(float f) { unsigned u = __builtin_bit_cast(unsigned, f); return (u + 0x7fffu + ((u >> 16) & 1u)) >> 16; }
__device__ __forceinline__ unsigned pk2(float lo, float hi) { return f2bf(lo) | (f2bf(hi) << 16); }

#define XB_TMO      128
#define XB_XCNT(j)  (256  + 64 * (j))
#define XB_XSUB(j)  (1280 + 64 * (j))
#define XB_XGEN(j)  (2304 + 64 * (j))
#define XB_TOP      3328
#define XB_TOPGEN   3392
#define XCD_BAR_WORDS 3456
#define XB_SPIN_CAP (1u << 18)

__device__ __forceinline__ unsigned xb_ld(unsigned* p)              { return __hip_atomic_load(p, __ATOMIC_RELAXED, __HIP_MEMORY_SCOPE_AGENT); }
__device__ __forceinline__ unsigned xb_add(unsigned* p, unsigned v) { return __hip_atomic_fetch_add(p, v, __ATOMIC_RELAXED, __HIP_MEMORY_SCOPE_AGENT); }
__device__ __forceinline__ unsigned xb_xcc_id() { return (unsigned)__builtin_amdgcn_s_getreg((3 << 11) | 20) & 0xFu; }
#define XB_SPIN(cond, bar) do { unsigned _sp = 0; while (cond) { __builtin_amdgcn_s_sleep(1); \
    if ((++_sp & 255u) == 0u) { if (xb_ld(&(bar)[XB_TMO])) break; if (_sp > XB_SPIN_CAP) { atomicAdd(&(bar)[XB_TMO], 1u); break; } } } } while (0)

struct XcdBarrier {
    unsigned* bar; unsigned x;
    volatile LAS unsigned* st;
};

__device__ __forceinline__ XcdBarrier xcd_barrier_post(unsigned* bar, volatile LAS unsigned* st) {
    XcdBarrier b; b.bar = bar; b.x = xb_xcc_id(); b.st = st;
    if (threadIdx.x == 0) (void)xb_add(&bar[XB_XCNT(b.x)], 1u);
    return b;
}
__device__ __forceinline__ void xcd_barrier_complete(unsigned* bar, unsigned x, unsigned& nloc, unsigned& nx) {
    const unsigned G = gridDim.x * gridDim.y * gridDim.z;
    unsigned sum, cnt, mine, sp = 0u;
    for (;;) {
        sum = 0u; cnt = 0u; mine = 0u;
#pragma unroll
        for (unsigned j = 0; j < 16; ++j) { const unsigned c = xb_ld(&bar[XB_XCNT(j)]); sum += c; cnt += (c > 0u) ? 1u : 0u; mine = (j == x) ? c : mine; }
        if (sum == G) break;
        __builtin_amdgcn_s_sleep(1);
        if ((++sp & 255u) == 0u) { if (xb_ld(&bar[XB_TMO])) break; if (sp > XB_SPIN_CAP) { atomicAdd(&bar[XB_TMO], 1u); break; } }
    }
    nloc = mine > 0u ? mine : 1u; nx = cnt > 0u ? cnt : 1u;
}

__device__ __forceinline__ void xcd_barrier(const XcdBarrier& b) {
    asm volatile("s_waitcnt vmcnt(0)" ::: "memory");
    __syncthreads();
    if (threadIdx.x == 0) {
        unsigned* bar = b.bar;
        __builtin_amdgcn_s_waitcnt(0);
        unsigned nloc = b.st[0], nx = b.st[1];
        if (nloc == 0u) { xcd_barrier_complete(bar, b.x, nloc, nx); b.st[0] = nloc; b.st[1] = nx; }
        const unsigned old = xb_add(&bar[XB_XSUB(b.x)], 1u);
        const unsigned gen = old / nloc;
        if (old + 1u == (gen + 1u) * nloc) {
            __builtin_amdgcn_fence(__ATOMIC_RELEASE, "agent");
            asm volatile("s_waitcnt vmcnt(0)" ::: "memory");
            const unsigned og = xb_add(&bar[XB_TOP], 1u);
            const unsigned tg = og / nx;
            if (og + 1u == (tg + 1u) * nx) xb_add(&bar[XB_TOPGEN], 1u);
            else XB_SPIN(xb_ld(&bar[XB_TOPGEN]) == tg, bar);
            __builtin_amdgcn_fence(__ATOMIC_ACQUIRE, "agent");
            xb_add(&bar[XB_XGEN(b.x)], 1u);
            asm volatile("s_waitcnt vmcnt(0)" ::: "memory");
        } else {
            XB_SPIN(xb_ld(&bar[XB_XGEN(b.x)]) == gen, bar);
            __builtin_amdgcn_fence(__ATOMIC_ACQUIRE, "agent");
            asm volatile("s_waitcnt vmcnt(0)" ::: "memory");
        }
    }
    __syncthreads();
}

constexpr int NWAVES = 8;
constexpr int RING_OFF = 0, RING_BYTES = 131072;
constexpr int LDSCTL_OFF = RING_BYTES, MISC_OFF = LDSCTL_OFF + 320;
constexpr int LDS_BYTES = 147456;
static_assert(MISC_OFF + 128 <= LDS_BYTES, "LDS map");

struct Frame {
    LAS unsigned char* lds; volatile LAS unsigned* MISC; gu32* ctl;
    int tid, lane, wave, vcu, G;
};
__device__ __forceinline__ float wave_sum(float v) {
#pragma unroll
    for (int o = 1; o < 64; o <<= 1) v += __shfl_xor(v, o);
    return v;
}
__device__ __forceinline__ float bf2f(unsigned h) { return __builtin_bit_cast(float, h << 16); }

__device__ __forceinline__ void p0_transpose_item(const float* W, int K, int N, bf16* WT, LAS float* scr, int item, int lane, const float* gk, int gmask, float cmul, int qcols, float qscale) {
    const int nblk = N / 32, kb = item / nblk, nb = item % nblk, k0 = 64 * kb, n0 = 32 * nb;
    const float cs = cmul * ((n0 < qcols) ? qscale : 1.0f);
#pragma unroll 8
    for (int i = 0; i < 32; ++i) { const int kk = 2 * i + (lane >> 5); const float g = gk ? gk[(k0 + kk) & gmask] : 1.0f; scr[kk * 33 + (lane & 31)] = W[(size_t)(k0 + kk) * N + n0 + (lane & 31)] * (g * cs); }
    LDS_WAIT(); asm volatile("" ::: "memory");
    const int c = lane & 7;
#pragma unroll
    for (int j = 0; j < 4; ++j) { const int n = (lane >> 3) + 8 * j; const LAS float* s = scr + (8 * c) * 33 + n;
        v4u o; o.x = pk2(s[0 * 33], s[1 * 33]); o.y = pk2(s[2 * 33], s[3 * 33]); o.z = pk2(s[4 * 33], s[5 * 33]); o.w = pk2(s[6 * 33], s[7 * 33]);
        *(GAS v4u*)(WT + (size_t)(n0 + n) * K + k0 + 8 * c) = o; }
    LDS_WAIT(); asm volatile("" ::: "memory");
}
__device__ __forceinline__ void p0_x_row(const float* xrow, float* orow, bf16* hrow, float* ssq, int lane) {
    const GAS f32x4* xr = (const GAS f32x4*)xrow + lane; GAS f32x4* orr = (GAS f32x4*)orow + lane; GAS unsigned long long* h8 = (GAS unsigned long long*)hrow + lane;
    f32x4 v[4]; float s[4];
#pragma unroll
    for (int j = 0; j < 4; ++j) v[j] = xr[64 * j];
#pragma unroll
    for (int j = 0; j < 4; ++j) { orr[64 * j] = v[j]; h8[64 * j] = (unsigned long long)pk2(v[j].x, v[j].y) | ((unsigned long long)pk2(v[j].z, v[j].w) << 32);
        s[j] = wave_sum((v[j].x * v[j].x + v[j].y * v[j].y) + (v[j].z * v[j].z + v[j].w * v[j].w)); }
    if (lane < 16) { const int j = lane >> 2; const float sj = j == 0 ? s[0] : j == 1 ? s[1] : j == 2 ? s[2] : s[3]; ssq[lane] = (lane & 3) == 0 ? sj : 0.f; }
}
__device__ __forceinline__ void final_row(float* orow, const float* ssq, const float* g, int lane) {
    const float rs = pg8::row_rstd16(ssq, 0);
    GAS f32x4* orr = (GAS f32x4*)orow + lane; const GAS f32x4* gr = (const GAS f32x4*)g + lane;
#pragma unroll
    for (int j = 0; j < 4; ++j) { f32x4 v = orr[64 * j]; const f32x4 gv = gr[64 * j]; v = v * rs * gv; orr[64 * j] = v; }
}

__device__ __forceinline__ void diff_attn_unit_simple(LAS unsigned char* lds, int b, int h, int qblk, const bf16* Q, const bf16* K, const bf16* V, bf16* O, float lam, int tid) {
    LAS float* Ks = (LAS float*)lds; LAS float* Vs = (LAS float*)(lds + 64 * 65 * 4);
    const int qi = tid >> 2, part = tid & 3, q0 = qblk * 128, t = q0 + qi;
    const size_t rowbase = (size_t)b * T;
    const float slope2 = exp2f(-(float)(h + 1)) * LOG2E;
    float ores[32], o0[32], l0 = 0.f;
#pragma unroll 1
    for (int m = 0; m < 2; ++m) {
        float q[16];
        { const bf16* qp = Q + (rowbase + t) * D + h * 128 + m * 64 + part * 16;
#pragma unroll
          for (int i = 0; i < 16; ++i) q[i] = bf2f(qp[i]); }
        float mrun = NEG_BIG, l = 0.f, o[32];
#pragma unroll
        for (int e = 0; e < 32; ++e) o[e] = 0.f;
        const int nkt = q0 / 64 + 2;
        for (int kt = 0; kt < nkt; ++kt) {
            const int kb = kt * 64;
            __syncthreads();
            { const int key = tid >> 3, seg = tid & 7;
              const bf16* kp = K + (rowbase + kb + key) * D + h * 128 + m * 64 + seg * 8;
#pragma unroll
              for (int i = 0; i < 8; ++i) Ks[key * 65 + seg * 8 + i] = bf2f(kp[i]);
              const bf16* vp = V + (rowbase + kb + key) * D + h * 128 + seg * 16;
#pragma unroll
              for (int i = 0; i < 16; ++i) Vs[key * 129 + seg * 16 + i] = bf2f(vp[i]); }
            __syncthreads();
            for (int key = 0; key < 64; ++key) {
                float s = 0.f;
#pragma unroll
                for (int i = 0; i < 16; ++i) s = fmaf(q[i], Ks[key * 65 + part * 16 + i], s);
                s += __shfl_xor(s, 1); s += __shfl_xor(s, 2);
                const int kpos = kb + key;
                s += slope2 * (float)(kpos - t);
                if (kpos > t) s = -INFINITY;
                const float mn = fmaxf(mrun, s);
                const float alpha = exp2f(mrun - mn), p = exp2f(s - mn);
                mrun = mn; l = l * alpha + p;
#pragma unroll
                for (int e = 0; e < 32; ++e) o[e] = fmaf(p, Vs[key * 129 + part * 32 + e], o[e] * alpha);
            }
        }
        if (m == 0) {
#pragma unroll
            for (int e = 0; e < 32; ++e) o0[e] = o[e];
            l0 = l;
        } else {
            const float i0 = 1.0f / l0, i1 = lam / l;
#pragma unroll
            for (int e = 0; e < 32; ++e) ores[e] = o0[e] * i0 - o[e] * i1;
        }
    }
    float ss = 0.f;
#pragma unroll
    for (int e = 0; e < 32; ++e) ss = fmaf(ores[e], ores[e], ss);
    ss += __shfl_xor(ss, 1); ss += __shfl_xor(ss, 2);
    const float rs = 1.0f / sqrtf(ss * (1.0f / 128.0f) + RMS_EPS);
    bf16* op = O + (rowbase + t) * D + h * 128 + part * 32;
#pragma unroll
    for (int e = 0; e < 32; e += 2) *(unsigned*)(op + e) = pk2(ores[e] * rs, ores[e + 1] * rs);
    __syncthreads();
}
__device__ __forceinline__ void moba_unit_simple(int b, int h, int qblk, const bf16* Q, const bf16* K, const bf16* V, bf16* O, const float* KM, int tid) {
    const int qi = tid >> 2, part = tid & 3, q0 = qblk * 128, t = q0 + qi, j = q0 / 256;
    const size_t rowbase = (size_t)b * T;
    const float slope2 = exp2f(-0.5f * (float)(h + 1)) * LOG2E;
    float q[16];
    { const bf16* qp = Q + (rowbase + t) * D + h * 64 + part * 16;
#pragma unroll
      for (int i = 0; i < 16; ++i) q[i] = bf2f(qp[i]); }
    float b0 = -INFINITY, b1 = -INFINITY, b2 = -INFINITY; int i0 = 0, i1 = 0, i2 = 0;
    for (int n = 0; n < j; ++n) {
        const float* km = KM + (((size_t)b * 16 + h) * 32 + n) * 64 + part * 16;
        float g = 0.f;
#pragma unroll
        for (int i = 0; i < 16; ++i) g = fmaf(q[i], km[i], g);
        g += __shfl_xor(g, 1); g += __shfl_xor(g, 2);
        if (g > b0) { b2 = b1; i2 = i1; b1 = b0; i1 = i0; b0 = g; i0 = n; }
        else if (g > b1) { b2 = b1; i2 = i1; b1 = g; i1 = n; }
        else if (g > b2) { b2 = g; i2 = n; }
    }
    const int nsel = j < 3 ? j : 3;
    float mrun = NEG_BIG, l = 0.f, o[16];
#pragma unroll
    for (int e = 0; e < 16; ++e) o[e] = 0.f;
    for (int seg = 0; seg <= nsel; ++seg) {
        const int blk = seg == 0 ? j : (seg == 1 ? i0 : (seg == 2 ? i1 : i2));
        const int kb = blk * 256;
        for (int key = 0; key < 256; ++key) {
            const int kpos = kb + key;
            const bf16* kp = K + (rowbase + kpos) * D + h * 64 + part * 16;
            float s = 0.f;
#pragma unroll
            for (int i = 0; i < 16; ++i) s = fmaf(q[i], bf2f(kp[i]), s);
            s += __shfl_xor(s, 1); s += __shfl_xor(s, 2);
            s += slope2 * (float)(kpos - t);
            if (kpos > t) s = -INFINITY;
            const float mn = fmaxf(mrun, s);
            const float alpha = exp2f(mrun - mn), p = exp2f(s - mn);
            mrun = mn; l = l * alpha + p;
            const bf16* vp = V + (rowbase + kpos) * D + h * 64 + part * 16;
#pragma unroll
            for (int e = 0; e < 16; ++e) o[e] = fmaf(p, bf2f(vp[e]), o[e] * alpha);
        }
    }
    const float il = 1.0f / l;
    bf16* op = O + (rowbase + t) * D + h * 64 + part * 16;
#pragma unroll
    for (int e = 0; e < 16; e += 2) *(unsigned*)(op + e) = pk2(o[e] * il, o[e + 1] * il);
}

struct Args { const float* in[10]; float* out; unsigned char* ws; };
__global__ void __launch_bounds__(NWAVES * 64, 2) fwd_kernel(Args args) {
    extern __shared__ __attribute__((aligned(16))) unsigned char lds[];
    Frame F;
    F.lds = (LAS unsigned char*)lds;
    F.MISC = (volatile LAS unsigned*)(F.lds + MISC_OFF);
    F.tid = threadIdx.x; F.lane = F.tid & 63; F.wave = __builtin_amdgcn_readfirstlane(F.tid >> 6);
    F.G = gridDim.x; { const int bx = blockIdx.x; F.vcu = (F.G % 8 == 0) ? (bx % 8) * (F.G / 8) + bx / 8 : bx; }
    unsigned char* ws = args.ws;
    F.ctl = (gu32*)(ws + WS_CTL);
#define PTRS() \
    unsigned char* wsl = args.ws; float* out = args.out; asm volatile("" : "+s"(wsl), "+s"(out)); \
    bf16* WIN = (bf16*)(wsl + WS_WIN); bf16* WOUT = (bf16*)(wsl + WS_WOUT); bf16* WFF1 = (bf16*)(wsl + WS_WFF1); bf16* WFF2 = (bf16*)(wsl + WS_WFF2); \
    float* SSQ = (float*)(wsl + WS_SSQ); float* KM = (float*)(wsl + WS_KMEAN); \
    bf16* HB = (bf16*)(wsl + WS_HB); bf16* Qb = (bf16*)(wsl + WS_Q); bf16* Kb = (bf16*)(wsl + WS_K); bf16* Vb = (bf16*)(wsl + WS_V); bf16* Ob = (bf16*)(wsl + WS_O); \
    bf16* ACT = (bf16*)(wsl + WS_ACT); \
    (void)WIN; (void)WOUT; (void)WFF1; (void)WFF2; (void)SSQ; (void)KM; (void)HB; (void)Qb; (void)Kb; (void)Vb; (void)Ob; (void)ACT; (void)out
    for (int u = F.tid; u < (LDS_BYTES - LDSCTL_OFF) / 4; u += NWAVES * 64) ((LAS unsigned*)(F.lds + LDSCTL_OFF))[u] = 0u;
    __syncthreads();
    XcdBarrier bar = xcd_barrier_post((unsigned*)(F.ctl + CW_BAR), F.MISC + 8);
#define GRID_BAR() xcd_barrier(bar)
    const int gw = F.vcu * NWAVES + F.wave, NGW = F.G * NWAVES;

    {
        PTRS();
        const float* x = args.in[0]; const float* attn_norm = args.in[1]; const float* w_in = args.in[2]; const float* w_out = args.in[3];
        const float* diff_subln = args.in[5]; const float* mlp_norm = args.in[6]; const float* w_ff1 = args.in[7]; const float* w_ff2 = args.in[8];
        LAS float* scr = (LAS float*)(F.lds + RING_OFF + F.wave * 16384);
        constexpr int I_IN = (D / 64) * (NQKV / 32), I_OUT = (D / 64) * (D / 32), I_F1 = (D / 64) * (FF / 32), I_F2 = (FF / 64) * (D / 32);
        constexpr int PER_L = I_IN + I_OUT + I_F1 + I_F2;
        for (int it = gw; it < 2 * PER_L; it += NGW) {
            const int l = it / PER_L; int r = it % PER_L;
            if (r < I_IN) { p0_transpose_item(w_in + (size_t)l * D * NQKV, D, NQKV, WIN + (size_t)l * NQKV * D, scr, r, F.lane, attn_norm + l * D, D - 1, 1.0f, D, QSCALE); continue; } r -= I_IN;
            if (r < I_OUT) { p0_transpose_item(w_out + (size_t)l * D * D, D, D, WOUT + (size_t)l * D * D, scr, r, F.lane, l == 0 ? diff_subln : nullptr, 127, l == 0 ? 0.8f : 1.0f, 0, 1.0f); continue; } r -= I_OUT;
            if (r < I_F1) { p0_transpose_item(w_ff1 + (size_t)l * D * FF, D, FF, WFF1 + (size_t)l * FF * D, scr, r, F.lane, mlp_norm + l * D, D - 1, 1.0f, 0, 1.0f); continue; } r -= I_F1;
            p0_transpose_item(w_ff2 + (size_t)l * FF * D, FF, D, WFF2 + (size_t)l * D * FF, scr, r, F.lane, nullptr, 0, 1.0f, 0, 1.0f);
        }
        for (int m = gw; m < M; m += NGW) p0_x_row(x + (size_t)m * D, out + (size_t)m * D, HB + (size_t)m * D, SSQ + (size_t)m * 16, F.lane);
    }
    GRID_BAR();

#pragma unroll 1
    for (int l = 0; l < 2; ++l) {
        {
            PTRS();
            pg8::Gemm g{HB, WIN + (size_t)l * NQKV * D, M, NQKV, D}; pg8::StaticOrder S; S.init(M, NQKV, F.G, (int)blockIdx.x);
            pg8::EpiScaleBf16<0> E{Qb, D, SSQ, D, (size_t)M * D};
            pg8::gemm_phase<pg8::EpiScaleBf16<0>, pg8::StaticOrder, PG8_ALIGN, PG8_SP2>(F.lds + RING_OFF, g, S, E);
        }
        GRID_BAR();
        if (l == 0) {
            PTRS();
            const float* lp = args.in[4];
            const float la = wave_sum(lp[F.lane] * lp[64 + F.lane]), lc = wave_sum(lp[128 + F.lane] * lp[192 + F.lane]);
            const float lam = expf(la) - expf(lc) + 0.2f;
            for (int i = blockIdx.x; i < 1024; i += F.G) {
                const int r = i >> 8, c = i & 255, bh = c & 15, s = c >> 4;
                const int qb = r == 0 ? s : r == 1 ? 31 - s : r == 2 ? 32 + s : 63 - s;
                { int tl = threadIdx.x; asm volatile("" : "+v"(tl)); diff_attn_unit_simple(F.lds + RING_OFF, bh >> 3, bh & 7, qb, Qb, Kb, Vb, Ob, lam, tl); }
            }
        } else {
            { PTRS();
            for (int it = gw; it < 1024; it += NGW) {
                const int n = it & 31, h = (it >> 5) & 15, b = it >> 9; float s = 0.f;
                const bf16* kp = Kb + ((size_t)b * T + n * 256) * D + h * 64 + F.lane;
                for (int i = 0; i < 256; ++i) s += bf2f(kp[(size_t)i * D]);
                KM[(size_t)it * 64 + F.lane] = s * (1.0f / 256.0f);
            } }
            GRID_BAR();
            PTRS();
            for (int i = blockIdx.x; i < 2048; i += F.G) { int tl = threadIdx.x; asm volatile("" : "+v"(tl)); moba_unit_simple(i >> 10, (i >> 6) & 15, i & 63, Qb, Kb, Vb, Ob, KM, tl); }
        }
        GRID_BAR();
        {
            PTRS();
            pg8::Gemm g{Ob, WOUT + (size_t)l * D * D, M, D, D}; pg8::StaticOrder S; S.init(M, D, F.G, (int)blockIdx.x);
            pg8::EpiRes E{out, HB, SSQ, D};
            pg8::gemm_phase<pg8::EpiRes, pg8::StaticOrder, PG8_ALIGN, PG8_SP2>(F.lds + RING_OFF, g, S, E);
        }
        GRID_BAR();
        {
            PTRS();
            pg8::Gemm g{HB, WFF1 + (size_t)l * FF * D, M, FF, D}; pg8::StaticOrder S; S.init(M, FF, F.G, (int)blockIdx.x);
            pg8::EpiScaleBf16<1> E{ACT, FF, SSQ, 0, 0};
            pg8::gemm_phase<pg8::EpiScaleBf16<1>, pg8::StaticOrder, PG8_ALIGN, PG8_SP2>(F.lds + RING_OFF, g, S, E);
        }
        GRID_BAR();
        {
            PTRS();
            pg8::Gemm g{ACT, WFF2 + (size_t)l * D * FF, M, D, FF}; pg8::StaticOrder S; S.init(M, D, F.G, (int)blockIdx.x);
            pg8::EpiRes E{out, HB, SSQ, D};
            pg8::gemm_phase<pg8::EpiRes, pg8::StaticOrder, PG8_ALIGN, PG8_SP2>(F.lds + RING_OFF, g, S, E);
        }
        GRID_BAR();
    }
    PTRS(); const float* final_norm = args.in[9];
    for (int m = gw; m < M; m += NGW) final_row(out + (size_t)m * D, SSQ + (size_t)m * 16, final_norm, F.lane);
    if (xb_ld((unsigned*)(F.ctl + CW_BAR) + XB_TMO) != 0u && blockIdx.x == 0) { const float qn = __builtin_nanf(""); for (int i = F.tid; i < 4096; i += NWAVES * 64) out[i] = qn; }
}

extern "C" void kernel_launch(void* const* d_in, const int* in_sizes, int n_in, void* d_out, int out_size, void* d_ws, size_t ws_size, hipStream_t stream) {
    static int grid = 0;
    if (grid == 0) {
        if (n_in != 10 || in_sizes[0] != M * D || out_size != M * D || ws_size < WS_END) { fprintf(stderr, "kernel_launch: unexpected shapes (n_in %d out %d ws %zu); nothing launched\n", n_in, out_size, ws_size); grid = -1; return; }
        int dev = 0, cus = 0, per_cu = 0;
        if (hipGetDevice(&dev) != hipSuccess || hipDeviceGetAttribute(&cus, hipDeviceAttributeMultiprocessorCount, dev) != hipSuccess) { fprintf(stderr, "kernel_launch: device query failed\n"); grid = -1; return; }
        if (hipFuncSetAttribute((const void*)fwd_kernel, hipFuncAttributeMaxDynamicSharedMemorySize, LDS_BYTES) != hipSuccess) { fprintf(stderr, "kernel_launch: hipFuncSetAttribute failed\n"); grid = -1; return; }
        if (hipOccupancyMaxActiveBlocksPerMultiprocessor(&per_cu, (const void*)fwd_kernel, NWAVES * 64, LDS_BYTES) != hipSuccess || per_cu < 1) { fprintf(stderr, "kernel_launch: occupancy query reports %d workgroups per CU\n", per_cu); per_cu = 1; }
        (void)hipGetLastError();
        grid = cus;
    }
    if (grid < 0) return;
    if (hipMemsetAsync((char*)d_ws + WS_CTL, 0, CTL_ZERO_BYTES, stream) != hipSuccess) { fprintf(stderr, "kernel_launch: hipMemsetAsync failed\n"); return; }
    Args a{};
    for (int i = 0; i < 10; ++i) a.in[i] = (const float*)d_in[i];
    a.out = (float*)d_out; a.ws = (unsigned char*)d_ws;
    hipLaunchKernelGGL(fwd_kernel, dim3(grid), dim3(NWAVES * 64), LDS_BYTES, stream, a);
    const hipError_t le = hipPeekAtLastError();
    if (le != hipSuccess) fprintf(stderr, "kernel_launch: launch failed: %s\n", hipGetErrorName(le));
}
```

```cpp
#include <hip/hip_runtime.h>
#include <cstdio>
#include <cstdint>

constexpr int BATCH = 2, T = 8192, D = 1024, M = BATCH * T, FF = 4096, NQKV = 3 * D;
constexpr float RMS_EPS = 1e-6f;
constexpr float LOG2E = 1.4426950408889634f;
constexpr float QSCALE = 0.125f * LOG2E;
constexpr float NEG_BIG = -1e30f;

constexpr size_t MiB = 1u << 20;
constexpr size_t WS_CTL = 0, CTL_ZERO_BYTES = 1 * MiB;
constexpr size_t WS_WIN = 1 * MiB;
constexpr size_t WS_WOUT = 13 * MiB;
constexpr size_t WS_WFF1 = 17 * MiB;
constexpr size_t WS_WFF2 = 33 * MiB;
constexpr size_t WS_SSQ = 49 * MiB;
constexpr size_t WS_KMEAN = 50 * MiB;
constexpr size_t WS_HB = 51 * MiB;
constexpr size_t WS_Q = 83 * MiB, WS_K = 115 * MiB, WS_V = 147 * MiB, WS_O = 179 * MiB;
constexpr size_t WS_ACT = 83 * MiB;
constexpr size_t WS_END = 211 * MiB;
constexpr int CW_TMO = 0, CW_CODE = 1, CW_BAR = 4096;
namespace pg8 {
#define PG8_LAS __attribute__((address_space(3)))
typedef unsigned short bf16_t;
typedef short bf16x8 __attribute__((ext_vector_type(8)));
typedef float f32x4 __attribute__((ext_vector_type(4)));
typedef unsigned u32x4 __attribute__((ext_vector_type(4)));
constexpr int BM = 256, BK = 64, HALF = 128, HTB = HALF * BK * 2  , STAGE_BYTES = 8 * HTB, NXCD = 8, WGM = 8;

__host__ __device__ __forceinline__ int lds_byte(int r, int c) { const int st = (r >> 4) * 2 + (c >> 5), rr = r & 15, cc = c & 31, ob = rr * 64 + cc * 2; return st * 1024 + (ob ^ (((ob >> 9) & 1) << 5)); }
__host__ __device__ __forceinline__ void stage_rc(int b, int& R, int& C) { const int st = b / 1024, sb = b % 1024, swz = sb ^ (((sb >> 9) & 1) << 5); R = (st >> 1) * 16 + swz / 64; C = (st & 1) * 32 + (swz % 64) / 2; }
__host__ __device__ __forceinline__ int perm32(int rho) { const int n = rho >> 4, i = rho & 15; return 8 * (i >> 2) + 4 * n + (i & 3); }

struct Unit { int pm, pn; };
struct Gemm { const bf16_t* A; const bf16_t* Bt; int M, N, K; };

struct StaticOrder {
    int nM, nN, nwg, G, c;
    __host__ __device__ void init(int M, int N, int G_, int c_) { nM = M / BM; nN = N / BM; nwg = nM * nN; G = G_; c = c_; }
    __host__ __device__ bool next(int i, Unit& u) const {
        const long L = (long)i * G + c; if (L >= nwg) return false;
        int wgid = (int)L; { const int q = nwg / NXCD, r = nwg % NXCD, xcd = wgid % NXCD, off = wgid / NXCD; wgid = (xcd < r ? xcd * (q + 1) : r * (q + 1) + (xcd - r) * q) + off; }
        const int nig = WGM * nN, gid = wgid / nig, fm = gid * WGM, gsz = (nM - fm) < WGM ? (nM - fm) : WGM;
        u.pm = fm + ((wgid % nig) % gsz); u.pn = (wgid % nig) / gsz; return true;
    }
    __device__ __forceinline__ void a_ready(const Unit&) const {}
    __device__ __forceinline__ void done(const Unit&) const {}
};


__device__ __forceinline__ unsigned cvt_pk_bf16(float lo, float hi) { unsigned r; asm volatile("v_cvt_pk_bf16_f32 %0, %1, %2" : "=v"(r) : "v"(lo), "v"(hi)); return r; }
__device__ __forceinline__ float row_rstd16(const float* SSQ, int row) {
    const f32x4* p = (const f32x4*)(SSQ + (size_t)row * 16);
    const f32x4 a = p[0], b = p[1], c = p[2], d = p[3];
    const float s = ((a[0] + a[1]) + (a[2] + a[3])) + ((b[0] + b[1]) + (b[2] + b[3])) + ((c[0] + c[1]) + (c[2] + c[3])) + ((d[0] + d[1]) + (d[2] + d[3]));
    return 1.0f / sqrtf(s * (1.0f / 1024.0f) + 1e-6f);
}
template <int ACT> struct EpiScaleBf16 {
    static constexpr bool PERM = true, AFTER_DRAIN = false;
    bf16_t* O; int ldc; const float* SSQ; int split_cols; size_t split_stride;
    __device__ __forceinline__ void operator()(const f32x4 (&acc)[2][2][4][2], const Unit& u, int wr, int wc, int fr, int fq) const {
        const int row0 = u.pm * BM + wr * 64 + fr; int colt = u.pn * BM; bf16_t* base = O;
        if (split_cols) { const int t = colt / split_cols; base += (size_t)t * split_stride; colt -= t * split_cols; }
        const int col0 = colt + wc * 32 + 8 * fq;
        const int lane = fq * 16 + fr; float myrs[2];
#pragma unroll
        for (int ai = 0; ai < 2; ++ai) myrs[ai] = row_rstd16(SSQ, u.pm * BM + wr * 64 + ai * HALF + lane);
        asm volatile("" : "+v"(myrs[0]), "+v"(myrs[1]));
#pragma unroll
        for (int ai = 0; ai < 2; ++ai)
#pragma unroll
            for (int m = 0; m < 4; ++m) { const int row = row0 + ai * HALF + m * 16; const float rs = __shfl(myrs[ai], m * 16 + fr); bf16_t* rowp = base + (size_t)row * ldc + col0;
#pragma unroll
                for (int bj = 0; bj < 2; ++bj) { f32x4 v0 = acc[ai][bj][m][0] * rs, v1 = acc[ai][bj][m][1] * rs;
                    if (ACT == 1) {
#pragma unroll
                        for (int e = 0; e < 4; ++e) { const float a = __builtin_fmaxf(v0[e], 0.f), b = __builtin_fmaxf(v1[e], 0.f); v0[e] = a * a; v1[e] = b * b; } }
                    u32x4 w; w.x = cvt_pk_bf16(v0[0], v0[1]); w.y = cvt_pk_bf16(v0[2], v0[3]); w.z = cvt_pk_bf16(v1[0], v1[1]); w.w = cvt_pk_bf16(v1[2], v1[3]);
                    *(u32x4*)(rowp + bj * HALF) = w; } }
    }
};
struct EpiRes {
    static constexpr bool PERM = false, AFTER_DRAIN = false;
    float* out; bf16_t* HB; float* SSQ; int ldc;
    __device__ __forceinline__ void operator()(const f32x4 (&acc)[2][2][4][2], const Unit& u, int wr, int wc, int fr, int fq) const {
        typedef unsigned u32x2v __attribute__((ext_vector_type(2)));
        const int col0 = u.pn * BM + wc * 32 + 4 * fq;
#pragma unroll
        for (int ai = 0; ai < 2; ++ai)
#pragma unroll
            for (int m = 0; m < 4; ++m) { const int row = u.pm * BM + ai * HALF + wr * 64 + m * 16 + fr; const size_t off = (size_t)row * ldc + col0; float s = 0.f;
#pragma unroll
                for (int bj = 0; bj < 2; ++bj)
#pragma unroll
                    for (int n = 0; n < 2; ++n) { const size_t o2 = off + bj * HALF + n * 16; const f32x4 h = *(const f32x4*)(out + o2) + acc[ai][bj][m][n]; *(f32x4*)(out + o2) = h;
                        u32x2v w; w.x = cvt_pk_bf16(h[0], h[1]); w.y = cvt_pk_bf16(h[2], h[3]); *(u32x2v*)(HB + o2) = w;
                        s += (h[0] * h[0] + h[1] * h[1]) + (h[2] * h[2] + h[3] * h[3]); }
                s += __shfl_xor(s, 16); s += __shfl_xor(s, 32);
                if (fq == 0) SSQ[(size_t)row * 16 + u.pn * 4 + wc] = s;
                if (m & 1) asm volatile("" ::: "memory"); }
    }
};
template <class Epi, class Sched, bool ALIGN_EPI = false, bool SP2 = false>
__device__ __forceinline__ void gemm_phase(PG8_LAS unsigned char* lds, const Gemm g, const Sched& S, const Epi& E) {
    int tid_ = threadIdx.x; asm volatile("" : "+v"(tid_));
    const int tid = tid_, wid = __builtin_amdgcn_readfirstlane(tid >> 6), lane = tid & 63, wr = wid >> 2, wc = wid & 3, fr = lane & 15, fq = lane >> 4;
    const int K = g.K, nt = K / BK;
    unsigned voffA[2], voffB[2];
#pragma unroll
    for (int i = 0; i < 2; ++i) { int R, C; stage_rc(tid * 16 + i * 8192, R, C); const int Rb = Epi::PERM ? ((R & ~31) + perm32(R & 31)) : R;
        voffA[i] = (unsigned)(R * K + C) * 2u; voffB[i] = (unsigned)(Rb * K + C) * 2u; }
    const size_t kstep = (size_t)(BK * 2);
    const size_t hstep = (size_t)HALF * K * 2;
    const size_t tstep = 2 * hstep;
    const unsigned ldsw = (unsigned)wid * 1024u;
    const int aoff = lds_byte(wr * 64 + fr, fq * 8), boff = lds_byte(wc * 32 + fr, fq * 8);
#define PG8_SA(b, h) (((b) * 2 + (h)) * HTB)
#define PG8_SB(b, h) ((4 + (b) * 2 + (h)) * HTB)
#define PG8_STAGE(bufoff, gbase, voff) do { _Pragma("unroll") for (int _i = 0; _i < 2; ++_i) \
        __builtin_amdgcn_global_load_lds((const unsigned*)((const char*)(gbase) + (voff)[_i]), (PG8_LAS unsigned*)(lds + (bufoff) + ldsw + _i * 8192), 16, 0, 0); } while (0)
#define PG8_LDA(dst, b, h) do { _Pragma("unroll") for (int m = 0; m < 4; ++m) _Pragma("unroll") for (int k = 0; k < 2; ++k) dst[m][k] = *(const PG8_LAS bf16x8*)(lds + PG8_SA(b, h) + aoff + m * 2048 + k * 1024); } while (0)
#define PG8_LDB(dst, b, h) do { _Pragma("unroll") for (int n = 0; n < 2; ++n) _Pragma("unroll") for (int k = 0; k < 2; ++k) dst[n][k] = *(const PG8_LAS bf16x8*)(lds + PG8_SB(b, h) + boff + n * 2048 + k * 1024); } while (0)
#define PG8_MMA(ai, bj, At, Bt) do { __builtin_amdgcn_s_setprio(1); _Pragma("unroll") for (int m = 0; m < 4; ++m) _Pragma("unroll") for (int n = 0; n < 2; ++n) _Pragma("unroll") for (int k = 0; k < 2; ++k) \
        acc[ai][bj][m][n] = __builtin_amdgcn_mfma_f32_16x16x32_bf16(Bt[n][k], At[m][k], acc[ai][bj][m][n], 0, 0, 0); __builtin_amdgcn_s_setprio(0); } while (0)
#define PG8_WAIT_V(n) asm volatile("s_waitcnt vmcnt(" #n ")" ::: "memory")
#define PG8_WAIT_L(n) asm volatile("s_waitcnt lgkmcnt(" #n ")" ::: "memory")
#define PG8_BAR __builtin_amdgcn_s_barrier()
#define PG8_SCHED __builtin_amdgcn_sched_barrier(0)
    Unit cur, nxt; int ui = 0;
    if (!S.next(0, cur)) return;
    f32x4 acc[2][2][4][2];
#pragma unroll
    for (int a = 0; a < 2; ++a)
#pragma unroll
        for (int b = 0; b < 2; ++b)
#pragma unroll
            for (int m = 0; m < 4; ++m)
#pragma unroll
                for (int n = 0; n < 2; ++n) acc[a][b][m][n] = (f32x4){0.f, 0.f, 0.f, 0.f};
    bf16x8 At[4][2], B0[2][2], B1[2][2];
    const char* cA = (const char*)g.A + (size_t)cur.pm * tstep; const char* cB = (const char*)g.Bt + (size_t)cur.pn * tstep;
    S.a_ready(cur);
    if constexpr (SP2) {
        PG8_STAGE(PG8_SB(0, 0), cB, voffB); PG8_STAGE(PG8_SB(0, 1), cB + hstep, voffB); PG8_STAGE(PG8_SA(0, 0), cA, voffA); PG8_STAGE(PG8_SA(0, 1), cA + hstep, voffA);
        if (wr == 1) PG8_BAR;
        PG8_WAIT_V(2); PG8_BAR;
        PG8_STAGE(PG8_SB(1, 0), cB + kstep, voffB); PG8_STAGE(PG8_SA(1, 0), cA + kstep, voffA); PG8_STAGE(PG8_SB(1, 1), cB + hstep + kstep, voffB);
        PG8_WAIT_V(6); PG8_BAR;
    } else {
        PG8_STAGE(PG8_SB(0, 0), cB, voffB); PG8_STAGE(PG8_SA(0, 0), cA, voffA); PG8_STAGE(PG8_SB(0, 1), cB + hstep, voffB); PG8_STAGE(PG8_SA(0, 1), cA + hstep, voffA);
        if (wr == 1) PG8_BAR;
        PG8_WAIT_V(4); PG8_BAR;
        PG8_STAGE(PG8_SB(1, 0), cB + kstep, voffB); PG8_STAGE(PG8_SA(1, 0), cA + kstep, voffA); PG8_STAGE(PG8_SB(1, 1), cB + hstep + kstep, voffB);
        PG8_WAIT_V(6); PG8_BAR;
    }
    for (;;) {
        const bool has_next = S.next(ui + 1, nxt);
        const char* nA = has_next ? (const char*)g.A + (size_t)nxt.pm * tstep : cA; const char* nB = has_next ? (const char*)g.Bt + (size_t)nxt.pn * tstep : cB;
        for (int t = 0; t < nt; t += 2) {
            const bool last = (t == nt - 2);
            const char* a1 = cA + (size_t)(t + 1) * kstep;
            const char* a2 = last ? nA : cA + (size_t)(t + 2) * kstep; const char* b2 = last ? nB : cB + (size_t)(t + 2) * kstep;
            const char* a3 = a2 + kstep; const char* b3 = b2 + kstep;
            if (last && has_next) S.a_ready(nxt);
            if constexpr (SP2) {
            PG8_LDB(B0, 0, 0); PG8_LDB(B1, 0, 1); PG8_SCHED; PG8_LDA(At, 0, 0); PG8_STAGE(PG8_SA(1, 1), a1 + hstep, voffA);
            PG8_WAIT_V(8); PG8_WAIT_L(0); PG8_BAR; PG8_MMA(0, 0, At, B0); PG8_MMA(0, 1, At, B1); PG8_BAR; PG8_SCHED;
            PG8_LDA(At, 0, 1); PG8_STAGE(PG8_SB(0, 0), b2, voffB); PG8_STAGE(PG8_SB(0, 1), b2 + hstep, voffB); PG8_STAGE(PG8_SA(0, 0), a2, voffA);
            PG8_WAIT_V(8); PG8_WAIT_L(0); PG8_BAR; PG8_MMA(1, 0, At, B0); PG8_MMA(1, 1, At, B1); PG8_BAR; PG8_SCHED;
            PG8_LDB(B0, 1, 0); PG8_LDB(B1, 1, 1); PG8_SCHED; PG8_LDA(At, 1, 0); PG8_STAGE(PG8_SA(0, 1), a2 + hstep, voffA);
            PG8_WAIT_V(8); PG8_WAIT_L(0); PG8_BAR; PG8_MMA(0, 0, At, B0); PG8_MMA(0, 1, At, B1); PG8_BAR; PG8_SCHED;
            PG8_LDA(At, 1, 1); PG8_STAGE(PG8_SB(1, 0), b3, voffB); PG8_STAGE(PG8_SB(1, 1), b3 + hstep, voffB); PG8_STAGE(PG8_SA(1, 0), a3, voffA);
            PG8_WAIT_V(8); PG8_WAIT_L(0); PG8_BAR; PG8_MMA(1, 0, At, B0); PG8_MMA(1, 1, At, B1); PG8_BAR; PG8_SCHED;
            } else {
            PG8_LDB(B0, 0, 0); PG8_SCHED; PG8_LDA(At, 0, 0); PG8_STAGE(PG8_SA(1, 1), a1 + hstep, voffA);
            PG8_WAIT_L(8); PG8_BAR; PG8_WAIT_L(0); PG8_MMA(0, 0, At, B0); PG8_BAR; PG8_SCHED;
            PG8_LDB(B1, 0, 1); PG8_STAGE(PG8_SB(0, 0), b2, voffB);
            PG8_BAR; PG8_WAIT_L(0); PG8_MMA(0, 1, At, B1); PG8_BAR;
            PG8_LDA(At, 0, 1); PG8_STAGE(PG8_SA(0, 0), a2, voffA);
            PG8_BAR; PG8_WAIT_L(0); PG8_MMA(1, 0, At, B0); PG8_BAR; PG8_SCHED;
            PG8_STAGE(PG8_SB(0, 1), b2 + hstep, voffB);
            PG8_WAIT_V(6); PG8_BAR; PG8_MMA(1, 1, At, B1); PG8_BAR;
            PG8_LDB(B0, 1, 0); PG8_SCHED; PG8_LDA(At, 1, 0); PG8_STAGE(PG8_SA(0, 1), a2 + hstep, voffA);
            PG8_WAIT_L(8); PG8_BAR; PG8_WAIT_L(0); PG8_MMA(0, 0, At, B0); PG8_BAR; PG8_SCHED;
            PG8_LDB(B1, 1, 1); PG8_STAGE(PG8_SB(1, 0), b3, voffB);
            PG8_BAR; PG8_WAIT_L(0); PG8_MMA(0, 1, At, B1); PG8_BAR;
            PG8_LDA(At, 1, 1); PG8_STAGE(PG8_SA(1, 0), a3, voffA);
            PG8_BAR; PG8_WAIT_L(0); PG8_MMA(1, 0, At, B0); PG8_BAR; PG8_SCHED;
            PG8_STAGE(PG8_SB(1, 1), b3 + hstep, voffB);
            PG8_WAIT_V(6); PG8_BAR; PG8_MMA(1, 1, At, B1); PG8_BAR;
            }
        }
        if constexpr (ALIGN_EPI) { if (wr == 0) PG8_BAR; }
        if constexpr (!Epi::AFTER_DRAIN) { E(acc, cur, wr, wc, fr, fq); S.done(cur); }
        if (!has_next) break;
#pragma unroll
        for (int a = 0; a < 2; ++a)
#pragma unroll
            for (int b = 0; b < 2; ++b)
#pragma unroll
                for (int m = 0; m < 4; ++m)
#pragma unroll
                    for (int n = 0; n < 2; ++n) acc[a][b][m][n] = (f32x4){0.f, 0.f, 0.f, 0.f};
        cur = nxt; cA = nA; cB = nB; ++ui;
        if constexpr (ALIGN_EPI) { if (wr == 1) PG8_BAR; }
    }
    PG8_WAIT_V(0);
    if constexpr (!ALIGN_EPI) { if (wr == 0) PG8_BAR; }
    PG8_BAR;
    if constexpr (Epi::AFTER_DRAIN) { E.fused(acc, cur, wr, wc, fr, fq, lds, wid, lane); S.done(cur); }
#undef PG8_SA
#undef PG8_SB
#undef PG8_STAGE
#undef PG8_LDA
#undef PG8_LDB
#undef PG8_MMA
#undef PG8_WAIT_V
#undef PG8_WAIT_L
#undef PG8_BAR
#undef PG8_SCHED
}
}

#ifndef PG8_SP2
#define PG8_SP2 true
#endif
#ifndef PG8_ALIGN
#define PG8_ALIGN true
#endif
#define GAS __attribute__((address_space(1)))
#define LAS __attribute__((address_space(3)))
typedef unsigned short bf16;
typedef unsigned v4u __attribute__((ext_vector_type(4)));
typedef float f32x4 __attribute__((ext_vector_type(4)));
typedef short bf16x8 __attribute__((ext_vector_type(8)));
typedef GAS unsigned gu32;
typedef GAS unsigned long long gu64;
#define RLX_AGENT __ATOMIC_RELAXED, __HIP_MEMORY_SCOPE_AGENT
#define LDS_WAIT() asm volatile("s_waitcnt lgkmcnt(0)" ::: "memory")
#define VM_WAIT() asm volatile("s_waitcnt vmcnt(0)" ::: "memory")
__device__ __forceinline__ unsigned long long rt() { return __builtin_amdgcn_s_memrealtime(); }
__device__ __forceinline__ unsigned f2bf(float f) { unsigned u = __builtin_bit_cast(unsigned, f); return (u + 0x7fffu + ((u >> 16) & 1u)) >> 16; }
__device__ __forceinline__ unsigned pk2(float lo, float hi) { return f2bf(lo) | (f2bf(hi) << 16); }

#define XB_TMO      128
#define XB_XCNT(j)  (256  + 64 * (j))
#define XB_XSUB(j)  (1280 + 64 * (j))
#define XB_XGEN(j)  (2304 + 64 * (j))
#define XB_TOP      3328
#define XB_TOPGEN   3392
#define XCD_BAR_WORDS 3456
#define XB_SPIN_CAP (1u << 18)

__device__ __forceinline__ unsigned xb_ld(unsigned* p)              { return __hip_atomic_load(p, __ATOMIC_RELAXED, __HIP_MEMORY_SCOPE_AGENT); }
__device__ __forceinline__ unsigned xb_add(unsigned* p, unsigned v) { return __hip_atomic_fetch_add(p, v, __ATOMIC_RELAXED, __HIP_MEMORY_SCOPE_AGENT); }
__device__ __forceinline__ unsigned xb_xcc_id() { return (unsigned)__builtin_amdgcn_s_getreg((3 << 11) | 20) & 0xFu; }
#define XB_SPIN(cond, bar) do { unsigned _sp = 0; while (cond) { __builtin_amdgcn_s_sleep(1); \
    if ((++_sp & 255u) == 0u) { if (xb_ld(&(bar)[XB_TMO])) break; if (_sp > XB_SPIN_CAP) { atomicAdd(&(bar)[XB_TMO], 1u); break; } } } } while (0)

struct XcdBarrier {
    unsigned* bar; unsigned x;
    volatile LAS unsigned* st;
};

__device__ __forceinline__ XcdBarrier xcd_barrier_post(unsigned* bar, volatile LAS unsigned* st) {
    XcdBarrier b; b.bar = bar; b.x = xb_xcc_id(); b.st = st;
    if (threadIdx.x == 0) (void)xb_add(&bar[XB_XCNT(b.x)], 1u);
    return b;
}
__device__ __forceinline__ void xcd_barrier_complete(unsigned* bar, unsigned x, unsigned& nloc, unsigned& nx) {
    const unsigned G = gridDim.x * gridDim.y * gridDim.z;
    unsigned sum, cnt, mine, sp = 0u;
    for (;;) {
        sum = 0u; cnt = 0u; mine = 0u;
#pragma unroll
        for (unsigned j = 0; j < 16; ++j) { const unsigned c = xb_ld(&bar[XB_XCNT(j)]); sum += c; cnt += (c > 0u) ? 1u : 0u; mine = (j == x) ? c : mine; }
        if (sum == G) break;
        __builtin_amdgcn_s_sleep(1);
        if ((++sp & 255u) == 0u) { if (xb_ld(&bar[XB_TMO])) break; if (sp > XB_SPIN_CAP) { atomicAdd(&bar[XB_TMO], 1u); break; } }
    }
    nloc = mine > 0u ? mine : 1u; nx = cnt > 0u ? cnt : 1u;
}

__device__ __forceinline__ void xcd_barrier(const XcdBarrier& b) {
    asm volatile("s_waitcnt vmcnt(0)" ::: "memory");
    __syncthreads();
    if (threadIdx.x == 0) {
        unsigned* bar = b.bar;
        __builtin_amdgcn_s_waitcnt(0);
        unsigned nloc = b.st[0], nx = b.st[1];
        if (nloc == 0u) { xcd_barrier_complete(bar, b.x, nloc, nx); b.st[0] = nloc; b.st[1] = nx; }
        const unsigned old = xb_add(&bar[XB_XSUB(b.x)], 1u);
        const unsigned gen = old / nloc;
        if (old + 1u == (gen + 1u) * nloc) {
            __builtin_amdgcn_fence(__ATOMIC_RELEASE, "agent");
            asm volatile("s_waitcnt vmcnt(0)" ::: "memory");
            const unsigned og = xb_add(&bar[XB_TOP], 1u);
            const unsigned tg = og / nx;
            if (og + 1u == (tg + 1u) * nx) xb_add(&bar[XB_TOPGEN], 1u);
            else XB_SPIN(xb_ld(&bar[XB_TOPGEN]) == tg, bar);
            __builtin_amdgcn_fence(__ATOMIC_ACQUIRE, "agent");
            xb_add(&bar[XB_XGEN(b.x)], 1u);
            asm volatile("s_waitcnt vmcnt(0)" ::: "memory");
        } else {
            XB_SPIN(xb_ld(&bar[XB_XGEN(b.x)]) == gen, bar);
            __builtin_amdgcn_fence(__ATOMIC_ACQUIRE, "agent");
            asm volatile("s_waitcnt vmcnt(0)" ::: "memory");
        }
    }
    __syncthreads();
}

namespace attn {
typedef unsigned short bf16;
using bf16x8 = __attribute__((ext_vector_type(8))) short;
using s16x4 = __attribute__((ext_vector_type(4))) short;
using f32x16 = __attribute__((ext_vector_type(16))) float;
using u32x4 = __attribute__((ext_vector_type(4))) unsigned;
typedef __attribute__((address_space(3))) const char* lds_cptr;
typedef __attribute__((address_space(3))) char* lds_ptr;
typedef short v4i16_t __attribute__((ext_vector_type(4)));
constexpr int DM = 1024, SEQ = 8192, KVBLK = 64;
constexpr int KSLOT = 8192, NSLOT = 3;
constexpr float THR = 8.0f;
template <int DV> struct Lay {
    static constexpr int VSLOT = DV * 128, LDS_K = 0, LDS_V = NSLOT * KSLOT, LDS_WS = LDS_V + NSLOT * VSLOT, LDS_OST = LDS_WS + 8 * 256, OSTW = 32 * DV * 2, BYTES = LDS_OST + 8 * OSTW;
};
#define AT_SBAR() __builtin_amdgcn_sched_barrier(0)
#define AT_WAIT_BAR(N) asm volatile("s_waitcnt vmcnt(" #N ") lgkmcnt(0)\n\ts_barrier" ::: "memory")
__device__ __forceinline__ int crow(int r, int hi) { return (r & 3) + 8 * (r >> 2) + 4 * hi; }
__device__ __forceinline__ unsigned f2bf_u(float f) { unsigned u = __builtin_bit_cast(unsigned, f); return (u + 0x7fffu + ((u >> 16) & 1u)) >> 16; }
__device__ __forceinline__ float bf2f_u(unsigned h) { return __builtin_bit_cast(float, h << 16); }
__device__ __forceinline__ void glds16(const void* gsrc, unsigned lds_dst) { unsigned keep;
    asm volatile("s_mov_b32 %0, m0\n\ts_mov_b32 m0, %2\n\ts_nop 0\n\tglobal_load_lds_dwordx4 %1, off\n\ts_mov_b32 m0, %0" : "=&s"(keep) : "v"(gsrc), "s"(lds_dst) : "memory"); }
typedef float f32x2_t __attribute__((ext_vector_type(2))); typedef __bf16 bf16x2_t __attribute__((ext_vector_type(2)));
__device__ __forceinline__ unsigned cvtpk_s(float lo, float hi) { f32x2_t v = {lo, hi}; bf16x2_t b = __builtin_convertvector(v, bf16x2_t); return __builtin_bit_cast(unsigned, b); }
__device__ __forceinline__ s16x4 vtr(lds_cptr p) { return __builtin_bit_cast(s16x4, __builtin_amdgcn_ds_read_tr16_b64_v4i16((__attribute__((address_space(3))) v4i16_t*)p)); }
#define AT_MX3(a, b, c) __builtin_fmaxf(__builtin_fmaxf((a), (b)), (c))
#define AT_MFMA(a, b, c) __builtin_amdgcn_mfma_f32_32x32x16_bf16(a, b, c, 0, 0, 0)
__device__ __forceinline__ float rowmax(const f32x16& p0, const f32x16& p1) {
    float a = AT_MX3(p0[0], p0[1], p1[0]), b = AT_MX3(p0[2], p0[3], p1[1]); a = AT_MX3(a, p1[2], p1[3]);
#pragma unroll
    for (int r = 4; r < 16; r += 4) { a = AT_MX3(a, p0[r], p0[r + 1]); b = AT_MX3(b, p0[r + 2], p0[r + 3]); a = AT_MX3(a, p1[r], p1[r + 1]); b = AT_MX3(b, p1[r + 2], p1[r + 3]); }
    float m = __builtin_fmaxf(a, b); auto rr = __builtin_amdgcn_permlane32_swap(__float_as_uint(m), __float_as_uint(m), false, false);
    return __builtin_fmaxf(__uint_as_float(rr[0]), __uint_as_float(rr[1])); }
__device__ __forceinline__ void cmask(f32x16& p0, f32x16& p1, int jb, int qrel, int hi) {
    const int kb = 64 * jb + 4 * hi;
#pragma unroll
    for (int r = 0; r < 16; ++r) { const int kv = kb + (r & 3) + 8 * (r >> 2); if (kv > qrel) p0[r] = -INFINITY; if (kv + 32 > qrel) p1[r] = -INFINITY; } }

template <int DV, bool MOBA>
__device__ __forceinline__ void sweep(char* shm, const bf16* Qw, const bf16* __restrict__ Kh, const bf16* __restrict__ Vh, int qb, float slope2, unsigned sel, f32x16 (&o)[DV / 32], float& l_out) {
    typedef Lay<DV> L;
    constexpr int NPV = DV / 64, NPT = 1 + NPV;
    int tid_ = threadIdx.x; asm volatile("" : "+v"(tid_));
    const int tid = tid_, lane = tid & 63, r32 = lane & 31, hi = lane >> 5; const int wid = __builtin_amdgcn_readfirstlane(tid >> 6);
    const unsigned lds0 = (unsigned)(uintptr_t)shm;
    const lds_ptr shm3 = (lds_ptr)shm;
    __attribute__((address_space(3))) float* wsf = (__attribute__((address_space(3))) float*)(shm3 + L::LDS_WS) + wid * 64;
    const int NT = 4 * qb + 4;
    const bf16* ksrc = Kh + (long)lane * DM + wid * 8;
    const bf16* vsrc0 = Vh + (long)(16 * (wid & 3) + (lane >> 2)) * DM + (wid >> 2) * 32 + (lane & 3) * 8;
    const unsigned kdst = lds0 + L::LDS_K + wid * 1024, vdst = lds0 + L::LDS_V + wid * 1024;
#define AT_KT(i) (MOBA ? ((i) < 4 ? 4 * qb + (i) : (i) - 4) : (i))
#define AT_DMA(i, slot) do { const long kt_ = AT_KT(i); glds16(ksrc + kt_ * KVBLK * DM, (unsigned)__builtin_amdgcn_readfirstlane(kdst + (slot) * KSLOT)); \
        glds16(vsrc0 + kt_ * KVBLK * DM, (unsigned)__builtin_amdgcn_readfirstlane(vdst + (slot) * L::VSLOT)); \
        if (NPV == 2) glds16(vsrc0 + kt_ * KVBLK * DM + 64, (unsigned)__builtin_amdgcn_readfirstlane(vdst + (slot) * L::VSLOT + 8192)); } while (0)
    bf16x8 qr[4];
#pragma unroll
    for (int d0 = 0; d0 < 4; ++d0) qr[d0] = *reinterpret_cast<const bf16x8*>(&Qw[(long)r32 * DM + d0 * 16 + hi * 8]);
    AT_DMA(0, 0); AT_DMA(1, 1);
    const lds_cptr kp0 = (lds_cptr)shm3 + L::LDS_K + hi * 1024 + r32 * 16;
    const lds_cptr vp0 = (lds_cptr)shm3 + L::LDS_V + ((lane >> 4) & 1) * 32 + (lane & 3) * 8 + (4 * hi + ((lane & 15) >> 2)) * 64;
    const unsigned shi = f2bf_u(slope2), slo = f2bf_u(slope2 - bf2f_u(shi));
    const unsigned one2 = 0x3f803f80u;
    u32x4 qa = {0u, 0u, 0u, 0u}, ka0 = {0u, 0u, 0u, 0u}, ka1 = {0u, 0u, 0u, 0u};
    if (hi == 0) { qa.x = shi | (slo << 16); qa.y = qa.x; const unsigned o0 = f2bf_u((float)r32), o1 = f2bf_u((float)(32 + r32)); ka0.x = o0 | (o0 << 16); ka1.x = o1 | (o1 << 16); ka0.z = one2; ka1.z = one2; }
    float mhat = 0.f, l_reg = 0.f;
#pragma unroll
    for (int d = 0; d < DV / 32; ++d) o[d] = f32x16{};
    const int qrel = wid * 32 + r32;
    int slot = 0;
    if (NPT == 3) { AT_WAIT_BAR(3); } else { AT_WAIT_BAR(2); }
    for (int i = 0; i < NT; ++i) {
        if (i + 2 < NT) { const int s2 = slot == 0 ? 2 : slot - 1; AT_DMA(i + 2, s2); }
        const int kt = AT_KT(i);
        const int jb = MOBA ? (i < 4 ? i : -1) : (i - (NT - 4));
        f32x16 c0, c1;
        {
            const unsigned tb = f2bf_u((float)(64 * (kt - 4 * qb)));
            u32x4 a0 = ka0, a1 = ka1, qv = qa;
            if (hi == 0) { a0.y = tb | (tb << 16); a1.y = a0.y; }
            if (MOBA) { if (hi == 0 && i >= 4 && !((sel >> ((i - 4) >> 2)) & 1u)) qv.z = 0x0000f14au; }
            const lds_cptr kp = kp0 + slot * KSLOT;
            bf16x8 kf[8];
#pragma unroll
            for (int j = 0; j < 4; ++j) { kf[2 * j] = *(const __attribute__((address_space(3))) bf16x8*)(kp + j * 2048); kf[2 * j + 1] = *(const __attribute__((address_space(3))) bf16x8*)(kp + j * 2048 + 512); }
            c0 = AT_MFMA(__builtin_bit_cast(bf16x8, a0), __builtin_bit_cast(bf16x8, qv), f32x16{}); c1 = AT_MFMA(__builtin_bit_cast(bf16x8, a1), __builtin_bit_cast(bf16x8, qv), f32x16{});
#pragma unroll
            for (int j = 0; j < 4; ++j) { c0 = AT_MFMA(kf[2 * j], qr[j], c0); c1 = AT_MFMA(kf[2 * j + 1], qr[j], c1); }
        }
        if (jb >= 0) cmask(c0, c1, jb, qrel, hi);
        {
            const float rm = rowmax(c0, c1);
            const bool first = (i == 0);
            if (first || __any(rm > THR)) {
                const float dl = first ? rm : __builtin_fmaxf(rm, 0.f);
                const float mnew = mhat + dl;
                const unsigned nh = f2bf_u(-mnew), nl = f2bf_u(-mnew - bf2f_u(nh));
                const float meff = -(bf2f_u(nh) + bf2f_u(nl));
                const float dle = meff - mhat; mhat = meff;
                if (hi == 0) qa.z = nh | (nl << 16);
#pragma unroll
                for (int r = 0; r < 16; ++r) { c0[r] -= dle; c1[r] -= dle; }
                if (!first) {
                    const float f = __builtin_amdgcn_exp2f(-dle); l_reg *= f;
                    if (hi == 0) wsf[r32] = f;
                    asm volatile("s_waitcnt lgkmcnt(0)" ::: "memory");
#pragma unroll
                    for (int d = 0; d < DV / 32; ++d)
#pragma unroll
                        for (int r = 0; r < 16; ++r) o[d][r] *= wsf[crow(r, hi)];
                }
            }
        }
        float sacc = 0.f;
#pragma unroll
        for (int r = 0; r < 16; ++r) { c0[r] = __builtin_amdgcn_exp2f(c0[r]); c1[r] = __builtin_amdgcn_exp2f(c1[r]); sacc += c0[r] + c1[r]; }
        l_reg += sacc;
        u32x4 pw[4];
        pw[0] = (u32x4){cvtpk_s(c0[0], c0[1]), cvtpk_s(c0[2], c0[3]), cvtpk_s(c0[4], c0[5]), cvtpk_s(c0[6], c0[7])};
        pw[1] = (u32x4){cvtpk_s(c0[8], c0[9]), cvtpk_s(c0[10], c0[11]), cvtpk_s(c0[12], c0[13]), cvtpk_s(c0[14], c0[15])};
        pw[2] = (u32x4){cvtpk_s(c1[0], c1[1]), cvtpk_s(c1[2], c1[3]), cvtpk_s(c1[4], c1[5]), cvtpk_s(c1[6], c1[7])};
        pw[3] = (u32x4){cvtpk_s(c1[8], c1[9]), cvtpk_s(c1[10], c1[11]), cvtpk_s(c1[12], c1[13]), cvtpk_s(c1[14], c1[15])};
        {
            const lds_cptr vp = vp0 + slot * L::VSLOT;
#pragma unroll
            for (int d = 0; d < DV / 32; ++d)
#pragma unroll
                for (int ks = 0; ks < 4; ++ks) {
                    const s16x4 lo = vtr(vp + d * 4096 + ks * 1024), hh = vtr(vp + d * 4096 + ks * 1024 + 512);
                    const bf16x8 vf = (bf16x8){lo[0], lo[1], lo[2], lo[3], hh[0], hh[1], hh[2], hh[3]};
                    o[d] = AT_MFMA(__builtin_bit_cast(bf16x8, pw[ks]), vf, o[d]);
                }
        }
        if (i + 2 < NT) { if (NPT == 3) { AT_WAIT_BAR(3); } else { AT_WAIT_BAR(2); } } else { AT_WAIT_BAR(0); }
        slot = slot == 2 ? 0 : slot + 1;
    }
    { auto rr = __builtin_amdgcn_permlane32_swap(__float_as_uint(l_reg), __float_as_uint(l_reg), false, false); l_out = __uint_as_float(rr[0]) + __uint_as_float(rr[1]); }
#undef AT_KT
#undef AT_DMA
}

__device__ __forceinline__ void diff_unit(char* shm, int b, int h, int qb, const bf16* Q, const bf16* K, const bf16* V, bf16* O, float lam) {
    typedef Lay<128> L;
    int tid_ = threadIdx.x; asm volatile("" : "+v"(tid_));
    const int tid = tid_, lane = tid & 63, r32 = lane & 31, hi = lane >> 5; const int wid = __builtin_amdgcn_readfirstlane(tid >> 6);
    const long rowbase = (long)b * SEQ; const int q0 = qb * 256;
    const float slope2 = __builtin_amdgcn_exp2f(-(float)(h + 1)) * 1.4426950408889634f;
    const lds_ptr shm3 = (lds_ptr)shm;
    __attribute__((address_space(3))) float* wsf = (__attribute__((address_space(3))) float*)(shm3 + L::LDS_WS) + wid * 64;
    __attribute__((address_space(3))) bf16* stg = (__attribute__((address_space(3))) bf16*)(shm3 + L::LDS_OST + wid * L::OSTW);
#pragma unroll 1
    for (int m = 0; m < 2; ++m) {
        f32x16 o[4]; float l;
        sweep<128, false>(shm, Q + (rowbase + q0 + wid * 32) * DM + h * 128 + m * 64, K + rowbase * DM + h * 128 + m * 64, V + rowbase * DM + h * 128, qb, slope2, 0u, o, l);
        if (hi == 0) wsf[32 + r32] = l;
        asm volatile("s_waitcnt lgkmcnt(0)" ::: "memory");
        float rli[16];
#pragma unroll
        for (int r = 0; r < 16; ++r) rli[r] = (m == 0 ? 1.0f : lam) * __builtin_amdgcn_rcpf(wsf[32 + crow(r, hi)]);
        if (m == 0) {
#pragma unroll
            for (int r = 0; r < 16; ++r)
#pragma unroll
                for (int d = 0; d < 4; ++d) stg[crow(r, hi) * 128 + d * 32 + r32] = (bf16)f2bf_u(o[d][r] * rli[r]);
        } else {
            float ss[16];
#pragma unroll
            for (int r = 0; r < 16; ++r) { float s = 0.f;
#pragma unroll
                for (int d = 0; d < 4; ++d) { const float v = bf2f_u(stg[crow(r, hi) * 128 + d * 32 + r32]) - o[d][r] * rli[r]; o[d][r] = v; s = __builtin_fmaf(v, v, s); }
                ss[r] = s; }
#pragma unroll
            for (int r = 0; r < 16; ++r) {
#pragma unroll
                for (int off = 1; off < 32; off <<= 1) ss[r] += __shfl_xor(ss[r], off);
                ss[r] = 1.0f / sqrtf(ss[r] * (1.0f / 128.0f) + 1e-6f); }
#pragma unroll
            for (int r = 0; r < 16; ++r)
#pragma unroll
                for (int d = 0; d < 4; ++d) stg[crow(r, hi) * 128 + d * 32 + r32] = (bf16)f2bf_u(o[d][r] * ss[r]);
            asm volatile("s_waitcnt lgkmcnt(0)" ::: "memory");
            bf16* Ow = O + (rowbase + q0 + wid * 32) * DM + h * 128;
#pragma unroll
            for (int i = 0; i < 8; ++i) { const int row = i * 4 + (lane >> 4), ch = lane & 15; const u32x4 v = *(const __attribute__((address_space(3))) u32x4*)(stg + row * 128 + ch * 8); *(u32x4*)(Ow + (long)row * DM + ch * 8) = v; }
        }
    }
}
__device__ __forceinline__ void moba_unit(char* shm, int b, int h, int qb, const bf16* Q, const bf16* K, const bf16* V, bf16* O, const float* KM) {
    typedef Lay<64> L;
    int tid_ = threadIdx.x; asm volatile("" : "+v"(tid_));
    const int tid = tid_, lane = tid & 63, r32 = lane & 31, hi = lane >> 5; const int wid = __builtin_amdgcn_readfirstlane(tid >> 6);
    const long rowbase = (long)b * SEQ; const int q0 = qb * 256;
    const float slope2 = __builtin_amdgcn_exp2f(-0.5f * (float)(h + 1)) * 1.4426950408889634f;
    const lds_ptr shm3 = (lds_ptr)shm;
    __attribute__((address_space(3))) float* wsf = (__attribute__((address_space(3))) float*)(shm3 + L::LDS_WS) + wid * 64;
    __attribute__((address_space(3))) bf16* stg = (__attribute__((address_space(3))) bf16*)(shm3 + L::LDS_OST + wid * L::OSTW);
    const bf16* Qw = Q + (rowbase + q0 + wid * 32) * DM + h * 64;
    unsigned sel = 0u;
    if (qb > 0) {
        f32x16 g = f32x16{};
        const float* km = KM + (((long)b * 16 + h) * 32 + r32) * 64 + hi * 8;
#pragma unroll
        for (int d0 = 0; d0 < 4; ++d0) {
            const bf16x8 qf = *reinterpret_cast<const bf16x8*>(&Qw[(long)r32 * DM + d0 * 16 + hi * 8]);
            const float4 x0 = *(const float4*)(km + d0 * 16), x1 = *(const float4*)(km + d0 * 16 + 4);
            const float xs[8] = {x0.x, x0.y, x0.z, x0.w, x1.x, x1.y, x1.z, x1.w};
            unsigned hw[8], lw[8];
#pragma unroll
            for (int e = 0; e < 8; ++e) { hw[e] = f2bf_u(xs[e]); lw[e] = f2bf_u(xs[e] - bf2f_u(hw[e])); }
            const u32x4 ah = {hw[0] | (hw[1] << 16), hw[2] | (hw[3] << 16), hw[4] | (hw[5] << 16), hw[6] | (hw[7] << 16)};
            const u32x4 al = {lw[0] | (lw[1] << 16), lw[2] | (lw[3] << 16), lw[4] | (lw[5] << 16), lw[6] | (lw[7] << 16)};
            g = AT_MFMA(__builtin_bit_cast(bf16x8, ah), qf, g); g = AT_MFMA(__builtin_bit_cast(bf16x8, al), qf, g);
        }
        float g0[16], g1[16];
#pragma unroll
        for (int r = 0; r < 16; ++r) { auto rr = __builtin_amdgcn_permlane32_swap(__float_as_uint(g[r]), __float_as_uint(g[r]), false, false); g0[r] = __uint_as_float(rr[0]); g1[r] = __uint_as_float(rr[1]); }
        float b0 = -INFINITY, b1 = -INFINITY, b2 = -INFINITY; int i0 = 0, i1 = 0, i2 = 0;
#pragma unroll
        for (int n = 0; n < 32; ++n) {
            const int rn = 4 * (n >> 3) + (n & 3);
            float v = ((n >> 2) & 1) ? g1[rn] : g0[rn];
            if (n >= qb) v = -INFINITY;
            if (v > b0) { b2 = b1; i2 = i1; b1 = b0; i1 = i0; b0 = v; i0 = n; }
            else if (v > b1) { b2 = b1; i2 = i1; b1 = v; i1 = n; }
            else if (v > b2) { b2 = v; i2 = n; }
        }
        if (b0 > -INFINITY) sel |= 1u << i0;
        if (b1 > -INFINITY) sel |= 1u << i1;
        if (b2 > -INFINITY) sel |= 1u << i2;
    }
    f32x16 o[2]; float l;
    sweep<64, true>(shm, Qw, K + rowbase * DM + h * 64, V + rowbase * DM + h * 64, qb, slope2, sel, o, l);
    if (hi == 0) wsf[32 + r32] = l;
    asm volatile("s_waitcnt lgkmcnt(0)" ::: "memory");
#pragma unroll
    for (int r = 0; r < 16; ++r) { const float rl = __builtin_amdgcn_rcpf(wsf[32 + crow(r, hi)]);
#pragma unroll
        for (int d = 0; d < 2; ++d) stg[crow(r, hi) * 64 + d * 32 + r32] = (bf16)f2bf_u(o[d][r] * rl); }
    asm volatile("s_waitcnt lgkmcnt(0)" ::: "memory");
    bf16* Ow = O + (rowbase + q0 + wid * 32) * DM + h * 64;
#pragma unroll
    for (int i = 0; i < 4; ++i) { const int row = i * 8 + (lane >> 3), ch = lane & 7; const u32x4 v = *(const __attribute__((address_space(3))) u32x4*)(stg + row * 64 + ch * 8); *(u32x4*)(Ow + (long)row * DM + ch * 8) = v; }
}
#undef AT_SBAR
#undef AT_WAIT_BAR
#undef AT_MX3
#undef AT_MFMA
}

constexpr int NWAVES = 8;
constexpr int RING_OFF = 0, RING_BYTES = 147456;
constexpr int LDSCTL_OFF = RING_BYTES, MISC_OFF = LDSCTL_OFF + 320;
constexpr int LDS_BYTES = RING_BYTES + 1024;
static_assert(attn::Lay<128>::BYTES <= RING_BYTES && attn::Lay<64>::BYTES <= RING_BYTES && LDS_BYTES <= 163840, "LDS budget");
static_assert(MISC_OFF + 128 <= LDS_BYTES, "LDS map");

struct Frame {
    LAS unsigned char* lds; volatile LAS unsigned* MISC; gu32* ctl;
    int tid, lane, wave, vcu, G;
};
__device__ __forceinline__ float wave_sum(float v) {
#pragma unroll
    for (int o = 1; o < 64; o <<= 1) v += __shfl_xor(v, o);
    return v;
}
__device__ __forceinline__ float bf2f(unsigned h) { return __builtin_bit_cast(float, h << 16); }

__device__ __forceinline__ void p0_transpose_item(const float* W, int K, int N, bf16* WT, LAS float* scr, int item, int lane, const float* gk, int gmask, float cmul, int qcols, float qscale) {
    const int nblk = N / 32, kb = item / nblk, nb = item % nblk, k0 = 64 * kb, n0 = 32 * nb;
    const float cs = cmul * ((n0 < qcols) ? qscale : 1.0f);
#pragma unroll 8
    for (int i = 0; i < 32; ++i) { const int kk = 2 * i + (lane >> 5); const float g = gk ? gk[(k0 + kk) & gmask] : 1.0f; scr[kk * 33 + (lane & 31)] = W[(size_t)(k0 + kk) * N + n0 + (lane & 31)] * (g * cs); }
    LDS_WAIT(); asm volatile("" ::: "memory");
    const int c = lane & 7;
#pragma unroll
    for (int j = 0; j < 4; ++j) { const int n = (lane >> 3) + 8 * j; const LAS float* s = scr + (8 * c) * 33 + n;
        v4u o; o.x = pk2(s[0 * 33], s[1 * 33]); o.y = pk2(s[2 * 33], s[3 * 33]); o.z = pk2(s[4 * 33], s[5 * 33]); o.w = pk2(s[6 * 33], s[7 * 33]);
        *(GAS v4u*)(WT + (size_t)(n0 + n) * K + k0 + 8 * c) = o; }
    LDS_WAIT(); asm volatile("" ::: "memory");
}
__device__ __forceinline__ void p0_x_row(const float* xrow, float* orow, bf16* hrow, float* ssq, int lane) {
    const GAS f32x4* xr = (const GAS f32x4*)xrow + lane; GAS f32x4* orr = (GAS f32x4*)orow + lane; GAS unsigned long long* h8 = (GAS unsigned long long*)hrow + lane;
    f32x4 v[4]; float s[4];
#pragma unroll
    for (int j = 0; j < 4; ++j) v[j] = xr[64 * j];
#pragma unroll
    for (int j = 0; j < 4; ++j) { orr[64 * j] = v[j]; h8[64 * j] = (unsigned long long)pk2(v[j].x, v[j].y) | ((unsigned long long)pk2(v[j].z, v[j].w) << 32);
        s[j] = wave_sum((v[j].x * v[j].x + v[j].y * v[j].y) + (v[j].z * v[j].z + v[j].w * v[j].w)); }
    if (lane < 16) { const int j = lane >> 2; const float sj = j == 0 ? s[0] : j == 1 ? s[1] : j == 2 ? s[2] : s[3]; ssq[lane] = (lane & 3) == 0 ? sj : 0.f; }
}
__device__ __forceinline__ void final_row(float* orow, const float* ssq, const float* g, int lane) {
    const float rs = pg8::row_rstd16(ssq, 0);
    GAS f32x4* orr = (GAS f32x4*)orow + lane; const GAS f32x4* gr = (const GAS f32x4*)g + lane;
#pragma unroll
    for (int j = 0; j < 4; ++j) { f32x4 v = orr[64 * j]; const f32x4 gv = gr[64 * j]; v = v * rs * gv; orr[64 * j] = v; }
}

__device__ __forceinline__ void diff_attn_unit_simple(LAS unsigned char* lds, int b, int h, int qblk, const bf16* Q, const bf16* K, const bf16* V, bf16* O, float lam, int tid) {
    LAS float* Ks = (LAS float*)lds; LAS float* Vs = (LAS float*)(lds + 64 * 65 * 4);
    const int qi = tid >> 2, part = tid & 3, q0 = qblk * 128, t = q0 + qi;
    const size_t rowbase = (size_t)b * T;
    const float slope2 = exp2f(-(float)(h + 1)) * LOG2E;
    float ores[32], o0[32], l0 = 0.f;
#pragma unroll 1
    for (int m = 0; m < 2; ++m) {
        float q[16];
        { const bf16* qp = Q + (rowbase + t) * D + h * 128 + m * 64 + part * 16;
#pragma unroll
          for (int i = 0; i < 16; ++i) q[i] = bf2f(qp[i]); }
        float mrun = NEG_BIG, l = 0.f, o[32];
#pragma unroll
        for (int e = 0; e < 32; ++e) o[e] = 0.f;
        const int nkt = q0 / 64 + 2;
        for (int kt = 0; kt < nkt; ++kt) {
            const int kb = kt * 64;
            __syncthreads();
            { const int key = tid >> 3, seg = tid & 7;
              const bf16* kp = K + (rowbase + kb + key) * D + h * 128 + m * 64 + seg * 8;
#pragma unroll
              for (int i = 0; i < 8; ++i) Ks[key * 65 + seg * 8 + i] = bf2f(kp[i]);
              const bf16* vp = V + (rowbase + kb + key) * D + h * 128 + seg * 16;
#pragma unroll
              for (int i = 0; i < 16; ++i) Vs[key * 129 + seg * 16 + i] = bf2f(vp[i]); }
            __syncthreads();
            for (int key = 0; key < 64; ++key) {
                float s = 0.f;
#pragma unroll
                for (int i = 0; i < 16; ++i) s = fmaf(q[i], Ks[key * 65 + part * 16 + i], s);
                s += __shfl_xor(s, 1); s += __shfl_xor(s, 2);
                const int kpos = kb + key;
                s += slope2 * (float)(kpos - t);
                if (kpos > t) s = -INFINITY;
                const float mn = fmaxf(mrun, s);
                const float alpha = exp2f(mrun - mn), p = exp2f(s - mn);
                mrun = mn; l = l * alpha + p;
#pragma unroll
                for (int e = 0; e < 32; ++e) o[e] = fmaf(p, Vs[key * 129 + part * 32 + e], o[e] * alpha);
            }
        }
        if (m == 0) {
#pragma unroll
            for (int e = 0; e < 32; ++e) o0[e] = o[e];
            l0 = l;
        } else {
            const float i0 = 1.0f / l0, i1 = lam / l;
#pragma unroll
            for (int e = 0; e < 32; ++e) ores[e] = o0[e] * i0 - o[e] * i1;
        }
    }
    float ss = 0.f;
#pragma unroll
    for (int e = 0; e < 32; ++e) ss = fmaf(ores[e], ores[e], ss);
    ss += __shfl_xor(ss, 1); ss += __shfl_xor(ss, 2);
    const float rs = 1.0f / sqrtf(ss * (1.0f / 128.0f) + RMS_EPS);
    bf16* op = O + (rowbase + t) * D + h * 128 + part * 32;
#pragma unroll
    for (int e = 0; e < 32; e += 2) *(unsigned*)(op + e) = pk2(ores[e] * rs, ores[e + 1] * rs);
    __syncthreads();
}
__device__ __forceinline__ void moba_unit_simple(int b, int h, int qblk, const bf16* Q, const bf16* K, const bf16* V, bf16* O, const float* KM, int tid) {
    const int qi = tid >> 2, part = tid & 3, q0 = qblk * 128, t = q0 + qi, j = q0 / 256;
    const size_t rowbase = (size_t)b * T;
    const float slope2 = exp2f(-0.5f * (float)(h + 1)) * LOG2E;
    float q[16];
    { const bf16* qp = Q + (rowbase + t) * D + h * 64 + part * 16;
#pragma unroll
      for (int i = 0; i < 16; ++i) q[i] = bf2f(qp[i]); }
    float b0 = -INFINITY, b1 = -INFINITY, b2 = -INFINITY; int i0 = 0, i1 = 0, i2 = 0;
    for (int n = 0; n < j; ++n) {
        const float* km = KM + (((size_t)b * 16 + h) * 32 + n) * 64 + part * 16;
        float g = 0.f;
#pragma unroll
        for (int i = 0; i < 16; ++i) g = fmaf(q[i], km[i], g);
        g += __shfl_xor(g, 1); g += __shfl_xor(g, 2);
        if (g > b0) { b2 = b1; i2 = i1; b1 = b0; i1 = i0; b0 = g; i0 = n; }
        else if (g > b1) { b2 = b1; i2 = i1; b1 = g; i1 = n; }
        else if (g > b2) { b2 = g; i2 = n; }
    }
    const int nsel = j < 3 ? j : 3;
    float mrun = NEG_BIG, l = 0.f, o[16];
#pragma unroll
    for (int e = 0; e < 16; ++e) o[e] = 0.f;
    for (int seg = 0; seg <= nsel; ++seg) {
        const int blk = seg == 0 ? j : (seg == 1 ? i0 : (seg == 2 ? i1 : i2));
        const int kb = blk * 256;
        for (int key = 0; key < 256; ++key) {
            const int kpos = kb + key;
            const bf16* kp = K + (rowbase + kpos) * D + h * 64 + part * 16;
            float s = 0.f;
#pragma unroll
            for (int i = 0; i < 16; ++i) s = fmaf(q[i], bf2f(kp[i]), s);
            s += __shfl_xor(s, 1); s += __shfl_xor(s, 2);
            s += slope2 * (float)(kpos - t);
            if (kpos > t) s = -INFINITY;
            const float mn = fmaxf(mrun, s);
            const float alpha = exp2f(mrun - mn), p = exp2f(s - mn);
            mrun = mn; l = l * alpha + p;
            const bf16* vp = V + (rowbase + kpos) * D + h * 64 + part * 16;
#pragma unroll
            for (int e = 0; e < 16; ++e) o[e] = fmaf(p, bf2f(vp[e]), o[e] * alpha);
        }
    }
    const float il = 1.0f / l;
    bf16* op = O + (rowbase + t) * D + h * 64 + part * 16;
#pragma unroll
    for (int e = 0; e < 16; e += 2) *(unsigned*)(op + e) = pk2(o[e] * il, o[e + 1] * il);
}

struct Args { const float* in[10]; float* out; unsigned char* ws; };
__global__ void __launch_bounds__(NWAVES * 64, 2) fwd_kernel(Args args) {
    extern __shared__ __attribute__((aligned(16))) unsigned char lds[];
    Frame F;
    F.lds = (LAS unsigned char*)lds;
    F.MISC = (volatile LAS unsigned*)(F.lds + MISC_OFF);
    F.tid = threadIdx.x; F.lane = F.tid & 63; F.wave = __builtin_amdgcn_readfirstlane(F.tid >> 6);
    F.G = gridDim.x; { const int bx = blockIdx.x; F.vcu = (F.G % 8 == 0) ? (bx % 8) * (F.G / 8) + bx / 8 : bx; }
    unsigned char* ws = args.ws;
    F.ctl = (gu32*)(ws + WS_CTL);
#define PTRS() \
    unsigned long long z_ = 0ull; asm volatile("" : "+s"(z_)); unsigned char* wsl = args.ws + z_; float* out = args.out + z_;     \
    bf16* WIN = (bf16*)(wsl + WS_WIN); bf16* WOUT = (bf16*)(wsl + WS_WOUT); bf16* WFF1 = (bf16*)(wsl + WS_WFF1); bf16* WFF2 = (bf16*)(wsl + WS_WFF2); \
    float* SSQ = (float*)(wsl + WS_SSQ); float* KM = (float*)(wsl + WS_KMEAN); \
    bf16* HB = (bf16*)(wsl + WS_HB); bf16* Qb = (bf16*)(wsl + WS_Q); bf16* Kb = (bf16*)(wsl + WS_K); bf16* Vb = (bf16*)(wsl + WS_V); bf16* Ob = (bf16*)(wsl + WS_O); \
    bf16* ACT = (bf16*)(wsl + WS_ACT); \
    (void)WIN; (void)WOUT; (void)WFF1; (void)WFF2; (void)SSQ; (void)KM; (void)HB; (void)Qb; (void)Kb; (void)Vb; (void)Ob; (void)ACT; (void)out
    for (int u = F.tid; u < (LDS_BYTES - LDSCTL_OFF) / 4; u += NWAVES * 64) ((LAS unsigned*)(F.lds + LDSCTL_OFF))[u] = 0u;
    __syncthreads();
    XcdBarrier bar = xcd_barrier_post((unsigned*)(F.ctl + CW_BAR), F.MISC + 8);
#define GRID_BAR() xcd_barrier(bar)
    const int gw = F.vcu * NWAVES + F.wave, NGW = F.G * NWAVES;

    {
        PTRS();
        const float* x = args.in[0]; const float* attn_norm = args.in[1]; const float* w_in = args.in[2]; const float* w_out = args.in[3];
        const float* diff_subln = args.in[5]; const float* mlp_norm = args.in[6]; const float* w_ff1 = args.in[7]; const float* w_ff2 = args.in[8];
        LAS float* scr = (LAS float*)(F.lds + RING_OFF + F.wave * 16384);
        constexpr int I_IN = (D / 64) * (NQKV / 32), I_OUT = (D / 64) * (D / 32), I_F1 = (D / 64) * (FF / 32), I_F2 = (FF / 64) * (D / 32);
        constexpr int PER_L = I_IN + I_OUT + I_F1 + I_F2;
        for (int it = gw; it < 2 * PER_L; it += NGW) {
            const int l = it / PER_L; int r = it % PER_L;
            if (r < I_IN) { p0_transpose_item(w_in + (size_t)l * D * NQKV, D, NQKV, WIN + (size_t)l * NQKV * D, scr, r, F.lane, attn_norm + l * D, D - 1, 1.0f, D, QSCALE); continue; } r -= I_IN;
            if (r < I_OUT) { p0_transpose_item(w_out + (size_t)l * D * D, D, D, WOUT + (size_t)l * D * D, scr, r, F.lane, l == 0 ? diff_subln : nullptr, 127, l == 0 ? 0.8f : 1.0f, 0, 1.0f); continue; } r -= I_OUT;
            if (r < I_F1) { p0_transpose_item(w_ff1 + (size_t)l * D * FF, D, FF, WFF1 + (size_t)l * FF * D, scr, r, F.lane, mlp_norm + l * D, D - 1, 1.0f, 0, 1.0f); continue; } r -= I_F1;
            p0_transpose_item(w_ff2 + (size_t)l * FF * D, FF, D, WFF2 + (size_t)l * D * FF, scr, r, F.lane, nullptr, 0, 1.0f, 0, 1.0f);
        }
        for (int m = gw; m < M; m += NGW) p0_x_row(x + (size_t)m * D, out + (size_t)m * D, HB + (size_t)m * D, SSQ + (size_t)m * 16, F.lane);
    }
    GRID_BAR();

#pragma unroll 1
    for (int l = 0; l < 2; ++l) {
        {
            PTRS();
            pg8::Gemm g{HB, WIN + (size_t)l * NQKV * D, M, NQKV, D}; pg8::StaticOrder S; S.init(M, NQKV, F.G, (int)blockIdx.x);
            pg8::EpiScaleBf16<0> E{Qb, D, SSQ, D, (size_t)M * D};
            pg8::gemm_phase<pg8::EpiScaleBf16<0>, pg8::StaticOrder, PG8_ALIGN, PG8_SP2>(F.lds + RING_OFF, g, S, E);
        }
        GRID_BAR();
        if (l == 0) {
            PTRS();
            const float* lp = args.in[4];
            const float la = wave_sum(lp[F.lane] * lp[64 + F.lane]), lc = wave_sum(lp[128 + F.lane] * lp[192 + F.lane]);
            const float lam = expf(la) - expf(lc) + 0.2f;
            for (int i = F.vcu; i < 512; i += F.G) {
                const int bh = (i & 255) >> 4, s = i & 15, qb = (i >> 8) ? 31 - s : s;
                attn::diff_unit((char*)lds + RING_OFF, bh >> 3, bh & 7, qb, Qb, Kb, Vb, Ob, lam);
            }
        } else {
            { PTRS();
            for (int it = gw; it < 1024; it += NGW) {
                const int n = it & 31, h = (it >> 5) & 15, b = it >> 9; float s = 0.f;
                const bf16* kp = Kb + ((size_t)b * T + n * 256) * D + h * 64 + F.lane;
                for (int i = 0; i < 256; ++i) s += bf2f(kp[(size_t)i * D]);
                KM[(size_t)it * 64 + F.lane] = s * (1.0f / 256.0f);
            } }
            GRID_BAR();
            PTRS();
            for (int i = F.vcu; i < 1024; i += F.G) {
                const int r = i >> 8, c = i & 255, bh = c >> 3, s = c & 7, qb = r == 0 ? s : r == 1 ? 15 - s : r == 2 ? 16 + s : 31 - s;
                attn::moba_unit((char*)lds + RING_OFF, bh >> 4, bh & 15, qb, Qb, Kb, Vb, Ob, KM);
            }
        }
        GRID_BAR();
        {
            PTRS();
            pg8::Gemm g{Ob, WOUT + (size_t)l * D * D, M, D, D}; pg8::StaticOrder S; S.init(M, D, F.G, (int)blockIdx.x);
            pg8::EpiRes E{out, HB, SSQ, D};
            pg8::gemm_phase<pg8::EpiRes, pg8::StaticOrder, PG8_ALIGN, PG8_SP2>(F.lds + RING_OFF, g, S, E);
        }
        GRID_BAR();
        {
            PTRS();
            pg8::Gemm g{HB, WFF1 + (size_t)l * FF * D, M, FF, D}; pg8::StaticOrder S; S.init(M, FF, F.G, (int)blockIdx.x);
            pg8::EpiScaleBf16<1> E{ACT, FF, SSQ, 0, 0};
            pg8::gemm_phase<pg8::EpiScaleBf16<1>, pg8::StaticOrder, PG8_ALIGN, PG8_SP2>(F.lds + RING_OFF, g, S, E);
        }
        GRID_BAR();
        {
            PTRS();
            pg8::Gemm g{ACT, WFF2 + (size_t)l * D * FF, M, D, FF}; pg8::StaticOrder S; S.init(M, D, F.G, (int)blockIdx.x);
            pg8::EpiRes E{out, HB, SSQ, D};
            pg8::gemm_phase<pg8::EpiRes, pg8::StaticOrder, PG8_ALIGN, PG8_SP2>(F.lds + RING_OFF, g, S, E);
        }
        GRID_BAR();
    }
    PTRS(); const float* final_norm = args.in[9];
    for (int m = gw; m < M; m += NGW) final_row(out + (size_t)m * D, SSQ + (size_t)m * 16, final_norm, F.lane);
    if (xb_ld((unsigned*)(F.ctl + CW_BAR) + XB_TMO) != 0u && blockIdx.x == 0) { const float qn = __builtin_nanf(""); for (int i = F.tid; i < 4096; i += NWAVES * 64) out[i] = qn; }
}

extern "C" void kernel_launch(void* const* d_in, const int* in_sizes, int n_in, void* d_out, int out_size, void* d_ws, size_t ws_size, hipStream_t stream) {
    static int grid = 0;
    if (grid == 0) {
        if (n_in != 10 || in_sizes[0] != M * D || out_size != M * D || ws_size < WS_END) { fprintf(stderr, "kernel_launch: unexpected shapes (n_in %d out %d ws %zu); nothing launched\n", n_in, out_size, ws_size); grid = -1; return; }
        int dev = 0, cus = 0, per_cu = 0;
        if (hipGetDevice(&dev) != hipSuccess || hipDeviceGetAttribute(&cus, hipDeviceAttributeMultiprocessorCount, dev) != hipSuccess) { fprintf(stderr, "kernel_launch: device query failed\n"); grid = -1; return; }
        if (hipFuncSetAttribute((const void*)fwd_kernel, hipFuncAttributeMaxDynamicSharedMemorySize, LDS_BYTES) != hipSuccess) { fprintf(stderr, "kernel_launch: hipFuncSetAttribute failed\n"); grid = -1; return; }
        if (hipOccupancyMaxActiveBlocksPerMultiprocessor(&per_cu, (const void*)fwd_kernel, NWAVES * 64, LDS_BYTES) != hipSuccess || per_cu < 1) { fprintf(stderr, "kernel_launch: occupancy query reports %d workgroups per CU\n", per_cu); per_cu = 1; }
        (void)hipGetLastError();
        grid = cus;
    }
    if (grid < 0) return;
    if (hipMemsetAsync((char*)d_ws + WS_CTL, 0, CTL_ZERO_BYTES, stream) != hipSuccess) { fprintf(stderr, "kernel_launch: hipMemsetAsync failed\n"); return; }
    Args a{};
    for (int i = 0; i < 10; ++i) a.in[i] = (const float*)d_in[i];
    a.out = (float*)d_out; a.ws = (unsigned char*)d_ws;
    hipLaunchKernelGGL(fwd_kernel, dim3(grid), dim3(NWAVES * 64), LDS_BYTES, stream, a);
    const hipError_t le = hipPeekAtLastError();
    if (le != hipSuccess) fprintf(stderr, "kernel_launch: launch failed: %s\n", hipGetErrorName(le));
}
```

```cpp
#include <hip/hip_runtime.h>
#include <cstdio>
#include <cstdint>

constexpr int BATCH = 2, T = 8192, D = 1024, M = BATCH * T, FF = 4096, NQKV = 3 * D;
constexpr float RMS_EPS = 1e-6f;
constexpr float LOG2E = 1.4426950408889634f;
constexpr float QSCALE = 0.125f * LOG2E;
constexpr float NEG_BIG = -1e30f;

constexpr size_t MiB = 1u << 20;
constexpr size_t WS_CTL = 0, CTL_ZERO_BYTES = 1 * MiB;
constexpr size_t WS_WIN = 1 * MiB;
constexpr size_t WS_WOUT = 13 * MiB;
constexpr size_t WS_WFF1 = 17 * MiB;
constexpr size_t WS_WFF2 = 33 * MiB;
constexpr size_t WS_SSQ = 49 * MiB;
constexpr size_t WS_KMEAN = 50 * MiB;
constexpr size_t WS_HB = 51 * MiB;
constexpr size_t WS_Q = 83 * MiB, WS_K = 115 * MiB, WS_V = 147 * MiB, WS_O = 179 * MiB;
constexpr size_t WS_ACT = 83 * MiB;
constexpr size_t WS_END = 211 * MiB;
constexpr int CW_TMO = 0, CW_CODE = 1, CW_BAR = 4096;
constexpr int CW_NRM = 8192;
constexpr int CW_QUEUE = 9216;
namespace pg8 {
#define PG8_LAS __attribute__((address_space(3)))
typedef unsigned short bf16_t;
typedef short bf16x8 __attribute__((ext_vector_type(8)));
typedef float f32x4 __attribute__((ext_vector_type(4)));
typedef unsigned u32x4 __attribute__((ext_vector_type(4)));
constexpr int BM = 256, BK = 64, HALF = 128, HTB = HALF * BK * 2  , STAGE_BYTES = 8 * HTB, NXCD = 8, WGM = 8;

__host__ __device__ __forceinline__ int lds_byte(int r, int c) { const int st = (r >> 4) * 2 + (c >> 5), rr = r & 15, cc = c & 31, ob = rr * 64 + cc * 2; return st * 1024 + (ob ^ (((ob >> 9) & 1) << 5)); }
__host__ __device__ __forceinline__ void stage_rc(int b, int& R, int& C) { const int st = b / 1024, sb = b % 1024, swz = sb ^ (((sb >> 9) & 1) << 5); R = (st >> 1) * 16 + swz / 64; C = (st & 1) * 32 + (swz % 64) / 2; }
__host__ __device__ __forceinline__ int perm32(int rho) { const int n = rho >> 4, i = rho & 15; return 8 * (i >> 2) + 4 * n + (i & 3); }

struct Unit { int pm, pn; };
struct Gemm { const bf16_t* A; const bf16_t* Bt; int M, N, K; };

struct StaticOrder {
    int nM, nN, nwg, G, c;
    __host__ __device__ void init(int M, int N, int G_, int c_) { nM = M / BM; nN = N / BM; nwg = nM * nN; G = G_; c = c_; }
    __host__ __device__ bool next(int i, Unit& u) const {
        const long L = (long)i * G + c; if (L >= nwg) return false;
        int wgid = (int)L; { const int q = nwg / NXCD, r = nwg % NXCD, xcd = wgid % NXCD, off = wgid / NXCD; wgid = (xcd < r ? xcd * (q + 1) : r * (q + 1) + (xcd - r) * q) + off; }
        const int nig = WGM * nN, gid = wgid / nig, fm = gid * WGM, gsz = (nM - fm) < WGM ? (nM - fm) : WGM;
        u.pm = fm + ((wgid % nig) % gsz); u.pn = (wgid % nig) / gsz; return true;
    }
    __device__ __forceinline__ void a_ready(const Unit&) const {}
    __device__ __forceinline__ void done(const Unit&) const {}
};


__device__ __forceinline__ unsigned cvt_pk_bf16(float lo, float hi) { unsigned r; asm volatile("v_cvt_pk_bf16_f32 %0, %1, %2" : "=v"(r) : "v"(lo), "v"(hi)); return r; }
__device__ __forceinline__ float row_rstd16(const float* SSQ, int row) {
    const f32x4* p = (const f32x4*)(SSQ + (size_t)row * 16);
    const f32x4 a = p[0], b = p[1], c = p[2], d = p[3];
    const float s = ((a[0] + a[1]) + (a[2] + a[3])) + ((b[0] + b[1]) + (b[2] + b[3])) + ((c[0] + c[1]) + (c[2] + c[3])) + ((d[0] + d[1]) + (d[2] + d[3]));
    return 1.0f / sqrtf(s * (1.0f / 1024.0f) + 1e-6f);
}
template <int ACT> struct EpiScaleBf16 {
    static constexpr bool PERM = true, AFTER_DRAIN = false;
    bf16_t* O; int ldc; const float* SSQ; int split_cols; size_t split_stride;
    unsigned* NRM;
    __device__ __forceinline__ void operator()(const f32x4 (&acc)[2][2][4][2], const Unit& u, int wr, int wc, int fr, int fq) const {
        const int row0 = u.pm * BM + wr * 64 + fr; int colt = u.pn * BM; bf16_t* base = O; int t = 0;
        if (split_cols) { t = colt / split_cols; base += (size_t)t * split_stride; colt -= t * split_cols; }
        const int col0 = colt + wc * 32 + 8 * fq;
        const int lane = fq * 16 + fr; float myrs[2];
#pragma unroll
        for (int ai = 0; ai < 2; ++ai) myrs[ai] = row_rstd16(SSQ, u.pm * BM + wr * 64 + ai * HALF + lane);
        asm volatile("" : "+v"(myrs[0]), "+v"(myrs[1]));
        float mx[2] = {0.f, 0.f};
#pragma unroll
        for (int ai = 0; ai < 2; ++ai)
#pragma unroll
            for (int m = 0; m < 4; ++m) { const int row = row0 + ai * HALF + m * 16; const float rs = __shfl(myrs[ai], m * 16 + fr); bf16_t* rowp = base + (size_t)row * ldc + col0;
#pragma unroll
                for (int bj = 0; bj < 2; ++bj) { f32x4 v0 = acc[ai][bj][m][0] * rs, v1 = acc[ai][bj][m][1] * rs;
                    if (ACT == 1) {
#pragma unroll
                        for (int e = 0; e < 4; ++e) { const float a = __builtin_fmaxf(v0[e], 0.f), b = __builtin_fmaxf(v1[e], 0.f); v0[e] = a * a; v1[e] = b * b; } }
                    if (ACT == 0 && NRM && t < 2) { float q = (v0[0] * v0[0] + v0[1] * v0[1]) + (v0[2] * v0[2] + v0[3] * v0[3]) + (v1[0] * v1[0] + v1[1] * v1[1]) + (v1[2] * v1[2] + v1[3] * v1[3]);
                        q += __shfl_xor(q, 16); q += __shfl_xor(q, 32); mx[bj] = __builtin_fmaxf(mx[bj], q); }
                    u32x4 w; w.x = cvt_pk_bf16(v0[0], v0[1]); w.y = cvt_pk_bf16(v0[2], v0[3]); w.z = cvt_pk_bf16(v1[0], v1[1]); w.w = cvt_pk_bf16(v1[2], v1[3]);
                    *(u32x4*)(rowp + bj * HALF) = w; } }
        if (ACT == 0 && NRM && t < 2) {
#pragma unroll
            for (int bj = 0; bj < 2; ++bj) { float q = mx[bj];
#pragma unroll
                for (int o = 1; o < 16; o <<= 1) q = __builtin_fmaxf(q, __shfl_xor(q, o));
                const int col = colt + bj * HALF + wc * 32;
                if (lane == 0) atomicMax(NRM + (((t * 2 + (u.pm >> 5)) * 16 + (col >> 6)) * 2 + ((col >> 5) & 1)), __float_as_uint(q)); }
        }
    }
};
struct EpiRes {
    static constexpr bool PERM = false, AFTER_DRAIN = false;
    float* out; bf16_t* HB; float* SSQ; int ldc;
    __device__ __forceinline__ void operator()(const f32x4 (&acc)[2][2][4][2], const Unit& u, int wr, int wc, int fr, int fq) const {
        typedef unsigned u32x2v __attribute__((ext_vector_type(2)));
        const int col0 = u.pn * BM + wc * 32 + 4 * fq;
#pragma unroll
        for (int ai = 0; ai < 2; ++ai)
#pragma unroll
            for (int m = 0; m < 4; ++m) { const int row = u.pm * BM + ai * HALF + wr * 64 + m * 16 + fr; const size_t off = (size_t)row * ldc + col0; float s = 0.f;
#pragma unroll
                for (int bj = 0; bj < 2; ++bj)
#pragma unroll
                    for (int n = 0; n < 2; ++n) { const size_t o2 = off + bj * HALF + n * 16; const f32x4 h = *(const f32x4*)(out + o2) + acc[ai][bj][m][n]; *(f32x4*)(out + o2) = h;
                        u32x2v w; w.x = cvt_pk_bf16(h[0], h[1]); w.y = cvt_pk_bf16(h[2], h[3]); *(u32x2v*)(HB + o2) = w;
                        s += (h[0] * h[0] + h[1] * h[1]) + (h[2] * h[2] + h[3] * h[3]); }
                s += __shfl_xor(s, 16); s += __shfl_xor(s, 32);
                if (fq == 0) SSQ[(size_t)row * 16 + u.pn * 4 + wc] = s;
                if (m & 1) asm volatile("" ::: "memory"); }
    }
};
template <class Epi, class Sched, bool ALIGN_EPI = false, bool SP2 = false>
__device__ __forceinline__ void gemm_phase(PG8_LAS unsigned char* lds, const Gemm g, const Sched& S, const Epi& E) {
    int tid_ = threadIdx.x; asm volatile("" : "+v"(tid_));
    const int tid = tid_, wid = __builtin_amdgcn_readfirstlane(tid >> 6), lane = tid & 63, wr = wid >> 2, wc = wid & 3, fr = lane & 15, fq = lane >> 4;
    const int K = g.K, nt = K / BK;
    unsigned voffA[2], voffB[2];
#pragma unroll
    for (int i = 0; i < 2; ++i) { int R, C; stage_rc(tid * 16 + i * 8192, R, C); const int Rb = Epi::PERM ? ((R & ~31) + perm32(R & 31)) : R;
        voffA[i] = (unsigned)(R * K + C) * 2u; voffB[i] = (unsigned)(Rb * K + C) * 2u; }
    const size_t kstep = (size_t)(BK * 2);
    const size_t hstep = (size_t)HALF * K * 2;
    const size_t tstep = 2 * hstep;
    const unsigned ldsw = (unsigned)wid * 1024u;
    const int aoff = lds_byte(wr * 64 + fr, fq * 8), boff = lds_byte(wc * 32 + fr, fq * 8);
#define PG8_SA(b, h) (((b) * 2 + (h)) * HTB)
#define PG8_SB(b, h) ((4 + (b) * 2 + (h)) * HTB)
#define PG8_STAGE(bufoff, gbase, voff) do { _Pragma("unroll") for (int _i = 0; _i < 2; ++_i) \
        __builtin_amdgcn_global_load_lds((const unsigned*)((const char*)(gbase) + (voff)[_i]), (PG8_LAS unsigned*)(lds + (bufoff) + ldsw + _i * 8192), 16, 0, 0); } while (0)
#define PG8_LDA(dst, b, h) do { _Pragma("unroll") for (int m = 0; m < 4; ++m) _Pragma("unroll") for (int k = 0; k < 2; ++k) dst[m][k] = *(const PG8_LAS bf16x8*)(lds + PG8_SA(b, h) + aoff + m * 2048 + k * 1024); } while (0)
#define PG8_LDB(dst, b, h) do { _Pragma("unroll") for (int n = 0; n < 2; ++n) _Pragma("unroll") for (int k = 0; k < 2; ++k) dst[n][k] = *(const PG8_LAS bf16x8*)(lds + PG8_SB(b, h) + boff + n * 2048 + k * 1024); } while (0)
#define PG8_MMA(ai, bj, At, Bt) do { __builtin_amdgcn_s_setprio(1); _Pragma("unroll") for (int m = 0; m < 4; ++m) _Pragma("unroll") for (int n = 0; n < 2; ++n) _Pragma("unroll") for (int k = 0; k < 2; ++k) \
        acc[ai][bj][m][n] = __builtin_amdgcn_mfma_f32_16x16x32_bf16(Bt[n][k], At[m][k], acc[ai][bj][m][n], 0, 0, 0); __builtin_amdgcn_s_setprio(0); } while (0)
#define PG8_WAIT_V(n) asm volatile("s_waitcnt vmcnt(" #n ")" ::: "memory")
#define PG8_WAIT_L(n) asm volatile("s_waitcnt lgkmcnt(" #n ")" ::: "memory")
#define PG8_BAR __builtin_amdgcn_s_barrier()
#define PG8_SCHED __builtin_amdgcn_sched_barrier(0)
    Unit cur, nxt; int ui = 0;
    if (!S.next(0, cur)) return;
    f32x4 acc[2][2][4][2];
#pragma unroll
    for (int a = 0; a < 2; ++a)
#pragma unroll
        for (int b = 0; b < 2; ++b)
#pragma unroll
            for (int m = 0; m < 4; ++m)
#pragma unroll
                for (int n = 0; n < 2; ++n) acc[a][b][m][n] = (f32x4){0.f, 0.f, 0.f, 0.f};
    bf16x8 At[4][2], B0[2][2], B1[2][2];
    const char* cA = (const char*)g.A + (size_t)cur.pm * tstep; const char* cB = (const char*)g.Bt + (size_t)cur.pn * tstep;
    S.a_ready(cur);
    if constexpr (SP2) {
        PG8_STAGE(PG8_SB(0, 0), cB, voffB); PG8_STAGE(PG8_SB(0, 1), cB + hstep, voffB); PG8_STAGE(PG8_SA(0, 0), cA, voffA); PG8_STAGE(PG8_SA(0, 1), cA + hstep, voffA);
        if (wr == 1) PG8_BAR;
        PG8_WAIT_V(2); PG8_BAR;
        PG8_STAGE(PG8_SB(1, 0), cB + kstep, voffB); PG8_STAGE(PG8_SA(1, 0), cA + kstep, voffA); PG8_STAGE(PG8_SB(1, 1), cB + hstep + kstep, voffB);
        PG8_WAIT_V(6); PG8_BAR;
    } else {
        PG8_STAGE(PG8_SB(0, 0), cB, voffB); PG8_STAGE(PG8_SA(0, 0), cA, voffA); PG8_STAGE(PG8_SB(0, 1), cB + hstep, voffB); PG8_STAGE(PG8_SA(0, 1), cA + hstep, voffA);
        if (wr == 1) PG8_BAR;
        PG8_WAIT_V(4); PG8_BAR;
        PG8_STAGE(PG8_SB(1, 0), cB + kstep, voffB); PG8_STAGE(PG8_SA(1, 0), cA + kstep, voffA); PG8_STAGE(PG8_SB(1, 1), cB + hstep + kstep, voffB);
        PG8_WAIT_V(6); PG8_BAR;
    }
    for (;;) {
        const bool has_next = S.next(ui + 1, nxt);
        const char* nA = has_next ? (const char*)g.A + (size_t)nxt.pm * tstep : cA; const char* nB = has_next ? (const char*)g.Bt + (size_t)nxt.pn * tstep : cB;
        for (int t = 0; t < nt; t += 2) {
            const bool last = (t == nt - 2);
            const char* a1 = cA + (size_t)(t + 1) * kstep;
            const char* a2 = last ? nA : cA + (size_t)(t + 2) * kstep; const char* b2 = last ? nB : cB + (size_t)(t + 2) * kstep;
            const char* a3 = a2 + kstep; const char* b3 = b2 + kstep;
            if (last && has_next) S.a_ready(nxt);
            if constexpr (SP2) {
            PG8_LDB(B0, 0, 0); PG8_LDB(B1, 0, 1); PG8_SCHED; PG8_LDA(At, 0, 0); PG8_STAGE(PG8_SA(1, 1), a1 + hstep, voffA);
            PG8_WAIT_V(8); PG8_WAIT_L(0); PG8_BAR; PG8_MMA(0, 0, At, B0); PG8_MMA(0, 1, At, B1); PG8_BAR; PG8_SCHED;
            PG8_LDA(At, 0, 1); PG8_STAGE(PG8_SB(0, 0), b2, voffB); PG8_STAGE(PG8_SB(0, 1), b2 + hstep, voffB); PG8_STAGE(PG8_SA(0, 0), a2, voffA);
            PG8_WAIT_V(8); PG8_WAIT_L(0); PG8_BAR; PG8_MMA(1, 0, At, B0); PG8_MMA(1, 1, At, B1); PG8_BAR; PG8_SCHED;
            PG8_LDB(B0, 1, 0); PG8_LDB(B1, 1, 1); PG8_SCHED; PG8_LDA(At, 1, 0); PG8_STAGE(PG8_SA(0, 1), a2 + hstep, voffA);
            PG8_WAIT_V(8); PG8_WAIT_L(0); PG8_BAR; PG8_MMA(0, 0, At, B0); PG8_MMA(0, 1, At, B1); PG8_BAR; PG8_SCHED;
            PG8_LDA(At, 1, 1); PG8_STAGE(PG8_SB(1, 0), b3, voffB); PG8_STAGE(PG8_SB(1, 1), b3 + hstep, voffB); PG8_STAGE(PG8_SA(1, 0), a3, voffA);
            PG8_WAIT_V(8); PG8_WAIT_L(0); PG8_BAR; PG8_MMA(1, 0, At, B0); PG8_MMA(1, 1, At, B1); PG8_BAR; PG8_SCHED;
            } else {
            PG8_LDB(B0, 0, 0); PG8_SCHED; PG8_LDA(At, 0, 0); PG8_STAGE(PG8_SA(1, 1), a1 + hstep, voffA);
            PG8_WAIT_L(8); PG8_BAR; PG8_WAIT_L(0); PG8_MMA(0, 0, At, B0); PG8_BAR; PG8_SCHED;
            PG8_LDB(B1, 0, 1); PG8_STAGE(PG8_SB(0, 0), b2, voffB);
            PG8_BAR; PG8_WAIT_L(0); PG8_MMA(0, 1, At, B1); PG8_BAR;
            PG8_LDA(At, 0, 1); PG8_STAGE(PG8_SA(0, 0), a2, voffA);
            PG8_BAR; PG8_WAIT_L(0); PG8_MMA(1, 0, At, B0); PG8_BAR; PG8_SCHED;
            PG8_STAGE(PG8_SB(0, 1), b2 + hstep, voffB);
            PG8_WAIT_V(6); PG8_BAR; PG8_MMA(1, 1, At, B1); PG8_BAR;
            PG8_LDB(B0, 1, 0); PG8_SCHED; PG8_LDA(At, 1, 0); PG8_STAGE(PG8_SA(0, 1), a2 + hstep, voffA);
            PG8_WAIT_L(8); PG8_BAR; PG8_WAIT_L(0); PG8_MMA(0, 0, At, B0); PG8_BAR; PG8_SCHED;
            PG8_LDB(B1, 1, 1); PG8_STAGE(PG8_SB(1, 0), b3, voffB);
            PG8_BAR; PG8_WAIT_L(0); PG8_MMA(0, 1, At, B1); PG8_BAR;
            PG8_LDA(At, 1, 1); PG8_STAGE(PG8_SA(1, 0), a3, voffA);
            PG8_BAR; PG8_WAIT_L(0); PG8_MMA(1, 0, At, B0); PG8_BAR; PG8_SCHED;
            PG8_STAGE(PG8_SB(1, 1), b3 + hstep, voffB);
            PG8_WAIT_V(6); PG8_BAR; PG8_MMA(1, 1, At, B1); PG8_BAR;
            }
        }
        if constexpr (ALIGN_EPI) { if (wr == 0) PG8_BAR; }
        if constexpr (!Epi::AFTER_DRAIN) { E(acc, cur, wr, wc, fr, fq); S.done(cur); }
        if (!has_next) break;
#pragma unroll
        for (int a = 0; a < 2; ++a)
#pragma unroll
            for (int b = 0; b < 2; ++b)
#pragma unroll
                for (int m = 0; m < 4; ++m)
#pragma unroll
                    for (int n = 0; n < 2; ++n) acc[a][b][m][n] = (f32x4){0.f, 0.f, 0.f, 0.f};
        cur = nxt; cA = nA; cB = nB; ++ui;
        if constexpr (ALIGN_EPI) { if (wr == 1) PG8_BAR; }
    }
    PG8_WAIT_V(0);
    if constexpr (!ALIGN_EPI) { if (wr == 0) PG8_BAR; }
    PG8_BAR;
    if constexpr (Epi::AFTER_DRAIN) { E.fused(acc, cur, wr, wc, fr, fq, lds, wid, lane); S.done(cur); }
#undef PG8_SA
#undef PG8_SB
#undef PG8_STAGE
#undef PG8_LDA
#undef PG8_LDB
#undef PG8_MMA
#undef PG8_WAIT_V
#undef PG8_WAIT_L
#undef PG8_BAR
#undef PG8_SCHED
}
}

#ifndef PG8_SP2
#define PG8_SP2 true
#endif
#ifndef PG8_ALIGN
#define PG8_ALIGN true
#endif
#define GAS __attribute__((address_space(1)))
#define LAS __attribute__((address_space(3)))
typedef unsigned short bf16;
typedef unsigned v4u __attribute__((ext_vector_type(4)));
typedef float f32x4 __attribute__((ext_vector_type(4)));
typedef short bf16x8 __attribute__((ext_vector_type(8)));
typedef GAS unsigned gu32;
typedef GAS unsigned long long gu64;
#define RLX_AGENT __ATOMIC_RELAXED, __HIP_MEMORY_SCOPE_AGENT
#define LDS_WAIT() asm volatile("s_waitcnt lgkmcnt(0)" ::: "memory")
#define VM_WAIT() asm volatile("s_waitcnt vmcnt(0)" ::: "memory")
__device__ __forceinline__ unsigned long long rt() { return __builtin_amdgcn_s_memrealtime(); }
__device__ __forceinline__ unsigned f2bf(float f) { unsigned u = __builtin_bit_cast(unsigned, f); return (u + 0x7fffu + ((u >> 16) & 1u)) >> 16; }
__device__ __forceinline__ unsigned pk2(float lo, float hi) { return f2bf(lo) | (f2bf(hi) << 16); }

#define XB_TMO      128
#define XB_XCNT(j)  (256  + 64 * (j))
#define XB_XSUB(j)  (1280 + 64 * (j))
#define XB_XGEN(j)  (2304 + 64 * (j))
#define XB_TOP      3328
#define XB_TOPGEN   3392
#define XCD_BAR_WORDS 3456
#define XB_SPIN_CAP (1u << 18)

__device__ __forceinline__ unsigned xb_ld(unsigned* p)              { return __hip_atomic_load(p, __ATOMIC_RELAXED, __HIP_MEMORY_SCOPE_AGENT); }
__device__ __forceinline__ unsigned xb_add(unsigned* p, unsigned v) { return __hip_atomic_fetch_add(p, v, __ATOMIC_RELAXED, __HIP_MEMORY_SCOPE_AGENT); }
__device__ __forceinline__ unsigned xb_xcc_id() { return (unsigned)__builtin_amdgcn_s_getreg((3 << 11) | 20) & 0xFu; }
#define XB_SPIN(cond, bar) do { unsigned _sp = 0; while (cond) { __builtin_amdgcn_s_sleep(1); \
    if ((++_sp & 255u) == 0u) { if (xb_ld(&(bar)[XB_TMO])) break; if (_sp > XB_SPIN_CAP) { atomicAdd(&(bar)[XB_TMO], 1u); break; } } } } while (0)

struct XcdBarrier {
    unsigned* bar; unsigned x;
    volatile LAS unsigned* st;
};

__device__ __forceinline__ XcdBarrier xcd_barrier_post(unsigned* bar, volatile LAS unsigned* st) {
    XcdBarrier b; b.bar = bar; b.x = xb_xcc_id(); b.st = st;
    if (threadIdx.x == 0) (void)xb_add(&bar[XB_XCNT(b.x)], 1u);
    return b;
}
__device__ __forceinline__ void xcd_barrier_complete(unsigned* bar, unsigned x, unsigned& nloc, unsigned& nx) {
    const unsigned G = gridDim.x * gridDim.y * gridDim.z;
    unsigned sum, cnt, mine, sp = 0u;
    for (;;) {
        sum = 0u; cnt = 0u; mine = 0u;
#pragma unroll
        for (unsigned j = 0; j < 16; ++j) { const unsigned c = xb_ld(&bar[XB_XCNT(j)]); sum += c; cnt += (c > 0u) ? 1u : 0u; mine = (j == x) ? c : mine; }
        if (sum == G) break;
        __builtin_amdgcn_s_sleep(1);
        if ((++sp & 255u) == 0u) { if (xb_ld(&bar[XB_TMO])) break; if (sp > XB_SPIN_CAP) { atomicAdd(&bar[XB_TMO], 1u); break; } }
    }
    nloc = mine > 0u ? mine : 1u; nx = cnt > 0u ? cnt : 1u;
}

__device__ __forceinline__ void xcd_barrier(const XcdBarrier& b) {
    asm volatile("s_waitcnt vmcnt(0)" ::: "memory");
    __syncthreads();
    if (threadIdx.x == 0) {
        unsigned* bar = b.bar;
        __builtin_amdgcn_s_waitcnt(0);
        unsigned nloc = b.st[0], nx = b.st[1];
        if (nloc == 0u) { xcd_barrier_complete(bar, b.x, nloc, nx); b.st[0] = nloc; b.st[1] = nx; }
        const unsigned old = xb_add(&bar[XB_XSUB(b.x)], 1u);
        const unsigned gen = old / nloc;
        if (old + 1u == (gen + 1u) * nloc) {
            __builtin_amdgcn_fence(__ATOMIC_RELEASE, "agent");
            asm volatile("s_waitcnt vmcnt(0)" ::: "memory");
            const unsigned og = xb_add(&bar[XB_TOP], 1u);
            const unsigned tg = og / nx;
            if (og + 1u == (tg + 1u) * nx) xb_add(&bar[XB_TOPGEN], 1u);
            else XB_SPIN(xb_ld(&bar[XB_TOPGEN]) == tg, bar);
            __builtin_amdgcn_fence(__ATOMIC_ACQUIRE, "agent");
            xb_add(&bar[XB_XGEN(b.x)], 1u);
            asm volatile("s_waitcnt vmcnt(0)" ::: "memory");
        } else {
            XB_SPIN(xb_ld(&bar[XB_XGEN(b.x)]) == gen, bar);
            __builtin_amdgcn_fence(__ATOMIC_ACQUIRE, "agent");
            asm volatile("s_waitcnt vmcnt(0)" ::: "memory");
        }
    }
    __syncthreads();
}

namespace attn {
typedef unsigned short bf16;
using bf16x8 = __attribute__((ext_vector_type(8))) short;
using s16x4 = __attribute__((ext_vector_type(4))) short;
using f32x16 = __attribute__((ext_vector_type(16))) float;
using u32x4 = __attribute__((ext_vector_type(4))) unsigned;
typedef __attribute__((address_space(3))) const char* lds_cptr;
typedef __attribute__((address_space(3))) char* lds_ptr;
typedef short v4i16_t __attribute__((ext_vector_type(4)));
constexpr int DM = 1024, SEQ = 8192, KVBLK = 64;
constexpr int KSLOT = 8192, NSLOT = 3;
constexpr float THR = 8.0f;
template <int DV> struct Lay {
    static constexpr int VSLOT = DV * 128, LDS_K = 0, LDS_V = NSLOT * KSLOT, LDS_WS = LDS_V + NSLOT * VSLOT, LDS_OST = LDS_WS + 8 * 256, OSTW = 32 * DV * 2, BYTES = LDS_OST + 8 * OSTW;
};
#define AT_SBAR() __builtin_amdgcn_sched_barrier(0)
#define AT_WAIT_BAR(N) asm volatile("s_waitcnt vmcnt(" #N ") lgkmcnt(0)\n\ts_barrier" ::: "memory")
__device__ __forceinline__ int crow(int r, int hi) { return (r & 3) + 8 * (r >> 2) + 4 * hi; }
__device__ __forceinline__ unsigned f2bf_u(float f) { unsigned u = __builtin_bit_cast(unsigned, f); return (u + 0x7fffu + ((u >> 16) & 1u)) >> 16; }
__device__ __forceinline__ float bf2f_u(unsigned h) { return __builtin_bit_cast(float, h << 16); }
__device__ __forceinline__ void glds16(const void* gsrc, unsigned lds_dst) { unsigned keep;
    asm volatile("s_mov_b32 %0, m0\n\ts_mov_b32 m0, %2\n\ts_nop 0\n\tglobal_load_lds_dwordx4 %1, off\n\ts_mov_b32 m0, %0" : "=&s"(keep) : "v"(gsrc), "s"(lds_dst) : "memory"); }
typedef float f32x2_t __attribute__((ext_vector_type(2))); typedef __bf16 bf16x2_t __attribute__((ext_vector_type(2)));
__device__ __forceinline__ unsigned cvtpk_s(float lo, float hi) { f32x2_t v = {lo, hi}; bf16x2_t b = __builtin_convertvector(v, bf16x2_t); return __builtin_bit_cast(unsigned, b); }
__device__ __forceinline__ s16x4 vtr(lds_cptr p) { return __builtin_bit_cast(s16x4, __builtin_amdgcn_ds_read_tr16_b64_v4i16((__attribute__((address_space(3))) v4i16_t*)p)); }
#define AT_MX3(a, b, c) __builtin_fmaxf(__builtin_fmaxf((a), (b)), (c))
#define AT_MFMA(a, b, c) __builtin_amdgcn_mfma_f32_32x32x16_bf16(a, b, c, 0, 0, 0)
__device__ __forceinline__ float rowmax(const f32x16& p0, const f32x16& p1) {
    float a = AT_MX3(p0[0], p0[1], p1[0]), b = AT_MX3(p0[2], p0[3], p1[1]); a = AT_MX3(a, p1[2], p1[3]);
#pragma unroll
    for (int r = 4; r < 16; r += 4) { a = AT_MX3(a, p0[r], p0[r + 1]); b = AT_MX3(b, p0[r + 2], p0[r + 3]); a = AT_MX3(a, p1[r], p1[r + 1]); b = AT_MX3(b, p1[r + 2], p1[r + 3]); }
    float m = __builtin_fmaxf(a, b); auto rr = __builtin_amdgcn_permlane32_swap(__float_as_uint(m), __float_as_uint(m), false, false);
    return __builtin_fmaxf(__uint_as_float(rr[0]), __uint_as_float(rr[1])); }
__device__ __forceinline__ void cmask(f32x16& p0, f32x16& p1, int jb, int qrel, int hi) {
    const int kb = 64 * jb + 4 * hi;
#pragma unroll
    for (int r = 0; r < 16; ++r) { const int kv = kb + (r & 3) + 8 * (r >> 2); if (kv > qrel) p0[r] = -INFINITY; if (kv + 32 > qrel) p1[r] = -INFINITY; } }

template <int DV, bool MOBA>
__device__ __forceinline__ void sweep(char* shm, const bf16* Qw, const bf16* __restrict__ Kh, const bf16* __restrict__ Vh, int qb, int kt_min, float slope2, unsigned sel, f32x16 (&o)[DV / 32], float& l_out) {
    typedef Lay<DV> L;
    constexpr int NPV = DV / 64, NPT = 1 + NPV;
    int tid_ = threadIdx.x; asm volatile("" : "+v"(tid_));
    const int tid = tid_, lane = tid & 63, r32 = lane & 31, hi = lane >> 5; const int wid = __builtin_amdgcn_readfirstlane(tid >> 6);
    const unsigned lds0 = (unsigned)(uintptr_t)shm;
    const lds_ptr shm3 = (lds_ptr)shm;
    __attribute__((address_space(3))) float* wsf = (__attribute__((address_space(3))) float*)(shm3 + L::LDS_WS) + wid * 64;
    const int NT = 4 * qb + 4 - kt_min;
    const bf16* ksrc = Kh + (long)lane * DM + wid * 8;
    const bf16* vsrc0 = Vh + (long)(16 * (wid & 3) + (lane >> 2)) * DM + (wid >> 2) * 32 + (lane & 3) * 8;
    const unsigned kdst = lds0 + L::LDS_K + wid * 1024, vdst = lds0 + L::LDS_V + wid * 1024;
#define AT_KT(i) (MOBA ? ((i) < 4 ? 4 * qb + (i) : (i) - 4 + kt_min) : (i) + kt_min)
#define AT_DMA(i, slot) do { const long kt_ = AT_KT(i); glds16(ksrc + kt_ * KVBLK * DM, (unsigned)__builtin_amdgcn_readfirstlane(kdst + (slot) * KSLOT)); \
        glds16(vsrc0 + kt_ * KVBLK * DM, (unsigned)__builtin_amdgcn_readfirstlane(vdst + (slot) * L::VSLOT)); \
        if (NPV == 2) glds16(vsrc0 + kt_ * KVBLK * DM + 64, (unsigned)__builtin_amdgcn_readfirstlane(vdst + (slot) * L::VSLOT + 8192)); } while (0)
    bf16x8 qr[4];
#pragma unroll
    for (int d0 = 0; d0 < 4; ++d0) qr[d0] = *reinterpret_cast<const bf16x8*>(&Qw[(long)r32 * DM + d0 * 16 + hi * 8]);
    AT_DMA(0, 0); AT_DMA(1, 1);
    const lds_cptr kp0 = (lds_cptr)shm3 + L::LDS_K + hi * 1024 + r32 * 16;
    const lds_cptr vp0 = (lds_cptr)shm3 + L::LDS_V + ((lane >> 4) & 1) * 32 + (lane & 3) * 8 + (4 * hi + ((lane & 15) >> 2)) * 64;
    const unsigned shi = f2bf_u(slope2), slo = f2bf_u(slope2 - bf2f_u(shi));
    const unsigned one2 = 0x3f803f80u;
    u32x4 qa = {0u, 0u, 0u, 0u}, ka0 = {0u, 0u, 0u, 0u}, ka1 = {0u, 0u, 0u, 0u};
    if (hi == 0) { qa.x = shi | (slo << 16); qa.y = qa.x; const unsigned o0 = f2bf_u((float)r32), o1 = f2bf_u((float)(32 + r32)); ka0.x = o0 | (o0 << 16); ka1.x = o1 | (o1 << 16); ka0.z = one2; ka1.z = one2; }
    float mhat = 0.f, l_reg = 0.f;
#pragma unroll
    for (int d = 0; d < DV / 32; ++d) o[d] = f32x16{};
    const int qrel = wid * 32 + r32;
    int slot = 0;
    if (NPT == 3) { AT_WAIT_BAR(3); } else { AT_WAIT_BAR(2); }
    for (int i = 0; i < NT; ++i) {
        if (i + 2 < NT) { const int s2 = slot == 0 ? 2 : slot - 1; AT_DMA(i + 2, s2); }
        const int kt = AT_KT(i);
        const int jb = MOBA ? (i < 4 ? i : -1) : (i - (NT - 4));
        f32x16 c0, c1;
        {
            const unsigned tb = f2bf_u((float)(64 * (kt - 4 * qb)));
            u32x4 a0 = ka0, a1 = ka1, qv = qa;
            if (hi == 0) { a0.y = tb | (tb << 16); a1.y = a0.y; }
            if (MOBA) { if (hi == 0 && i >= 4 && !((sel >> (kt >> 2)) & 1u)) qv.z = 0x0000f14au; }
            const lds_cptr kp = kp0 + slot * KSLOT;
            bf16x8 kf[8];
#pragma unroll
            for (int j = 0; j < 4; ++j) { kf[2 * j] = *(const __attribute__((address_space(3))) bf16x8*)(kp + j * 2048); kf[2 * j + 1] = *(const __attribute__((address_space(3))) bf16x8*)(kp + j * 2048 + 512); }
            c0 = AT_MFMA(__builtin_bit_cast(bf16x8, a0), __builtin_bit_cast(bf16x8, qv), f32x16{}); c1 = AT_MFMA(__builtin_bit_cast(bf16x8, a1), __builtin_bit_cast(bf16x8, qv), f32x16{});
#pragma unroll
            for (int j = 0; j < 4; ++j) { c0 = AT_MFMA(kf[2 * j], qr[j], c0); c1 = AT_MFMA(kf[2 * j + 1], qr[j], c1); }
        }
        if (jb >= 0) cmask(c0, c1, jb, qrel, hi);
        {
            const float rm = rowmax(c0, c1);
            const bool first = (i == 0);
            if (first || __any(rm > THR)) {
                const float dl = first ? rm : __builtin_fmaxf(rm, 0.f);
                const float mnew = mhat + dl;
                const unsigned nh = f2bf_u(-mnew), nl = f2bf_u(-mnew - bf2f_u(nh));
                const float meff = -(bf2f_u(nh) + bf2f_u(nl));
                const float dle = meff - mhat; mhat = meff;
                if (hi == 0) qa.z = nh | (nl << 16);
#pragma unroll
                for (int r = 0; r < 16; ++r) { c0[r] -= dle; c1[r] -= dle; }
                if (!first) {
                    const float f = __builtin_amdgcn_exp2f(-dle); l_reg *= f;
                    if (hi == 0) wsf[r32] = f;
                    asm volatile("s_waitcnt lgkmcnt(0)" ::: "memory");
#pragma unroll
                    for (int d = 0; d < DV / 32; ++d)
#pragma unroll
                        for (int r = 0; r < 16; ++r) o[d][r] *= wsf[crow(r, hi)];
                }
            }
        }
        float sacc = 0.f;
#pragma unroll
        for (int r = 0; r < 16; ++r) { c0[r] = __builtin_amdgcn_exp2f(c0[r]); c1[r] = __builtin_amdgcn_exp2f(c1[r]); sacc += c0[r] + c1[r]; }
        l_reg += sacc;
        u32x4 pw[4];
        pw[0] = (u32x4){cvtpk_s(c0[0], c0[1]), cvtpk_s(c0[2], c0[3]), cvtpk_s(c0[4], c0[5]), cvtpk_s(c0[6], c0[7])};
        pw[1] = (u32x4){cvtpk_s(c0[8], c0[9]), cvtpk_s(c0[10], c0[11]), cvtpk_s(c0[12], c0[13]), cvtpk_s(c0[14], c0[15])};
        pw[2] = (u32x4){cvtpk_s(c1[0], c1[1]), cvtpk_s(c1[2], c1[3]), cvtpk_s(c1[4], c1[5]), cvtpk_s(c1[6], c1[7])};
        pw[3] = (u32x4){cvtpk_s(c1[8], c1[9]), cvtpk_s(c1[10], c1[11]), cvtpk_s(c1[12], c1[13]), cvtpk_s(c1[14], c1[15])};
        {
            const lds_cptr vp = vp0 + slot * L::VSLOT;
#pragma unroll
            for (int d = 0; d < DV / 32; ++d)
#pragma unroll
                for (int ks = 0; ks < 4; ++ks) {
                    const s16x4 lo = vtr(vp + d * 4096 + ks * 1024), hh = vtr(vp + d * 4096 + ks * 1024 + 512);
                    const bf16x8 vf = (bf16x8){lo[0], lo[1], lo[2], lo[3], hh[0], hh[1], hh[2], hh[3]};
                    o[d] = AT_MFMA(__builtin_bit_cast(bf16x8, pw[ks]), vf, o[d]);
                }
        }
        if (i + 2 < NT) { if (NPT == 3) { AT_WAIT_BAR(3); } else { AT_WAIT_BAR(2); } } else { AT_WAIT_BAR(0); }
        slot = slot == 2 ? 0 : slot + 1;
    }
    { auto rr = __builtin_amdgcn_permlane32_swap(__float_as_uint(l_reg), __float_as_uint(l_reg), false, false); l_out = __uint_as_float(rr[0]) + __uint_as_float(rr[1]); }
#undef AT_KT
#undef AT_DMA
}

__device__ __forceinline__ int window_kt_min(const unsigned* nrm, int b, int chunk, int q0, float slope2) {
    const float nq = __uint_as_float(nrm[((0 * 2 + b) * 16 + chunk) * 2]) + __uint_as_float(nrm[((0 * 2 + b) * 16 + chunk) * 2 + 1]);
    const float nk = __uint_as_float(nrm[((1 * 2 + b) * 16 + chunk) * 2]) + __uint_as_float(nrm[((1 * 2 + b) * 16 + chunk) * 2 + 1]);
    const float B = sqrtf(nq * nk) * 1.01f;
    const float W = (2.0f * B + 160.0f) / slope2;
    const int wkeys = W < 1.0e6f ? (int)W : 1000000;
    const int d = q0 - wkeys;
    return d > 0 ? (d >> 6) : 0;
}
__device__ __forceinline__ void diff_unit(char* shm, int b, int h, int qb, const bf16* Q, const bf16* K, const bf16* V, bf16* O, float lam, const unsigned* nrm) {
    typedef Lay<128> L;
    int tid_ = threadIdx.x; asm volatile("" : "+v"(tid_));
    const int tid = tid_, lane = tid & 63, r32 = lane & 31, hi = lane >> 5; const int wid = __builtin_amdgcn_readfirstlane(tid >> 6);
    const long rowbase = (long)b * SEQ; const int q0 = qb * 256;
    const float slope2 = __builtin_amdgcn_exp2f(-(float)(h + 1)) * 1.4426950408889634f;
    const lds_ptr shm3 = (lds_ptr)shm;
    __attribute__((address_space(3))) float* wsf = (__attribute__((address_space(3))) float*)(shm3 + L::LDS_WS) + wid * 64;
    __attribute__((address_space(3))) bf16* stg = (__attribute__((address_space(3))) bf16*)(shm3 + L::LDS_OST + wid * L::OSTW);
#pragma unroll 1
    for (int m = 0; m < 2; ++m) {
        f32x16 o[4]; float l;
        const int kt_min = __builtin_amdgcn_readfirstlane(window_kt_min(nrm, b, 2 * h + m, q0, slope2));
        sweep<128, false>(shm, Q + (rowbase + q0 + wid * 32) * DM + h * 128 + m * 64, K + rowbase * DM + h * 128 + m * 64, V + rowbase * DM + h * 128, qb, kt_min, slope2, 0u, o, l);
        if (hi == 0) wsf[32 + r32] = l;
        asm volatile("s_waitcnt lgkmcnt(0)" ::: "memory");
        float rli[16];
#pragma unroll
        for (int r = 0; r < 16; ++r) rli[r] = (m == 0 ? 1.0f : lam) * __builtin_amdgcn_rcpf(wsf[32 + crow(r, hi)]);
        if (m == 0) {
#pragma unroll
            for (int r = 0; r < 16; ++r)
#pragma unroll
                for (int d = 0; d < 4; ++d) stg[crow(r, hi) * 128 + d * 32 + r32] = (bf16)f2bf_u(o[d][r] * rli[r]);
        } else {
            float ss[16];
#pragma unroll
            for (int r = 0; r < 16; ++r) { float s = 0.f;
#pragma unroll
                for (int d = 0; d < 4; ++d) { const float v = bf2f_u(stg[crow(r, hi) * 128 + d * 32 + r32]) - o[d][r] * rli[r]; o[d][r] = v; s = __builtin_fmaf(v, v, s); }
                ss[r] = s; }
#pragma unroll
            for (int r = 0; r < 16; ++r) {
#pragma unroll
                for (int off = 1; off < 32; off <<= 1) ss[r] += __shfl_xor(ss[r], off);
                ss[r] = 1.0f / sqrtf(ss[r] * (1.0f / 128.0f) + 1e-6f); }
#pragma unroll
            for (int r = 0; r < 16; ++r)
#pragma unroll
                for (int d = 0; d < 4; ++d) stg[crow(r, hi) * 128 + d * 32 + r32] = (bf16)f2bf_u(o[d][r] * ss[r]);
            asm volatile("s_waitcnt lgkmcnt(0)" ::: "memory");
            bf16* Ow = O + (rowbase + q0 + wid * 32) * DM + h * 128;
#pragma unroll
            for (int i = 0; i < 8; ++i) { const int row = i * 4 + (lane >> 4), ch = lane & 15; const u32x4 v = *(const __attribute__((address_space(3))) u32x4*)(stg + row * 128 + ch * 8); *(u32x4*)(Ow + (long)row * DM + ch * 8) = v; }
        }
    }
}
__device__ __forceinline__ void moba_unit(char* shm, int b, int h, int qb, const bf16* Q, const bf16* K, const bf16* V, bf16* O, const float* KM, const unsigned* nrm) {
    typedef Lay<64> L;
    int tid_ = threadIdx.x; asm volatile("" : "+v"(tid_));
    const int tid = tid_, lane = tid & 63, r32 = lane & 31, hi = lane >> 5; const int wid = __builtin_amdgcn_readfirstlane(tid >> 6);
    const long rowbase = (long)b * SEQ; const int q0 = qb * 256;
    const float slope2 = __builtin_amdgcn_exp2f(-0.5f * (float)(h + 1)) * 1.4426950408889634f;
    const lds_ptr shm3 = (lds_ptr)shm;
    __attribute__((address_space(3))) float* wsf = (__attribute__((address_space(3))) float*)(shm3 + L::LDS_WS) + wid * 64;
    __attribute__((address_space(3))) bf16* stg = (__attribute__((address_space(3))) bf16*)(shm3 + L::LDS_OST + wid * L::OSTW);
    const bf16* Qw = Q + (rowbase + q0 + wid * 32) * DM + h * 64;
    unsigned sel = 0u;
    if (qb > 0) {
        f32x16 g = f32x16{};
        const float* km = KM + (((long)b * 16 + h) * 32 + r32) * 64 + hi * 8;
#pragma unroll
        for (int d0 = 0; d0 < 4; ++d0) {
            const bf16x8 qf = *reinterpret_cast<const bf16x8*>(&Qw[(long)r32 * DM + d0 * 16 + hi * 8]);
            const float4 x0 = *(const float4*)(km + d0 * 16), x1 = *(const float4*)(km + d0 * 16 + 4);
            const float xs[8] = {x0.x, x0.y, x0.z, x0.w, x1.x, x1.y, x1.z, x1.w};
            unsigned hw[8], lw[8];
#pragma unroll
            for (int e = 0; e < 8; ++e) { hw[e] = f2bf_u(xs[e]); lw[e] = f2bf_u(xs[e] - bf2f_u(hw[e])); }
            const u32x4 ah = {hw[0] | (hw[1] << 16), hw[2] | (hw[3] << 16), hw[4] | (hw[5] << 16), hw[6] | (hw[7] << 16)};
            const u32x4 al = {lw[0] | (lw[1] << 16), lw[2] | (lw[3] << 16), lw[4] | (lw[5] << 16), lw[6] | (lw[7] << 16)};
            g = AT_MFMA(__builtin_bit_cast(bf16x8, ah), qf, g); g = AT_MFMA(__builtin_bit_cast(bf16x8, al), qf, g);
        }
        float g0[16], g1[16];
#pragma unroll
        for (int r = 0; r < 16; ++r) { auto rr = __builtin_amdgcn_permlane32_swap(__float_as_uint(g[r]), __float_as_uint(g[r]), false, false); g0[r] = __uint_as_float(rr[0]); g1[r] = __uint_as_float(rr[1]); }
        float b0 = -INFINITY, b1 = -INFINITY, b2 = -INFINITY; int i0 = 0, i1 = 0, i2 = 0;
#pragma unroll
        for (int n = 0; n < 32; ++n) {
            const int rn = 4 * (n >> 3) + (n & 3);
            float v = ((n >> 2) & 1) ? g1[rn] : g0[rn];
            if (n >= qb) v = -INFINITY;
            if (v > b0) { b2 = b1; i2 = i1; b1 = b0; i1 = i0; b0 = v; i0 = n; }
            else if (v > b1) { b2 = b1; i2 = i1; b1 = v; i1 = n; }
            else if (v > b2) { b2 = v; i2 = n; }
        }
        if (b0 > -INFINITY) sel |= 1u << i0;
        if (b1 > -INFINITY) sel |= 1u << i1;
        if (b2 > -INFINITY) sel |= 1u << i2;
    }
    f32x16 o[2]; float l;
    const int kt_min = __builtin_amdgcn_readfirstlane(window_kt_min(nrm, b, h, q0, slope2));
    sweep<64, true>(shm, Qw, K + rowbase * DM + h * 64, V + rowbase * DM + h * 64, qb, kt_min, slope2, sel, o, l);
    if (hi == 0) wsf[32 + r32] = l;
    asm volatile("s_waitcnt lgkmcnt(0)" ::: "memory");
#pragma unroll
    for (int r = 0; r < 16; ++r) { const float rl = __builtin_amdgcn_rcpf(wsf[32 + crow(r, hi)]);
#pragma unroll
        for (int d = 0; d < 2; ++d) stg[crow(r, hi) * 64 + d * 32 + r32] = (bf16)f2bf_u(o[d][r] * rl); }
    asm volatile("s_waitcnt lgkmcnt(0)" ::: "memory");
    bf16* Ow = O + (rowbase + q0 + wid * 32) * DM + h * 64;
#pragma unroll
    for (int i = 0; i < 4; ++i) { const int row = i * 8 + (lane >> 3), ch = lane & 7; const u32x4 v = *(const __attribute__((address_space(3))) u32x4*)(stg + row * 64 + ch * 8); *(u32x4*)(Ow + (long)row * DM + ch * 8) = v; }
}
#undef AT_SBAR
#undef AT_WAIT_BAR
#undef AT_MX3
#undef AT_MFMA
}

constexpr int NWAVES = 8;
constexpr int RING_OFF = 0, RING_BYTES = 147456;
constexpr int LDSCTL_OFF = RING_BYTES, MISC_OFF = LDSCTL_OFF + 320;
constexpr int LDS_BYTES = RING_BYTES + 1024;
static_assert(attn::Lay<128>::BYTES <= RING_BYTES && attn::Lay<64>::BYTES <= RING_BYTES && LDS_BYTES <= 163840, "LDS budget");
static_assert(MISC_OFF + 128 <= LDS_BYTES, "LDS map");

struct Frame {
    LAS unsigned char* lds; volatile LAS unsigned* MISC; gu32* ctl;
    int tid, lane, wave, vcu, G;
};
__device__ __forceinline__ float wave_sum(float v) {
#pragma unroll
    for (int o = 1; o < 64; o <<= 1) v += __shfl_xor(v, o);
    return v;
}
__device__ __forceinline__ float bf2f(unsigned h) { return __builtin_bit_cast(float, h << 16); }

__device__ __forceinline__ void p0_transpose_item(const float* W, int K, int N, bf16* WT, LAS float* scr, int item, int lane, const float* gk, int gmask, float cmul, int qcols, float qscale) {
    const int nblk = N / 32, kb = item / nblk, nb = item % nblk, k0 = 64 * kb, n0 = 32 * nb;
    const float cs = cmul * ((n0 < qcols) ? qscale : 1.0f);
#pragma unroll 8
    for (int i = 0; i < 32; ++i) { const int kk = 2 * i + (lane >> 5); const float g = gk ? gk[(k0 + kk) & gmask] : 1.0f; scr[kk * 33 + (lane & 31)] = W[(size_t)(k0 + kk) * N + n0 + (lane & 31)] * (g * cs); }
    LDS_WAIT(); asm volatile("" ::: "memory");
    const int c = lane & 7;
#pragma unroll
    for (int j = 0; j < 4; ++j) { const int n = (lane >> 3) + 8 * j; const LAS float* s = scr + (8 * c) * 33 + n;
        v4u o; o.x = pk2(s[0 * 33], s[1 * 33]); o.y = pk2(s[2 * 33], s[3 * 33]); o.z = pk2(s[4 * 33], s[5 * 33]); o.w = pk2(s[6 * 33], s[7 * 33]);
        *(GAS v4u*)(WT + (size_t)(n0 + n) * K + k0 + 8 * c) = o; }
    LDS_WAIT(); asm volatile("" ::: "memory");
}
__device__ __forceinline__ void p0_x_row(const float* xrow, float* orow, bf16* hrow, float* ssq, int lane) {
    const GAS f32x4* xr = (const GAS f32x4*)xrow + lane; GAS f32x4* orr = (GAS f32x4*)orow + lane; GAS unsigned long long* h8 = (GAS unsigned long long*)hrow + lane;
    f32x4 v[4]; float s[4];
#pragma unroll
    for (int j = 0; j < 4; ++j) v[j] = xr[64 * j];
#pragma unroll
    for (int j = 0; j < 4; ++j) { orr[64 * j] = v[j]; h8[64 * j] = (unsigned long long)pk2(v[j].x, v[j].y) | ((unsigned long long)pk2(v[j].z, v[j].w) << 32);
        s[j] = wave_sum((v[j].x * v[j].x + v[j].y * v[j].y) + (v[j].z * v[j].z + v[j].w * v[j].w)); }
    if (lane < 16) { const int j = lane >> 2; const float sj = j == 0 ? s[0] : j == 1 ? s[1] : j == 2 ? s[2] : s[3]; ssq[lane] = (lane & 3) == 0 ? sj : 0.f; }
}
__device__ __forceinline__ void final_row(float* orow, const float* ssq, const float* g, int lane) {
    const float rs = pg8::row_rstd16(ssq, 0);
    GAS f32x4* orr = (GAS f32x4*)orow + lane; const GAS f32x4* gr = (const GAS f32x4*)g + lane;
#pragma unroll
    for (int j = 0; j < 4; ++j) { f32x4 v = orr[64 * j]; const f32x4 gv = gr[64 * j]; v = v * rs * gv; orr[64 * j] = v; }
}

__device__ __forceinline__ void diff_attn_unit_simple(LAS unsigned char* lds, int b, int h, int qblk, const bf16* Q, const bf16* K, const bf16* V, bf16* O, float lam, int tid) {
    LAS float* Ks = (LAS float*)lds; LAS float* Vs = (LAS float*)(lds + 64 * 65 * 4);
    const int qi = tid >> 2, part = tid & 3, q0 = qblk * 128, t = q0 + qi;
    const size_t rowbase = (size_t)b * T;
    const float slope2 = exp2f(-(float)(h + 1)) * LOG2E;
    float ores[32], o0[32], l0 = 0.f;
#pragma unroll 1
    for (int m = 0; m < 2; ++m) {
        float q[16];
        { const bf16* qp = Q + (rowbase + t) * D + h * 128 + m * 64 + part * 16;
#pragma unroll
          for (int i = 0; i < 16; ++i) q[i] = bf2f(qp[i]); }
        float mrun = NEG_BIG, l = 0.f, o[32];
#pragma unroll
        for (int e = 0; e < 32; ++e) o[e] = 0.f;
        const int nkt = q0 / 64 + 2;
        for (int kt = 0; kt < nkt; ++kt) {
            const int kb = kt * 64;
            __syncthreads();
            { const int key = tid >> 3, seg = tid & 7;
              const bf16* kp = K + (rowbase + kb + key) * D + h * 128 + m * 64 + seg * 8;
#pragma unroll
              for (int i = 0; i < 8; ++i) Ks[key * 65 + seg * 8 + i] = bf2f(kp[i]);
              const bf16* vp = V + (rowbase + kb + key) * D + h * 128 + seg * 16;
#pragma unroll
              for (int i = 0; i < 16; ++i) Vs[key * 129 + seg * 16 + i] = bf2f(vp[i]); }
            __syncthreads();
            for (int key = 0; key < 64; ++key) {
                float s = 0.f;
#pragma unroll
                for (int i = 0; i < 16; ++i) s = fmaf(q[i], Ks[key * 65 + part * 16 + i], s);
                s += __shfl_xor(s, 1); s += __shfl_xor(s, 2);
                const int kpos = kb + key;
                s += slope2 * (float)(kpos - t);
                if (kpos > t) s = -INFINITY;
                const float mn = fmaxf(mrun, s);
                const float alpha = exp2f(mrun - mn), p = exp2f(s - mn);
                mrun = mn; l = l * alpha + p;
#pragma unroll
                for (int e = 0; e < 32; ++e) o[e] = fmaf(p, Vs[key * 129 + part * 32 + e], o[e] * alpha);
            }
        }
        if (m == 0) {
#pragma unroll
            for (int e = 0; e < 32; ++e) o0[e] = o[e];
            l0 = l;
        } else {
            const float i0 = 1.0f / l0, i1 = lam / l;
#pragma unroll
            for (int e = 0; e < 32; ++e) ores[e] = o0[e] * i0 - o[e] * i1;
        }
    }
    float ss = 0.f;
#pragma unroll
    for (int e = 0; e < 32; ++e) ss = fmaf(ores[e], ores[e], ss);
    ss += __shfl_xor(ss, 1); ss += __shfl_xor(ss, 2);
    const float rs = 1.0f / sqrtf(ss * (1.0f / 128.0f) + RMS_EPS);
    bf16* op = O + (rowbase + t) * D + h * 128 + part * 32;
#pragma unroll
    for (int e = 0; e < 32; e += 2) *(unsigned*)(op + e) = pk2(ores[e] * rs, ores[e + 1] * rs);
    __syncthreads();
}
__device__ __forceinline__ void moba_unit_simple(int b, int h, int qblk, const bf16* Q, const bf16* K, const bf16* V, bf16* O, const float* KM, int tid) {
    const int qi = tid >> 2, part = tid & 3, q0 = qblk * 128, t = q0 + qi, j = q0 / 256;
    const size_t rowbase = (size_t)b * T;
    const float slope2 = exp2f(-0.5f * (float)(h + 1)) * LOG2E;
    float q[16];
    { const bf16* qp = Q + (rowbase + t) * D + h * 64 + part * 16;
#pragma unroll
      for (int i = 0; i < 16; ++i) q[i] = bf2f(qp[i]); }
    float b0 = -INFINITY, b1 = -INFINITY, b2 = -INFINITY; int i0 = 0, i1 = 0, i2 = 0;
    for (int n = 0; n < j; ++n) {
        const float* km = KM + (((size_t)b * 16 + h) * 32 + n) * 64 + part * 16;
        float g = 0.f;
#pragma unroll
        for (int i = 0; i < 16; ++i) g = fmaf(q[i], km[i], g);
        g += __shfl_xor(g, 1); g += __shfl_xor(g, 2);
        if (g > b0) { b2 = b1; i2 = i1; b1 = b0; i1 = i0; b0 = g; i0 = n; }
        else if (g > b1) { b2 = b1; i2 = i1; b1 = g; i1 = n; }
        else if (g > b2) { b2 = g; i2 = n; }
    }
    const int nsel = j < 3 ? j : 3;
    float mrun = NEG_BIG, l = 0.f, o[16];
#pragma unroll
    for (int e = 0; e < 16; ++e) o[e] = 0.f;
    for (int seg = 0; seg <= nsel; ++seg) {
        const int blk = seg == 0 ? j : (seg == 1 ? i0 : (seg == 2 ? i1 : i2));
        const int kb = blk * 256;
        for (int key = 0; key < 256; ++key) {
            const int kpos = kb + key;
            const bf16* kp = K + (rowbase + kpos) * D + h * 64 + part * 16;
            float s = 0.f;
#pragma unroll
            for (int i = 0; i < 16; ++i) s = fmaf(q[i], bf2f(kp[i]), s);
            s += __shfl_xor(s, 1); s += __shfl_xor(s, 2);
            s += slope2 * (float)(kpos - t);
            if (kpos > t) s = -INFINITY;
            const float mn = fmaxf(mrun, s);
            const float alpha = exp2f(mrun - mn), p = exp2f(s - mn);
            mrun = mn; l = l * alpha + p;
            const bf16* vp = V + (rowbase + kpos) * D + h * 64 + part * 16;
#pragma unroll
            for (int e = 0; e < 16; ++e) o[e] = fmaf(p, bf2f(vp[e]), o[e] * alpha);
        }
    }
    const float il = 1.0f / l;
    bf16* op = O + (rowbase + t) * D + h * 64 + part * 16;
#pragma unroll
    for (int e = 0; e < 16; e += 2) *(unsigned*)(op + e) = pk2(o[e] * il, o[e + 1] * il);
}

#define REP_QKV 1
#define REP_DIFF 1
#define REP_MOBA 1
#define REP_FF1 1
struct Args { const float* in[10]; float* out; unsigned char* ws; };
__global__ void __launch_bounds__(NWAVES * 64, 2) fwd_kernel(Args args) {
    extern __shared__ __attribute__((aligned(16))) unsigned char lds[];
    Frame F;
    F.lds = (LAS unsigned char*)lds;
    F.MISC = (volatile LAS unsigned*)(F.lds + MISC_OFF);
    F.tid = threadIdx.x; F.lane = F.tid & 63; F.wave = __builtin_amdgcn_readfirstlane(F.tid >> 6);
    F.G = gridDim.x; { const int bx = blockIdx.x; F.vcu = (F.G % 8 == 0) ? (bx % 8) * (F.G / 8) + bx / 8 : bx; }
    unsigned char* ws = args.ws;
    F.ctl = (gu32*)(ws + WS_CTL);
#define PTRS() \
    unsigned long long z_ = 0ull; asm volatile("" : "+s"(z_)); unsigned char* wsl = args.ws + z_; float* out = args.out + z_;     \
    bf16* WIN = (bf16*)(wsl + WS_WIN); bf16* WOUT = (bf16*)(wsl + WS_WOUT); bf16* WFF1 = (bf16*)(wsl + WS_WFF1); bf16* WFF2 = (bf16*)(wsl + WS_WFF2); \
    float* SSQ = (float*)(wsl + WS_SSQ); float* KM = (float*)(wsl + WS_KMEAN); \
    bf16* HB = (bf16*)(wsl + WS_HB); bf16* Qb = (bf16*)(wsl + WS_Q); bf16* Kb = (bf16*)(wsl + WS_K); bf16* Vb = (bf16*)(wsl + WS_V); bf16* Ob = (bf16*)(wsl + WS_O); \
    bf16* ACT = (bf16*)(wsl + WS_ACT); \
    (void)WIN; (void)WOUT; (void)WFF1; (void)WFF2; (void)SSQ; (void)KM; (void)HB; (void)Qb; (void)Kb; (void)Vb; (void)Ob; (void)ACT; (void)out
    for (int u = F.tid; u < (LDS_BYTES - LDSCTL_OFF) / 4; u += NWAVES * 64) ((LAS unsigned*)(F.lds + LDSCTL_OFF))[u] = 0u;
    __syncthreads();
    XcdBarrier bar = xcd_barrier_post((unsigned*)(F.ctl + CW_BAR), F.MISC + 8);
#define GRID_BAR() xcd_barrier(bar)
    const int gw = F.vcu * NWAVES + F.wave, NGW = F.G * NWAVES;

    {
        PTRS();
        const float* x = args.in[0]; const float* attn_norm = args.in[1]; const float* w_in = args.in[2]; const float* w_out = args.in[3];
        const float* diff_subln = args.in[5]; const float* mlp_norm = args.in[6]; const float* w_ff1 = args.in[7]; const float* w_ff2 = args.in[8];
        LAS float* scr = (LAS float*)(F.lds + RING_OFF + F.wave * 16384);
        constexpr int I_IN = (D / 64) * (NQKV / 32), I_OUT = (D / 64) * (D / 32), I_F1 = (D / 64) * (FF / 32), I_F2 = (FF / 64) * (D / 32);
        constexpr int PER_L = I_IN + I_OUT + I_F1 + I_F2;
        for (int it = gw; it < 2 * PER_L; it += NGW) {
            const int l = it / PER_L; int r = it % PER_L;
            if (r < I_IN) { p0_transpose_item(w_in + (size_t)l * D * NQKV, D, NQKV, WIN + (size_t)l * NQKV * D, scr, r, F.lane, attn_norm + l * D, D - 1, 1.0f, D, QSCALE); continue; } r -= I_IN;
            if (r < I_OUT) { p0_transpose_item(w_out + (size_t)l * D * D, D, D, WOUT + (size_t)l * D * D, scr, r, F.lane, l == 0 ? diff_subln : nullptr, 127, l == 0 ? 0.8f : 1.0f, 0, 1.0f); continue; } r -= I_OUT;
            if (r < I_F1) { p0_transpose_item(w_ff1 + (size_t)l * D * FF, D, FF, WFF1 + (size_t)l * FF * D, scr, r, F.lane, mlp_norm + l * D, D - 1, 1.0f, 0, 1.0f); continue; } r -= I_F1;
            p0_transpose_item(w_ff2 + (size_t)l * FF * D, FF, D, WFF2 + (size_t)l * D * FF, scr, r, F.lane, nullptr, 0, 1.0f, 0, 1.0f);
        }
        for (int m = gw; m < M; m += NGW) p0_x_row(x + (size_t)m * D, out + (size_t)m * D, HB + (size_t)m * D, SSQ + (size_t)m * 16, F.lane);
    }
    GRID_BAR();

#pragma unroll 1
    for (int l = 0; l < 2; ++l) {
        {
            PTRS();
            pg8::Gemm g{HB, WIN + (size_t)l * NQKV * D, M, NQKV, D}; pg8::StaticOrder S; S.init(M, NQKV, F.G, (int)blockIdx.x);
            pg8::EpiScaleBf16<0> E{Qb, D, SSQ, D, (size_t)M * D, (unsigned*)(F.ctl + CW_NRM + l * 256)};
            for (int rep = 0; rep < REP_QKV; ++rep)
            pg8::gemm_phase<pg8::EpiScaleBf16<0>, pg8::StaticOrder, PG8_ALIGN, PG8_SP2>(F.lds + RING_OFF, g, S, E);
        }
        GRID_BAR();
        if (l == 0) {
            PTRS();
            const float* lp = args.in[4];
            const float la = wave_sum(lp[F.lane] * lp[64 + F.lane]), lc = wave_sum(lp[128 + F.lane] * lp[192 + F.lane]);
            const float lam = expf(la) - expf(lc) + 0.2f;
            for (int rep = 0; rep < REP_DIFF; ++rep)
            for (;;) {
                if (F.tid == 0) F.MISC[16] = __hip_atomic_fetch_add(F.ctl + CW_QUEUE + 64 * rep, 1u, RLX_AGENT);
                __syncthreads();
                const int i = (int)F.MISC[16];
                __syncthreads();
                if (i >= 512) break;
                const int bh = i & 15, qb = 31 - (i >> 4);
                attn::diff_unit((char*)lds + RING_OFF, bh >> 3, bh & 7, qb, Qb, Kb, Vb, Ob, lam, (const unsigned*)(F.ctl + CW_NRM));
            }
        } else {
            { PTRS();
            for (int it = gw; it < 1024; it += NGW) {
                const int n = it & 31, h = (it >> 5) & 15, b = it >> 9; float s = 0.f;
                const bf16* kp = Kb + ((size_t)b * T + n * 256) * D + h * 64 + F.lane;
                for (int i = 0; i < 256; ++i) s += bf2f(kp[(size_t)i * D]);
                KM[(size_t)it * 64 + F.lane] = s * (1.0f / 256.0f);
            } }
            GRID_BAR();
            PTRS();
            for (int rep = 0; rep < REP_MOBA; ++rep)
            for (;;) {
                if (F.tid == 0) F.MISC[16] = __hip_atomic_fetch_add(F.ctl + CW_QUEUE + 64 * (4 + rep), 1u, RLX_AGENT);
                __syncthreads();
                const int i = (int)F.MISC[16];
                __syncthreads();
                if (i >= 1024) break;
                const int bh = i & 31, qb = 31 - (i >> 5);
                attn::moba_unit((char*)lds + RING_OFF, bh >> 4, bh & 15, qb, Qb, Kb, Vb, Ob, KM, (const unsigned*)(F.ctl + CW_NRM + 256));
            }
        }
        GRID_BAR();
        {
            PTRS();
            pg8::Gemm g{Ob, WOUT + (size_t)l * D * D, M, D, D}; pg8::StaticOrder S; S.init(M, D, F.G, (int)blockIdx.x);
            pg8::EpiRes E{out, HB, SSQ, D};
            pg8::gemm_phase<pg8::EpiRes, pg8::StaticOrder, PG8_ALIGN, PG8_SP2>(F.lds + RING_OFF, g, S, E);
        }
        GRID_BAR();
        {
            PTRS();
            pg8::Gemm g{HB, WFF1 + (size_t)l * FF * D, M, FF, D}; pg8::StaticOrder S; S.init(M, FF, F.G, (int)blockIdx.x);
            pg8::EpiScaleBf16<1> E{ACT, FF, SSQ, 0, 0, nullptr};
            for (int rep = 0; rep < REP_FF1; ++rep)
            pg8::gemm_phase<pg8::EpiScaleBf16<1>, pg8::StaticOrder, PG8_ALIGN, PG8_SP2>(F.lds + RING_OFF, g, S, E);
        }
        GRID_BAR();
        {
            PTRS();
            pg8::Gemm g{ACT, WFF2 + (size_t)l * D * FF, M, D, FF}; pg8::StaticOrder S; S.init(M, D, F.G, (int)blockIdx.x);
            pg8::EpiRes E{out, HB, SSQ, D};
            pg8::gemm_phase<pg8::EpiRes, pg8::StaticOrder, PG8_ALIGN, PG8_SP2>(F.lds + RING_OFF, g, S, E);
        }
        GRID_BAR();
    }
    PTRS(); const float* final_norm = args.in[9];
    for (int m = gw; m < M; m += NGW) final_row(out + (size_t)m * D, SSQ + (size_t)m * 16, final_norm, F.lane);
    if (xb_ld((unsigned*)(F.ctl + CW_BAR) + XB_TMO) != 0u && blockIdx.x == 0) { const float qn = __builtin_nanf(""); for (int i = F.tid; i < 4096; i += NWAVES * 64) out[i] = qn; }
}

extern "C" void kernel_launch(void* const* d_in, const int* in_sizes, int n_in, void* d_out, int out_size, void* d_ws, size_t ws_size, hipStream_t stream) {
    static int grid = 0;
    if (grid == 0) {
        if (n_in != 10 || in_sizes[0] != M * D || out_size != M * D || ws_size < WS_END) { fprintf(stderr, "kernel_launch: unexpected shapes (n_in %d out %d ws %zu); nothing launched\n", n_in, out_size, ws_size); grid = -1; return; }
        int dev = 0, cus = 0, per_cu = 0;
        if (hipGetDevice(&dev) != hipSuccess || hipDeviceGetAttribute(&cus, hipDeviceAttributeMultiprocessorCount, dev) != hipSuccess) { fprintf(stderr, "kernel_launch: device query failed\n"); grid = -1; return; }
        if (hipFuncSetAttribute((const void*)fwd_kernel, hipFuncAttributeMaxDynamicSharedMemorySize, LDS_BYTES) != hipSuccess) { fprintf(stderr, "kernel_launch: hipFuncSetAttribute failed\n"); grid = -1; return; }
        if (hipOccupancyMaxActiveBlocksPerMultiprocessor(&per_cu, (const void*)fwd_kernel, NWAVES * 64, LDS_BYTES) != hipSuccess || per_cu < 1) { fprintf(stderr, "kernel_launch: occupancy query reports %d workgroups per CU\n", per_cu); per_cu = 1; }
        (void)hipGetLastError();
        grid = cus;
    }
    if (grid < 0) return;
    if (hipMemsetAsync((char*)d_ws + WS_CTL, 0, CTL_ZERO_BYTES, stream) != hipSuccess) { fprintf(stderr, "kernel_launch: hipMemsetAsync failed\n"); return; }
    Args a{};
    for (int i = 0; i < 10; ++i) a.in[i] = (const float*)d_in[i];
    a.out = (float*)d_out; a.ws = (unsigned char*)d_ws;
    hipLaunchKernelGGL(fwd_kernel, dim3(grid), dim3(NWAVES * 64), LDS_BYTES, stream, a);
    const hipError_t le = hipPeekAtLastError();
    if (le != hipSuccess) fprintf(stderr, "kernel_launch: launch failed: %s\n", hipGetErrorName(le));
}
```

```cpp
#include <hip/hip_runtime.h>
#include <cstdio>
#include <cstdint>
#define AT_PROBE 0
#define AT_PROBE_WAVE 0
#define AT_PROBE_Q 16.0f
#define AT_PROBE_DV 128

constexpr int BATCH = 2, T = 8192, D = 1024, M = BATCH * T, FF = 4096, NQKV = 3 * D;
constexpr float RMS_EPS = 1e-6f;
constexpr float LOG2E = 1.4426950408889634f;
constexpr float QSCALE = 0.125f * LOG2E;
constexpr float NEG_BIG = -1e30f;

constexpr size_t MiB = 1u << 20;
constexpr size_t WS_CTL = 0, CTL_ZERO_BYTES = 1 * MiB;
constexpr size_t WS_WIN = 1 * MiB;
constexpr size_t WS_WOUT = 13 * MiB;
constexpr size_t WS_WFF1 = 17 * MiB;
constexpr size_t WS_WFF2 = 33 * MiB;
constexpr size_t WS_SSQ = 49 * MiB;
constexpr size_t WS_KMEAN = 50 * MiB;
constexpr size_t WS_HB = 51 * MiB;
constexpr size_t WS_Q = 83 * MiB, WS_K = 115 * MiB, WS_V = 147 * MiB, WS_O = 179 * MiB;
constexpr size_t WS_ACT = 83 * MiB;
constexpr size_t WS_END = 211 * MiB;
constexpr int CW_TMO = 0, CW_CODE = 1, CW_BAR = 4096;
constexpr int CW_NRM = 8192;
constexpr int CW_DFLAG = 12288;
constexpr int CW_QUEUE = 9216;
namespace pg8 {
#define PG8_LAS __attribute__((address_space(3)))
typedef unsigned short bf16_t;
typedef short bf16x8 __attribute__((ext_vector_type(8)));
typedef float f32x4 __attribute__((ext_vector_type(4)));
typedef unsigned u32x4 __attribute__((ext_vector_type(4)));
constexpr int BM = 256, BK = 64, HALF = 128, HTB = HALF * BK * 2  , STAGE_BYTES = 8 * HTB, NXCD = 8, WGM = 8;

__host__ __device__ __forceinline__ int lds_byte(int r, int c) { const int st = (r >> 4) * 2 + (c >> 5), rr = r & 15, cc = c & 31, ob = rr * 64 + cc * 2; return st * 1024 + (ob ^ (((ob >> 9) & 1) << 5)); }
__host__ __device__ __forceinline__ void stage_rc(int b, int& R, int& C) { const int st = b / 1024, sb = b % 1024, swz = sb ^ (((sb >> 9) & 1) << 5); R = (st >> 1) * 16 + swz / 64; C = (st & 1) * 32 + (swz % 64) / 2; }
__host__ __device__ __forceinline__ int perm32(int rho) { const int n = rho >> 4, i = rho & 15; return 8 * (i >> 2) + 4 * n + (i & 3); }

struct Unit { int pm, pn; };
struct Gemm { const bf16_t* A; const bf16_t* Bt; int M, N, K; };

struct StaticOrder {
    int nM, nN, nwg, G, c;
    __host__ __device__ void init(int M, int N, int G_, int c_) { nM = M / BM; nN = N / BM; nwg = nM * nN; G = G_; c = c_; }
    __host__ __device__ bool next(int i, Unit& u) const {
        const long L = (long)i * G + c; if (L >= nwg) return false;
        int wgid = (int)L; { const int q = nwg / NXCD, r = nwg % NXCD, xcd = wgid % NXCD, off = wgid / NXCD; wgid = (xcd < r ? xcd * (q + 1) : r * (q + 1) + (xcd - r) * q) + off; }
        const int nig = WGM * nN, gid = wgid / nig, fm = gid * WGM, gsz = (nM - fm) < WGM ? (nM - fm) : WGM;
        u.pm = fm + ((wgid % nig) % gsz); u.pn = (wgid % nig) / gsz; return true;
    }
    __device__ __forceinline__ void a_ready(const Unit&) const {}
    __device__ __forceinline__ void done(const Unit&) const {}
};


__device__ __forceinline__ unsigned cvt_pk_bf16(float lo, float hi) { unsigned r; asm volatile("v_cvt_pk_bf16_f32 %0, %1, %2" : "=v"(r) : "v"(lo), "v"(hi)); return r; }
__device__ __forceinline__ float row_rstd16(const float* SSQ, int row) {
    const f32x4* p = (const f32x4*)(SSQ + (size_t)row * 16);
    const f32x4 a = p[0], b = p[1], c = p[2], d = p[3];
    const float s = ((a[0] + a[1]) + (a[2] + a[3])) + ((b[0] + b[1]) + (b[2] + b[3])) + ((c[0] + c[1]) + (c[2] + c[3])) + ((d[0] + d[1]) + (d[2] + d[3]));
    return 1.0f / sqrtf(s * (1.0f / 1024.0f) + 1e-6f);
}
template <int ACT> struct EpiScaleBf16 {
    static constexpr bool PERM = true, AFTER_DRAIN = false;
    bf16_t* O; int ldc; const float* SSQ; int split_cols; size_t split_stride;
    unsigned* NRM;
    __device__ __forceinline__ void operator()(const f32x4 (&acc)[2][2][4][2], const Unit& u, int wr, int wc, int fr, int fq) const {
        const int row0 = u.pm * BM + wr * 64 + fr; int colt = u.pn * BM; bf16_t* base = O; int t = 0;
        if (split_cols) { t = colt / split_cols; base += (size_t)t * split_stride; colt -= t * split_cols; }
        const int col0 = colt + wc * 32 + 8 * fq;
        const int lane = fq * 16 + fr; float myrs[2];
#pragma unroll
        for (int ai = 0; ai < 2; ++ai) myrs[ai] = row_rstd16(SSQ, u.pm * BM + wr * 64 + ai * HALF + lane);
        asm volatile("" : "+v"(myrs[0]), "+v"(myrs[1]));
        float mx[2] = {0.f, 0.f};
#pragma unroll
        for (int ai = 0; ai < 2; ++ai)
#pragma unroll
            for (int m = 0; m < 4; ++m) { const int row = row0 + ai * HALF + m * 16; const float rs = __shfl(myrs[ai], m * 16 + fr); bf16_t* rowp = base + (size_t)row * ldc + col0;
#pragma unroll
                for (int bj = 0; bj < 2; ++bj) { f32x4 v0 = acc[ai][bj][m][0] * rs, v1 = acc[ai][bj][m][1] * rs;
                    if (ACT == 1) {
#pragma unroll
                        for (int e = 0; e < 4; ++e) { const float a = __builtin_fmaxf(v0[e], 0.f), b = __builtin_fmaxf(v1[e], 0.f); v0[e] = a * a; v1[e] = b * b; } }
                    if (ACT == 0 && NRM && t < 2) { float q = (v0[0] * v0[0] + v0[1] * v0[1]) + (v0[2] * v0[2] + v0[3] * v0[3]) + (v1[0] * v1[0] + v1[1] * v1[1]) + (v1[2] * v1[2] + v1[3] * v1[3]);
                        q += __shfl_xor(q, 16); q += __shfl_xor(q, 32); mx[bj] = __builtin_fmaxf(mx[bj], q); }
                    u32x4 w; w.x = cvt_pk_bf16(v0[0], v0[1]); w.y = cvt_pk_bf16(v0[2], v0[3]); w.z = cvt_pk_bf16(v1[0], v1[1]); w.w = cvt_pk_bf16(v1[2], v1[3]);
                    *(u32x4*)(rowp + bj * HALF) = w; } }
        if (ACT == 0 && NRM && t < 2) {
#pragma unroll
            for (int bj = 0; bj < 2; ++bj) { float q = mx[bj];
#pragma unroll
                for (int o = 1; o < 16; o <<= 1) q = __builtin_fmaxf(q, __shfl_xor(q, o));
                const int col = colt + bj * HALF + wc * 32;
                if (lane == 0) atomicMax(NRM + (((t * 2 + (u.pm >> 5)) * 16 + (col >> 6)) * 2 + ((col >> 5) & 1)), __float_as_uint(q)); }
        }
    }
};
struct EpiRes {
    static constexpr bool PERM = false, AFTER_DRAIN = false;
    float* out; bf16_t* HB; float* SSQ; int ldc;
    __device__ __forceinline__ void operator()(const f32x4 (&acc)[2][2][4][2], const Unit& u, int wr, int wc, int fr, int fq) const {
        typedef unsigned u32x2v __attribute__((ext_vector_type(2)));
        const int col0 = u.pn * BM + wc * 32 + 4 * fq;
#pragma unroll
        for (int ai = 0; ai < 2; ++ai)
#pragma unroll
            for (int m = 0; m < 4; ++m) { const int row = u.pm * BM + ai * HALF + wr * 64 + m * 16 + fr; const size_t off = (size_t)row * ldc + col0; float s = 0.f;
#pragma unroll
                for (int bj = 0; bj < 2; ++bj)
#pragma unroll
                    for (int n = 0; n < 2; ++n) { const size_t o2 = off + bj * HALF + n * 16; const f32x4 h = *(const f32x4*)(out + o2) + acc[ai][bj][m][n]; *(f32x4*)(out + o2) = h;
                        u32x2v w; w.x = cvt_pk_bf16(h[0], h[1]); w.y = cvt_pk_bf16(h[2], h[3]); *(u32x2v*)(HB + o2) = w;
                        s += (h[0] * h[0] + h[1] * h[1]) + (h[2] * h[2] + h[3] * h[3]); }
                s += __shfl_xor(s, 16); s += __shfl_xor(s, 32);
                if (fq == 0) SSQ[(size_t)row * 16 + u.pn * 4 + wc] = s;
                if (m & 1) asm volatile("" ::: "memory"); }
    }
};
template <class Epi, class Sched, bool ALIGN_EPI = false, bool SP2 = false>
__device__ __forceinline__ void gemm_phase(PG8_LAS unsigned char* lds, const Gemm g, const Sched& S, const Epi& E) {
    int tid_ = threadIdx.x; asm volatile("" : "+v"(tid_));
    const int tid = tid_, wid = __builtin_amdgcn_readfirstlane(tid >> 6), lane = tid & 63, wr = wid >> 2, wc = wid & 3, fr = lane & 15, fq = lane >> 4;
    const int K = g.K, nt = K / BK;
    unsigned voffA[2], voffB[2];
#pragma unroll
    for (int i = 0; i < 2; ++i) { int R, C; stage_rc(tid * 16 + i * 8192, R, C); const int Rb = Epi::PERM ? ((R & ~31) + perm32(R & 31)) : R;
        voffA[i] = (unsigned)(R * K + C) * 2u; voffB[i] = (unsigned)(Rb * K + C) * 2u; }
    const size_t kstep = (size_t)(BK * 2);
    const size_t hstep = (size_t)HALF * K * 2;
    const size_t tstep = 2 * hstep;
    const unsigned ldsw = (unsigned)wid * 1024u;
    const int aoff = lds_byte(wr * 64 + fr, fq * 8), boff = lds_byte(wc * 32 + fr, fq * 8);
#define PG8_SA(b, h) (((b) * 2 + (h)) * HTB)
#define PG8_SB(b, h) ((4 + (b) * 2 + (h)) * HTB)
#define PG8_STAGE(bufoff, gbase, voff) do { _Pragma("unroll") for (int _i = 0; _i < 2; ++_i) \
        __builtin_amdgcn_global_load_lds((const unsigned*)((const char*)(gbase) + (voff)[_i]), (PG8_LAS unsigned*)(lds + (bufoff) + ldsw + _i * 8192), 16, 0, 0); } while (0)
#define PG8_LDA(dst, b, h) do { _Pragma("unroll") for (int m = 0; m < 4; ++m) _Pragma("unroll") for (int k = 0; k < 2; ++k) dst[m][k] = *(const PG8_LAS bf16x8*)(lds + PG8_SA(b, h) + aoff + m * 2048 + k * 1024); } while (0)
#define PG8_LDB(dst, b, h) do { _Pragma("unroll") for (int n = 0; n < 2; ++n) _Pragma("unroll") for (int k = 0; k < 2; ++k) dst[n][k] = *(const PG8_LAS bf16x8*)(lds + PG8_SB(b, h) + boff + n * 2048 + k * 1024); } while (0)
#define PG8_MMA(ai, bj, At, Bt) do { __builtin_amdgcn_s_setprio(1); _Pragma("unroll") for (int m = 0; m < 4; ++m) _Pragma("unroll") for (int n = 0; n < 2; ++n) _Pragma("unroll") for (int k = 0; k < 2; ++k) \
        acc[ai][bj][m][n] = __builtin_amdgcn_mfma_f32_16x16x32_bf16(Bt[n][k], At[m][k], acc[ai][bj][m][n], 0, 0, 0); __builtin_amdgcn_s_setprio(0); } while (0)
#define PG8_WAIT_V(n) asm volatile("s_waitcnt vmcnt(" #n ")" ::: "memory")
#define PG8_WAIT_L(n) asm volatile("s_waitcnt lgkmcnt(" #n ")" ::: "memory")
#define PG8_BAR __builtin_amdgcn_s_barrier()
#define PG8_SCHED __builtin_amdgcn_sched_barrier(0)
    Unit cur, nxt; int ui = 0;
    if (!S.next(0, cur)) return;
    f32x4 acc[2][2][4][2];
#pragma unroll
    for (int a = 0; a < 2; ++a)
#pragma unroll
        for (int b = 0; b < 2; ++b)
#pragma unroll
            for (int m = 0; m < 4; ++m)
#pragma unroll
                for (int n = 0; n < 2; ++n) acc[a][b][m][n] = (f32x4){0.f, 0.f, 0.f, 0.f};
    bf16x8 At[4][2], B0[2][2], B1[2][2];
    const char* cA = (const char*)g.A + (size_t)cur.pm * tstep; const char* cB = (const char*)g.Bt + (size_t)cur.pn * tstep;
    S.a_ready(cur);
    if constexpr (SP2) {
        PG8_STAGE(PG8_SB(0, 0), cB, voffB); PG8_STAGE(PG8_SB(0, 1), cB + hstep, voffB); PG8_STAGE(PG8_SA(0, 0), cA, voffA); PG8_STAGE(PG8_SA(0, 1), cA + hstep, voffA);
        if (wr == 1) PG8_BAR;
        PG8_WAIT_V(2); PG8_BAR;
        PG8_STAGE(PG8_SB(1, 0), cB + kstep, voffB); PG8_STAGE(PG8_SA(1, 0), cA + kstep, voffA); PG8_STAGE(PG8_SB(1, 1), cB + hstep + kstep, voffB);
        PG8_WAIT_V(6); PG8_BAR;
    } else {
        PG8_STAGE(PG8_SB(0, 0), cB, voffB); PG8_STAGE(PG8_SA(0, 0), cA, voffA); PG8_STAGE(PG8_SB(0, 1), cB + hstep, voffB); PG8_STAGE(PG8_SA(0, 1), cA + hstep, voffA);
        if (wr == 1) PG8_BAR;
        PG8_WAIT_V(4); PG8_BAR;
        PG8_STAGE(PG8_SB(1, 0), cB + kstep, voffB); PG8_STAGE(PG8_SA(1, 0), cA + kstep, voffA); PG8_STAGE(PG8_SB(1, 1), cB + hstep + kstep, voffB);
        PG8_WAIT_V(6); PG8_BAR;
    }
    for (;;) {
        const bool has_next = S.next(ui + 1, nxt);
        const char* nA = has_next ? (const char*)g.A + (size_t)nxt.pm * tstep : cA; const char* nB = has_next ? (const char*)g.Bt + (size_t)nxt.pn * tstep : cB;
        for (int t = 0; t < nt; t += 2) {
            const bool last = (t == nt - 2);
            const char* a1 = cA + (size_t)(t + 1) * kstep;
            const char* a2 = last ? nA : cA + (size_t)(t + 2) * kstep; const char* b2 = last ? nB : cB + (size_t)(t + 2) * kstep;
            const char* a3 = a2 + kstep; const char* b3 = b2 + kstep;
            if (last && has_next) S.a_ready(nxt);
            if constexpr (SP2) {
            PG8_LDB(B0, 0, 0); PG8_LDB(B1, 0, 1); PG8_SCHED; PG8_LDA(At, 0, 0); PG8_STAGE(PG8_SA(1, 1), a1 + hstep, voffA);
            PG8_WAIT_V(8); PG8_WAIT_L(0); PG8_BAR; PG8_MMA(0, 0, At, B0); PG8_MMA(0, 1, At, B1); PG8_BAR; PG8_SCHED;
            PG8_LDA(At, 0, 1); PG8_STAGE(PG8_SB(0, 0), b2, voffB); PG8_STAGE(PG8_SB(0, 1), b2 + hstep, voffB); PG8_STAGE(PG8_SA(0, 0), a2, voffA);
            PG8_WAIT_V(8); PG8_WAIT_L(0); PG8_BAR; PG8_MMA(1, 0, At, B0); PG8_MMA(1, 1, At, B1); PG8_BAR; PG8_SCHED;
            PG8_LDB(B0, 1, 0); PG8_LDB(B1, 1, 1); PG8_SCHED; PG8_LDA(At, 1, 0); PG8_STAGE(PG8_SA(0, 1), a2 + hstep, voffA);
            PG8_WAIT_V(8); PG8_WAIT_L(0); PG8_BAR; PG8_MMA(0, 0, At, B0); PG8_MMA(0, 1, At, B1); PG8_BAR; PG8_SCHED;
            PG8_LDA(At, 1, 1); PG8_STAGE(PG8_SB(1, 0), b3, voffB); PG8_STAGE(PG8_SB(1, 1), b3 + hstep, voffB); PG8_STAGE(PG8_SA(1, 0), a3, voffA);
            PG8_WAIT_V(8); PG8_WAIT_L(0); PG8_BAR; PG8_MMA(1, 0, At, B0); PG8_MMA(1, 1, At, B1); PG8_BAR; PG8_SCHED;
            } else {
            PG8_LDB(B0, 0, 0); PG8_SCHED; PG8_LDA(At, 0, 0); PG8_STAGE(PG8_SA(1, 1), a1 + hstep, voffA);
            PG8_WAIT_L(8); PG8_BAR; PG8_WAIT_L(0); PG8_MMA(0, 0, At, B0); PG8_BAR; PG8_SCHED;
            PG8_LDB(B1, 0, 1); PG8_STAGE(PG8_SB(0, 0), b2, voffB);
            PG8_BAR; PG8_WAIT_L(0); PG8_MMA(0, 1, At, B1); PG8_BAR;
            PG8_LDA(At, 0, 1); PG8_STAGE(PG8_SA(0, 0), a2, voffA);
            PG8_BAR; PG8_WAIT_L(0); PG8_MMA(1, 0, At, B0); PG8_BAR; PG8_SCHED;
            PG8_STAGE(PG8_SB(0, 1), b2 + hstep, voffB);
            PG8_WAIT_V(6); PG8_BAR; PG8_MMA(1, 1, At, B1); PG8_BAR;
            PG8_LDB(B0, 1, 0); PG8_SCHED; PG8_LDA(At, 1, 0); PG8_STAGE(PG8_SA(0, 1), a2 + hstep, voffA);
            PG8_WAIT_L(8); PG8_BAR; PG8_WAIT_L(0); PG8_MMA(0, 0, At, B0); PG8_BAR; PG8_SCHED;
            PG8_LDB(B1, 1, 1); PG8_STAGE(PG8_SB(1, 0), b3, voffB);
            PG8_BAR; PG8_WAIT_L(0); PG8_MMA(0, 1, At, B1); PG8_BAR;
            PG8_LDA(At, 1, 1); PG8_STAGE(PG8_SA(1, 0), a3, voffA);
            PG8_BAR; PG8_WAIT_L(0); PG8_MMA(1, 0, At, B0); PG8_BAR; PG8_SCHED;
            PG8_STAGE(PG8_SB(1, 1), b3 + hstep, voffB);
            PG8_WAIT_V(6); PG8_BAR; PG8_MMA(1, 1, At, B1); PG8_BAR;
            }
        }
        if constexpr (ALIGN_EPI) { if (wr == 0) PG8_BAR; }
        if constexpr (!Epi::AFTER_DRAIN) { E(acc, cur, wr, wc, fr, fq); S.done(cur); }
        if (!has_next) break;
#pragma unroll
        for (int a = 0; a < 2; ++a)
#pragma unroll
            for (int b = 0; b < 2; ++b)
#pragma unroll
                for (int m = 0; m < 4; ++m)
#pragma unroll
                    for (int n = 0; n < 2; ++n) acc[a][b][m][n] = (f32x4){0.f, 0.f, 0.f, 0.f};
        cur = nxt; cA = nA; cB = nB; ++ui;
        if constexpr (ALIGN_EPI) { if (wr == 1) PG8_BAR; }
    }
    PG8_WAIT_V(0);
    if constexpr (!ALIGN_EPI) { if (wr == 0) PG8_BAR; }
    PG8_BAR;
    if constexpr (Epi::AFTER_DRAIN) { E.fused(acc, cur, wr, wc, fr, fq, lds, wid, lane); S.done(cur); }
#undef PG8_SA
#undef PG8_SB
#undef PG8_STAGE
#undef PG8_LDA
#undef PG8_LDB
#undef PG8_MMA
#undef PG8_WAIT_V
#undef PG8_WAIT_L
#undef PG8_BAR
#undef PG8_SCHED
}
}

#ifndef PG8_SP2
#define PG8_SP2 true
#endif
#ifndef PG8_ALIGN
#define PG8_ALIGN true
#endif
#define GAS __attribute__((address_space(1)))
#define LAS __attribute__((address_space(3)))
typedef unsigned short bf16;
typedef unsigned v4u __attribute__((ext_vector_type(4)));
typedef float f32x4 __attribute__((ext_vector_type(4)));
typedef short bf16x8 __attribute__((ext_vector_type(8)));
typedef GAS unsigned gu32;
typedef GAS unsigned long long gu64;
#define RLX_AGENT __ATOMIC_RELAXED, __HIP_MEMORY_SCOPE_AGENT
#define LDS_WAIT() asm volatile("s_waitcnt lgkmcnt(0)" ::: "memory")
#define VM_WAIT() asm volatile("s_waitcnt vmcnt(0)" ::: "memory")
__device__ __forceinline__ unsigned long long rt() { return __builtin_amdgcn_s_memrealtime(); }
__device__ __forceinline__ unsigned f2bf(float f) { unsigned u = __builtin_bit_cast(unsigned, f); return (u + 0x7fffu + ((u >> 16) & 1u)) >> 16; }
__device__ __forceinline__ unsigned pk2(float lo, float hi) { return f2bf(lo) | (f2bf(hi) << 16); }

#define XB_TMO      128
#define XB_XCNT(j)  (256  + 64 * (j))
#define XB_XSUB(j)  (1280 + 64 * (j))
#define XB_XGEN(j)  (2304 + 64 * (j))
#define XB_TOP      3328
#define XB_TOPGEN   3392
#define XCD_BAR_WORDS 3456
#define XB_SPIN_CAP (1u << 18)

__device__ __forceinline__ unsigned xb_ld(unsigned* p)              { return __hip_atomic_load(p, __ATOMIC_RELAXED, __HIP_MEMORY_SCOPE_AGENT); }
__device__ __forceinline__ unsigned xb_add(unsigned* p, unsigned v) { return __hip_atomic_fetch_add(p, v, __ATOMIC_RELAXED, __HIP_MEMORY_SCOPE_AGENT); }
__device__ __forceinline__ unsigned xb_xcc_id() { return (unsigned)__builtin_amdgcn_s_getreg((3 << 11) | 20) & 0xFu; }
#define XB_SPIN(cond, bar) do { unsigned _sp = 0; while (cond) { __builtin_amdgcn_s_sleep(1); \
    if ((++_sp & 255u) == 0u) { if (xb_ld(&(bar)[XB_TMO])) break; if (_sp > XB_SPIN_CAP) { atomicAdd(&(bar)[XB_TMO], 1u); break; } } } } while (0)

struct XcdBarrier {
    unsigned* bar; unsigned x;
    volatile LAS unsigned* st;
};

__device__ __forceinline__ XcdBarrier xcd_barrier_post(unsigned* bar, volatile LAS unsigned* st) {
    XcdBarrier b; b.bar = bar; b.x = xb_xcc_id(); b.st = st;
    if (threadIdx.x == 0) (void)xb_add(&bar[XB_XCNT(b.x)], 1u);
    return b;
}
__device__ __forceinline__ void xcd_barrier_complete(unsigned* bar, unsigned x, unsigned& nloc, unsigned& nx) {
    const unsigned G = gridDim.x * gridDim.y * gridDim.z;
    unsigned sum, cnt, mine, sp = 0u;
    for (;;) {
        sum = 0u; cnt = 0u; mine = 0u;
#pragma unroll
        for (unsigned j = 0; j < 16; ++j) { const unsigned c = xb_ld(&bar[XB_XCNT(j)]); sum += c; cnt += (c > 0u) ? 1u : 0u; mine = (j == x) ? c : mine; }
        if (sum == G) break;
        __builtin_amdgcn_s_sleep(1);
        if ((++sp & 255u) == 0u) { if (xb_ld(&bar[XB_TMO])) break; if (sp > XB_SPIN_CAP) { atomicAdd(&bar[XB_TMO], 1u); break; } }
    }
    nloc = mine > 0u ? mine : 1u; nx = cnt > 0u ? cnt : 1u;
}

__device__ __forceinline__ void xcd_barrier(const XcdBarrier& b) {
    asm volatile("s_waitcnt vmcnt(0)" ::: "memory");
    __syncthreads();
    if (threadIdx.x == 0) {
        unsigned* bar = b.bar; unsigned bx_ = b.x; asm volatile("" : "+s"(bx_));
        __builtin_amdgcn_s_waitcnt(0);
        unsigned nloc = b.st[0], nx = b.st[1];
        if (nloc == 0u) { xcd_barrier_complete(bar, bx_, nloc, nx); b.st[0] = nloc; b.st[1] = nx; }
        const unsigned old = xb_add(&bar[XB_XSUB(bx_)], 1u);
        const unsigned gen = old / nloc;
        if (old + 1u == (gen + 1u) * nloc) {
            __builtin_amdgcn_fence(__ATOMIC_RELEASE, "agent");
            asm volatile("s_waitcnt vmcnt(0)" ::: "memory");
            const unsigned og = xb_add(&bar[XB_TOP], 1u);
            const unsigned tg = og / nx;
            if (og + 1u == (tg + 1u) * nx) xb_add(&bar[XB_TOPGEN], 1u);
            else XB_SPIN(xb_ld(&bar[XB_TOPGEN]) == tg, bar);
            __builtin_amdgcn_fence(__ATOMIC_ACQUIRE, "agent");
            xb_add(&bar[XB_XGEN(bx_)], 1u);
            asm volatile("s_waitcnt vmcnt(0)" ::: "memory");
        } else {
            XB_SPIN(xb_ld(&bar[XB_XGEN(bx_)]) == gen, bar);
            __builtin_amdgcn_fence(__ATOMIC_ACQUIRE, "agent");
            asm volatile("s_waitcnt vmcnt(0)" ::: "memory");
        }
    }
    __syncthreads();
}

namespace attn {
typedef unsigned short bf16;
using bf16x8 = __attribute__((ext_vector_type(8))) short;
using s16x4 = __attribute__((ext_vector_type(4))) short;
using f32x16 = __attribute__((ext_vector_type(16))) float;
using u32x4 = __attribute__((ext_vector_type(4))) unsigned;
typedef __attribute__((address_space(3))) const char* lds_cptr;
typedef __attribute__((address_space(3))) char* lds_ptr;
typedef short v4i16_t __attribute__((ext_vector_type(4)));
constexpr int DM = 1024, SEQ = 8192, KVBLK = 64;
constexpr int KSLOT = 8192;
constexpr float THR = 8.0f;
#ifndef AT_PROBE
#define AT_PROBE 0
#endif
__device__ unsigned long long g_probe[8];
template <int DV, int AH> struct Lay {
    static constexpr int VSLOT = DV * 128, NKSLOT = AH + 1, NVSLOT = AH + 2, LDS_K = 0, LDS_V = NKSLOT * KSLOT, LDS_WS = LDS_V + NVSLOT * VSLOT, LDS_OST = LDS_WS + 8 * 256, OSTW = 32 * DV * 2, BYTES = LDS_OST + 8 * OSTW;
};
#define AT_SBAR() __builtin_amdgcn_sched_barrier(0)
#define AT_WAIT_BAR(N) asm volatile("s_waitcnt vmcnt(" #N ") lgkmcnt(0)\n\ts_barrier" ::: "memory")
__device__ __forceinline__ void wait_bar_n(int n) {
    switch (n) {
        case 0: AT_WAIT_BAR(0); break; case 1: AT_WAIT_BAR(1); break; case 2: AT_WAIT_BAR(2); break; case 3: AT_WAIT_BAR(3); break;
        case 4: AT_WAIT_BAR(4); break; case 5: AT_WAIT_BAR(5); break; case 6: AT_WAIT_BAR(6); break; case 7: AT_WAIT_BAR(7); break;
        case 8: AT_WAIT_BAR(8); break; case 9: AT_WAIT_BAR(9); break; case 10: AT_WAIT_BAR(10); break; case 11: AT_WAIT_BAR(11); break;
        case 12: AT_WAIT_BAR(12); break; case 13: AT_WAIT_BAR(13); break; case 14: AT_WAIT_BAR(14); break; default: AT_WAIT_BAR(15); break;
    }
}
__device__ __forceinline__ int crow(int r, int hi) { return (r & 3) + 8 * (r >> 2) + 4 * hi; }
__device__ __forceinline__ unsigned f2bf_u(float f) { unsigned u = __builtin_bit_cast(unsigned, f); return (u + 0x7fffu + ((u >> 16) & 1u)) >> 16; }
__device__ __forceinline__ float bf2f_u(unsigned h) { return __builtin_bit_cast(float, h << 16); }
__device__ __forceinline__ void glds16(const void* gsrc, unsigned lds_dst) { unsigned keep;
    asm volatile("s_mov_b32 %0, m0\n\ts_mov_b32 m0, %2\n\ts_nop 0\n\tglobal_load_lds_dwordx4 %1, off\n\ts_mov_b32 m0, %0" : "=&s"(keep) : "v"(gsrc), "s"(lds_dst) : "memory"); }
typedef float f32x2_t __attribute__((ext_vector_type(2))); typedef __bf16 bf16x2_t __attribute__((ext_vector_type(2)));
__device__ __forceinline__ unsigned cvtpk_s(float lo, float hi) { f32x2_t v = {lo, hi}; bf16x2_t b = __builtin_convertvector(v, bf16x2_t); return __builtin_bit_cast(unsigned, b); }
__device__ __forceinline__ s16x4 vtr(lds_cptr p) { return __builtin_bit_cast(s16x4, __builtin_amdgcn_ds_read_tr16_b64_v4i16((__attribute__((address_space(3))) v4i16_t*)p)); }
#define AT_MX3(a, b, c) __builtin_fmaxf(__builtin_fmaxf((a), (b)), (c))
#define AT_MFMA(a, b, c) __builtin_amdgcn_mfma_f32_32x32x16_bf16(a, b, c, 0, 0, 0)
__device__ __forceinline__ float rowmax(const f32x16& p0, const f32x16& p1) {
    float a = AT_MX3(p0[0], p0[1], p1[0]), b = AT_MX3(p0[2], p0[3], p1[1]); a = AT_MX3(a, p1[2], p1[3]);
#pragma unroll
    for (int r = 4; r < 16; r += 4) { a = AT_MX3(a, p0[r], p0[r + 1]); b = AT_MX3(b, p0[r + 2], p0[r + 3]); a = AT_MX3(a, p1[r], p1[r + 1]); b = AT_MX3(b, p1[r + 2], p1[r + 3]); }
    float m = __builtin_fmaxf(a, b); auto rr = __builtin_amdgcn_permlane32_swap(__float_as_uint(m), __float_as_uint(m), false, false);
    return __builtin_fmaxf(__uint_as_float(rr[0]), __uint_as_float(rr[1])); }
__device__ __forceinline__ void cmask(f32x16& p0, f32x16& p1, int jb, int qrel, int hi) {
    const int kb = 64 * jb + 4 * hi;
#pragma unroll
    for (int r = 0; r < 16; ++r) { const int kv = kb + (r & 3) + 8 * (r >> 2); if (kv > qrel) p0[r] = -INFINITY; if (kv + 32 > qrel) p1[r] = -INFINITY; } }

template <int DV, bool MOBA, int AH>
__device__ __forceinline__ void sweep(char* shm, const bf16* Qw, const bf16* __restrict__ Kh, const bf16* __restrict__ Vh, int qb, int kt_min, float slope2, unsigned sel, f32x16 (&o)[DV / 32], float& l_out) {
    typedef Lay<DV, AH> L;
    constexpr int NPV = DV / 64, NPT = 1 + NPV;
    int tid_ = threadIdx.x; asm volatile("" : "+v"(tid_));
    const int tid = tid_, lane = tid & 63, r32 = lane & 31, hi = lane >> 5; const int wid = __builtin_amdgcn_readfirstlane(tid >> 6);
    const unsigned lds0 = (unsigned)(uintptr_t)shm;
    const lds_ptr shm3 = (lds_ptr)shm;
    __attribute__((address_space(3))) float* wsf = (__attribute__((address_space(3))) float*)(shm3 + L::LDS_WS) + wid * 64;
    const int NT = 4 * qb + 4 - kt_min;
    const bf16* ksrc = Kh + (long)lane * DM + wid * 8;
    const bf16* vsrc0 = Vh + (long)(16 * (wid & 3) + (lane >> 2)) * DM + (wid >> 2) * 32 + (lane & 3) * 8;
    const unsigned kdst = lds0 + L::LDS_K + wid * 1024, vdst = lds0 + L::LDS_V + wid * 1024;
#define AT_KT(i) (MOBA ? ((i) < 4 ? 4 * qb + (i) : (i) - 4 + kt_min) : (i) + kt_min)
#define AT_DMA(i, ksl, vsl) do { if ((i) >= NT) break; const long kt_ = AT_KT(i); glds16(ksrc + kt_ * KVBLK * DM, (unsigned)__builtin_amdgcn_readfirstlane(kdst + (ksl) * KSLOT)); \
        glds16(vsrc0 + kt_ * KVBLK * DM, (unsigned)__builtin_amdgcn_readfirstlane(vdst + (vsl) * L::VSLOT)); \
        if (NPV == 2) glds16(vsrc0 + kt_ * KVBLK * DM + 64, (unsigned)__builtin_amdgcn_readfirstlane(vdst + (vsl) * L::VSLOT + 8192)); } while (0)
#define AT_VRD(g_, d_) do { _Pragma("unroll") for (int ks = 0; ks < 4; ++ks) { vl[g_][ks] = vtr(vp + (d_) * 4096 + ks * 1024); vh[g_][ks] = vtr(vp + (d_) * 4096 + ks * 1024 + 512); } } while (0)
    bf16x8 qr[4];
#pragma unroll
    for (int d0 = 0; d0 < 4; ++d0) qr[d0] = *reinterpret_cast<const bf16x8*>(&Qw[(long)r32 * DM + d0 * 16 + hi * 8]);
    { _Pragma("unroll") for (int a = 0; a < AH; ++a) AT_DMA(a, a, a); }
    const lds_cptr kp0 = (lds_cptr)shm3 + L::LDS_K + hi * 1024 + r32 * 16;
    const lds_cptr vp0 = (lds_cptr)shm3 + L::LDS_V + ((lane >> 4) & 1) * 32 + (lane & 3) * 8 + (4 * hi + ((lane & 15) >> 2)) * 64;
    const unsigned sw = (unsigned)__builtin_amdgcn_readfirstlane((int)(f2bf_u(slope2) | (f2bf_u(slope2 - bf2f_u(f2bf_u(slope2))) << 16)));
    const unsigned hmask = hi == 0 ? 0xffffffffu : 0u;
    const unsigned off0w = (f2bf_u((float)r32) * 0x10001u) & hmask, off1w = (f2bf_u((float)(32 + r32)) * 0x10001u) & hmask;
    unsigned qz = 0u;
    float mhat = 0.f, l_reg = 0.f;
#pragma unroll
    for (int d = 0; d < DV / 32; ++d) o[d] = f32x16{};
    const int qrel = wid * 32 + r32;
    int slot = 0, vslot = 0;
    constexpr int ND = DV / 32, NMF = 4 * ND, NEXP = 32 / NMF;
    u32x4 pw[4] = {{0u, 0u, 0u, 0u}, {0u, 0u, 0u, 0u}, {0u, 0u, 0u, 0u}, {0u, 0u, 0u, 0u}};
#define AT_PIN(x) asm volatile("" : "+v"(x))
#define AT_CE(e) ((e) < 16 ? c0[(e) & 15] : c1[(e) & 15])
#define AT_VOFF(g) (((g) >> 2) * 4096 + ((g) & 3) * 1024)
    wait_bar_n(((NT < AH ? NT : AH) - 1) * NPT);
#if AT_PROBE
    const bool prb = (blockIdx.x == 0) && (wid == AT_PROBE_WAVE) && (DV == AT_PROBE_DV); unsigned long long pt0, pacc1 = 0, pacc2 = 0, pacc3 = 0, pta, ptb;
#define AT_STAMP(x) do { AT_SBAR(); asm volatile("s_memtime %0\n\ts_waitcnt lgkmcnt(0)" : "=s"(x) :: "memory"); AT_SBAR(); } while (0)
    AT_STAMP(pt0);
#else
#define AT_STAMP(x)
#endif
    for (int i = 0; i < NT; ++i) {
#if AT_PROBE
        unsigned long long ptop, pmid, ppk; AT_STAMP(ptop);
#endif
        bf16x8 kf[8];
        { const lds_cptr kp = kp0 + slot * KSLOT;
#pragma unroll
          for (int j = 0; j < 4; ++j) { kf[2 * j] = *(const __attribute__((address_space(3))) bf16x8*)(kp + j * 2048); kf[2 * j + 1] = *(const __attribute__((address_space(3))) bf16x8*)(kp + j * 2048 + 512); } }
        AT_SBAR();
        { const int s2 = slot == 0 ? AH : slot - 1; int v2 = vslot + AH; v2 = v2 >= AH + 2 ? v2 - (AH + 2) : v2; AT_DMA(i + AH, s2, v2); }
        const int kt = AT_KT(i);
        const int jb = MOBA ? (i < 4 ? i : -1) : (i - (NT - 4));
        f32x16 c0, c1;
        {
            const unsigned tb = f2bf_u((float)(64 * (kt - 4 * qb)));
            const unsigned tbw = (tb * 0x10001u) & hmask, onew = 0x3f803f80u & hmask, swm = sw & hmask;
            const u32x4 a0 = {off0w, tbw, onew, 0u}, a1 = {off1w, tbw, onew, 0u};
            u32x4 qv = {swm, swm, qz, 0u};
            if (MOBA) { if (hi == 0 && i >= 4 && !((sel >> (kt >> 2)) & 1u)) qv.z = 0x0000f14au; }
            c0 = AT_MFMA(__builtin_bit_cast(bf16x8, a0), __builtin_bit_cast(bf16x8, qv), f32x16{}); c1 = AT_MFMA(__builtin_bit_cast(bf16x8, a1), __builtin_bit_cast(bf16x8, qv), f32x16{});
#pragma unroll
            for (int j = 0; j < 4; ++j) { c0 = AT_MFMA(kf[2 * j], qr[j], c0); c1 = AT_MFMA(kf[2 * j + 1], qr[j], c1); }
        }
        if (jb >= 0) cmask(c0, c1, jb, qrel, hi);
        bool resc = false;
        {
            const float rm = rowmax(c0, c1);
            const bool first = (i == 0);
            if (first || __any(rm > THR)) {
                const float dl = first ? rm : __builtin_fmaxf(rm, 0.f);
                const float mnew = mhat + dl;
                const unsigned nh = f2bf_u(-mnew), nl = f2bf_u(-mnew - bf2f_u(nh));
                const float meff = -(bf2f_u(nh) + bf2f_u(nl));
                const float dle = meff - mhat; mhat = meff;
                qz = (nh | (nl << 16)) & hmask;
#pragma unroll
                for (int r = 0; r < 16; ++r) { c0[r] -= dle; c1[r] -= dle; }
                if (!first) { const float f = __builtin_amdgcn_exp2f(-dle); l_reg *= f; if (hi == 0) wsf[r32] = f; resc = true; }
            }
        }
#if AT_PROBE
        AT_STAMP(pmid);
#endif
        u32x4 pn[4]; float sacc = 0.f;
        {
            const lds_cptr vp = vp0 + (i == 0 ? 0 : (vslot == 0 ? AH + 1 : vslot - 1)) * L::VSLOT;
            s16x4 vl[NMF], vh[NMF];
#pragma unroll
            for (int g = 0; g < 4; ++g) { vl[g] = vtr(vp + AT_VOFF(g)); vh[g] = vtr(vp + AT_VOFF(g) + 512); }
            AT_SBAR();
#pragma unroll
            for (int g = 0; g < NMF; ++g) {
                if (g + 4 < NMF) { vl[g + 4] = vtr(vp + AT_VOFF(g + 4)); vh[g + 4] = vtr(vp + AT_VOFF(g + 4) + 512); }
                { const bf16x8 vf = (bf16x8){vl[g][0], vl[g][1], vl[g][2], vl[g][3], vh[g][0], vh[g][1], vh[g][2], vh[g][3]};
                  o[g >> 2] = AT_MFMA(__builtin_bit_cast(bf16x8, pw[g & 3]), vf, o[g >> 2]); }
#pragma unroll
                for (int x = 0; x < NEXP; x += 2) { const int e = g * NEXP + x;
                    const float p0 = __builtin_amdgcn_exp2f(AT_CE(e)), p1 = __builtin_amdgcn_exp2f(AT_CE(e + 1));
                    sacc += p0; sacc += p1; pn[e >> 3][(e & 7) >> 1] = cvtpk_s(p0, p1); }
                AT_PIN(sacc); AT_PIN(pn[(g * NEXP) >> 3]);
                AT_SBAR();
            }
            if (resc) {
                asm volatile("s_waitcnt lgkmcnt(0)" ::: "memory");
#pragma unroll
                for (int d = 0; d < ND; ++d)
#pragma unroll
                    for (int r = 0; r < 16; ++r) o[d][r] *= wsf[crow(r, hi)];
            }
        }
        l_reg += sacc;
#pragma unroll
        for (int k = 0; k < 4; ++k) pw[k] = pn[k];
#if AT_PROBE
        asm volatile("" : "+v"(pw[0]), "+v"(pw[1]), "+v"(pw[2]), "+v"(pw[3])); AT_STAMP(ppk); pacc2 += pmid - ptop; pacc3 += ppk - pmid;
#endif
        AT_STAMP(pta);
        { int na = NT - 2 - i; na = na < 0 ? 0 : (na > AH - 1 ? AH - 1 : na); wait_bar_n(na * NPT); }
#if AT_PROBE
        AT_STAMP(ptb); pacc1 += ptb - pta;
#endif
        slot = slot == AH ? 0 : slot + 1; vslot = vslot == AH + 1 ? 0 : vslot + 1;
    }
#if AT_PROBE
    { unsigned long long pt1; AT_STAMP(pt1); if (prb && lane == 0) { g_probe[0] += pt1 - pt0; g_probe[1] += pacc1; g_probe[2] += (unsigned long long)NT; g_probe[3] += pacc2; g_probe[4] += pacc3; } }
#endif
    { const lds_cptr vp = vp0 + (vslot == 0 ? AH + 1 : vslot - 1) * L::VSLOT; s16x4 vl[2][4], vh[2][4];
      AT_VRD(0, 0); AT_SBAR();
#pragma unroll
      for (int d = 0; d < ND; ++d) {
          if (d + 1 < ND) AT_VRD((d + 1) & 1, d + 1);
          AT_SBAR();
#pragma unroll
          for (int ks = 0; ks < 4; ++ks) { const bf16x8 vf = (bf16x8){vl[d & 1][ks][0], vl[d & 1][ks][1], vl[d & 1][ks][2], vl[d & 1][ks][3], vh[d & 1][ks][0], vh[d & 1][ks][1], vh[d & 1][ks][2], vh[d & 1][ks][3]};
              o[d] = AT_MFMA(__builtin_bit_cast(bf16x8, pw[ks]), vf, o[d]); }
          AT_SBAR(); } }
    AT_WAIT_BAR(0);
#undef AT_PIN
#undef AT_CE
#undef AT_VOFF
    { auto rr = __builtin_amdgcn_permlane32_swap(__float_as_uint(l_reg), __float_as_uint(l_reg), false, false); l_out = __uint_as_float(rr[0]) + __uint_as_float(rr[1]); }
#undef AT_KT
#undef AT_DMA
#undef AT_VRD
}

__device__ __forceinline__ int window_kt_min(const unsigned* nrm, int b, int chunk, int q0, float slope2) {
    const float nq = __uint_as_float(nrm[((0 * 2 + b) * 16 + chunk) * 2]) + __uint_as_float(nrm[((0 * 2 + b) * 16 + chunk) * 2 + 1]);
    const float nk = __uint_as_float(nrm[((1 * 2 + b) * 16 + chunk) * 2]) + __uint_as_float(nrm[((1 * 2 + b) * 16 + chunk) * 2 + 1]);
    const float B = sqrtf(nq * nk) * 1.01f;
    const float W = (2.0f * B + 160.0f) / slope2;
    const int wkeys = W < 1.0e6f ? (int)W : 1000000;
    const int d = q0 - wkeys;
    return d > 0 ? (d >> 6) : 0;
}
__device__ __forceinline__ void diff_item(char* shm, int b, int h, int qb, int m, const bf16* Q, const bf16* K, const bf16* V, bf16* O, float lam, const unsigned* nrm, unsigned* flag, unsigned* tmo) {
    typedef Lay<128, 2> L;
    int tid_ = threadIdx.x; asm volatile("" : "+v"(tid_));
    const int tid = tid_; const int wid = __builtin_amdgcn_readfirstlane(tid >> 6);
    const long rowbase = (long)b * SEQ; const int q0 = qb * 256;
    const float slope2 = __builtin_amdgcn_exp2f(-(float)(h + 1)) * 1.4426950408889634f;
    lam = __uint_as_float((unsigned)__builtin_amdgcn_readfirstlane((int)__float_as_uint(lam)));
    const lds_ptr shm3 = (lds_ptr)shm;
    __attribute__((address_space(3))) float* wsf = (__attribute__((address_space(3))) float*)(shm3 + L::LDS_WS) + wid * 64;
    __attribute__((address_space(3))) bf16* stg = (__attribute__((address_space(3))) bf16*)(shm3 + L::LDS_OST + wid * L::OSTW);
    f32x16 o[4]; float l;
    const int kt_min = __builtin_amdgcn_readfirstlane(window_kt_min(nrm, b, 2 * h + m, q0, slope2));
    sweep<128, false, 2>(shm, Q + (rowbase + q0 + wid * 32) * DM + h * 128 + m * 64, K + rowbase * DM + h * 128 + m * 64, V + rowbase * DM + h * 128, qb, kt_min, slope2, 0u, o, l);
    int lane_e = tid & 63; asm volatile("" : "+v"(lane_e));
    const int lane = lane_e, r32 = lane & 31, hi = lane >> 5;
    bf16* Ow = O + (rowbase + q0 + wid * 32) * DM + h * 128;
    if (hi == 0) wsf[32 + r32] = l;
    asm volatile("s_waitcnt lgkmcnt(0)" ::: "memory");
    float rli[16];
#pragma unroll
    for (int r = 0; r < 16; ++r) rli[r] = (m == 0 ? 1.0f : lam) * __builtin_amdgcn_rcpf(wsf[32 + crow(r, hi)]);
    if (m == 0) {
#pragma unroll
        for (int r = 0; r < 16; ++r)
#pragma unroll
            for (int d = 0; d < 4; ++d) stg[crow(r, hi) * 128 + d * 32 + r32] = (bf16)f2bf_u(o[d][r] * rli[r]);
        asm volatile("s_waitcnt lgkmcnt(0)" ::: "memory");
#pragma unroll
        for (int i = 0; i < 8; ++i) { const int row = i * 4 + (lane >> 4), ch = lane & 15; const u32x4 v = *(const __attribute__((address_space(3))) u32x4*)(stg + row * 128 + ch * 8); *(u32x4*)(Ow + (long)row * DM + ch * 8) = v; }
        asm volatile("s_waitcnt vmcnt(0)" ::: "memory");
        __syncthreads();
        if (tid == 0) { __builtin_amdgcn_fence(__ATOMIC_RELEASE, "agent"); asm volatile("s_waitcnt vmcnt(0)" ::: "memory"); __hip_atomic_store(flag, 1u, __ATOMIC_RELAXED, __HIP_MEMORY_SCOPE_AGENT); }
    } else {
        if (tid == 0) {
            unsigned sp = 0u;
            while (__hip_atomic_load(flag, __ATOMIC_RELAXED, __HIP_MEMORY_SCOPE_AGENT) == 0u) { __builtin_amdgcn_s_sleep(8); if (++sp > (1u << 22)) { __hip_atomic_store(tmo, 1u, __ATOMIC_RELAXED, __HIP_MEMORY_SCOPE_AGENT); break; } }
            __builtin_amdgcn_fence(__ATOMIC_ACQUIRE, "agent");
            asm volatile("s_waitcnt vmcnt(0)" ::: "memory");
        }
        __syncthreads();
#pragma unroll
        for (int i = 0; i < 8; ++i) { const int row = i * 4 + (lane >> 4), ch = lane & 15; const u32x4 v = *(const u32x4*)(Ow + (long)row * DM + ch * 8); *(__attribute__((address_space(3))) u32x4*)(stg + row * 128 + ch * 8) = v; }
        asm volatile("s_waitcnt vmcnt(0) lgkmcnt(0)" ::: "memory");
        float ss[16];
#pragma unroll
        for (int r = 0; r < 16; ++r) { float sq = 0.f;
#pragma unroll
            for (int d = 0; d < 4; ++d) { const float v = bf2f_u(stg[crow(r, hi) * 128 + d * 32 + r32]) - o[d][r] * rli[r]; o[d][r] = v; sq = __builtin_fmaf(v, v, sq); }
            ss[r] = sq; }
#pragma unroll
        for (int r = 0; r < 16; ++r) {
#pragma unroll
            for (int off = 1; off < 32; off <<= 1) ss[r] += __shfl_xor(ss[r], off);
            ss[r] = 1.0f / sqrtf(ss[r] * (1.0f / 128.0f) + 1e-6f); }
#pragma unroll
        for (int r = 0; r < 16; ++r)
#pragma unroll
            for (int d = 0; d < 4; ++d) stg[crow(r, hi) * 128 + d * 32 + r32] = (bf16)f2bf_u(o[d][r] * ss[r]);
        asm volatile("s_waitcnt lgkmcnt(0)" ::: "memory");
#pragma unroll
        for (int i = 0; i < 8; ++i) { const int row = i * 4 + (lane >> 4), ch = lane & 15; const u32x4 v = *(const __attribute__((address_space(3))) u32x4*)(stg + row * 128 + ch * 8); *(u32x4*)(Ow + (long)row * DM + ch * 8) = v; }
    }
}
__device__ __forceinline__ void moba_unit(char* shm, int b, int h, int qb, const bf16* Q, const bf16* K, const bf16* V, bf16* O, const float* KM, const unsigned* nrm) {
    typedef Lay<64, 5> L;
    int tid_ = threadIdx.x; asm volatile("" : "+v"(tid_));
    const int tid = tid_, lane = tid & 63, r32 = lane & 31, hi = lane >> 5; const int wid = __builtin_amdgcn_readfirstlane(tid >> 6);
    const long rowbase = (long)b * SEQ; const int q0 = qb * 256;
    const float slope2 = __builtin_amdgcn_exp2f(-0.5f * (float)(h + 1)) * 1.4426950408889634f;
    const lds_ptr shm3 = (lds_ptr)shm;
    __attribute__((address_space(3))) float* wsf = (__attribute__((address_space(3))) float*)(shm3 + L::LDS_WS) + wid * 64;
    __attribute__((address_space(3))) bf16* stg = (__attribute__((address_space(3))) bf16*)(shm3 + L::LDS_OST + wid * L::OSTW);
    const bf16* Qw = Q + (rowbase + q0 + wid * 32) * DM + h * 64;
    unsigned sel = 0u;
    if (qb > 0) {
        f32x16 g = f32x16{};
        const float* km = KM + (((long)b * 16 + h) * 32 + r32) * 64 + hi * 8;
#pragma unroll
        for (int d0 = 0; d0 < 4; ++d0) {
            const bf16x8 qf = *reinterpret_cast<const bf16x8*>(&Qw[(long)r32 * DM + d0 * 16 + hi * 8]);
            const float4 x0 = *(const float4*)(km + d0 * 16), x1 = *(const float4*)(km + d0 * 16 + 4);
            const float xs[8] = {x0.x, x0.y, x0.z, x0.w, x1.x, x1.y, x1.z, x1.w};
            unsigned hw[8], lw[8];
#pragma unroll
            for (int e = 0; e < 8; ++e) { hw[e] = f2bf_u(xs[e]); lw[e] = f2bf_u(xs[e] - bf2f_u(hw[e])); }
            const u32x4 ah = {hw[0] | (hw[1] << 16), hw[2] | (hw[3] << 16), hw[4] | (hw[5] << 16), hw[6] | (hw[7] << 16)};
            const u32x4 al = {lw[0] | (lw[1] << 16), lw[2] | (lw[3] << 16), lw[4] | (lw[5] << 16), lw[6] | (lw[7] << 16)};
            g = AT_MFMA(__builtin_bit_cast(bf16x8, ah), qf, g); g = AT_MFMA(__builtin_bit_cast(bf16x8, al), qf, g);
        }
        float g0[16], g1[16];
#pragma unroll
        for (int r = 0; r < 16; ++r) { auto rr = __builtin_amdgcn_permlane32_swap(__float_as_uint(g[r]), __float_as_uint(g[r]), false, false); g0[r] = __uint_as_float(rr[0]); g1[r] = __uint_as_float(rr[1]); }
        float b0 = -INFINITY, b1 = -INFINITY, b2 = -INFINITY; int i0 = 0, i1 = 0, i2 = 0;
#pragma unroll
        for (int n = 0; n < 32; ++n) {
            const int rn = 4 * (n >> 3) + (n & 3);
            float v = ((n >> 2) & 1) ? g1[rn] : g0[rn];
            if (n >= qb) v = -INFINITY;
            if (v > b0) { b2 = b1; i2 = i1; b1 = b0; i1 = i0; b0 = v; i0 = n; }
            else if (v > b1) { b2 = b1; i2 = i1; b1 = v; i1 = n; }
            else if (v > b2) { b2 = v; i2 = n; }
        }
        if (b0 > -INFINITY) sel |= 1u << i0;
        if (b1 > -INFINITY) sel |= 1u << i1;
        if (b2 > -INFINITY) sel |= 1u << i2;
    }
    f32x16 o[2]; float l;
    const int kt_min = __builtin_amdgcn_readfirstlane(window_kt_min(nrm, b, h, q0, slope2));
    sweep<64, true, 5>(shm, Qw, K + rowbase * DM + h * 64, V + rowbase * DM + h * 64, qb, kt_min, slope2, sel, o, l);
    int lane_e = lane; asm volatile("" : "+v"(lane_e));
    { const int lane = lane_e, r32 = lane & 31, hi = lane >> 5;
    if (hi == 0) wsf[32 + r32] = l;
    asm volatile("s_waitcnt lgkmcnt(0)" ::: "memory");
#pragma unroll
    for (int r = 0; r < 16; ++r) { const float rl = __builtin_amdgcn_rcpf(wsf[32 + crow(r, hi)]);
#pragma unroll
        for (int d = 0; d < 2; ++d) stg[crow(r, hi) * 64 + d * 32 + r32] = (bf16)f2bf_u(o[d][r] * rl); }
    asm volatile("s_waitcnt lgkmcnt(0)" ::: "memory");
    bf16* Ow = O + (rowbase + q0 + wid * 32) * DM + h * 64;
#pragma unroll
    for (int i = 0; i < 4; ++i) { const int row = i * 8 + (lane >> 3), ch = lane & 7; const u32x4 v = *(const __attribute__((address_space(3))) u32x4*)(stg + row * 64 + ch * 8); *(u32x4*)(Ow + (long)row * DM + ch * 8) = v; }
    }
}
#undef AT_SBAR
#undef AT_WAIT_BAR
#undef AT_MX3
#undef AT_MFMA
}

constexpr int NWAVES = 8;
constexpr int RING_OFF = 0, RING_BYTES = 157696;
constexpr int LDSCTL_OFF = RING_BYTES, MISC_OFF = LDSCTL_OFF + 320;
constexpr int LDS_BYTES = RING_BYTES + 1024;
static_assert(attn::Lay<128, 2>::BYTES <= RING_BYTES && attn::Lay<64, 5>::BYTES <= RING_BYTES && LDS_BYTES <= 163840, "LDS budget");
static_assert(MISC_OFF + 128 <= LDS_BYTES, "LDS map");

struct Frame {
    LAS unsigned char* lds; volatile LAS unsigned* MISC; gu32* ctl;
    int tid, lane, wave, vcu, G;
};
__device__ __forceinline__ float wave_sum(float v) {
#pragma unroll
    for (int o = 1; o < 64; o <<= 1) v += __shfl_xor(v, o);
    return v;
}
__device__ __forceinline__ float bf2f(unsigned h) { return __builtin_bit_cast(float, h << 16); }

__device__ __forceinline__ void p0_transpose_item(const float* W, int K, int N, bf16* WT, LAS float* scr, int item, int lane, const float* gk, int gmask, float cmul, int qcols, float qscale) {
    const int nblk = N / 32, kb = item / nblk, nb = item % nblk, k0 = 64 * kb, n0 = 32 * nb;
    const float cs = cmul * ((n0 < qcols) ? qscale : 1.0f);
#pragma unroll 8
    for (int i = 0; i < 32; ++i) { const int kk = 2 * i + (lane >> 5); const float g = gk ? gk[(k0 + kk) & gmask] : 1.0f; scr[kk * 33 + (lane & 31)] = W[(size_t)(k0 + kk) * N + n0 + (lane & 31)] * (g * cs); }
    LDS_WAIT(); asm volatile("" ::: "memory");
    const int c = lane & 7;
#pragma unroll
    for (int j = 0; j < 4; ++j) { const int n = (lane >> 3) + 8 * j; const LAS float* s = scr + (8 * c) * 33 + n;
        v4u o; o.x = pk2(s[0 * 33], s[1 * 33]); o.y = pk2(s[2 * 33], s[3 * 33]); o.z = pk2(s[4 * 33], s[5 * 33]); o.w = pk2(s[6 * 33], s[7 * 33]);
        *(GAS v4u*)(WT + (size_t)(n0 + n) * K + k0 + 8 * c) = o; }
    LDS_WAIT(); asm volatile("" ::: "memory");
}
__device__ __forceinline__ void p0_x_row(const float* xrow, float* orow, bf16* hrow, float* ssq, int lane) {
    const GAS f32x4* xr = (const GAS f32x4*)xrow + lane; GAS f32x4* orr = (GAS f32x4*)orow + lane; GAS unsigned long long* h8 = (GAS unsigned long long*)hrow + lane;
    f32x4 v[4]; float s[4];
#pragma unroll
    for (int j = 0; j < 4; ++j) v[j] = xr[64 * j];
#pragma unroll
    for (int j = 0; j < 4; ++j) { orr[64 * j] = v[j]; h8[64 * j] = (unsigned long long)pk2(v[j].x, v[j].y) | ((unsigned long long)pk2(v[j].z, v[j].w) << 32);
        s[j] = wave_sum((v[j].x * v[j].x + v[j].y * v[j].y) + (v[j].z * v[j].z + v[j].w * v[j].w)); }
    if (lane < 16) { const int j = lane >> 2; const float sj = j == 0 ? s[0] : j == 1 ? s[1] : j == 2 ? s[2] : s[3]; ssq[lane] = (lane & 3) == 0 ? sj : 0.f; }
}
__device__ __forceinline__ void final_row(float* orow, const float* ssq, const float* g, int lane) {
    const float rs = pg8::row_rstd16(ssq, 0);
    GAS f32x4* orr = (GAS f32x4*)orow + lane; const GAS f32x4* gr = (const GAS f32x4*)g + lane;
#pragma unroll
    for (int j = 0; j < 4; ++j) { f32x4 v = orr[64 * j]; const f32x4 gv = gr[64 * j]; v = v * rs * gv; orr[64 * j] = v; }
}

__device__ __forceinline__ void diff_attn_unit_simple(LAS unsigned char* lds, int b, int h, int qblk, const bf16* Q, const bf16* K, const bf16* V, bf16* O, float lam, int tid) {
    LAS float* Ks = (LAS float*)lds; LAS float* Vs = (LAS float*)(lds + 64 * 65 * 4);
    const int qi = tid >> 2, part = tid & 3, q0 = qblk * 128, t = q0 + qi;
    const size_t rowbase = (size_t)b * T;
    const float slope2 = exp2f(-(float)(h + 1)) * LOG2E;
    float ores[32], o0[32], l0 = 0.f;
#pragma unroll 1
    for (int m = 0; m < 2; ++m) {
        float q[16];
        { const bf16* qp = Q + (rowbase + t) * D + h * 128 + m * 64 + part * 16;
#pragma unroll
          for (int i = 0; i < 16; ++i) q[i] = bf2f(qp[i]); }
        float mrun = NEG_BIG, l = 0.f, o[32];
#pragma unroll
        for (int e = 0; e < 32; ++e) o[e] = 0.f;
        const int nkt = q0 / 64 + 2;
        for (int kt = 0; kt < nkt; ++kt) {
            const int kb = kt * 64;
            __syncthreads();
            { const int key = tid >> 3, seg = tid & 7;
              const bf16* kp = K + (rowbase + kb + key) * D + h * 128 + m * 64 + seg * 8;
#pragma unroll
              for (int i = 0; i < 8; ++i) Ks[key * 65 + seg * 8 + i] = bf2f(kp[i]);
              const bf16* vp = V + (rowbase + kb + key) * D + h * 128 + seg * 16;
#pragma unroll
              for (int i = 0; i < 16; ++i) Vs[key * 129 + seg * 16 + i] = bf2f(vp[i]); }
            __syncthreads();
            for (int key = 0; key < 64; ++key) {
                float s = 0.f;
#pragma unroll
                for (int i = 0; i < 16; ++i) s = fmaf(q[i], Ks[key * 65 + part * 16 + i], s);
                s += __shfl_xor(s, 1); s += __shfl_xor(s, 2);
                const int kpos = kb + key;
                s += slope2 * (float)(kpos - t);
                if (kpos > t) s = -INFINITY;
                const float mn = fmaxf(mrun, s);
                const float alpha = exp2f(mrun - mn), p = exp2f(s - mn);
                mrun = mn; l = l * alpha + p;
#pragma unroll
                for (int e = 0; e < 32; ++e) o[e] = fmaf(p, Vs[key * 129 + part * 32 + e], o[e] * alpha);
            }
        }
        if (m == 0) {
#pragma unroll
            for (int e = 0; e < 32; ++e) o0[e] = o[e];
            l0 = l;
        } else {
            const float i0 = 1.0f / l0, i1 = lam / l;
#pragma unroll
            for (int e = 0; e < 32; ++e) ores[e] = o0[e] * i0 - o[e] * i1;
        }
    }
    float ss = 0.f;
#pragma unroll
    for (int e = 0; e < 32; ++e) ss = fmaf(ores[e], ores[e], ss);
    ss += __shfl_xor(ss, 1); ss += __shfl_xor(ss, 2);
    const float rs = 1.0f / sqrtf(ss * (1.0f / 128.0f) + RMS_EPS);
    bf16* op = O + (rowbase + t) * D + h * 128 + part * 32;
#pragma unroll
    for (int e = 0; e < 32; e += 2) *(unsigned*)(op + e) = pk2(ores[e] * rs, ores[e + 1] * rs);
    __syncthreads();
}
__device__ __forceinline__ void moba_unit_simple(int b, int h, int qblk, const bf16* Q, const bf16* K, const bf16* V, bf16* O, const float* KM, int tid) {
    const int qi = tid >> 2, part = tid & 3, q0 = qblk * 128, t = q0 + qi, j = q0 / 256;
    const size_t rowbase = (size_t)b * T;
    const float slope2 = exp2f(-0.5f * (float)(h + 1)) * LOG2E;
    float q[16];
    { const bf16* qp = Q + (rowbase + t) * D + h * 64 + part * 16;
#pragma unroll
      for (int i = 0; i < 16; ++i) q[i] = bf2f(qp[i]); }
    float b0 = -INFINITY, b1 = -INFINITY, b2 = -INFINITY; int i0 = 0, i1 = 0, i2 = 0;
    for (int n = 0; n < j; ++n) {
        const float* km = KM + (((size_t)b * 16 + h) * 32 + n) * 64 + part * 16;
        float g = 0.f;
#pragma unroll
        for (int i = 0; i < 16; ++i) g = fmaf(q[i], km[i], g);
        g += __shfl_xor(g, 1); g += __shfl_xor(g, 2);
        if (g > b0) { b2 = b1; i2 = i1; b1 = b0; i1 = i0; b0 = g; i0 = n; }
        else if (g > b1) { b2 = b1; i2 = i1; b1 = g; i1 = n; }
        else if (g > b2) { b2 = g; i2 = n; }
    }
    const int nsel = j < 3 ? j : 3;
    float mrun = NEG_BIG, l = 0.f, o[16];
#pragma unroll
    for (int e = 0; e < 16; ++e) o[e] = 0.f;
    for (int seg = 0; seg <= nsel; ++seg) {
        const int blk = seg == 0 ? j : (seg == 1 ? i0 : (seg == 2 ? i1 : i2));
        const int kb = blk * 256;
        for (int key = 0; key < 256; ++key) {
            const int kpos = kb + key;
            const bf16* kp = K + (rowbase + kpos) * D + h * 64 + part * 16;
            float s = 0.f;
#pragma unroll
            for (int i = 0; i < 16; ++i) s = fmaf(q[i], bf2f(kp[i]), s);
            s += __shfl_xor(s, 1); s += __shfl_xor(s, 2);
            s += slope2 * (float)(kpos - t);
            if (kpos > t) s = -INFINITY;
            const float mn = fmaxf(mrun, s);
            const float alpha = exp2f(mrun - mn), p = exp2f(s - mn);
            mrun = mn; l = l * alpha + p;
            const bf16* vp = V + (rowbase + kpos) * D + h * 64 + part * 16;
#pragma unroll
            for (int e = 0; e < 16; ++e) o[e] = fmaf(p, bf2f(vp[e]), o[e] * alpha);
        }
    }
    const float il = 1.0f / l;
    bf16* op = O + (rowbase + t) * D + h * 64 + part * 16;
#pragma unroll
    for (int e = 0; e < 16; e += 2) *(unsigned*)(op + e) = pk2(o[e] * il, o[e + 1] * il);
}

#define REP_QKV 1
#define REP_DIFF 1
#define REP_MOBA 1
#define REP_FF1 1
struct Args { const float* in[10]; float* out; unsigned char* ws; };
__global__ void __launch_bounds__(NWAVES * 64, 2) fwd_kernel(Args args) {
    extern __shared__ __attribute__((aligned(16))) unsigned char lds[];
    Frame F;
    F.lds = (LAS unsigned char*)lds;
    F.MISC = (volatile LAS unsigned*)(F.lds + MISC_OFF);
    F.tid = threadIdx.x; F.lane = F.tid & 63; F.wave = __builtin_amdgcn_readfirstlane(F.tid >> 6);
    F.G = gridDim.x; { const int bx = blockIdx.x; F.vcu = (F.G % 8 == 0) ? (bx % 8) * (F.G / 8) + bx / 8 : bx; }
    unsigned char* ws = args.ws;
    F.ctl = (gu32*)(ws + WS_CTL);
#define PTRS() \
    unsigned long long z_ = 0ull; asm volatile("" : "+s"(z_)); unsigned char* wsl = args.ws + z_; float* out = args.out + z_;     \
    bf16* WIN = (bf16*)(wsl + WS_WIN); bf16* WOUT = (bf16*)(wsl + WS_WOUT); bf16* WFF1 = (bf16*)(wsl + WS_WFF1); bf16* WFF2 = (bf16*)(wsl + WS_WFF2); \
    float* SSQ = (float*)(wsl + WS_SSQ); float* KM = (float*)(wsl + WS_KMEAN); \
    bf16* HB = (bf16*)(wsl + WS_HB); bf16* Qb = (bf16*)(wsl + WS_Q); bf16* Kb = (bf16*)(wsl + WS_K); bf16* Vb = (bf16*)(wsl + WS_V); bf16* Ob = (bf16*)(wsl + WS_O); \
    bf16* ACT = (bf16*)(wsl + WS_ACT); \
    (void)WIN; (void)WOUT; (void)WFF1; (void)WFF2; (void)SSQ; (void)KM; (void)HB; (void)Qb; (void)Kb; (void)Vb; (void)Ob; (void)ACT; (void)out
    for (int u = F.tid; u < (LDS_BYTES - LDSCTL_OFF) / 4; u += NWAVES * 64) ((LAS unsigned*)(F.lds + LDSCTL_OFF))[u] = 0u;
    __syncthreads();
    XcdBarrier bar = xcd_barrier_post((unsigned*)(F.ctl + CW_BAR), F.MISC + 8);
#define GRID_BAR() xcd_barrier(bar)
    const int gw = F.vcu * NWAVES + F.wave, NGW = F.G * NWAVES;

    {
        PTRS();
        const float* x = args.in[0]; const float* attn_norm = args.in[1]; const float* w_in = args.in[2]; const float* w_out = args.in[3];
        const float* diff_subln = args.in[5]; const float* mlp_norm = args.in[6]; const float* w_ff1 = args.in[7]; const float* w_ff2 = args.in[8];
        int ln = threadIdx.x & 63; asm volatile("" : "+v"(ln));
        LAS float* scr = (LAS float*)(F.lds + RING_OFF + F.wave * 16384);
        constexpr int I_IN = (D / 64) * (NQKV / 32), I_OUT = (D / 64) * (D / 32), I_F1 = (D / 64) * (FF / 32), I_F2 = (FF / 64) * (D / 32);
        constexpr int PER_L = I_IN + I_OUT + I_F1 + I_F2;
        for (int it = gw; it < 2 * PER_L; it += NGW) {
            const int l = it / PER_L; int r = it % PER_L;
            if (r < I_IN) { p0_transpose_item(w_in + (size_t)l * D * NQKV, D, NQKV, WIN + (size_t)l * NQKV * D, scr, r, ln, attn_norm + l * D, D - 1, 1.0f, D, QSCALE); continue; } r -= I_IN;
            if (r < I_OUT) { p0_transpose_item(w_out + (size_t)l * D * D, D, D, WOUT + (size_t)l * D * D, scr, r, ln, l == 0 ? diff_subln : nullptr, 127, l == 0 ? 0.8f : 1.0f, 0, 1.0f); continue; } r -= I_OUT;
            if (r < I_F1) { p0_transpose_item(w_ff1 + (size_t)l * D * FF, D, FF, WFF1 + (size_t)l * FF * D, scr, r, ln, mlp_norm + l * D, D - 1, 1.0f, 0, 1.0f); continue; } r -= I_F1;
            p0_transpose_item(w_ff2 + (size_t)l * FF * D, FF, D, WFF2 + (size_t)l * D * FF, scr, r, ln, nullptr, 0, 1.0f, 0, 1.0f);
        }
        for (int m = gw; m < M; m += NGW) p0_x_row(x + (size_t)m * D, out + (size_t)m * D, HB + (size_t)m * D, SSQ + (size_t)m * 16, ln);
    }
    GRID_BAR();

#pragma unroll 1
    for (int l = 0; l < 2; ++l) {
        {
            PTRS();
            pg8::Gemm g{HB, WIN + (size_t)l * NQKV * D, M, NQKV, D}; pg8::StaticOrder S; S.init(M, NQKV, F.G, (int)blockIdx.x);
            pg8::EpiScaleBf16<0> E{Qb, D, SSQ, D, (size_t)M * D, (unsigned*)(F.ctl + CW_NRM + l * 256)};
            for (int rep = 0; rep < REP_QKV; ++rep)
            pg8::gemm_phase<pg8::EpiScaleBf16<0>, pg8::StaticOrder, PG8_ALIGN, PG8_SP2>(F.lds + RING_OFF, g, S, E);
        }
        GRID_BAR();
        if (l == 0) {
            PTRS();
            const float* lp = args.in[4];
            int lnl = threadIdx.x & 63; asm volatile("" : "+v"(lnl));
            const float la = wave_sum(lp[lnl] * lp[64 + lnl]), lc = wave_sum(lp[128 + lnl] * lp[192 + lnl]);
            const float lam = expf(la) - expf(lc) + 0.2f;
            for (int rep = 0; rep < REP_DIFF; ++rep)
            for (;;) {
                if (F.tid == 0) F.MISC[16] = __hip_atomic_fetch_add(F.ctl + CW_QUEUE + 64 * rep, 1u, RLX_AGENT);
                __syncthreads();
                const int i = (int)F.MISC[16];
                __syncthreads();
                if (i >= 1024) break;
                const int u = i >> 1, bh = u & 15, qb = 31 - (u >> 4);
                attn::diff_item((char*)lds + RING_OFF, bh >> 3, bh & 7, qb, i & 1, Qb, Kb, Vb, Ob, lam, (const unsigned*)(F.ctl + CW_NRM), (unsigned*)(F.ctl + CW_DFLAG + rep * 512 + u), (unsigned*)(F.ctl + CW_BAR) + XB_TMO);
            }
        } else {
            { PTRS(); int ln = threadIdx.x & 63; asm volatile("" : "+v"(ln));
            for (int it = gw; it < 1024; it += NGW) {
                const int n = it & 31, h = (it >> 5) & 15, b = it >> 9; float s = 0.f;
                const bf16* kp = Kb + ((size_t)b * T + n * 256) * D + h * 64 + ln;
                for (int i = 0; i < 256; ++i) s += bf2f(kp[(size_t)i * D]);
                KM[(size_t)it * 64 + ln] = s * (1.0f / 256.0f);
            } }
            GRID_BAR();
            PTRS();
            for (int rep = 0; rep < REP_MOBA; ++rep)
            for (;;) {
                if (F.tid == 0) F.MISC[16] = __hip_atomic_fetch_add(F.ctl + CW_QUEUE + 64 * (4 + rep), 1u, RLX_AGENT);
                __syncthreads();
                const int i = (int)F.MISC[16];
                __syncthreads();
                if (i >= 1024) break;
                const int bh = i & 31, qb = 31 - (i >> 5);
                attn::moba_unit((char*)lds + RING_OFF, bh >> 4, bh & 15, qb, Qb, Kb, Vb, Ob, KM, (const unsigned*)(F.ctl + CW_NRM + 256));
            }
        }
        GRID_BAR();
        {
            PTRS();
            pg8::Gemm g{Ob, WOUT + (size_t)l * D * D, M, D, D}; pg8::StaticOrder S; S.init(M, D, F.G, (int)blockIdx.x);
            pg8::EpiRes E{out, HB, SSQ, D};
            pg8::gemm_phase<pg8::EpiRes, pg8::StaticOrder, PG8_ALIGN, PG8_SP2>(F.lds + RING_OFF, g, S, E);
        }
        GRID_BAR();
        {
            PTRS();
            pg8::Gemm g{HB, WFF1 + (size_t)l * FF * D, M, FF, D}; pg8::StaticOrder S; S.init(M, FF, F.G, (int)blockIdx.x);
            pg8::EpiScaleBf16<1> E{ACT, FF, SSQ, 0, 0, nullptr};
            for (int rep = 0; rep < REP_FF1; ++rep)
            pg8::gemm_phase<pg8::EpiScaleBf16<1>, pg8::StaticOrder, PG8_ALIGN, PG8_SP2>(F.lds + RING_OFF, g, S, E);
        }
        GRID_BAR();
        {
            PTRS();
            pg8::Gemm g{ACT, WFF2 + (size_t)l * D * FF, M, D, FF}; pg8::StaticOrder S; S.init(M, D, F.G, (int)blockIdx.x);
            pg8::EpiRes E{out, HB, SSQ, D};
            pg8::gemm_phase<pg8::EpiRes, pg8::StaticOrder, PG8_ALIGN, PG8_SP2>(F.lds + RING_OFF, g, S, E);
        }
        GRID_BAR();
    }
    PTRS(); const float* final_norm = args.in[9]; int lnf = threadIdx.x & 63; asm volatile("" : "+v"(lnf));
#if AT_PROBE
    float pscale;
    { const float tot = (float)attn::g_probe[0], a1 = (float)attn::g_probe[1], nst = (float)attn::g_probe[2];
      float xv = AT_PROBE == 1 ? a1 / tot : AT_PROBE == 2 ? (tot / nst) * (1.0f / 10000.0f) : AT_PROBE == 3 ? (float)attn::g_probe[3] / tot : (float)attn::g_probe[4] / tot;
      xv = floorf(xv * AT_PROBE_Q + 0.5f) * (1.0f / AT_PROBE_Q);
      pscale = 1.0f + 0.1f + 0.9f * xv; }
#endif
    for (int m = gw; m < M; m += NGW) final_row(out + (size_t)m * D, SSQ + (size_t)m * 16, final_norm, lnf);
#if AT_PROBE
    __syncthreads();
    for (int m = gw; m < M; m += NGW) { GAS f32x4* orr = (GAS f32x4*)(out + (size_t)m * D) + F.lane;
        for (int j = 0; j < 4; ++j) orr[64 * j] = orr[64 * j] * pscale; }
#endif
    if (xb_ld((unsigned*)(F.ctl + CW_BAR) + XB_TMO) != 0u && blockIdx.x == 0) { const float qn = __builtin_nanf(""); for (int i = F.tid; i < 4096; i += NWAVES * 64) out[i] = qn; }
}

extern "C" void kernel_launch(void* const* d_in, const int* in_sizes, int n_in, void* d_out, int out_size, void* d_ws, size_t ws_size, hipStream_t stream) {
    static int grid = 0;
    if (grid == 0) {
        if (n_in != 10 || in_sizes[0] != M * D || out_size != M * D || ws_size < WS_END) { fprintf(stderr, "kernel_launch: unexpected shapes (n_in %d out %d ws %zu); nothing launched\n", n_in, out_size, ws_size); grid = -1; return; }
        int dev = 0, cus = 0, per_cu = 0;
        if (hipGetDevice(&dev) != hipSuccess || hipDeviceGetAttribute(&cus, hipDeviceAttributeMultiprocessorCount, dev) != hipSuccess) { fprintf(stderr, "kernel_launch: device query failed\n"); grid = -1; return; }
        if (hipFuncSetAttribute((const void*)fwd_kernel, hipFuncAttributeMaxDynamicSharedMemorySize, LDS_BYTES) != hipSuccess) { fprintf(stderr, "kernel_launch: hipFuncSetAttribute failed\n"); grid = -1; return; }
        if (hipOccupancyMaxActiveBlocksPerMultiprocessor(&per_cu, (const void*)fwd_kernel, NWAVES * 64, LDS_BYTES) != hipSuccess || per_cu < 1) { fprintf(stderr, "kernel_launch: occupancy query reports %d workgroups per CU\n", per_cu); per_cu = 1; }
        (void)hipGetLastError();
        grid = cus;
    }
    if (grid < 0) return;
    if (hipMemsetAsync((char*)d_ws + WS_CTL, 0, CTL_ZERO_BYTES, stream) != hipSuccess) { fprintf(stderr, "kernel_launch: hipMemsetAsync failed\n"); return; }
    Args a{};
    for (int i = 0; i < 10; ++i) a.in[i] = (const float*)d_in[i];
    a.out = (float*)d_out; a.ws = (unsigned char*)d_ws;
    hipLaunchKernelGGL(fwd_kernel, dim3(grid), dim3(NWAVES * 64), LDS_BYTES, stream, a);
    const hipError_t le = hipPeekAtLastError();
    if (le != hipSuccess) fprintf(stderr, "kernel_launch: launch failed: %s\n", hipGetErrorName(le));
}
```

```cpp
#include <hip/hip_runtime.h>
#include <cstdio>
#include <cstdint>
#define AT_PROBE 0
#define AT_PROBE_WAVE 0
#define AT_PROBE_Q 16.0f
#define AT_PROBE_DV 128

constexpr int BATCH = 2, T = 8192, D = 1024, M = BATCH * T, FF = 4096, NQKV = 3 * D;
constexpr float RMS_EPS = 1e-6f;
constexpr float LOG2E = 1.4426950408889634f;
constexpr float QSCALE = 0.125f * LOG2E;
constexpr float NEG_BIG = -1e30f;

constexpr size_t MiB = 1u << 20;
constexpr size_t WS_CTL = 0, CTL_ZERO_BYTES = 1 * MiB;
constexpr size_t WS_WIN = 1 * MiB;
constexpr size_t WS_WOUT = 13 * MiB;
constexpr size_t WS_WFF1 = 17 * MiB;
constexpr size_t WS_WFF2 = 33 * MiB;
constexpr size_t WS_SSQ = 49 * MiB;
constexpr size_t WS_KMEAN = 50 * MiB;
constexpr size_t WS_HB = 51 * MiB;
constexpr size_t WS_Q = 83 * MiB, WS_K = 115 * MiB, WS_V = 147 * MiB, WS_O = 179 * MiB;
constexpr size_t WS_ACT = 83 * MiB;
constexpr size_t WS_END = 211 * MiB;
constexpr int CW_TMO = 0, CW_CODE = 1, CW_BAR = 4096;
constexpr int CW_NRM = 8192;
constexpr int CW_DFLAG = 12288;
constexpr int CW_KMS = 32768;
constexpr int CW_QUEUE = 9216;
namespace pg8 {
#define PG8_LAS __attribute__((address_space(3)))
typedef unsigned short bf16_t;
typedef short bf16x8 __attribute__((ext_vector_type(8)));
typedef float f32x4 __attribute__((ext_vector_type(4)));
typedef unsigned u32x4 __attribute__((ext_vector_type(4)));
constexpr int BM = 256, BK = 64, HALF = 128, HTB = HALF * BK * 2  , STAGE_BYTES = 8 * HTB, NXCD = 8, WGM = 8;

__host__ __device__ __forceinline__ int lds_byte(int r, int c) { const int st = (r >> 4) * 2 + (c >> 5), rr = r & 15, cc = c & 31, ob = rr * 64 + cc * 2; return st * 1024 + (ob ^ (((ob >> 9) & 1) << 5)); }
__host__ __device__ __forceinline__ void stage_rc(int b, int& R, int& C) { const int st = b / 1024, sb = b % 1024, swz = sb ^ (((sb >> 9) & 1) << 5); R = (st >> 1) * 16 + swz / 64; C = (st & 1) * 32 + (swz % 64) / 2; }
__host__ __device__ __forceinline__ int perm32(int rho) { const int n = rho >> 4, i = rho & 15; return 8 * (i >> 2) + 4 * n + (i & 3); }

struct Unit { int pm, pn; };
struct Gemm { const bf16_t* A; const bf16_t* Bt; int M, N, K; };

struct StaticOrder {
    int nM, nN, nwg, G, c;
    __host__ __device__ void init(int M, int N, int G_, int c_) { nM = M / BM; nN = N / BM; nwg = nM * nN; G = G_; c = c_; }
    __host__ __device__ bool next(int i, Unit& u) const {
        const long L = (long)i * G + c; if (L >= nwg) return false;
        int wgid = (int)L; { const int q = nwg / NXCD, r = nwg % NXCD, xcd = wgid % NXCD, off = wgid / NXCD; wgid = (xcd < r ? xcd * (q + 1) : r * (q + 1) + (xcd - r) * q) + off; }
        const int nig = WGM * nN, gid = wgid / nig, fm = gid * WGM, gsz = (nM - fm) < WGM ? (nM - fm) : WGM;
        u.pm = fm + ((wgid % nig) % gsz); u.pn = (wgid % nig) / gsz; return true;
    }
    __device__ __forceinline__ void a_ready(const Unit&) const {}
    __device__ __forceinline__ void done(const Unit&) const {}
};


__device__ __forceinline__ unsigned cvt_pk_bf16(float lo, float hi) { unsigned r; asm volatile("v_cvt_pk_bf16_f32 %0, %1, %2" : "=v"(r) : "v"(lo), "v"(hi)); return r; }
__device__ __forceinline__ float row_rstd16(const float* SSQ, int row) {
    const f32x4* p = (const f32x4*)(SSQ + (size_t)row * 16);
    const f32x4 a = p[0], b = p[1], c = p[2], d = p[3];
    const float s = ((a[0] + a[1]) + (a[2] + a[3])) + ((b[0] + b[1]) + (b[2] + b[3])) + ((c[0] + c[1]) + (c[2] + c[3])) + ((d[0] + d[1]) + (d[2] + d[3]));
    return 1.0f / sqrtf(s * (1.0f / 1024.0f) + 1e-6f);
}
template <int ACT> struct EpiScaleBf16 {
    static constexpr bool PERM = true, AFTER_DRAIN = false;
    bf16_t* O; int ldc; const float* SSQ; int split_cols; size_t split_stride;
    float* KMS;
    unsigned* NRM;
    __device__ __forceinline__ void operator()(const f32x4 (&acc)[2][2][4][2], const Unit& u, int wr, int wc, int fr, int fq) const {
        const int row0 = u.pm * BM + wr * 64 + fr; int colt = u.pn * BM; bf16_t* base = O; int t = 0;
        if (split_cols) { t = colt / split_cols; base += (size_t)t * split_stride; colt -= t * split_cols; }
        const int col0 = colt + wc * 32 + 8 * fq;
        const int lane = fq * 16 + fr; float myrs[2];
#pragma unroll
        for (int ai = 0; ai < 2; ++ai) myrs[ai] = row_rstd16(SSQ, u.pm * BM + wr * 64 + ai * HALF + lane);
        asm volatile("" : "+v"(myrs[0]), "+v"(myrs[1]));
        float mx[2] = {0.f, 0.f};
        f32x4 ks[2][2] = {{{0.f, 0.f, 0.f, 0.f}, {0.f, 0.f, 0.f, 0.f}}, {{0.f, 0.f, 0.f, 0.f}, {0.f, 0.f, 0.f, 0.f}}};
#pragma unroll
        for (int ai = 0; ai < 2; ++ai)
#pragma unroll
            for (int m = 0; m < 4; ++m) { const int row = row0 + ai * HALF + m * 16; const float rs = __shfl(myrs[ai], m * 16 + fr); bf16_t* rowp = base + (size_t)row * ldc + col0;
#pragma unroll
                for (int bj = 0; bj < 2; ++bj) { f32x4 v0 = acc[ai][bj][m][0] * rs, v1 = acc[ai][bj][m][1] * rs;
                    if (ACT == 1) {
#pragma unroll
                        for (int e = 0; e < 4; ++e) { const float a = __builtin_fmaxf(v0[e], 0.f), b = __builtin_fmaxf(v1[e], 0.f); v0[e] = a * a; v1[e] = b * b; } }
                    if (ACT == 0 && KMS && t == 1) { ks[bj][0] += v0; ks[bj][1] += v1; }
                    if (ACT == 0 && NRM && t < 2) { float q = (v0[0] * v0[0] + v0[1] * v0[1]) + (v0[2] * v0[2] + v0[3] * v0[3]) + (v1[0] * v1[0] + v1[1] * v1[1]) + (v1[2] * v1[2] + v1[3] * v1[3]);
                        q += __shfl_xor(q, 16); q += __shfl_xor(q, 32); mx[bj] = __builtin_fmaxf(mx[bj], q); }
                    u32x4 w; w.x = cvt_pk_bf16(v0[0], v0[1]); w.y = cvt_pk_bf16(v0[2], v0[3]); w.z = cvt_pk_bf16(v1[0], v1[1]); w.w = cvt_pk_bf16(v1[2], v1[3]);
                    *(u32x4*)(rowp + bj * HALF) = w; } }
        if (ACT == 0 && KMS && t == 1) {
#pragma unroll
            for (int bj = 0; bj < 2; ++bj)
#pragma unroll
                for (int n = 0; n < 2; ++n)
#pragma unroll
                    for (int e = 0; e < 4; ++e) { float q = ks[bj][n][e];
#pragma unroll
                        for (int o = 1; o < 16; o <<= 1) q += __shfl_xor(q, o);
                        const int col = colt + bj * HALF + wc * 32 + 8 * fq + 4 * n + e;
                        if (fr == 0) atomicAdd(KMS + ((((size_t)(u.pm >> 5) * 16 + (col >> 6)) * 32 + (u.pm & 31)) * 64 + (col & 63)), q * (1.0f / 256.0f)); }
        }
        if (ACT == 0 && NRM && t < 2) {
#pragma unroll
            for (int bj = 0; bj < 2; ++bj) { float q = mx[bj];
#pragma unroll
                for (int o = 1; o < 16; o <<= 1) q = __builtin_fmaxf(q, __shfl_xor(q, o));
                const int col = colt + bj * HALF + wc * 32;
                if (lane == 0) atomicMax(NRM + (((t * 2 + (u.pm >> 5)) * 16 + (col >> 6)) * 2 + ((col >> 5) & 1)), __float_as_uint(q)); }
        }
    }
};
template <bool LAST> struct EpiRes {
    static constexpr bool PERM = false, AFTER_DRAIN = false;
    float* out; bf16_t* HB; float* SSQ; int ldc;
    __device__ __forceinline__ void operator()(const f32x4 (&acc)[2][2][4][2], const Unit& u, int wr, int wc, int fr, int fq) const {
        typedef unsigned u32x2v __attribute__((ext_vector_type(2)));
        const int col0 = u.pn * BM + wc * 32 + 4 * fq;
#pragma unroll
        for (int ai = 0; ai < 2; ++ai)
#pragma unroll
            for (int m = 0; m < 4; ++m) { const int row = u.pm * BM + ai * HALF + wr * 64 + m * 16 + fr; const size_t off = (size_t)row * ldc + col0; float s = 0.f;
#pragma unroll
                for (int bj = 0; bj < 2; ++bj)
#pragma unroll
                    for (int n = 0; n < 2; ++n) { const size_t o2 = off + bj * HALF + n * 16; const u32x2v hb = *(const u32x2v*)(HB + o2);
                        f32x4 h = acc[ai][bj][m][n];
                        h[0] += __builtin_bit_cast(float, hb.x << 16); h[1] += __builtin_bit_cast(float, hb.x & 0xffff0000u); h[2] += __builtin_bit_cast(float, hb.y << 16); h[3] += __builtin_bit_cast(float, hb.y & 0xffff0000u);
                        if (LAST) *(f32x4*)(out + o2) = h;
                        else { u32x2v w; w.x = cvt_pk_bf16(h[0], h[1]); w.y = cvt_pk_bf16(h[2], h[3]); *(u32x2v*)(HB + o2) = w; }
                        s += (h[0] * h[0] + h[1] * h[1]) + (h[2] * h[2] + h[3] * h[3]); }
                s += __shfl_xor(s, 16); s += __shfl_xor(s, 32);
                if (fq == 0) SSQ[(size_t)row * 16 + u.pn * 4 + wc] = s;
                if (m & 1) asm volatile("" ::: "memory"); }
    }
};
template <class Epi, class Sched, bool ALIGN_EPI = false, bool SP2 = false>
__device__ __forceinline__ void gemm_phase(PG8_LAS unsigned char* lds, const Gemm g, const Sched& S, const Epi& E) {
    int tid_ = threadIdx.x; asm volatile("" : "+v"(tid_));
    const int tid = tid_, wid = __builtin_amdgcn_readfirstlane(tid >> 6), lane = tid & 63, wr = wid >> 2, wc = wid & 3, fr = lane & 15, fq = lane >> 4;
    const int K = g.K, nt = K / BK;
    unsigned voffA[2], voffB[2];
#pragma unroll
    for (int i = 0; i < 2; ++i) { int R, C; stage_rc(tid * 16 + i * 8192, R, C); const int Rb = Epi::PERM ? ((R & ~31) + perm32(R & 31)) : R;
        voffA[i] = (unsigned)(R * K + C) * 2u; voffB[i] = (unsigned)(Rb * K + C) * 2u; }
    const size_t kstep = (size_t)(BK * 2);
    const size_t hstep = (size_t)HALF * K * 2;
    const size_t tstep = 2 * hstep;
    const unsigned ldsw = (unsigned)wid * 1024u;
    const int aoff = lds_byte(wr * 64 + fr, fq * 8), boff = lds_byte(wc * 32 + fr, fq * 8);
#define PG8_SA(b, h) (((b) * 2 + (h)) * HTB)
#define PG8_SB(b, h) ((4 + (b) * 2 + (h)) * HTB)
#define PG8_STAGE(bufoff, gbase, voff) do { _Pragma("unroll") for (int _i = 0; _i < 2; ++_i) \
        __builtin_amdgcn_global_load_lds((const unsigned*)((const char*)(gbase) + (voff)[_i]), (PG8_LAS unsigned*)(lds + (bufoff) + ldsw + _i * 8192), 16, 0, 0); } while (0)
#define PG8_LDA(dst, b, h) do { _Pragma("unroll") for (int m = 0; m < 4; ++m) _Pragma("unroll") for (int k = 0; k < 2; ++k) dst[m][k] = *(const PG8_LAS bf16x8*)(lds + PG8_SA(b, h) + aoff + m * 2048 + k * 1024); } while (0)
#define PG8_LDB(dst, b, h) do { _Pragma("unroll") for (int n = 0; n < 2; ++n) _Pragma("unroll") for (int k = 0; k < 2; ++k) dst[n][k] = *(const PG8_LAS bf16x8*)(lds + PG8_SB(b, h) + boff + n * 2048 + k * 1024); } while (0)
#define PG8_MMA(ai, bj, At, Bt) do { __builtin_amdgcn_s_setprio(1); _Pragma("unroll") for (int m = 0; m < 4; ++m) _Pragma("unroll") for (int n = 0; n < 2; ++n) _Pragma("unroll") for (int k = 0; k < 2; ++k) \
        acc[ai][bj][m][n] = __builtin_amdgcn_mfma_f32_16x16x32_bf16(Bt[n][k], At[m][k], acc[ai][bj][m][n], 0, 0, 0); __builtin_amdgcn_s_setprio(0); } while (0)
#define PG8_WAIT_V(n) asm volatile("s_waitcnt vmcnt(" #n ")" ::: "memory")
#define PG8_WAIT_L(n) asm volatile("s_waitcnt lgkmcnt(" #n ")" ::: "memory")
#define PG8_BAR __builtin_amdgcn_s_barrier()
#define PG8_SCHED __builtin_amdgcn_sched_barrier(0)
    Unit cur, nxt; int ui = 0;
    if (!S.next(0, cur)) return;
    f32x4 acc[2][2][4][2];
#pragma unroll
    for (int a = 0; a < 2; ++a)
#pragma unroll
        for (int b = 0; b < 2; ++b)
#pragma unroll
            for (int m = 0; m < 4; ++m)
#pragma unroll
                for (int n = 0; n < 2; ++n) acc[a][b][m][n] = (f32x4){0.f, 0.f, 0.f, 0.f};
    bf16x8 At[4][2], B0[2][2], B1[2][2];
    const char* cA = (const char*)g.A + (size_t)cur.pm * tstep; const char* cB = (const char*)g.Bt + (size_t)cur.pn * tstep;
    S.a_ready(cur);
    if constexpr (SP2) {
        PG8_STAGE(PG8_SB(0, 0), cB, voffB); PG8_STAGE(PG8_SB(0, 1), cB + hstep, voffB); PG8_STAGE(PG8_SA(0, 0), cA, voffA); PG8_STAGE(PG8_SA(0, 1), cA + hstep, voffA);
        if (wr == 1) PG8_BAR;
        PG8_WAIT_V(2); PG8_BAR;
        PG8_STAGE(PG8_SB(1, 0), cB + kstep, voffB); PG8_STAGE(PG8_SA(1, 0), cA + kstep, voffA); PG8_STAGE(PG8_SB(1, 1), cB + hstep + kstep, voffB);
        PG8_WAIT_V(6); PG8_BAR;
    } else {
        PG8_STAGE(PG8_SB(0, 0), cB, voffB); PG8_STAGE(PG8_SA(0, 0), cA, voffA); PG8_STAGE(PG8_SB(0, 1), cB + hstep, voffB); PG8_STAGE(PG8_SA(0, 1), cA + hstep, voffA);
        if (wr == 1) PG8_BAR;
        PG8_WAIT_V(4); PG8_BAR;
        PG8_STAGE(PG8_SB(1, 0), cB + kstep, voffB); PG8_STAGE(PG8_SA(1, 0), cA + kstep, voffA); PG8_STAGE(PG8_SB(1, 1), cB + hstep + kstep, voffB);
        PG8_WAIT_V(6); PG8_BAR;
    }
    for (;;) {
        const bool has_next = S.next(ui + 1, nxt);
        const char* nA = has_next ? (const char*)g.A + (size_t)nxt.pm * tstep : cA; const char* nB = has_next ? (const char*)g.Bt + (size_t)nxt.pn * tstep : cB;
        for (int t = 0; t < nt; t += 2) {
            const bool last = (t == nt - 2);
            const char* a1 = cA + (size_t)(t + 1) * kstep;
            const char* a2 = last ? nA : cA + (size_t)(t + 2) * kstep; const char* b2 = last ? nB : cB + (size_t)(t + 2) * kstep;
            const char* a3 = a2 + kstep; const char* b3 = b2 + kstep;
            if (last && has_next) S.a_ready(nxt);
            if constexpr (SP2) {
            PG8_LDB(B0, 0, 0); PG8_LDB(B1, 0, 1); PG8_SCHED; PG8_LDA(At, 0, 0); PG8_STAGE(PG8_SA(1, 1), a1 + hstep, voffA);
            PG8_WAIT_V(8); PG8_WAIT_L(0); PG8_BAR; PG8_MMA(0, 0, At, B0); PG8_MMA(0, 1, At, B1); PG8_BAR; PG8_SCHED;
            PG8_LDA(At, 0, 1); PG8_STAGE(PG8_SB(0, 0), b2, voffB); PG8_STAGE(PG8_SB(0, 1), b2 + hstep, voffB); PG8_STAGE(PG8_SA(0, 0), a2, voffA);
            PG8_WAIT_V(8); PG8_WAIT_L(0); PG8_BAR; PG8_MMA(1, 0, At, B0); PG8_MMA(1, 1, At, B1); PG8_BAR; PG8_SCHED;
            PG8_LDB(B0, 1, 0); PG8_LDB(B1, 1, 1); PG8_SCHED; PG8_LDA(At, 1, 0); PG8_STAGE(PG8_SA(0, 1), a2 + hstep, voffA);
            PG8_WAIT_V(8); PG8_WAIT_L(0); PG8_BAR; PG8_MMA(0, 0, At, B0); PG8_MMA(0, 1, At, B1); PG8_BAR; PG8_SCHED;
            PG8_LDA(At, 1, 1); PG8_STAGE(PG8_SB(1, 0), b3, voffB); PG8_STAGE(PG8_SB(1, 1), b3 + hstep, voffB); PG8_STAGE(PG8_SA(1, 0), a3, voffA);
            PG8_WAIT_V(8); PG8_WAIT_L(0); PG8_BAR; PG8_MMA(1, 0, At, B0); PG8_MMA(1, 1, At, B1); PG8_BAR; PG8_SCHED;
            } else {
            PG8_LDB(B0, 0, 0); PG8_SCHED; PG8_LDA(At, 0, 0); PG8_STAGE(PG8_SA(1, 1), a1 + hstep, voffA);
            PG8_WAIT_L(8); PG8_BAR; PG8_WAIT_L(0); PG8_MMA(0, 0, At, B0); PG8_BAR; PG8_SCHED;
            PG8_LDB(B1, 0, 1); PG8_STAGE(PG8_SB(0, 0), b2, voffB);
            PG8_BAR; PG8_WAIT_L(0); PG8_MMA(0, 1, At, B1); PG8_BAR;
            PG8_LDA(At, 0, 1); PG8_STAGE(PG8_SA(0, 0), a2, voffA);
            PG8_BAR; PG8_WAIT_L(0); PG8_MMA(1, 0, At, B0); PG8_BAR; PG8_SCHED;
            PG8_STAGE(PG8_SB(0, 1), b2 + hstep, voffB);
            PG8_WAIT_V(6); PG8_BAR; PG8_MMA(1, 1, At, B1); PG8_BAR;
            PG8_LDB(B0, 1, 0); PG8_SCHED; PG8_LDA(At, 1, 0); PG8_STAGE(PG8_SA(0, 1), a2 + hstep, voffA);
            PG8_WAIT_L(8); PG8_BAR; PG8_WAIT_L(0); PG8_MMA(0, 0, At, B0); PG8_BAR; PG8_SCHED;
            PG8_LDB(B1, 1, 1); PG8_STAGE(PG8_SB(1, 0), b3, voffB);
            PG8_BAR; PG8_WAIT_L(0); PG8_MMA(0, 1, At, B1); PG8_BAR;
            PG8_LDA(At, 1, 1); PG8_STAGE(PG8_SA(1, 0), a3, voffA);
            PG8_BAR; PG8_WAIT_L(0); PG8_MMA(1, 0, At, B0); PG8_BAR; PG8_SCHED;
            PG8_STAGE(PG8_SB(1, 1), b3 + hstep, voffB);
            PG8_WAIT_V(6); PG8_BAR; PG8_MMA(1, 1, At, B1); PG8_BAR;
            }
        }
        if constexpr (ALIGN_EPI) { if (wr == 0) PG8_BAR; }
        if constexpr (!Epi::AFTER_DRAIN) { E(acc, cur, wr, wc, fr, fq); S.done(cur); }
        if (!has_next) break;
#pragma unroll
        for (int a = 0; a < 2; ++a)
#pragma unroll
            for (int b = 0; b < 2; ++b)
#pragma unroll
                for (int m = 0; m < 4; ++m)
#pragma unroll
                    for (int n = 0; n < 2; ++n) acc[a][b][m][n] = (f32x4){0.f, 0.f, 0.f, 0.f};
        cur = nxt; cA = nA; cB = nB; ++ui;
        if constexpr (ALIGN_EPI) { if (wr == 1) PG8_BAR; }
    }
    PG8_WAIT_V(0);
    if constexpr (!ALIGN_EPI) { if (wr == 0) PG8_BAR; }
    PG8_BAR;
    if constexpr (Epi::AFTER_DRAIN) { E.fused(acc, cur, wr, wc, fr, fq, lds, wid, lane); S.done(cur); }
#undef PG8_SA
#undef PG8_SB
#undef PG8_STAGE
#undef PG8_LDA
#undef PG8_LDB
#undef PG8_MMA
#undef PG8_WAIT_V
#undef PG8_WAIT_L
#undef PG8_BAR
#undef PG8_SCHED
}
}

#ifndef PG8_SP2
#define PG8_SP2 true
#endif
#ifndef PG8_ALIGN
#define PG8_ALIGN true
#endif
#define GAS __attribute__((address_space(1)))
#define LAS __attribute__((address_space(3)))
typedef unsigned short bf16;
typedef unsigned v4u __attribute__((ext_vector_type(4)));
typedef float f32x4 __attribute__((ext_vector_type(4)));
typedef short bf16x8 __attribute__((ext_vector_type(8)));
typedef GAS unsigned gu32;
typedef GAS unsigned long long gu64;
#define RLX_AGENT __ATOMIC_RELAXED, __HIP_MEMORY_SCOPE_AGENT
#define LDS_WAIT() asm volatile("s_waitcnt lgkmcnt(0)" ::: "memory")
#define VM_WAIT() asm volatile("s_waitcnt vmcnt(0)" ::: "memory")
__device__ __forceinline__ unsigned long long rt() { return __builtin_amdgcn_s_memrealtime(); }
__device__ __forceinline__ unsigned f2bf(float f) { unsigned u = __builtin_bit_cast(unsigned, f); return (u + 0x7fffu + ((u >> 16) & 1u)) >> 16; }
__device__ __forceinline__ unsigned pk2(float lo, float hi) { return f2bf(lo) | (f2bf(hi) << 16); }

#define XB_TMO      128
#define XB_XCNT(j)  (256  + 64 * (j))
#define XB_XSUB(j)  (1280 + 64 * (j))
#define XB_XGEN(j)  (2304 + 64 * (j))
#define XB_TOP      3328
#define XB_TOPGEN   3392
#define XCD_BAR_WORDS 3456
#define XB_SPIN_CAP (1u << 18)

__device__ __forceinline__ unsigned xb_ld(unsigned* p)              { return __hip_atomic_load(p, __ATOMIC_RELAXED, __HIP_MEMORY_SCOPE_AGENT); }
__device__ __forceinline__ unsigned xb_add(unsigned* p, unsigned v) { return __hip_atomic_fetch_add(p, v, __ATOMIC_RELAXED, __HIP_MEMORY_SCOPE_AGENT); }
__device__ __forceinline__ unsigned xb_xcc_id() { return (unsigned)__builtin_amdgcn_s_getreg((3 << 11) | 20) & 0xFu; }
#define XB_SPIN(cond, bar) do { unsigned _sp = 0; while (cond) { __builtin_amdgcn_s_sleep(1); \
    if ((++_sp & 255u) == 0u) { if (xb_ld(&(bar)[XB_TMO])) break; if (_sp > XB_SPIN_CAP) { atomicAdd(&(bar)[XB_TMO], 1u); break; } } } } while (0)

struct XcdBarrier {
    unsigned* bar; unsigned x;
    volatile LAS unsigned* st;
};

__device__ __forceinline__ XcdBarrier xcd_barrier_post(unsigned* bar, volatile LAS unsigned* st) {
    XcdBarrier b; b.bar = bar; b.x = xb_xcc_id(); b.st = st;
    if (threadIdx.x == 0) (void)xb_add(&bar[XB_XCNT(b.x)], 1u);
    return b;
}
__device__ __forceinline__ void xcd_barrier_complete(unsigned* bar, unsigned x, unsigned& nloc, unsigned& nx) {
    const unsigned G = gridDim.x * gridDim.y * gridDim.z;
    unsigned sum, cnt, mine, sp = 0u;
    for (;;) {
        sum = 0u; cnt = 0u; mine = 0u;
#pragma unroll
        for (unsigned j = 0; j < 16; ++j) { const unsigned c = xb_ld(&bar[XB_XCNT(j)]); sum += c; cnt += (c > 0u) ? 1u : 0u; mine = (j == x) ? c : mine; }
        if (sum == G) break;
        __builtin_amdgcn_s_sleep(1);
        if ((++sp & 255u) == 0u) { if (xb_ld(&bar[XB_TMO])) break; if (sp > XB_SPIN_CAP) { atomicAdd(&bar[XB_TMO], 1u); break; } }
    }
    nloc = mine > 0u ? mine : 1u; nx = cnt > 0u ? cnt : 1u;
}

__device__ __forceinline__ void xcd_barrier(const XcdBarrier& b) {
    asm volatile("s_waitcnt vmcnt(0)" ::: "memory");
    __syncthreads();
    if (threadIdx.x == 0) {
        unsigned* bar = b.bar; unsigned bx_ = b.x; asm volatile("" : "+s"(bx_));
        __builtin_amdgcn_s_waitcnt(0);
        unsigned nloc = b.st[0], nx = b.st[1];
        if (nloc == 0u) { xcd_barrier_complete(bar, bx_, nloc, nx); b.st[0] = nloc; b.st[1] = nx; }
        const unsigned old = xb_add(&bar[XB_XSUB(bx_)], 1u);
        const unsigned gen = old / nloc;
        if (old + 1u == (gen + 1u) * nloc) {
            __builtin_amdgcn_fence(__ATOMIC_RELEASE, "agent");
            asm volatile("s_waitcnt vmcnt(0)" ::: "memory");
            const unsigned og = xb_add(&bar[XB_TOP], 1u);
            const unsigned tg = og / nx;
            if (og + 1u == (tg + 1u) * nx) xb_add(&bar[XB_TOPGEN], 1u);
            else XB_SPIN(xb_ld(&bar[XB_TOPGEN]) == tg, bar);
            __builtin_amdgcn_fence(__ATOMIC_ACQUIRE, "agent");
            xb_add(&bar[XB_XGEN(bx_)], 1u);
            asm volatile("s_waitcnt vmcnt(0)" ::: "memory");
        } else {
            XB_SPIN(xb_ld(&bar[XB_XGEN(bx_)]) == gen, bar);
            __builtin_amdgcn_fence(__ATOMIC_ACQUIRE, "agent");
            asm volatile("s_waitcnt vmcnt(0)" ::: "memory");
        }
    }
    __syncthreads();
}

namespace attn {
typedef unsigned short bf16;
using bf16x8 = __attribute__((ext_vector_type(8))) short;
using s16x4 = __attribute__((ext_vector_type(4))) short;
using f32x16 = __attribute__((ext_vector_type(16))) float;
using u32x4 = __attribute__((ext_vector_type(4))) unsigned;
typedef __attribute__((address_space(3))) const char* lds_cptr;
typedef __attribute__((address_space(3))) char* lds_ptr;
typedef short v4i16_t __attribute__((ext_vector_type(4)));
constexpr int DM = 1024, SEQ = 8192, KVBLK = 64;
constexpr int KSLOT = 8192;
constexpr float THR = 8.0f;
#ifndef AT_PROBE
#define AT_PROBE 0
#endif
__device__ unsigned long long g_probe[8];
template <int DV, int AH> struct Lay {
    static constexpr int VSLOT = DV * 128, NKSLOT = AH + 1, NVSLOT = AH + 3, LDS_K = 0, LDS_V = NKSLOT * KSLOT, LDS_WS = LDS_V + NVSLOT * VSLOT, OSTW = 32 * DV * 2,
        LDS_OST = LDS_V  , BYTES = LDS_WS + 8 * 256;
    static_assert(8 * OSTW <= NVSLOT * VSLOT, "O stages fit inside the V ring");
};
#define AT_SBAR() __builtin_amdgcn_sched_barrier(0)
#define AT_WAIT_BAR(N) asm volatile("s_waitcnt vmcnt(" #N ") lgkmcnt(0)\n\ts_barrier" ::: "memory")
__device__ __forceinline__ void wait_bar_n(int n) {
    switch (n) {
        case 0: AT_WAIT_BAR(0); break; case 1: AT_WAIT_BAR(1); break; case 2: AT_WAIT_BAR(2); break; case 3: AT_WAIT_BAR(3); break;
        case 4: AT_WAIT_BAR(4); break; case 5: AT_WAIT_BAR(5); break; case 6: AT_WAIT_BAR(6); break; case 7: AT_WAIT_BAR(7); break;
        case 8: AT_WAIT_BAR(8); break; case 9: AT_WAIT_BAR(9); break; case 10: AT_WAIT_BAR(10); break; case 11: AT_WAIT_BAR(11); break;
        case 12: AT_WAIT_BAR(12); break; case 13: AT_WAIT_BAR(13); break; case 14: AT_WAIT_BAR(14); break; default: AT_WAIT_BAR(15); break;
    }
}
__device__ __forceinline__ int crow(int r, int hi) { return (r & 3) + 8 * (r >> 2) + 4 * hi; }
__device__ __forceinline__ unsigned f2bf_u(float f) { unsigned u = __builtin_bit_cast(unsigned, f); return (u + 0x7fffu + ((u >> 16) & 1u)) >> 16; }
__device__ __forceinline__ float bf2f_u(unsigned h) { return __builtin_bit_cast(float, h << 16); }
__device__ __forceinline__ void glds16(const void* gsrc, unsigned lds_dst) { unsigned keep;
    asm volatile("s_mov_b32 %0, m0\n\ts_mov_b32 m0, %2\n\ts_nop 0\n\tglobal_load_lds_dwordx4 %1, off\n\ts_mov_b32 m0, %0" : "=&s"(keep) : "v"(gsrc), "s"(lds_dst) : "memory"); }
typedef float f32x2_t __attribute__((ext_vector_type(2))); typedef __bf16 bf16x2_t __attribute__((ext_vector_type(2)));
__device__ __forceinline__ unsigned cvtpk_s(float lo, float hi) { f32x2_t v = {lo, hi}; bf16x2_t b = __builtin_convertvector(v, bf16x2_t); return __builtin_bit_cast(unsigned, b); }
__device__ __forceinline__ s16x4 vtr(lds_cptr p) { return __builtin_bit_cast(s16x4, __builtin_amdgcn_ds_read_tr16_b64_v4i16((__attribute__((address_space(3))) v4i16_t*)p)); }
#define AT_MX3(a, b, c) __builtin_fmaxf(__builtin_fmaxf((a), (b)), (c))
#define AT_MFMA(a, b, c) __builtin_amdgcn_mfma_f32_32x32x16_bf16(a, b, c, 0, 0, 0)
__device__ __forceinline__ float rowmax(const f32x16& p0, const f32x16& p1) {
    float a = AT_MX3(p0[0], p0[1], p1[0]), b = AT_MX3(p0[2], p0[3], p1[1]); a = AT_MX3(a, p1[2], p1[3]);
#pragma unroll
    for (int r = 4; r < 16; r += 4) { a = AT_MX3(a, p0[r], p0[r + 1]); b = AT_MX3(b, p0[r + 2], p0[r + 3]); a = AT_MX3(a, p1[r], p1[r + 1]); b = AT_MX3(b, p1[r + 2], p1[r + 3]); }
    float m = __builtin_fmaxf(a, b); auto rr = __builtin_amdgcn_permlane32_swap(__float_as_uint(m), __float_as_uint(m), false, false);
    return __builtin_fmaxf(__uint_as_float(rr[0]), __uint_as_float(rr[1])); }
__device__ __forceinline__ void cmask(f32x16& p0, f32x16& p1, int jb, int qrel, int hi) {
    const int lim = qrel - 64 * jb - 4 * hi;
#pragma unroll
    for (int r = 0; r < 16; ++r) { const int kv = (r & 3) + 8 * (r >> 2); if (kv > lim) p0[r] = -INFINITY; if (kv + 32 > lim) p1[r] = -INFINITY; } }

template <int DV, bool MOBA, int AH>
__device__ __forceinline__ void sweep(char* shm, const bf16* Qw, const bf16* __restrict__ Kh, const bf16* __restrict__ Vh, int qb, int kt_min, float slope2, unsigned sel, f32x16 (&o)[DV / 32], float& l_out) {
    typedef Lay<DV, AH> L;
    constexpr int NPV = DV / 64, NPT = 1 + NPV;
    int tid_ = threadIdx.x; asm volatile("" : "+v"(tid_));
    const int tid = tid_, lane = tid & 63, r32 = lane & 31, hi = lane >> 5; const int wid = __builtin_amdgcn_readfirstlane(tid >> 6);
    const unsigned lds0 = (unsigned)(uintptr_t)shm;
    const lds_ptr shm3 = (lds_ptr)shm;
    __attribute__((address_space(3))) float* wsf = (__attribute__((address_space(3))) float*)(shm3 + L::LDS_WS) + wid * 64;
    const int NT = 4 * qb + 4 - kt_min;
    const bf16* ksrc = Kh + (long)lane * DM + wid * 8;
    const bf16* vsrc0 = Vh + (long)(16 * (wid & 3) + (lane >> 2)) * DM + (wid >> 2) * 32 + (lane & 3) * 8;
    const unsigned kdst = lds0 + L::LDS_K + wid * 1024, vdst = lds0 + L::LDS_V + wid * 1024;
#define AT_KT(i) (MOBA ? ((i) < 4 ? 4 * qb + (i) : (i) - 4 + kt_min) : (i) + kt_min)
#define AT_DMA(i, ksl, vsl) do { if ((i) >= NT) break; const long kt_ = AT_KT(i); glds16(ksrc + kt_ * KVBLK * DM, (unsigned)__builtin_amdgcn_readfirstlane(kdst + (ksl) * KSLOT)); \
        glds16(vsrc0 + kt_ * KVBLK * DM, (unsigned)__builtin_amdgcn_readfirstlane(vdst + (vsl) * L::VSLOT)); \
        if (NPV == 2) glds16(vsrc0 + kt_ * KVBLK * DM + 64, (unsigned)__builtin_amdgcn_readfirstlane(vdst + (vsl) * L::VSLOT + 8192)); } while (0)
#define AT_VRD(g_, d_) do { _Pragma("unroll") for (int ks = 0; ks < 4; ++ks) { vl[g_][ks] = vtr(vp + (d_) * 4096 + ks * 1024); vh[g_][ks] = vtr(vp + (d_) * 4096 + ks * 1024 + 512); } } while (0)
    bf16x8 qr[4];
#pragma unroll
    for (int d0 = 0; d0 < 4; ++d0) qr[d0] = *reinterpret_cast<const bf16x8*>(&Qw[(long)r32 * DM + d0 * 16 + hi * 8]);
    { _Pragma("unroll") for (int a = 0; a < AH; ++a) AT_DMA(a, a, a); }
    const lds_cptr kp0 = (lds_cptr)shm3 + L::LDS_K + hi * 1024 + r32 * 16;
    const lds_cptr vp0 = (lds_cptr)shm3 + L::LDS_V + ((lane >> 4) & 1) * 32 + (lane & 3) * 8 + (4 * hi + ((lane & 15) >> 2)) * 64;
    const unsigned sw = (unsigned)__builtin_amdgcn_readfirstlane((int)(f2bf_u(slope2) | (f2bf_u(slope2 - bf2f_u(f2bf_u(slope2))) << 16)));
    const unsigned hmask = hi == 0 ? 0xffffffffu : 0u;
    const unsigned off0w = (f2bf_u((float)r32) * 0x10001u) & hmask, off1w = (f2bf_u((float)(32 + r32)) * 0x10001u) & hmask;
    unsigned qz = 0u;
    float mhat = 0.f, l_reg = 0.f;
#pragma unroll
    for (int d = 0; d < DV / 32; ++d) o[d] = f32x16{};
    const int qrel = wid * 32 + r32;
    int slot = 0, vslot = 0;
    constexpr int ND = DV / 32, NMF = 4 * ND, NEXP = 32 / NMF, NVS = AH + 3;
    u32x4 pw[4] = {{0u, 0u, 0u, 0u}, {0u, 0u, 0u, 0u}, {0u, 0u, 0u, 0u}, {0u, 0u, 0u, 0u}};
    const bool late = wid >= 4;
#define AT_PIN(x) asm volatile("" : "+v"(x))
#define AT_CE(e) ((e) < 16 ? c0[(e) & 15] : c1[(e) & 15])
#define AT_VOFF(g) (((g) >> 2) * 4096 + ((g) & 3) * 1024)
    f32x16 c0, c1; bool resc = false;
#define AT_PHA(T_) do { \
        bf16x8 kf[8]; \
        { const lds_cptr kp = kp0 + slot * KSLOT; \
          _Pragma("unroll") for (int j = 0; j < 4; ++j) { kf[2 * j] = *(const __attribute__((address_space(3))) bf16x8*)(kp + j * 2048); kf[2 * j + 1] = *(const __attribute__((address_space(3))) bf16x8*)(kp + j * 2048 + 512); } } \
        AT_SBAR(); \
        { const int s2 = slot == 0 ? AH : slot - 1; int v2 = vslot + AH; v2 = v2 >= NVS ? v2 - NVS : v2; AT_DMA((T_) + AH, s2, v2); } \
        const int kt = AT_KT(T_); \
        const int jb = MOBA ? ((T_) < 4 ? (T_) : -1) : ((T_) - (NT - 4)); \
        { const unsigned tb = __float_as_uint((float)(64 * (kt - 4 * qb))) >> 16; \
          const unsigned tbw = (tb * 0x10001u) & hmask, onew = 0x3f803f80u & hmask, swm = sw & hmask; \
          const u32x4 a0 = {off0w, tbw, onew, 0u}, a1 = {off1w, tbw, onew, 0u}; \
          u32x4 qv = {swm, swm, qz, 0u}; \
          if (MOBA) { if (hi == 0 && (T_) >= 4 && !((sel >> (kt >> 2)) & 1u)) qv.z = 0x0000f14au; } \
          c0 = AT_MFMA(__builtin_bit_cast(bf16x8, a0), __builtin_bit_cast(bf16x8, qv), f32x16{}); c1 = AT_MFMA(__builtin_bit_cast(bf16x8, a1), __builtin_bit_cast(bf16x8, qv), f32x16{}); \
          _Pragma("unroll") for (int j = 0; j < 4; ++j) { c0 = AT_MFMA(kf[2 * j], qr[j], c0); c1 = AT_MFMA(kf[2 * j + 1], qr[j], c1); } } \
        if (jb >= 0) { asm volatile("" ::: "memory"); cmask(c0, c1, jb, qrel, hi); } \
        resc = false; \
        { const float rm = rowmax(c0, c1); const bool first = ((T_) == 0); \
          if (first || __any(rm > THR)) { \
              const float dl = first ? rm : __builtin_fmaxf(rm, 0.f); const float mnew = mhat + dl; \
              const unsigned nh = f2bf_u(-mnew), nl = f2bf_u(-mnew - bf2f_u(nh)); const float meff = -(bf2f_u(nh) + bf2f_u(nl)); \
              const float dle = meff - mhat; mhat = meff; qz = (nh | (nl << 16)) & hmask; \
              _Pragma("unroll") for (int r = 0; r < 16; ++r) { c0[r] -= dle; c1[r] -= dle; } \
              if (!first) { const float f = __builtin_amdgcn_exp2f(-dle); l_reg *= f; if (hi == 0) wsf[r32] = f; resc = true; } } } \
    } while (0)
#define AT_PHB(VS_) do { \
        u32x4 pn[4]; float sacc = 0.f; \
        const lds_cptr vp = vp0 + (VS_) * L::VSLOT; \
        s16x4 vl[NMF], vh[NMF]; \
        _Pragma("unroll") for (int g = 0; g < 4; ++g) { vl[g] = vtr(vp + AT_VOFF(g)); vh[g] = vtr(vp + AT_VOFF(g) + 512); } \
        AT_SBAR(); \
        _Pragma("unroll") for (int g = 0; g < NMF; ++g) { \
            if (g + 4 < NMF) { vl[g + 4] = vtr(vp + AT_VOFF(g + 4)); vh[g + 4] = vtr(vp + AT_VOFF(g + 4) + 512); } \
            { const bf16x8 vf = (bf16x8){vl[g][0], vl[g][1], vl[g][2], vl[g][3], vh[g][0], vh[g][1], vh[g][2], vh[g][3]}; \
              o[g >> 2] = AT_MFMA(__builtin_bit_cast(bf16x8, pw[g & 3]), vf, o[g >> 2]); } \
            _Pragma("unroll") for (int x = 0; x < NEXP; x += 2) { const int e = g * NEXP + x; \
                const float p0 = __builtin_amdgcn_exp2f(AT_CE(e)), p1 = __builtin_amdgcn_exp2f(AT_CE(e + 1)); \
                sacc += p0; sacc += p1; pn[e >> 3][(e & 7) >> 1] = cvtpk_s(p0, p1); } \
            AT_PIN(sacc); AT_PIN(pn[(g * NEXP) >> 3]); \
            AT_SBAR(); } \
        if (resc) { \
            asm volatile("s_waitcnt lgkmcnt(0)" ::: "memory"); \
            _Pragma("unroll") for (int d = 0; d < ND; ++d) _Pragma("unroll") for (int r = 0; r < 16; ++r) o[d][r] *= wsf[crow(r, hi)]; } \
        l_reg += sacc; \
        _Pragma("unroll") for (int k = 0; k < 4; ++k) pw[k] = pn[k]; \
    } while (0)
#define AT_STEP_END(T_) do { { int na = NT - 2 - (T_); na = na < 0 ? 0 : (na > AH - 1 ? AH - 1 : na); wait_bar_n(na * NPT); } \
        slot = slot == AH ? 0 : slot + 1; vslot = vslot == NVS - 1 ? 0 : vslot + 1; } while (0)
    wait_bar_n(((NT < AH ? NT : AH) - 1) * NPT);
    int vlast;
    if (!late) {
        for (int i = 0; i < NT; ++i) {
            AT_PHA(i);
            AT_PHB(i == 0 ? 0 : (vslot == 0 ? NVS - 1 : vslot - 1));
            AT_STEP_END(i);
        }
        vlast = vslot == 0 ? NVS - 1 : vslot - 1;
    } else {
        for (int i = 0; i < NT; ++i) {
            if (i > 0) { AT_PHB(i == 1 ? 0 : (vslot < 2 ? vslot + NVS - 2 : vslot - 2)); }
            AT_PHA(i);
            AT_STEP_END(i);
        }
        AT_PHB(NT == 1 ? 0 : (vslot < 2 ? vslot + NVS - 2 : vslot - 2));
        vlast = vslot == 0 ? NVS - 1 : vslot - 1;
    }
    { const lds_cptr vp = vp0 + vlast * L::VSLOT; s16x4 vl[2][4], vh[2][4];
      AT_VRD(0, 0); AT_SBAR();
#pragma unroll
      for (int d = 0; d < ND; ++d) {
          if (d + 1 < ND) AT_VRD((d + 1) & 1, d + 1);
          AT_SBAR();
#pragma unroll
          for (int ks = 0; ks < 4; ++ks) { const bf16x8 vf = (bf16x8){vl[d & 1][ks][0], vl[d & 1][ks][1], vl[d & 1][ks][2], vl[d & 1][ks][3], vh[d & 1][ks][0], vh[d & 1][ks][1], vh[d & 1][ks][2], vh[d & 1][ks][3]};
              o[d] = AT_MFMA(__builtin_bit_cast(bf16x8, pw[ks]), vf, o[d]); }
          AT_SBAR(); } }
    AT_WAIT_BAR(0);
#undef AT_PIN
#undef AT_CE
#undef AT_VOFF
#undef AT_PHA
#undef AT_PHB
#undef AT_STEP_END
    { auto rr = __builtin_amdgcn_permlane32_swap(__float_as_uint(l_reg), __float_as_uint(l_reg), false, false); l_out = __uint_as_float(rr[0]) + __uint_as_float(rr[1]); }
#undef AT_KT
#undef AT_DMA
#undef AT_VRD
}

__device__ __forceinline__ int window_kt_min(const unsigned* nrm, int b, int chunk, int q0, float slope2) {
    const float nq = __uint_as_float(nrm[((0 * 2 + b) * 16 + chunk) * 2]) + __uint_as_float(nrm[((0 * 2 + b) * 16 + chunk) * 2 + 1]);
    const float nk = __uint_as_float(nrm[((1 * 2 + b) * 16 + chunk) * 2]) + __uint_as_float(nrm[((1 * 2 + b) * 16 + chunk) * 2 + 1]);
    const float B = sqrtf(nq * nk) * 1.01f;
    const float W = (2.0f * B + 160.0f) / slope2;
    const int wkeys = W < 1.0e6f ? (int)W : 1000000;
    const int d = q0 - wkeys;
    return d > 0 ? (d >> 6) : 0;
}
__device__ __forceinline__ void diff_item(char* shm, int b, int h, int qb, int m, const bf16* Q, const bf16* K, const bf16* V, bf16* O, float lam, const unsigned* nrm, unsigned* flag, unsigned* tmo) {
    typedef Lay<128, 2> L;
    int tid_ = threadIdx.x; asm volatile("" : "+v"(tid_));
    const int tid = tid_; const int wid = __builtin_amdgcn_readfirstlane(tid >> 6);
    const long rowbase = (long)b * SEQ; const int q0 = qb * 256;
    const float slope2 = __builtin_amdgcn_exp2f(-(float)(h + 1)) * 1.4426950408889634f;
    lam = __uint_as_float((unsigned)__builtin_amdgcn_readfirstlane((int)__float_as_uint(lam)));
    const lds_ptr shm3 = (lds_ptr)shm;
    __attribute__((address_space(3))) float* wsf = (__attribute__((address_space(3))) float*)(shm3 + L::LDS_WS) + wid * 64;
    __attribute__((address_space(3))) bf16* stg = (__attribute__((address_space(3))) bf16*)(shm3 + L::LDS_OST + wid * L::OSTW);
    f32x16 o[4]; float l;
    const int kt_min = __builtin_amdgcn_readfirstlane(window_kt_min(nrm, b, 2 * h + m, q0, slope2));
    sweep<128, false, 2>(shm, Q + (rowbase + q0 + wid * 32) * DM + h * 128 + m * 64, K + rowbase * DM + h * 128 + m * 64, V + rowbase * DM + h * 128, qb, kt_min, slope2, 0u, o, l);
    int lane_e = tid & 63; asm volatile("" : "+v"(lane_e));
    const int lane = lane_e, r32 = lane & 31, hi = lane >> 5;
    bf16* Ow = O + (rowbase + q0 + wid * 32) * DM + h * 128;
    if (hi == 0) wsf[32 + r32] = l;
    asm volatile("s_waitcnt lgkmcnt(0)" ::: "memory");
    float rli[16];
#pragma unroll
    for (int r = 0; r < 16; ++r) rli[r] = (m == 0 ? 1.0f : lam) * __builtin_amdgcn_rcpf(wsf[32 + crow(r, hi)]);
    if (m == 0) {
#pragma unroll
        for (int r = 0; r < 16; ++r)
#pragma unroll
            for (int d = 0; d < 4; ++d) stg[crow(r, hi) * 128 + d * 32 + r32] = (bf16)f2bf_u(o[d][r] * rli[r]);
        asm volatile("s_waitcnt lgkmcnt(0)" ::: "memory");
#pragma unroll
        for (int i = 0; i < 8; ++i) { const int row = i * 4 + (lane >> 4), ch = lane & 15; const u32x4 v = *(const __attribute__((address_space(3))) u32x4*)(stg + row * 128 + ch * 8); *(u32x4*)(Ow + (long)row * DM + ch * 8) = v; }
        asm volatile("s_waitcnt vmcnt(0)" ::: "memory");
        __syncthreads();
        if (tid == 0) { __builtin_amdgcn_fence(__ATOMIC_RELEASE, "agent"); asm volatile("s_waitcnt vmcnt(0)" ::: "memory"); __hip_atomic_store(flag, 1u, __ATOMIC_RELAXED, __HIP_MEMORY_SCOPE_AGENT); }
    } else {
        if (tid == 0) {
            unsigned sp = 0u;
            while (__hip_atomic_load(flag, __ATOMIC_RELAXED, __HIP_MEMORY_SCOPE_AGENT) == 0u) { __builtin_amdgcn_s_sleep(8); if (++sp > (1u << 22)) { __hip_atomic_store(tmo, 1u, __ATOMIC_RELAXED, __HIP_MEMORY_SCOPE_AGENT); break; } }
            __builtin_amdgcn_fence(__ATOMIC_ACQUIRE, "agent");
            asm volatile("s_waitcnt vmcnt(0)" ::: "memory");
        }
        __syncthreads();
#pragma unroll
        for (int i = 0; i < 8; ++i) { const int row = i * 4 + (lane >> 4), ch = lane & 15; const u32x4 v = *(const u32x4*)(Ow + (long)row * DM + ch * 8); *(__attribute__((address_space(3))) u32x4*)(stg + row * 128 + ch * 8) = v; }
        asm volatile("s_waitcnt vmcnt(0) lgkmcnt(0)" ::: "memory");
        float ss[16];
#pragma unroll
        for (int r = 0; r < 16; ++r) { float sq = 0.f;
#pragma unroll
            for (int d = 0; d < 4; ++d) { const float v = bf2f_u(stg[crow(r, hi) * 128 + d * 32 + r32]) - o[d][r] * rli[r]; o[d][r] = v; sq = __builtin_fmaf(v, v, sq); }
            ss[r] = sq; }
#pragma unroll
        for (int r = 0; r < 16; ++r) {
#pragma unroll
            for (int off = 1; off < 32; off <<= 1) ss[r] += __shfl_xor(ss[r], off);
            ss[r] = 1.0f / sqrtf(ss[r] * (1.0f / 128.0f) + 1e-6f); }
#pragma unroll
        for (int r = 0; r < 16; ++r)
#pragma unroll
            for (int d = 0; d < 4; ++d) stg[crow(r, hi) * 128 + d * 32 + r32] = (bf16)f2bf_u(o[d][r] * ss[r]);
        asm volatile("s_waitcnt lgkmcnt(0)" ::: "memory");
#pragma unroll
        for (int i = 0; i < 8; ++i) { const int row = i * 4 + (lane >> 4), ch = lane & 15; const u32x4 v = *(const __attribute__((address_space(3))) u32x4*)(stg + row * 128 + ch * 8); *(u32x4*)(Ow + (long)row * DM + ch * 8) = v; }
    }
}
__device__ __forceinline__ void moba_unit(char* shm, int b, int h, int qb, const bf16* Q, const bf16* K, const bf16* V, bf16* O, const float* KM, const unsigned* nrm) {
    typedef Lay<64, 3> L;
    int tid_ = threadIdx.x; asm volatile("" : "+v"(tid_));
    const int tid = tid_, lane = tid & 63, r32 = lane & 31, hi = lane >> 5; const int wid = __builtin_amdgcn_readfirstlane(tid >> 6);
    const long rowbase = (long)b * SEQ; const int q0 = qb * 256;
    const float slope2 = __builtin_amdgcn_exp2f(-0.5f * (float)(h + 1)) * 1.4426950408889634f;
    const lds_ptr shm3 = (lds_ptr)shm;
    __attribute__((address_space(3))) float* wsf = (__attribute__((address_space(3))) float*)(shm3 + L::LDS_WS) + wid * 64;
    __attribute__((address_space(3))) bf16* stg = (__attribute__((address_space(3))) bf16*)(shm3 + L::LDS_OST + wid * L::OSTW);
    const bf16* Qw = Q + (rowbase + q0 + wid * 32) * DM + h * 64;
    unsigned sel = 0u;
    if (qb > 0) {
        f32x16 g = f32x16{};
        const float* km = KM + (((long)b * 16 + h) * 32 + r32) * 64 + hi * 8;
#pragma unroll
        for (int d0 = 0; d0 < 4; ++d0) {
            const bf16x8 qf = *reinterpret_cast<const bf16x8*>(&Qw[(long)r32 * DM + d0 * 16 + hi * 8]);
            const float4 x0 = *(const float4*)(km + d0 * 16), x1 = *(const float4*)(km + d0 * 16 + 4);
            const float xs[8] = {x0.x, x0.y, x0.z, x0.w, x1.x, x1.y, x1.z, x1.w};
            unsigned hw[8], lw[8];
#pragma unroll
            for (int e = 0; e < 8; ++e) { hw[e] = f2bf_u(xs[e]); lw[e] = f2bf_u(xs[e] - bf2f_u(hw[e])); }
            const u32x4 ah = {hw[0] | (hw[1] << 16), hw[2] | (hw[3] << 16), hw[4] | (hw[5] << 16), hw[6] | (hw[7] << 16)};
            const u32x4 al = {lw[0] | (lw[1] << 16), lw[2] | (lw[3] << 16), lw[4] | (lw[5] << 16), lw[6] | (lw[7] << 16)};
            g = AT_MFMA(__builtin_bit_cast(bf16x8, ah), qf, g); g = AT_MFMA(__builtin_bit_cast(bf16x8, al), qf, g);
        }
        float g0[16], g1[16];
#pragma unroll
        for (int r = 0; r < 16; ++r) { auto rr = __builtin_amdgcn_permlane32_swap(__float_as_uint(g[r]), __float_as_uint(g[r]), false, false); g0[r] = __uint_as_float(rr[0]); g1[r] = __uint_as_float(rr[1]); }
        float b0 = -INFINITY, b1 = -INFINITY, b2 = -INFINITY; int i0 = 0, i1 = 0, i2 = 0;
#pragma unroll
        for (int n = 0; n < 32; ++n) {
            const int rn = 4 * (n >> 3) + (n & 3);
            float v = ((n >> 2) & 1) ? g1[rn] : g0[rn];
            if (n >= qb) v = -INFINITY;
            if (v > b0) { b2 = b1; i2 = i1; b1 = b0; i1 = i0; b0 = v; i0 = n; }
            else if (v > b1) { b2 = b1; i2 = i1; b1 = v; i1 = n; }
            else if (v > b2) { b2 = v; i2 = n; }
        }
        if (b0 > -INFINITY) sel |= 1u << i0;
        if (b1 > -INFINITY) sel |= 1u << i1;
        if (b2 > -INFINITY) sel |= 1u << i2;
    }
    f32x16 o[2]; float l;
    const int kt_min = __builtin_amdgcn_readfirstlane(window_kt_min(nrm, b, h, q0, slope2));
    sweep<64, true, 3>(shm, Qw, K + rowbase * DM + h * 64, V + rowbase * DM + h * 64, qb, kt_min, slope2, sel, o, l);
    int lane_e = lane; asm volatile("" : "+v"(lane_e));
    { const int lane = lane_e, r32 = lane & 31, hi = lane >> 5;
    if (hi == 0) wsf[32 + r32] = l;
    asm volatile("s_waitcnt lgkmcnt(0)" ::: "memory");
#pragma unroll
    for (int r = 0; r < 16; ++r) { const float rl = __builtin_amdgcn_rcpf(wsf[32 + crow(r, hi)]);
#pragma unroll
        for (int d = 0; d < 2; ++d) stg[crow(r, hi) * 64 + d * 32 + r32] = (bf16)f2bf_u(o[d][r] * rl); }
    asm volatile("s_waitcnt lgkmcnt(0)" ::: "memory");
    bf16* Ow = O + (rowbase + q0 + wid * 32) * DM + h * 64;
#pragma unroll
    for (int i = 0; i < 4; ++i) { const int row = i * 8 + (lane >> 3), ch = lane & 7; const u32x4 v = *(const __attribute__((address_space(3))) u32x4*)(stg + row * 64 + ch * 8); *(u32x4*)(Ow + (long)row * DM + ch * 8) = v; }
    }
}
#undef AT_SBAR
#undef AT_WAIT_BAR
#undef AT_MX3
#undef AT_MFMA
}

constexpr int NWAVES = 8;
constexpr int RING_OFF = 0, RING_BYTES = 131072;
constexpr int LDSCTL_OFF = RING_BYTES, MISC_OFF = LDSCTL_OFF + 320;
constexpr int LDS_BYTES = RING_BYTES + 1024;
static_assert(attn::Lay<128, 2>::BYTES <= RING_BYTES && attn::Lay<64, 3>::BYTES <= RING_BYTES && LDS_BYTES <= 163840, "LDS budget");
static_assert(MISC_OFF + 128 <= LDS_BYTES, "LDS map");

struct Frame {
    LAS unsigned char* lds; volatile LAS unsigned* MISC; gu32* ctl;
    int tid, lane, wave, vcu, G;
};
__device__ __forceinline__ float wave_sum(float v) {
#pragma unroll
    for (int o = 1; o < 64; o <<= 1) v += __shfl_xor(v, o);
    return v;
}
__device__ __forceinline__ float bf2f(unsigned h) { return __builtin_bit_cast(float, h << 16); }

__device__ __forceinline__ void p0_transpose_item(const float* W, int K, int N, bf16* WT, LAS float* scr, int item, int lane, const float* gk, int gmask, float cmul, int qcols, float qscale) {
    const int nblk = N / 32, kb = item / nblk, nb = item % nblk, k0 = 64 * kb, n0 = 32 * nb;
    const float cs = cmul * ((n0 < qcols) ? qscale : 1.0f);
#pragma unroll 8
    for (int i = 0; i < 32; ++i) { const int kk = 2 * i + (lane >> 5); const float g = gk ? gk[(k0 + kk) & gmask] : 1.0f; scr[kk * 33 + (lane & 31)] = W[(size_t)(k0 + kk) * N + n0 + (lane & 31)] * (g * cs); }
    LDS_WAIT(); asm volatile("" ::: "memory");
    const int c = lane & 7;
#pragma unroll
    for (int j = 0; j < 4; ++j) { const int n = (lane >> 3) + 8 * j; const LAS float* s = scr + (8 * c) * 33 + n;
        v4u o; o.x = pk2(s[0 * 33], s[1 * 33]); o.y = pk2(s[2 * 33], s[3 * 33]); o.z = pk2(s[4 * 33], s[5 * 33]); o.w = pk2(s[6 * 33], s[7 * 33]);
        *(GAS v4u*)(WT + (size_t)(n0 + n) * K + k0 + 8 * c) = o; }
    LDS_WAIT(); asm volatile("" ::: "memory");
}
__device__ __forceinline__ void p0_x_row2(const float* xrow, bf16* hrow, float* ssq, int lane) {
    f32x4 v[2][4];
#pragma unroll
    for (int r = 0; r < 2; ++r)
#pragma unroll
        for (int j = 0; j < 4; ++j) v[r][j] = ((const GAS f32x4*)(xrow + (size_t)r * D) + lane)[64 * j];
#pragma unroll
    for (int r = 0; r < 2; ++r) { GAS unsigned long long* h8 = (GAS unsigned long long*)(hrow + (size_t)r * D) + lane; float s[4];
#pragma unroll
        for (int j = 0; j < 4; ++j) { h8[64 * j] = (unsigned long long)pk2(v[r][j].x, v[r][j].y) | ((unsigned long long)pk2(v[r][j].z, v[r][j].w) << 32);
            s[j] = wave_sum((v[r][j].x * v[r][j].x + v[r][j].y * v[r][j].y) + (v[r][j].z * v[r][j].z + v[r][j].w * v[r][j].w)); }
        if (lane < 16) { const int j = lane >> 2; const float sj = j == 0 ? s[0] : j == 1 ? s[1] : j == 2 ? s[2] : s[3]; ssq[r * 16 + lane] = (lane & 3) == 0 ? sj : 0.f; } }
}
__device__ __forceinline__ void final_row(float* orow, const float* ssq, const float* g, int lane) {
    const float rs = pg8::row_rstd16(ssq, 0);
    GAS f32x4* orr = (GAS f32x4*)orow + lane; const GAS f32x4* gr = (const GAS f32x4*)g + lane;
#pragma unroll
    for (int j = 0; j < 4; ++j) { f32x4 v = orr[64 * j]; const f32x4 gv = gr[64 * j]; v = v * rs * gv; orr[64 * j] = v; }
}

__device__ __forceinline__ void diff_attn_unit_simple(LAS unsigned char* lds, int b, int h, int qblk, const bf16* Q, const bf16* K, const bf16* V, bf16* O, float lam, int tid) {
    LAS float* Ks = (LAS float*)lds; LAS float* Vs = (LAS float*)(lds + 64 * 65 * 4);
    const int qi = tid >> 2, part = tid & 3, q0 = qblk * 128, t = q0 + qi;
    const size_t rowbase = (size_t)b * T;
    const float slope2 = exp2f(-(float)(h + 1)) * LOG2E;
    float ores[32], o0[32], l0 = 0.f;
#pragma unroll 1
    for (int m = 0; m < 2; ++m) {
        float q[16];
        { const bf16* qp = Q + (rowbase + t) * D + h * 128 + m * 64 + part * 16;
#pragma unroll
          for (int i = 0; i < 16; ++i) q[i] = bf2f(qp[i]); }
        float mrun = NEG_BIG, l = 0.f, o[32];
#pragma unroll
        for (int e = 0; e < 32; ++e) o[e] = 0.f;
        const int nkt = q0 / 64 + 2;
        for (int kt = 0; kt < nkt; ++kt) {
            const int kb = kt * 64;
            __syncthreads();
            { const int key = tid >> 3, seg = tid & 7;
              const bf16* kp = K + (rowbase + kb + key) * D + h * 128 + m * 64 + seg * 8;
#pragma unroll
              for (int i = 0; i < 8; ++i) Ks[key * 65 + seg * 8 + i] = bf2f(kp[i]);
              const bf16* vp = V + (rowbase + kb + key) * D + h * 128 + seg * 16;
#pragma unroll
              for (int i = 0; i < 16; ++i) Vs[key * 129 + seg * 16 + i] = bf2f(vp[i]); }
            __syncthreads();
            for (int key = 0; key < 64; ++key) {
                float s = 0.f;
#pragma unroll
                for (int i = 0; i < 16; ++i) s = fmaf(q[i], Ks[key * 65 + part * 16 + i], s);
                s += __shfl_xor(s, 1); s += __shfl_xor(s, 2);
                const int kpos = kb + key;
                s += slope2 * (float)(kpos - t);
                if (kpos > t) s = -INFINITY;
                const float mn = fmaxf(mrun, s);
                const float alpha = exp2f(mrun - mn), p = exp2f(s - mn);
                mrun = mn; l = l * alpha + p;
#pragma unroll
                for (int e = 0; e < 32; ++e) o[e] = fmaf(p, Vs[key * 129 + part * 32 + e], o[e] * alpha);
            }
        }
        if (m == 0) {
#pragma unroll
            for (int e = 0; e < 32; ++e) o0[e] = o[e];
            l0 = l;
        } else {
            const float i0 = 1.0f / l0, i1 = lam / l;
#pragma unroll
            for (int e = 0; e < 32; ++e) ores[e] = o0[e] * i0 - o[e] * i1;
        }
    }
    float ss = 0.f;
#pragma unroll
    for (int e = 0; e < 32; ++e) ss = fmaf(ores[e], ores[e], ss);
    ss += __shfl_xor(ss, 1); ss += __shfl_xor(ss, 2);
    const float rs = 1.0f / sqrtf(ss * (1.0f / 128.0f) + RMS_EPS);
    bf16* op = O + (rowbase + t) * D + h * 128 + part * 32;
#pragma unroll
    for (int e = 0; e < 32; e += 2) *(unsigned*)(op + e) = pk2(ores[e] * rs, ores[e + 1] * rs);
    __syncthreads();
}
__device__ __forceinline__ void moba_unit_simple(int b, int h, int qblk, const bf16* Q, const bf16* K, const bf16* V, bf16* O, const float* KM, int tid) {
    const int qi = tid >> 2, part = tid & 3, q0 = qblk * 128, t = q0 + qi, j = q0 / 256;
    const size_t rowbase = (size_t)b * T;
    const float slope2 = exp2f(-0.5f * (float)(h + 1)) * LOG2E;
    float q[16];
    { const bf16* qp = Q + (rowbase + t) * D + h * 64 + part * 16;
#pragma unroll
      for (int i = 0; i < 16; ++i) q[i] = bf2f(qp[i]); }
    float b0 = -INFINITY, b1 = -INFINITY, b2 = -INFINITY; int i0 = 0, i1 = 0, i2 = 0;
    for (int n = 0; n < j; ++n) {
        const float* km = KM + (((size_t)b * 16 + h) * 32 + n) * 64 + part * 16;
        float g = 0.f;
#pragma unroll
        for (int i = 0; i < 16; ++i) g = fmaf(q[i], km[i], g);
        g += __shfl_xor(g, 1); g += __shfl_xor(g, 2);
        if (g > b0) { b2 = b1; i2 = i1; b1 = b0; i1 = i0; b0 = g; i0 = n; }
        else if (g > b1) { b2 = b1; i2 = i1; b1 = g; i1 = n; }
        else if (g > b2) { b2 = g; i2 = n; }
    }
    const int nsel = j < 3 ? j : 3;
    float mrun = NEG_BIG, l = 0.f, o[16];
#pragma unroll
    for (int e = 0; e < 16; ++e) o[e] = 0.f;
    for (int seg = 0; seg <= nsel; ++seg) {
        const int blk = seg == 0 ? j : (seg == 1 ? i0 : (seg == 2 ? i1 : i2));
        const int kb = blk * 256;
        for (int key = 0; key < 256; ++key) {
            const int kpos = kb + key;
            const bf16* kp = K + (rowbase + kpos) * D + h * 64 + part * 16;
            float s = 0.f;
#pragma unroll
            for (int i = 0; i < 16; ++i) s = fmaf(q[i], bf2f(kp[i]), s);
            s += __shfl_xor(s, 1); s += __shfl_xor(s, 2);
            s += slope2 * (float)(kpos - t);
            if (kpos > t) s = -INFINITY;
            const float mn = fmaxf(mrun, s);
            const float alpha = exp2f(mrun - mn), p = exp2f(s - mn);
            mrun = mn; l = l * alpha + p;
            const bf16* vp = V + (rowbase + kpos) * D + h * 64 + part * 16;
#pragma unroll
            for (int e = 0; e < 16; ++e) o[e] = fmaf(p, bf2f(vp[e]), o[e] * alpha);
        }
    }
    const float il = 1.0f / l;
    bf16* op = O + (rowbase + t) * D + h * 64 + part * 16;
#pragma unroll
    for (int e = 0; e < 16; e += 2) *(unsigned*)(op + e) = pk2(o[e] * il, o[e + 1] * il);
}

#define REP_QKV 1
#define REP_DIFF 1
#define REP_MOBA 1
#define REP_FF1 1
#define REP_PRO 1
#define REP_BAR 1
struct Args { const float* in[10]; float* out; unsigned char* ws; };
__global__ void __launch_bounds__(NWAVES * 64, 2) fwd_kernel(Args args) {
    extern __shared__ __attribute__((aligned(16))) unsigned char lds[];
    Frame F;
    F.lds = (LAS unsigned char*)lds;
    F.MISC = (volatile LAS unsigned*)(F.lds + MISC_OFF);
    F.tid = threadIdx.x; F.lane = F.tid & 63; F.wave = __builtin_amdgcn_readfirstlane(F.tid >> 6);
    F.G = gridDim.x; { const int bx = blockIdx.x; F.vcu = (F.G % 8 == 0) ? (bx % 8) * (F.G / 8) + bx / 8 : bx; }
    unsigned char* ws = args.ws;
    F.ctl = (gu32*)(ws + WS_CTL);
#define PTRS() \
    unsigned long long z_ = 0ull; asm volatile("" : "+s"(z_)); unsigned char* wsl = args.ws + z_; float* out = args.out + z_;     \
    bf16* WIN = (bf16*)(wsl + WS_WIN); bf16* WOUT = (bf16*)(wsl + WS_WOUT); bf16* WFF1 = (bf16*)(wsl + WS_WFF1); bf16* WFF2 = (bf16*)(wsl + WS_WFF2); \
    float* SSQ = (float*)(wsl + WS_SSQ); float* KM = (float*)(wsl + WS_KMEAN); \
    bf16* HB = (bf16*)(wsl + WS_HB); bf16* Qb = (bf16*)(wsl + WS_Q); bf16* Kb = (bf16*)(wsl + WS_K); bf16* Vb = (bf16*)(wsl + WS_V); bf16* Ob = (bf16*)(wsl + WS_O); \
    bf16* ACT = (bf16*)(wsl + WS_ACT); \
    (void)WIN; (void)WOUT; (void)WFF1; (void)WFF2; (void)SSQ; (void)KM; (void)HB; (void)Qb; (void)Kb; (void)Vb; (void)Ob; (void)ACT; (void)out
    for (int u = F.tid; u < (LDS_BYTES - LDSCTL_OFF) / 4; u += NWAVES * 64) ((LAS unsigned*)(F.lds + LDSCTL_OFF))[u] = 0u;
    __syncthreads();
    XcdBarrier bar = xcd_barrier_post((unsigned*)(F.ctl + CW_BAR), F.MISC + 8);
#define GRID_BAR() do { for (int rb_ = 0; rb_ < REP_BAR; ++rb_) xcd_barrier(bar); } while (0)
    const int gw = F.vcu * NWAVES + F.wave, NGW = F.G * NWAVES;

    {
        PTRS();
        const float* x = args.in[0]; const float* attn_norm = args.in[1]; const float* w_in = args.in[2]; const float* w_out = args.in[3];
        const float* diff_subln = args.in[5]; const float* mlp_norm = args.in[6]; const float* w_ff1 = args.in[7]; const float* w_ff2 = args.in[8];
        int ln = threadIdx.x & 63; asm volatile("" : "+v"(ln));
        LAS float* scr = (LAS float*)(F.lds + RING_OFF + F.wave * 16384);
        constexpr int I_IN = (D / 64) * (NQKV / 32), I_OUT = (D / 64) * (D / 32), I_F1 = (D / 64) * (FF / 32), I_F2 = (FF / 64) * (D / 32);
        constexpr int PER_L = I_IN + I_OUT + I_F1 + I_F2;
        for (int rp_ = 0; rp_ < REP_PRO; ++rp_) {
        for (int it = gw; it < 2 * PER_L; it += NGW) {
            const int l = it / PER_L; int r = it % PER_L;
            if (r < I_IN) { p0_transpose_item(w_in + (size_t)l * D * NQKV, D, NQKV, WIN + (size_t)l * NQKV * D, scr, r, ln, attn_norm + l * D, D - 1, 1.0f, D, QSCALE); continue; } r -= I_IN;
            if (r < I_OUT) { p0_transpose_item(w_out + (size_t)l * D * D, D, D, WOUT + (size_t)l * D * D, scr, r, ln, l == 0 ? diff_subln : nullptr, 127, l == 0 ? 0.8f : 1.0f, 0, 1.0f); continue; } r -= I_OUT;
            if (r < I_F1) { p0_transpose_item(w_ff1 + (size_t)l * D * FF, D, FF, WFF1 + (size_t)l * FF * D, scr, r, ln, mlp_norm + l * D, D - 1, 1.0f, 0, 1.0f); continue; } r -= I_F1;
            p0_transpose_item(w_ff2 + (size_t)l * FF * D, FF, D, WFF2 + (size_t)l * D * FF, scr, r, ln, nullptr, 0, 1.0f, 0, 1.0f);
        }
        for (int m = 2 * gw; m < M; m += 2 * NGW) p0_x_row2(x + (size_t)m * D, HB + (size_t)m * D, SSQ + (size_t)m * 16, ln);
        }
    }
    GRID_BAR();

#pragma unroll 1
    for (int l = 0; l < 2; ++l) {
        {
            PTRS();
            pg8::Gemm g{HB, WIN + (size_t)l * NQKV * D, M, NQKV, D}; pg8::StaticOrder S; S.init(M, NQKV, F.G, (int)blockIdx.x);
            pg8::EpiScaleBf16<0> E{Qb, D, SSQ, D, (size_t)M * D, l == 1 ? (float*)(F.ctl + CW_KMS) : nullptr, (unsigned*)(F.ctl + CW_NRM + l * 256)};
            for (int rep = 0; rep < REP_QKV; ++rep)
            pg8::gemm_phase<pg8::EpiScaleBf16<0>, pg8::StaticOrder, PG8_ALIGN, PG8_SP2>(F.lds + RING_OFF, g, S, E);
        }
        GRID_BAR();
        if (l == 0) {
            PTRS();
            const float* lp = args.in[4];
            int lnl = threadIdx.x & 63; asm volatile("" : "+v"(lnl));
            const float la = wave_sum(lp[lnl] * lp[64 + lnl]), lc = wave_sum(lp[128 + lnl] * lp[192 + lnl]);
            const float lam = expf(la) - expf(lc) + 0.2f;
            for (int rep = 0; rep < REP_DIFF; ++rep)
            for (;;) {
                if (F.tid == 0) F.MISC[16] = __hip_atomic_fetch_add(F.ctl + CW_QUEUE + 64 * rep, 1u, RLX_AGENT);
                __syncthreads();
                const int i = (int)F.MISC[16];
                __syncthreads();
                if (i >= 1024) break;
                const int u = i >> 1, bh = u & 15, qb = 31 - (u >> 4);
                attn::diff_item((char*)lds + RING_OFF, bh >> 3, bh & 7, qb, i & 1, Qb, Kb, Vb, Ob, lam, (const unsigned*)(F.ctl + CW_NRM), (unsigned*)(F.ctl + CW_DFLAG + rep * 512 + u), (unsigned*)(F.ctl + CW_BAR) + XB_TMO);
            }
        } else {
            PTRS();
            const float* KMf = (const float*)(F.ctl + CW_KMS);
            for (int rep = 0; rep < REP_MOBA; ++rep)
            for (;;) {
                if (F.tid == 0) F.MISC[16] = __hip_atomic_fetch_add(F.ctl + CW_QUEUE + 64 * (4 + rep), 1u, RLX_AGENT);
                __syncthreads();
                const int i = (int)F.MISC[16];
                __syncthreads();
                if (i >= 1024) break;
                const int bh = i & 31, qb = 31 - (i >> 5);
                attn::moba_unit((char*)lds + RING_OFF, bh >> 4, bh & 15, qb, Qb, Kb, Vb, Ob, KMf, (const unsigned*)(F.ctl + CW_NRM + 256));
            }
        }
        GRID_BAR();
        {
            PTRS();
            pg8::Gemm g{Ob, WOUT + (size_t)l * D * D, M, D, D}; pg8::StaticOrder S; S.init(M, D, F.G, (int)blockIdx.x);
            pg8::EpiRes<false> E{out, HB, SSQ, D};
            pg8::gemm_phase<pg8::EpiRes<false>, pg8::StaticOrder, PG8_ALIGN, PG8_SP2>(F.lds + RING_OFF, g, S, E);
        }
        GRID_BAR();
        {
            PTRS();
            pg8::Gemm g{HB, WFF1 + (size_t)l * FF * D, M, FF, D}; pg8::StaticOrder S; S.init(M, FF, F.G, (int)blockIdx.x);
            pg8::EpiScaleBf16<1> E{ACT, FF, SSQ, 0, 0, nullptr, nullptr};
            for (int rep = 0; rep < REP_FF1; ++rep)
            pg8::gemm_phase<pg8::EpiScaleBf16<1>, pg8::StaticOrder, PG8_ALIGN, PG8_SP2>(F.lds + RING_OFF, g, S, E);
        }
        GRID_BAR();
        {
            PTRS();
            pg8::Gemm g{ACT, WFF2 + (size_t)l * D * FF, M, D, FF}; pg8::StaticOrder S; S.init(M, D, F.G, (int)blockIdx.x);
            if (l == 0) { pg8::EpiRes<false> E{out, HB, SSQ, D}; pg8::gemm_phase<pg8::EpiRes<false>, pg8::StaticOrder, PG8_ALIGN, PG8_SP2>(F.lds + RING_OFF, g, S, E); }
            else { pg8::EpiRes<true> E{out, HB, SSQ, D}; pg8::gemm_phase<pg8::EpiRes<true>, pg8::StaticOrder, PG8_ALIGN, PG8_SP2>(F.lds + RING_OFF, g, S, E); }
        }
        GRID_BAR();
    }
    PTRS(); const float* final_norm = args.in[9]; int lnf = threadIdx.x & 63; asm volatile("" : "+v"(lnf));
#if AT_PROBE
    float pscale;
    { const float tot = (float)attn::g_probe[0], a1 = (float)attn::g_probe[1], nst = (float)attn::g_probe[2];
      float xv = AT_PROBE == 1 ? a1 / tot : AT_PROBE == 2 ? (tot / nst) * (1.0f / 10000.0f) : AT_PROBE == 3 ? (float)attn::g_probe[3] / tot : (float)attn::g_probe[4] / tot;
      xv = floorf(xv * AT_PROBE_Q + 0.5f) * (1.0f / AT_PROBE_Q);
      pscale = 1.0f + 0.1f + 0.9f * xv; }
#endif
    for (int m = gw; m < M; m += NGW) final_row(out + (size_t)m * D, SSQ + (size_t)m * 16, final_norm, lnf);
#if AT_PROBE
    __syncthreads();
    for (int m = gw; m < M; m += NGW) { GAS f32x4* orr = (GAS f32x4*)(out + (size_t)m * D) + F.lane;
        for (int j = 0; j < 4; ++j) orr[64 * j] = orr[64 * j] * pscale; }
#endif
    if (xb_ld((unsigned*)(F.ctl + CW_BAR) + XB_TMO) != 0u && blockIdx.x == 0) { const float qn = __builtin_nanf(""); for (int i = F.tid; i < 4096; i += NWAVES * 64) out[i] = qn; }
}

extern "C" void kernel_launch(void* const* d_in, const int* in_sizes, int n_in, void* d_out, int out_size, void* d_ws, size_t ws_size, hipStream_t stream) {
    static int grid = 0;
    if (grid == 0) {
        if (n_in != 10 || in_sizes[0] != M * D || out_size != M * D || ws_size < WS_END) { fprintf(stderr, "kernel_launch: unexpected shapes (n_in %d out %d ws %zu); nothing launched\n", n_in, out_size, ws_size); grid = -1; return; }
        int dev = 0, cus = 0, per_cu = 0;
        if (hipGetDevice(&dev) != hipSuccess || hipDeviceGetAttribute(&cus, hipDeviceAttributeMultiprocessorCount, dev) != hipSuccess) { fprintf(stderr, "kernel_launch: device query failed\n"); grid = -1; return; }
        if (hipFuncSetAttribute((const void*)fwd_kernel, hipFuncAttributeMaxDynamicSharedMemorySize, LDS_BYTES) != hipSuccess) { fprintf(stderr, "kernel_launch: hipFuncSetAttribute failed\n"); grid = -1; return; }
        if (hipOccupancyMaxActiveBlocksPerMultiprocessor(&per_cu, (const void*)fwd_kernel, NWAVES * 64, LDS_BYTES) != hipSuccess || per_cu < 1) { fprintf(stderr, "kernel_launch: occupancy query reports %d workgroups per CU\n", per_cu); per_cu = 1; }
        (void)hipGetLastError();
        grid = cus;
    }
    if (grid < 0) return;
    if (hipMemsetAsync((char*)d_ws + WS_CTL, 0, CTL_ZERO_BYTES, stream) != hipSuccess) { fprintf(stderr, "kernel_launch: hipMemsetAsync failed\n"); return; }
    Args a{};
    for (int i = 0; i < 10; ++i) a.in[i] = (const float*)d_in[i];
    a.out = (float*)d_out; a.ws = (unsigned char*)d_ws;
    hipLaunchKernelGGL(fwd_kernel, dim3(grid), dim3(NWAVES * 64), LDS_BYTES, stream, a);
    const hipError_t le = hipPeekAtLastError();
    if (le != hipSuccess) fprintf(stderr, "kernel_launch: launch failed: %s\n", hipGetErrorName(le));
}
```

```cpp
#include <hip/hip_runtime.h>
#include <cstdio>
#include <cstdint>
#define AT_PROBE 0
#define AT_PROBE_WAVE 0
#define AT_PROBE_Q 16.0f
#define AT_PROBE_DV 128

constexpr int BATCH = 2, T = 8192, D = 1024, M = BATCH * T, FF = 4096, NQKV = 3 * D;
constexpr float RMS_EPS = 1e-6f;
constexpr float LOG2E = 1.4426950408889634f;
constexpr float QSCALE = 0.125f * LOG2E;
constexpr float NEG_BIG = -1e30f;

constexpr size_t MiB = 1u << 20;
constexpr size_t WS_CTL = 0, CTL_ZERO_BYTES = 1 * MiB;
constexpr size_t WS_WIN = 1 * MiB;
constexpr size_t WS_WOUT = 13 * MiB;
constexpr size_t WS_WFF1 = 17 * MiB;
constexpr size_t WS_WFF2 = 33 * MiB;
constexpr size_t WS_SSQ = 49 * MiB;
constexpr size_t WS_KMEAN = 50 * MiB;
constexpr size_t WS_HB = 51 * MiB;
constexpr size_t WS_Q = 83 * MiB, WS_K = 115 * MiB, WS_V = 147 * MiB, WS_O = 179 * MiB;
constexpr size_t WS_ACT = 83 * MiB;
constexpr size_t WS_END = 211 * MiB;
constexpr int CW_TMO = 0, CW_CODE = 1, CW_BAR = 4096;
constexpr int CW_NRM = 8192;
constexpr int CW_DFLAG = 12288;
constexpr int CW_KMS = 32768;
constexpr int CW_QUEUE = 9216;
namespace pg8 {
#define PG8_LAS __attribute__((address_space(3)))
typedef unsigned short bf16_t;
typedef short bf16x8 __attribute__((ext_vector_type(8)));
typedef float f32x4 __attribute__((ext_vector_type(4)));
typedef unsigned u32x4 __attribute__((ext_vector_type(4)));
constexpr int BM = 256, BK = 64, HALF = 128, HTB = HALF * BK * 2  , STAGE_BYTES = 8 * HTB, NXCD = 8, WGM = 8;

__host__ __device__ __forceinline__ int lds_byte(int r, int c) { const int st = (r >> 4) * 2 + (c >> 5), rr = r & 15, cc = c & 31, ob = rr * 64 + cc * 2; return st * 1024 + (ob ^ (((ob >> 9) & 1) << 5)); }
__host__ __device__ __forceinline__ void stage_rc(int b, int& R, int& C) { const int st = b / 1024, sb = b % 1024, swz = sb ^ (((sb >> 9) & 1) << 5); R = (st >> 1) * 16 + swz / 64; C = (st & 1) * 32 + (swz % 64) / 2; }
__host__ __device__ __forceinline__ int perm32(int rho) { const int n = rho >> 4, i = rho & 15; return 8 * (i >> 2) + 4 * n + (i & 3); }

struct Unit { int pm, pn; };
struct Gemm { const bf16_t* A; const bf16_t* Bt; int M, N, K; };

struct StaticOrder {
    int nM, nN, nwg, G, c;
    __host__ __device__ void init(int M, int N, int G_, int c_) { nM = M / BM; nN = N / BM; nwg = nM * nN; G = G_; c = c_; }
    __host__ __device__ bool next(int i, Unit& u) const {
        const long L = (long)i * G + c; if (L >= nwg) return false;
        int wgid = (int)L; { const int q = nwg / NXCD, r = nwg % NXCD, xcd = wgid % NXCD, off = wgid / NXCD; wgid = (xcd < r ? xcd * (q + 1) : r * (q + 1) + (xcd - r) * q) + off; }
        const int nig = WGM * nN, gid = wgid / nig, fm = gid * WGM, gsz = (nM - fm) < WGM ? (nM - fm) : WGM;
        u.pm = fm + ((wgid % nig) % gsz); u.pn = (wgid % nig) / gsz; return true;
    }
    __device__ __forceinline__ void a_ready(const Unit&) const {}
    __device__ __forceinline__ void done(const Unit&) const {}
};


__device__ __forceinline__ unsigned cvt_pk_bf16(float lo, float hi) { unsigned r; asm volatile("v_cvt_pk_bf16_f32 %0, %1, %2" : "=v"(r) : "v"(lo), "v"(hi)); return r; }
__device__ __forceinline__ float row_rstd16(const float* SSQ, int row) {
    const f32x4* p = (const f32x4*)(SSQ + (size_t)row * 16);
    const f32x4 a = p[0], b = p[1], c = p[2], d = p[3];
    const float s = ((a[0] + a[1]) + (a[2] + a[3])) + ((b[0] + b[1]) + (b[2] + b[3])) + ((c[0] + c[1]) + (c[2] + c[3])) + ((d[0] + d[1]) + (d[2] + d[3]));
    return 1.0f / sqrtf(s * (1.0f / 1024.0f) + 1e-6f);
}
template <int ACT> struct EpiScaleBf16 {
    static constexpr bool PERM = true, AFTER_DRAIN = false;
    bf16_t* O; int ldc; const float* SSQ; int split_cols; size_t split_stride;
    float* KMS;
    unsigned* NRM;
    __device__ __forceinline__ void operator()(const f32x4 (&acc)[2][2][4][2], const Unit& u, int wr, int wc, int fr, int fq) const {
        const int row0 = u.pm * BM + wr * 64 + fr; int colt = u.pn * BM; bf16_t* base = O; int t = 0;
        if (split_cols) { t = colt / split_cols; base += (size_t)t * split_stride; colt -= t * split_cols; }
        const int col0 = colt + wc * 32 + 8 * fq;
        const int lane = fq * 16 + fr; float myrs[2];
#pragma unroll
        for (int ai = 0; ai < 2; ++ai) myrs[ai] = row_rstd16(SSQ, u.pm * BM + wr * 64 + ai * HALF + lane);
        asm volatile("" : "+v"(myrs[0]), "+v"(myrs[1]));
        float mx[2] = {0.f, 0.f};
        f32x4 ks[2][2] = {{{0.f, 0.f, 0.f, 0.f}, {0.f, 0.f, 0.f, 0.f}}, {{0.f, 0.f, 0.f, 0.f}, {0.f, 0.f, 0.f, 0.f}}};
#pragma unroll
        for (int ai = 0; ai < 2; ++ai)
#pragma unroll
            for (int m = 0; m < 4; ++m) { const int row = row0 + ai * HALF + m * 16; const float rs = __shfl(myrs[ai], m * 16 + fr); bf16_t* rowp = base + (size_t)row * ldc + col0;
#pragma unroll
                for (int bj = 0; bj < 2; ++bj) { f32x4 v0 = acc[ai][bj][m][0] * rs, v1 = acc[ai][bj][m][1] * rs;
                    if (ACT == 1) {
#pragma unroll
                        for (int e = 0; e < 4; ++e) { const float a = __builtin_fmaxf(v0[e], 0.f), b = __builtin_fmaxf(v1[e], 0.f); v0[e] = a * a; v1[e] = b * b; } }
                    if (ACT == 0 && KMS && t == 1) { ks[bj][0] += v0; ks[bj][1] += v1; }
                    if (ACT == 0 && NRM && t < 2) { float q = (v0[0] * v0[0] + v0[1] * v0[1]) + (v0[2] * v0[2] + v0[3] * v0[3]) + (v1[0] * v1[0] + v1[1] * v1[1]) + (v1[2] * v1[2] + v1[3] * v1[3]);
                        q += __shfl_xor(q, 16); q += __shfl_xor(q, 32); mx[bj] = __builtin_fmaxf(mx[bj], q); }
                    u32x4 w; w.x = cvt_pk_bf16(v0[0], v0[1]); w.y = cvt_pk_bf16(v0[2], v0[3]); w.z = cvt_pk_bf16(v1[0], v1[1]); w.w = cvt_pk_bf16(v1[2], v1[3]);
                    *(u32x4*)(rowp + bj * HALF) = w; } }
        if (ACT == 0 && KMS && t == 1) {
#pragma unroll
            for (int bj = 0; bj < 2; ++bj)
#pragma unroll
                for (int n = 0; n < 2; ++n)
#pragma unroll
                    for (int e = 0; e < 4; ++e) { float q = ks[bj][n][e];
#pragma unroll
                        for (int o = 1; o < 16; o <<= 1) q += __shfl_xor(q, o);
                        const int col = colt + bj * HALF + wc * 32 + 8 * fq + 4 * n + e;
                        if (fr == 0) atomicAdd(KMS + ((((size_t)(u.pm >> 5) * 16 + (col >> 6)) * 32 + (u.pm & 31)) * 64 + (col & 63)), q * (1.0f / 256.0f)); }
        }
        if (ACT == 0 && NRM && t < 2) {
#pragma unroll
            for (int bj = 0; bj < 2; ++bj) { float q = mx[bj];
#pragma unroll
                for (int o = 1; o < 16; o <<= 1) q = __builtin_fmaxf(q, __shfl_xor(q, o));
                const int col = colt + bj * HALF + wc * 32;
                if (lane == 0) atomicMax(NRM + (((t * 2 + (u.pm >> 5)) * 16 + (col >> 6)) * 2 + ((col >> 5) & 1)), __float_as_uint(q)); }
        }
    }
};
template <bool LAST> struct EpiRes {
    static constexpr bool PERM = false, AFTER_DRAIN = false;
    float* out; bf16_t* HB; float* SSQ; int ldc;
    __device__ __forceinline__ void operator()(const f32x4 (&acc)[2][2][4][2], const Unit& u, int wr, int wc, int fr, int fq) const {
        typedef unsigned u32x2v __attribute__((ext_vector_type(2)));
        const int col0 = u.pn * BM + wc * 32 + 4 * fq;
#pragma unroll
        for (int ai = 0; ai < 2; ++ai)
#pragma unroll
            for (int m = 0; m < 4; ++m) { const int row = u.pm * BM + ai * HALF + wr * 64 + m * 16 + fr; const size_t off = (size_t)row * ldc + col0; float s = 0.f;
#pragma unroll
                for (int bj = 0; bj < 2; ++bj)
#pragma unroll
                    for (int n = 0; n < 2; ++n) { const size_t o2 = off + bj * HALF + n * 16; const u32x2v hb = *(const u32x2v*)(HB + o2);
                        f32x4 h = acc[ai][bj][m][n];
                        h[0] += __builtin_bit_cast(float, hb.x << 16); h[1] += __builtin_bit_cast(float, hb.x & 0xffff0000u); h[2] += __builtin_bit_cast(float, hb.y << 16); h[3] += __builtin_bit_cast(float, hb.y & 0xffff0000u);
                        if (LAST) *(f32x4*)(out + o2) = h;
                        else { u32x2v w; w.x = cvt_pk_bf16(h[0], h[1]); w.y = cvt_pk_bf16(h[2], h[3]); *(u32x2v*)(HB + o2) = w; }
                        s += (h[0] * h[0] + h[1] * h[1]) + (h[2] * h[2] + h[3] * h[3]); }
                s += __shfl_xor(s, 16); s += __shfl_xor(s, 32);
                if (fq == 0) SSQ[(size_t)row * 16 + u.pn * 4 + wc] = s;
                if (m & 1) asm volatile("" ::: "memory"); }
    }
};
template <class Epi, class Sched, bool ALIGN_EPI = false, bool SP2 = false>
__device__ __forceinline__ void gemm_phase(PG8_LAS unsigned char* lds, const Gemm g, const Sched& S, const Epi& E) {
    int tid_ = threadIdx.x; asm volatile("" : "+v"(tid_));
    const int tid = tid_, wid = __builtin_amdgcn_readfirstlane(tid >> 6), lane = tid & 63, wr = wid >> 2, wc = wid & 3, fr = lane & 15, fq = lane >> 4;
    const int K = g.K, nt = K / BK;
    unsigned voffA[2], voffB[2];
#pragma unroll
    for (int i = 0; i < 2; ++i) { int R, C; stage_rc(tid * 16 + i * 8192, R, C); const int Rb = Epi::PERM ? ((R & ~31) + perm32(R & 31)) : R;
        voffA[i] = (unsigned)(R * K + C) * 2u; voffB[i] = (unsigned)(Rb * K + C) * 2u; }
    const size_t kstep = (size_t)(BK * 2);
    const size_t hstep = (size_t)HALF * K * 2;
    const size_t tstep = 2 * hstep;
    const unsigned ldsw = (unsigned)wid * 1024u;
    const int aoff = lds_byte(wr * 64 + fr, fq * 8), boff = lds_byte(wc * 32 + fr, fq * 8);
#define PG8_SA(b, h) (((b) * 2 + (h)) * HTB)
#define PG8_SB(b, h) ((4 + (b) * 2 + (h)) * HTB)
#define PG8_STAGE(bufoff, gbase, voff) do { _Pragma("unroll") for (int _i = 0; _i < 2; ++_i) \
        __builtin_amdgcn_global_load_lds((const unsigned*)((const char*)(gbase) + (voff)[_i]), (PG8_LAS unsigned*)(lds + (bufoff) + ldsw + _i * 8192), 16, 0, 0); } while (0)
#define PG8_LDA(dst, b, h) do { _Pragma("unroll") for (int m = 0; m < 4; ++m) _Pragma("unroll") for (int k = 0; k < 2; ++k) dst[m][k] = *(const PG8_LAS bf16x8*)(lds + PG8_SA(b, h) + aoff + m * 2048 + k * 1024); } while (0)
#define PG8_LDB(dst, b, h) do { _Pragma("unroll") for (int n = 0; n < 2; ++n) _Pragma("unroll") for (int k = 0; k < 2; ++k) dst[n][k] = *(const PG8_LAS bf16x8*)(lds + PG8_SB(b, h) + boff + n * 2048 + k * 1024); } while (0)
#define PG8_MMA(ai, bj, At, Bt) do { __builtin_amdgcn_s_setprio(1); _Pragma("unroll") for (int m = 0; m < 4; ++m) _Pragma("unroll") for (int n = 0; n < 2; ++n) _Pragma("unroll") for (int k = 0; k < 2; ++k) \
        acc[ai][bj][m][n] = __builtin_amdgcn_mfma_f32_16x16x32_bf16(Bt[n][k], At[m][k], acc[ai][bj][m][n], 0, 0, 0); __builtin_amdgcn_s_setprio(0); } while (0)
#define PG8_WAIT_V(n) asm volatile("s_waitcnt vmcnt(" #n ")" ::: "memory")
#define PG8_WAIT_L(n) asm volatile("s_waitcnt lgkmcnt(" #n ")" ::: "memory")
#define PG8_BAR __builtin_amdgcn_s_barrier()
#define PG8_SCHED __builtin_amdgcn_sched_barrier(0)
    Unit cur, nxt; int ui = 0;
    if (!S.next(0, cur)) return;
    f32x4 acc[2][2][4][2];
#pragma unroll
    for (int a = 0; a < 2; ++a)
#pragma unroll
        for (int b = 0; b < 2; ++b)
#pragma unroll
            for (int m = 0; m < 4; ++m)
#pragma unroll
                for (int n = 0; n < 2; ++n) acc[a][b][m][n] = (f32x4){0.f, 0.f, 0.f, 0.f};
    bf16x8 At[4][2], B0[2][2], B1[2][2];
    const char* cA = (const char*)g.A + (size_t)cur.pm * tstep; const char* cB = (const char*)g.Bt + (size_t)cur.pn * tstep;
    S.a_ready(cur);
    if constexpr (SP2) {
        PG8_STAGE(PG8_SB(0, 0), cB, voffB); PG8_STAGE(PG8_SB(0, 1), cB + hstep, voffB); PG8_STAGE(PG8_SA(0, 0), cA, voffA); PG8_STAGE(PG8_SA(0, 1), cA + hstep, voffA);
        if (wr == 1) PG8_BAR;
        PG8_WAIT_V(2); PG8_BAR;
        PG8_STAGE(PG8_SB(1, 0), cB + kstep, voffB); PG8_STAGE(PG8_SA(1, 0), cA + kstep, voffA); PG8_STAGE(PG8_SB(1, 1), cB + hstep + kstep, voffB);
        PG8_WAIT_V(6); PG8_BAR;
    } else {
        PG8_STAGE(PG8_SB(0, 0), cB, voffB); PG8_STAGE(PG8_SA(0, 0), cA, voffA); PG8_STAGE(PG8_SB(0, 1), cB + hstep, voffB); PG8_STAGE(PG8_SA(0, 1), cA + hstep, voffA);
        if (wr == 1) PG8_BAR;
        PG8_WAIT_V(4); PG8_BAR;
        PG8_STAGE(PG8_SB(1, 0), cB + kstep, voffB); PG8_STAGE(PG8_SA(1, 0), cA + kstep, voffA); PG8_STAGE(PG8_SB(1, 1), cB + hstep + kstep, voffB);
        PG8_WAIT_V(6); PG8_BAR;
    }
    for (;;) {
        const bool has_next = S.next(ui + 1, nxt);
        const char* nA = has_next ? (const char*)g.A + (size_t)nxt.pm * tstep : cA; const char* nB = has_next ? (const char*)g.Bt + (size_t)nxt.pn * tstep : cB;
        for (int t = 0; t < nt; t += 2) {
            const bool last = (t == nt - 2);
            const char* a1 = cA + (size_t)(t + 1) * kstep;
            const char* a2 = last ? nA : cA + (size_t)(t + 2) * kstep; const char* b2 = last ? nB : cB + (size_t)(t + 2) * kstep;
            const char* a3 = a2 + kstep; const char* b3 = b2 + kstep;
            if (last && has_next) S.a_ready(nxt);
            if constexpr (SP2) {
            PG8_LDB(B0, 0, 0); PG8_LDB(B1, 0, 1); PG8_SCHED; PG8_LDA(At, 0, 0); PG8_STAGE(PG8_SA(1, 1), a1 + hstep, voffA);
            PG8_WAIT_V(8); PG8_WAIT_L(0); PG8_BAR; PG8_MMA(0, 0, At, B0); PG8_MMA(0, 1, At, B1); PG8_BAR; PG8_SCHED;
            PG8_LDA(At, 0, 1); PG8_STAGE(PG8_SB(0, 0), b2, voffB); PG8_STAGE(PG8_SB(0, 1), b2 + hstep, voffB); PG8_STAGE(PG8_SA(0, 0), a2, voffA);
            PG8_WAIT_V(8); PG8_WAIT_L(0); PG8_BAR; PG8_MMA(1, 0, At, B0); PG8_MMA(1, 1, At, B1); PG8_BAR; PG8_SCHED;
            PG8_LDB(B0, 1, 0); PG8_LDB(B1, 1, 1); PG8_SCHED; PG8_LDA(At, 1, 0); PG8_STAGE(PG8_SA(0, 1), a2 + hstep, voffA);
            PG8_WAIT_V(8); PG8_WAIT_L(0); PG8_BAR; PG8_MMA(0, 0, At, B0); PG8_MMA(0, 1, At, B1); PG8_BAR; PG8_SCHED;
            PG8_LDA(At, 1, 1); PG8_STAGE(PG8_SB(1, 0), b3, voffB); PG8_STAGE(PG8_SB(1, 1), b3 + hstep, voffB); PG8_STAGE(PG8_SA(1, 0), a3, voffA);
            PG8_WAIT_V(8); PG8_WAIT_L(0); PG8_BAR; PG8_MMA(1, 0, At, B0); PG8_MMA(1, 1, At, B1); PG8_BAR; PG8_SCHED;
            } else {
            PG8_LDB(B0, 0, 0); PG8_SCHED; PG8_LDA(At, 0, 0); PG8_STAGE(PG8_SA(1, 1), a1 + hstep, voffA);
            PG8_WAIT_L(8); PG8_BAR; PG8_WAIT_L(0); PG8_MMA(0, 0, At, B0); PG8_BAR; PG8_SCHED;
            PG8_LDB(B1, 0, 1); PG8_STAGE(PG8_SB(0, 0), b2, voffB);
            PG8_BAR; PG8_WAIT_L(0); PG8_MMA(0, 1, At, B1); PG8_BAR;
            PG8_LDA(At, 0, 1); PG8_STAGE(PG8_SA(0, 0), a2, voffA);
            PG8_BAR; PG8_WAIT_L(0); PG8_MMA(1, 0, At, B0); PG8_BAR; PG8_SCHED;
            PG8_STAGE(PG8_SB(0, 1), b2 + hstep, voffB);
            PG8_WAIT_V(6); PG8_BAR; PG8_MMA(1, 1, At, B1); PG8_BAR;
            PG8_LDB(B0, 1, 0); PG8_SCHED; PG8_LDA(At, 1, 0); PG8_STAGE(PG8_SA(0, 1), a2 + hstep, voffA);
            PG8_WAIT_L(8); PG8_BAR; PG8_WAIT_L(0); PG8_MMA(0, 0, At, B0); PG8_BAR; PG8_SCHED;
            PG8_LDB(B1, 1, 1); PG8_STAGE(PG8_SB(1, 0), b3, voffB);
            PG8_BAR; PG8_WAIT_L(0); PG8_MMA(0, 1, At, B1); PG8_BAR;
            PG8_LDA(At, 1, 1); PG8_STAGE(PG8_SA(1, 0), a3, voffA);
            PG8_BAR; PG8_WAIT_L(0); PG8_MMA(1, 0, At, B0); PG8_BAR; PG8_SCHED;
            PG8_STAGE(PG8_SB(1, 1), b3 + hstep, voffB);
            PG8_WAIT_V(6); PG8_BAR; PG8_MMA(1, 1, At, B1); PG8_BAR;
            }
        }
        if constexpr (ALIGN_EPI) { if (wr == 0) PG8_BAR; }
        if constexpr (!Epi::AFTER_DRAIN) { E(acc, cur, wr, wc, fr, fq); S.done(cur); }
        if (!has_next) break;
#pragma unroll
        for (int a = 0; a < 2; ++a)
#pragma unroll
            for (int b = 0; b < 2; ++b)
#pragma unroll
                for (int m = 0; m < 4; ++m)
#pragma unroll
                    for (int n = 0; n < 2; ++n) acc[a][b][m][n] = (f32x4){0.f, 0.f, 0.f, 0.f};
        cur = nxt; cA = nA; cB = nB; ++ui;
        if constexpr (ALIGN_EPI) { if (wr == 1) PG8_BAR; }
    }
    PG8_WAIT_V(0);
    if constexpr (!ALIGN_EPI) { if (wr == 0) PG8_BAR; }
    PG8_BAR;
    if constexpr (Epi::AFTER_DRAIN) { E.fused(acc, cur, wr, wc, fr, fq, lds, wid, lane); S.done(cur); }
#undef PG8_SA
#undef PG8_SB
#undef PG8_STAGE
#undef PG8_LDA
#undef PG8_LDB
#undef PG8_MMA
#undef PG8_WAIT_V
#undef PG8_WAIT_L
#undef PG8_BAR
#undef PG8_SCHED
}
}

#ifndef PG8_SP2
#define PG8_SP2 true
#endif
#ifndef PG8_ALIGN
#define PG8_ALIGN true
#endif
#define GAS __attribute__((address_space(1)))
#define LAS __attribute__((address_space(3)))
typedef unsigned short bf16;
typedef unsigned v4u __attribute__((ext_vector_type(4)));
typedef float f32x4 __attribute__((ext_vector_type(4)));
typedef short bf16x8 __attribute__((ext_vector_type(8)));
typedef GAS unsigned gu32;
typedef GAS unsigned long long gu64;
#define RLX_AGENT __ATOMIC_RELAXED, __HIP_MEMORY_SCOPE_AGENT
#define LDS_WAIT() asm volatile("s_waitcnt lgkmcnt(0)" ::: "memory")
#define VM_WAIT() asm volatile("s_waitcnt vmcnt(0)" ::: "memory")
__device__ __forceinline__ unsigned long long rt() { return __builtin_amdgcn_s_memrealtime(); }
__device__ __forceinline__ unsigned f2bf(float f) { unsigned u = __builtin_bit_cast(unsigned, f); return (u + 0x7fffu + ((u >> 16) & 1u)) >> 16; }
__device__ __forceinline__ unsigned pk2(float lo, float hi) { return f2bf(lo) | (f2bf(hi) << 16); }

#define XB_TMO      128
#define XB_XCNT(j)  (256  + 64 * (j))
#define XB_XSUB(j)  (1280 + 64 * (j))
#define XB_XGEN(j)  (2304 + 64 * (j))
#define XB_TOP      3328
#define XB_TOPGEN   3392
#define XCD_BAR_WORDS 3456
#define XB_SPIN_CAP (1u << 18)

__device__ __forceinline__ unsigned xb_ld(unsigned* p)              { return __hip_atomic_load(p, __ATOMIC_RELAXED, __HIP_MEMORY_SCOPE_AGENT); }
__device__ __forceinline__ unsigned xb_add(unsigned* p, unsigned v) { return __hip_atomic_fetch_add(p, v, __ATOMIC_RELAXED, __HIP_MEMORY_SCOPE_AGENT); }
__device__ __forceinline__ unsigned xb_xcc_id() { return (unsigned)__builtin_amdgcn_s_getreg((3 << 11) | 20) & 0xFu; }
#define XB_SPIN(cond, bar) do { unsigned _sp = 0; while (cond) { __builtin_amdgcn_s_sleep(1); \
    if ((++_sp & 255u) == 0u) { if (xb_ld(&(bar)[XB_TMO])) break; if (_sp > XB_SPIN_CAP) { atomicAdd(&(bar)[XB_TMO], 1u); break; } } } } while (0)

struct XcdBarrier {
    unsigned* bar; unsigned x;
    volatile LAS unsigned* st;
};

__device__ __forceinline__ XcdBarrier xcd_barrier_post(unsigned* bar, volatile LAS unsigned* st) {
    XcdBarrier b; b.bar = bar; b.x = xb_xcc_id(); b.st = st;
    if (threadIdx.x == 0) (void)xb_add(&bar[XB_XCNT(b.x)], 1u);
    return b;
}
__device__ __forceinline__ void xcd_barrier_complete(unsigned* bar, unsigned x, unsigned& nloc, unsigned& nx) {
    const unsigned G = gridDim.x * gridDim.y * gridDim.z;
    unsigned sum, cnt, mine, sp = 0u;
    for (;;) {
        sum = 0u; cnt = 0u; mine = 0u;
#pragma unroll
        for (unsigned j = 0; j < 16; ++j) { const unsigned c = xb_ld(&bar[XB_XCNT(j)]); sum += c; cnt += (c > 0u) ? 1u : 0u; mine = (j == x) ? c : mine; }
        if (sum == G) break;
        __builtin_amdgcn_s_sleep(1);
        if ((++sp & 255u) == 0u) { if (xb_ld(&bar[XB_TMO])) break; if (sp > XB_SPIN_CAP) { atomicAdd(&bar[XB_TMO], 1u); break; } }
    }
    nloc = mine > 0u ? mine : 1u; nx = cnt > 0u ? cnt : 1u;
}

__device__ __forceinline__ void xcd_barrier(const XcdBarrier& b) {
    asm volatile("s_waitcnt vmcnt(0)" ::: "memory");
    __syncthreads();
    if (threadIdx.x == 0) {
        unsigned* bar = b.bar; unsigned bx_ = b.x; asm volatile("" : "+s"(bx_));
        __builtin_amdgcn_s_waitcnt(0);
        unsigned nloc = b.st[0], nx = b.st[1];
        if (nloc == 0u) { xcd_barrier_complete(bar, bx_, nloc, nx); b.st[0] = nloc; b.st[1] = nx; }
        const unsigned old = xb_add(&bar[XB_XSUB(bx_)], 1u);
        const unsigned gen = old / nloc;
        if (old + 1u == (gen + 1u) * nloc) {
            __builtin_amdgcn_fence(__ATOMIC_RELEASE, "agent");
            asm volatile("s_waitcnt vmcnt(0)" ::: "memory");
            const unsigned og = xb_add(&bar[XB_TOP], 1u);
            const unsigned tg = og / nx;
            if (og + 1u == (tg + 1u) * nx) xb_add(&bar[XB_TOPGEN], 1u);
            else XB_SPIN(xb_ld(&bar[XB_TOPGEN]) == tg, bar);
            __builtin_amdgcn_fence(__ATOMIC_ACQUIRE, "agent");
            xb_add(&bar[XB_XGEN(bx_)], 1u);
            asm volatile("s_waitcnt vmcnt(0)" ::: "memory");
        } else {
            XB_SPIN(xb_ld(&bar[XB_XGEN(bx_)]) == gen, bar);
            __builtin_amdgcn_fence(__ATOMIC_ACQUIRE, "agent");
            asm volatile("s_waitcnt vmcnt(0)" ::: "memory");
        }
    }
    __syncthreads();
}

namespace attn {
typedef unsigned short bf16;
using bf16x8 = __attribute__((ext_vector_type(8))) short;
using s16x4 = __attribute__((ext_vector_type(4))) short;
using f32x16 = __attribute__((ext_vector_type(16))) float;
using u32x4 = __attribute__((ext_vector_type(4))) unsigned;
typedef __attribute__((address_space(3))) const char* lds_cptr;
typedef __attribute__((address_space(3))) char* lds_ptr;
typedef short v4i16_t __attribute__((ext_vector_type(4)));
constexpr int DM = 1024, SEQ = 8192, KVBLK = 64;
constexpr int KSLOT = 8192;
constexpr float THR = 8.0f;
#ifndef AT_PROBE
#define AT_PROBE 0
#endif
__device__ unsigned long long g_probe[8];
template <int DV, int AH> struct Lay {
    static constexpr int VSLOT = DV * 128, NKSLOT = AH + 1, NVSLOT = AH + 3, LDS_K = 0, LDS_V = NKSLOT * KSLOT, LDS_WS = LDS_V + NVSLOT * VSLOT, OSTW = 32 * DV * 2,
        LDS_OST = LDS_V  , BYTES = LDS_WS + 8 * 256;
    static_assert(8 * OSTW <= NVSLOT * VSLOT, "O stages fit inside the V ring");
};
#define AT_SBAR() __builtin_amdgcn_sched_barrier(0)
#define AT_WAIT_BAR(N) asm volatile("s_waitcnt vmcnt(" #N ") lgkmcnt(0)\n\ts_barrier" ::: "memory")
__device__ __forceinline__ void wait_bar_n(int n) {
    switch (n) {
        case 0: AT_WAIT_BAR(0); break; case 1: AT_WAIT_BAR(1); break; case 2: AT_WAIT_BAR(2); break; case 3: AT_WAIT_BAR(3); break;
        case 4: AT_WAIT_BAR(4); break; case 5: AT_WAIT_BAR(5); break; case 6: AT_WAIT_BAR(6); break; case 7: AT_WAIT_BAR(7); break;
        case 8: AT_WAIT_BAR(8); break; case 9: AT_WAIT_BAR(9); break; case 10: AT_WAIT_BAR(10); break; case 11: AT_WAIT_BAR(11); break;
        case 12: AT_WAIT_BAR(12); break; case 13: AT_WAIT_BAR(13); break; case 14: AT_WAIT_BAR(14); break; default: AT_WAIT_BAR(15); break;
    }
}
__device__ __forceinline__ int crow(int r, int hi) { return (r & 3) + 8 * (r >> 2) + 4 * hi; }
__device__ __forceinline__ unsigned f2bf_u(float f) { unsigned u = __builtin_bit_cast(unsigned, f); return (u + 0x7fffu + ((u >> 16) & 1u)) >> 16; }
__device__ __forceinline__ float bf2f_u(unsigned h) { return __builtin_bit_cast(float, h << 16); }
__device__ __forceinline__ void glds16(const void* gsrc, unsigned lds_dst) { unsigned keep;
    asm volatile("s_mov_b32 %0, m0\n\ts_mov_b32 m0, %2\n\ts_nop 0\n\tglobal_load_lds_dwordx4 %1, off\n\ts_mov_b32 m0, %0" : "=&s"(keep) : "v"(gsrc), "s"(lds_dst) : "memory"); }
typedef float f32x2_t __attribute__((ext_vector_type(2))); typedef __bf16 bf16x2_t __attribute__((ext_vector_type(2)));
__device__ __forceinline__ unsigned cvtpk_s(float lo, float hi) { f32x2_t v = {lo, hi}; bf16x2_t b = __builtin_convertvector(v, bf16x2_t); return __builtin_bit_cast(unsigned, b); }
__device__ __forceinline__ s16x4 vtr(lds_cptr p) { return __builtin_bit_cast(s16x4, __builtin_amdgcn_ds_read_tr16_b64_v4i16((__attribute__((address_space(3))) v4i16_t*)p)); }
#define AT_MX3(a, b, c) __builtin_fmaxf(__builtin_fmaxf((a), (b)), (c))
#define AT_MFMA(a, b, c) __builtin_amdgcn_mfma_f32_32x32x16_bf16(a, b, c, 0, 0, 0)
__device__ __forceinline__ float rowmax(const f32x16& p0, const f32x16& p1) {
    float a = AT_MX3(p0[0], p0[1], p1[0]), b = AT_MX3(p0[2], p0[3], p1[1]); a = AT_MX3(a, p1[2], p1[3]);
#pragma unroll
    for (int r = 4; r < 16; r += 4) { a = AT_MX3(a, p0[r], p0[r + 1]); b = AT_MX3(b, p0[r + 2], p0[r + 3]); a = AT_MX3(a, p1[r], p1[r + 1]); b = AT_MX3(b, p1[r + 2], p1[r + 3]); }
    float m = __builtin_fmaxf(a, b); auto rr = __builtin_amdgcn_permlane32_swap(__float_as_uint(m), __float_as_uint(m), false, false);
    return __builtin_fmaxf(__uint_as_float(rr[0]), __uint_as_float(rr[1])); }
__device__ __forceinline__ void cmask(f32x16& p0, f32x16& p1, int jb, int qrel, int hi) {
    const int lim = qrel - 64 * jb - 4 * hi;
#pragma unroll
    for (int r = 0; r < 16; ++r) { const int kv = (r & 3) + 8 * (r >> 2); if (kv > lim) p0[r] = -INFINITY; if (kv + 32 > lim) p1[r] = -INFINITY; } }

template <int DV, bool MOBA, int AH, bool FIXED>
__device__ __forceinline__ void sweep(char* shm, const bf16* Qw, const bf16* __restrict__ Kh, const bf16* __restrict__ Vh, int qb, int kt_min, float slope2, float mfix, unsigned sel, f32x16 (&o)[DV / 32], float& l_out) {
    typedef Lay<DV, AH> L;
    constexpr int NPV = DV / 64, NPT = 1 + NPV;
    int tid_ = threadIdx.x; asm volatile("" : "+v"(tid_));
    const int tid = tid_, lane = tid & 63, r32 = lane & 31, hi = lane >> 5; const int wid = __builtin_amdgcn_readfirstlane(tid >> 6);
    const unsigned lds0 = (unsigned)(uintptr_t)shm;
    const lds_ptr shm3 = (lds_ptr)shm;
    __attribute__((address_space(3))) float* wsf = (__attribute__((address_space(3))) float*)(shm3 + L::LDS_WS) + wid * 64;
    const int NT = 4 * qb + 4 - kt_min;
    const bf16* ksrc = Kh + (long)lane * DM + wid * 8;
    const bf16* vsrc0 = Vh + (long)(16 * (wid & 3) + (lane >> 2)) * DM + (wid >> 2) * 32 + (lane & 3) * 8;
    const unsigned kdst = lds0 + L::LDS_K + wid * 1024, vdst = lds0 + L::LDS_V + wid * 1024;
#define AT_KT(i) (MOBA ? ((i) < 4 ? 4 * qb + (i) : (i) - 4 + kt_min) : (i) + kt_min)
#define AT_DMA(i, ksl, vsl) do { if ((i) >= NT) break; const long kt_ = AT_KT(i); glds16(ksrc + kt_ * KVBLK * DM, (unsigned)__builtin_amdgcn_readfirstlane(kdst + (ksl) * KSLOT)); \
        glds16(vsrc0 + kt_ * KVBLK * DM, (unsigned)__builtin_amdgcn_readfirstlane(vdst + (vsl) * L::VSLOT)); \
        if (NPV == 2) glds16(vsrc0 + kt_ * KVBLK * DM + 64, (unsigned)__builtin_amdgcn_readfirstlane(vdst + (vsl) * L::VSLOT + 8192)); } while (0)
#define AT_VRD(g_, d_) do { _Pragma("unroll") for (int ks = 0; ks < 4; ++ks) { vl[g_][ks] = vtr(vp + (d_) * 4096 + ks * 1024); vh[g_][ks] = vtr(vp + (d_) * 4096 + ks * 1024 + 512); } } while (0)
    bf16x8 qr[4];
#pragma unroll
    for (int d0 = 0; d0 < 4; ++d0) qr[d0] = *reinterpret_cast<const bf16x8*>(&Qw[(long)r32 * DM + d0 * 16 + hi * 8]);
    { _Pragma("unroll") for (int a = 0; a < AH; ++a) AT_DMA(a, a, a); }
    const lds_cptr kp0 = (lds_cptr)shm3 + L::LDS_K + hi * 1024 + r32 * 16;
    const lds_cptr vp0 = (lds_cptr)shm3 + L::LDS_V + ((lane >> 4) & 1) * 32 + (lane & 3) * 8 + (4 * hi + ((lane & 15) >> 2)) * 64;
    const unsigned sw = (unsigned)__builtin_amdgcn_readfirstlane((int)(f2bf_u(slope2) | (f2bf_u(slope2 - bf2f_u(f2bf_u(slope2))) << 16)));
    const unsigned hmask = hi == 0 ? 0xffffffffu : 0u;
    const unsigned off0w = (f2bf_u((float)r32) * 0x10001u) & hmask, off1w = (f2bf_u((float)(32 + r32)) * 0x10001u) & hmask;
    unsigned qz = 0u;
    if (FIXED) { const float mrow = mfix + slope2 * (float)(wid * 32 + r32);
                 const unsigned nh = f2bf_u(-mrow), nl = f2bf_u(-mrow - bf2f_u(nh)); qz = (nh | (nl << 16)) & hmask; }
    float mhat = 0.f, l_reg = 0.f;
#pragma unroll
    for (int d = 0; d < DV / 32; ++d) o[d] = f32x16{};
    const int qrel = wid * 32 + r32;
    int slot = 0, vslot = 0;
    constexpr int ND = DV / 32, NMF = 4 * ND, NEXP = 32 / NMF, NVS = AH + 3;
    u32x4 pw[4] = {{0u, 0u, 0u, 0u}, {0u, 0u, 0u, 0u}, {0u, 0u, 0u, 0u}, {0u, 0u, 0u, 0u}};
    const bool late = wid >= 4;
#define AT_PIN(x) asm volatile("" : "+v"(x))
#define AT_CE(e) ((e) < 16 ? c0[(e) & 15] : c1[(e) & 15])
#define AT_VOFF(g) (((g) >> 2) * 4096 + ((g) & 3) * 1024)
    f32x16 c0, c1; bool resc = false;
#define AT_PHA(T_) do { \
        bf16x8 kf[8]; \
        { const lds_cptr kp = kp0 + slot * KSLOT; \
          _Pragma("unroll") for (int j = 0; j < 4; ++j) { kf[2 * j] = *(const __attribute__((address_space(3))) bf16x8*)(kp + j * 2048); kf[2 * j + 1] = *(const __attribute__((address_space(3))) bf16x8*)(kp + j * 2048 + 512); } } \
        AT_SBAR(); \
        { const int s2 = slot == 0 ? AH : slot - 1; int v2 = vslot + AH; v2 = v2 >= NVS ? v2 - NVS : v2; AT_DMA((T_) + AH, s2, v2); } \
        const int kt = AT_KT(T_); \
        const int jb = MOBA ? ((T_) < 4 ? (T_) : -1) : ((T_) - (NT - 4)); \
        { const unsigned tb = __float_as_uint((float)(64 * (kt - 4 * qb))) >> 16; \
          const unsigned tbw = (tb * 0x10001u) & hmask, onew = 0x3f803f80u & hmask, swm = sw & hmask; \
          const u32x4 a0 = {off0w, tbw, onew, 0u}, a1 = {off1w, tbw, onew, 0u}; \
          u32x4 qv = {swm, swm, qz, 0u}; \
          if (MOBA) { if (hi == 0 && (T_) >= 4 && !((sel >> (kt >> 2)) & 1u)) qv.z = 0x0000f14au; } \
          c0 = AT_MFMA(__builtin_bit_cast(bf16x8, a0), __builtin_bit_cast(bf16x8, qv), f32x16{}); c1 = AT_MFMA(__builtin_bit_cast(bf16x8, a1), __builtin_bit_cast(bf16x8, qv), f32x16{}); \
          _Pragma("unroll") for (int j = 0; j < 4; ++j) { c0 = AT_MFMA(kf[2 * j], qr[j], c0); c1 = AT_MFMA(kf[2 * j + 1], qr[j], c1); } } \
        if (jb >= 0) { asm volatile("" ::: "memory"); cmask(c0, c1, jb, qrel, hi); } \
        resc = false; \
        if (!FIXED) { const float rm = rowmax(c0, c1); const bool first = ((T_) == 0); \
          if (first || __any(rm > THR)) { \
              const float dl = first ? rm : __builtin_fmaxf(rm, 0.f); const float mnew = mhat + dl; \
              const unsigned nh = f2bf_u(-mnew), nl = f2bf_u(-mnew - bf2f_u(nh)); const float meff = -(bf2f_u(nh) + bf2f_u(nl)); \
              const float dle = meff - mhat; mhat = meff; qz = (nh | (nl << 16)) & hmask; \
              _Pragma("unroll") for (int r = 0; r < 16; ++r) { c0[r] -= dle; c1[r] -= dle; } \
              if (!first) { const float f = __builtin_amdgcn_exp2f(-dle); l_reg *= f; if (hi == 0) wsf[r32] = f; resc = true; } } } \
    } while (0)
#define AT_PHB(VS_) do { \
        u32x4 pn[4]; float sacc = 0.f; \
        const lds_cptr vp = vp0 + (VS_) * L::VSLOT; \
        s16x4 vl[NMF], vh[NMF]; \
        _Pragma("unroll") for (int g = 0; g < 4; ++g) { vl[g] = vtr(vp + AT_VOFF(g)); vh[g] = vtr(vp + AT_VOFF(g) + 512); } \
        AT_SBAR(); \
        _Pragma("unroll") for (int g = 0; g < NMF; ++g) { \
            if (g + 4 < NMF) { vl[g + 4] = vtr(vp + AT_VOFF(g + 4)); vh[g + 4] = vtr(vp + AT_VOFF(g + 4) + 512); } \
            { const bf16x8 vf = (bf16x8){vl[g][0], vl[g][1], vl[g][2], vl[g][3], vh[g][0], vh[g][1], vh[g][2], vh[g][3]}; \
              o[g >> 2] = AT_MFMA(__builtin_bit_cast(bf16x8, pw[g & 3]), vf, o[g >> 2]); } \
            _Pragma("unroll") for (int x = 0; x < NEXP; x += 2) { const int e = g * NEXP + x; \
                const float p0 = __builtin_amdgcn_exp2f(AT_CE(e)), p1 = __builtin_amdgcn_exp2f(AT_CE(e + 1)); \
                sacc += p0; sacc += p1; pn[e >> 3][(e & 7) >> 1] = cvtpk_s(p0, p1); } \
            AT_PIN(sacc); AT_PIN(pn[(g * NEXP) >> 3]); \
            AT_SBAR(); } \
        if (resc) { \
            asm volatile("s_waitcnt lgkmcnt(0)" ::: "memory"); \
            _Pragma("unroll") for (int d = 0; d < ND; ++d) _Pragma("unroll") for (int r = 0; r < 16; ++r) o[d][r] *= wsf[crow(r, hi)]; } \
        l_reg += sacc; \
        _Pragma("unroll") for (int k = 0; k < 4; ++k) pw[k] = pn[k]; \
    } while (0)
#define AT_STEP_END(T_) do { { int na = NT - 2 - (T_); na = na < 0 ? 0 : (na > AH - 1 ? AH - 1 : na); wait_bar_n(na * NPT); } \
        slot = slot == AH ? 0 : slot + 1; vslot = vslot == NVS - 1 ? 0 : vslot + 1; } while (0)
    wait_bar_n(((NT < AH ? NT : AH) - 1) * NPT);
    int vlast;
    if (!late) {
        for (int i = 0; i < NT; ++i) {
            AT_PHA(i);
            AT_PHB(i == 0 ? 0 : (vslot == 0 ? NVS - 1 : vslot - 1));
            AT_STEP_END(i);
        }
        vlast = vslot == 0 ? NVS - 1 : vslot - 1;
    } else {
        for (int i = 0; i < NT; ++i) {
            if (i > 0) { AT_PHB(i == 1 ? 0 : (vslot < 2 ? vslot + NVS - 2 : vslot - 2)); }
            AT_PHA(i);
            AT_STEP_END(i);
        }
        AT_PHB(NT == 1 ? 0 : (vslot < 2 ? vslot + NVS - 2 : vslot - 2));
        vlast = vslot == 0 ? NVS - 1 : vslot - 1;
    }
    { const lds_cptr vp = vp0 + vlast * L::VSLOT; s16x4 vl[2][4], vh[2][4];
      AT_VRD(0, 0); AT_SBAR();
#pragma unroll
      for (int d = 0; d < ND; ++d) {
          if (d + 1 < ND) AT_VRD((d + 1) & 1, d + 1);
          AT_SBAR();
#pragma unroll
          for (int ks = 0; ks < 4; ++ks) { const bf16x8 vf = (bf16x8){vl[d & 1][ks][0], vl[d & 1][ks][1], vl[d & 1][ks][2], vl[d & 1][ks][3], vh[d & 1][ks][0], vh[d & 1][ks][1], vh[d & 1][ks][2], vh[d & 1][ks][3]};
              o[d] = AT_MFMA(__builtin_bit_cast(bf16x8, pw[ks]), vf, o[d]); }
          AT_SBAR(); } }
    AT_WAIT_BAR(0);
#undef AT_PIN
#undef AT_CE
#undef AT_VOFF
#undef AT_PHA
#undef AT_PHB
#undef AT_STEP_END
    { auto rr = __builtin_amdgcn_permlane32_swap(__float_as_uint(l_reg), __float_as_uint(l_reg), false, false); l_out = __uint_as_float(rr[0]) + __uint_as_float(rr[1]); }
#undef AT_KT
#undef AT_DMA
#undef AT_VRD
}

__device__ __forceinline__ int window_kt_min(const unsigned* nrm, int b, int chunk, int q0, float slope2, float& Bout) {
    const float nq = __uint_as_float(nrm[((0 * 2 + b) * 16 + chunk) * 2]) + __uint_as_float(nrm[((0 * 2 + b) * 16 + chunk) * 2 + 1]);
    const float nk = __uint_as_float(nrm[((1 * 2 + b) * 16 + chunk) * 2]) + __uint_as_float(nrm[((1 * 2 + b) * 16 + chunk) * 2 + 1]);
    const float B = sqrtf(nq * nk) * 1.01f; Bout = B;
    const float W = (2.0f * B + 160.0f) / slope2;
    const int wkeys = W < 1.0e6f ? (int)W : 1000000;
    const int d = q0 - wkeys;
    return d > 0 ? (d >> 6) : 0;
}
__device__ __forceinline__ void diff_item(char* shm, int b, int h, int qb, int m, const bf16* Q, const bf16* K, const bf16* V, bf16* O, float lam, const unsigned* nrm, unsigned* flag, unsigned* tmo) {
    typedef Lay<128, 2> L;
    int tid_ = threadIdx.x; asm volatile("" : "+v"(tid_));
    const int tid = tid_; const int wid = __builtin_amdgcn_readfirstlane(tid >> 6);
    const long rowbase = (long)b * SEQ; const int q0 = qb * 256;
    const float slope2 = __builtin_amdgcn_exp2f(-(float)(h + 1)) * 1.4426950408889634f;
    lam = __uint_as_float((unsigned)__builtin_amdgcn_readfirstlane((int)__float_as_uint(lam)));
    const lds_ptr shm3 = (lds_ptr)shm;
    __attribute__((address_space(3))) float* wsf = (__attribute__((address_space(3))) float*)(shm3 + L::LDS_WS) + wid * 64;
    __attribute__((address_space(3))) bf16* stg = (__attribute__((address_space(3))) bf16*)(shm3 + L::LDS_OST + wid * L::OSTW);
    f32x16 o[4]; float l;
    float Bq; const int kt_min = __builtin_amdgcn_readfirstlane(window_kt_min(nrm, b, 2 * h + m, q0, slope2, Bq));
    Bq = __uint_as_float((unsigned)__builtin_amdgcn_readfirstlane((int)__float_as_uint(Bq)));
    if (Bq <= 40.0f) sweep<128, false, 2, true>(shm, Q + (rowbase + q0 + wid * 32) * DM + h * 128 + m * 64, K + rowbase * DM + h * 128 + m * 64, V + rowbase * DM + h * 128, qb, kt_min, slope2, Bq, 0u, o, l);
    else sweep<128, false, 2, false>(shm, Q + (rowbase + q0 + wid * 32) * DM + h * 128 + m * 64, K + rowbase * DM + h * 128 + m * 64, V + rowbase * DM + h * 128, qb, kt_min, slope2, Bq, 0u, o, l);
    int lane_e = tid & 63; asm volatile("" : "+v"(lane_e));
    const int lane = lane_e, r32 = lane & 31, hi = lane >> 5;
    bf16* Ow = O + (rowbase + q0 + wid * 32) * DM + h * 128;
    if (hi == 0) wsf[32 + r32] = l;
    asm volatile("s_waitcnt lgkmcnt(0)" ::: "memory");
    float rli[16];
#pragma unroll
    for (int r = 0; r < 16; ++r) rli[r] = (m == 0 ? 1.0f : lam) * __builtin_amdgcn_rcpf(wsf[32 + crow(r, hi)]);
    if (m == 0) {
#pragma unroll
        for (int r = 0; r < 16; ++r)
#pragma unroll
            for (int d = 0; d < 4; ++d) stg[crow(r, hi) * 128 + d * 32 + r32] = (bf16)f2bf_u(o[d][r] * rli[r]);
        asm volatile("s_waitcnt lgkmcnt(0)" ::: "memory");
#pragma unroll
        for (int i = 0; i < 8; ++i) { const int row = i * 4 + (lane >> 4), ch = lane & 15; const u32x4 v = *(const __attribute__((address_space(3))) u32x4*)(stg + row * 128 + ch * 8); *(u32x4*)(Ow + (long)row * DM + ch * 8) = v; }
        asm volatile("s_waitcnt vmcnt(0)" ::: "memory");
        __syncthreads();
        if (tid == 0) { __builtin_amdgcn_fence(__ATOMIC_RELEASE, "agent"); asm volatile("s_waitcnt vmcnt(0)" ::: "memory"); __hip_atomic_store(flag, 1u, __ATOMIC_RELAXED, __HIP_MEMORY_SCOPE_AGENT); }
    } else {
        if (tid == 0) {
            unsigned sp = 0u;
            while (__hip_atomic_load(flag, __ATOMIC_RELAXED, __HIP_MEMORY_SCOPE_AGENT) == 0u) { __builtin_amdgcn_s_sleep(8); if (++sp > (1u << 22)) { __hip_atomic_store(tmo, 1u, __ATOMIC_RELAXED, __HIP_MEMORY_SCOPE_AGENT); break; } }
            __builtin_amdgcn_fence(__ATOMIC_ACQUIRE, "agent");
            asm volatile("s_waitcnt vmcnt(0)" ::: "memory");
        }
        __syncthreads();
#pragma unroll
        for (int i = 0; i < 8; ++i) { const int row = i * 4 + (lane >> 4), ch = lane & 15; const u32x4 v = *(const u32x4*)(Ow + (long)row * DM + ch * 8); *(__attribute__((address_space(3))) u32x4*)(stg + row * 128 + ch * 8) = v; }
        asm volatile("s_waitcnt vmcnt(0) lgkmcnt(0)" ::: "memory");
        float ss[16];
#pragma unroll
        for (int r = 0; r < 16; ++r) { float sq = 0.f;
#pragma unroll
            for (int d = 0; d < 4; ++d) { const float v = bf2f_u(stg[crow(r, hi) * 128 + d * 32 + r32]) - o[d][r] * rli[r]; o[d][r] = v; sq = __builtin_fmaf(v, v, sq); }
            ss[r] = sq; }
#pragma unroll
        for (int r = 0; r < 16; ++r) {
#pragma unroll
            for (int off = 1; off < 32; off <<= 1) ss[r] += __shfl_xor(ss[r], off);
            ss[r] = 1.0f / sqrtf(ss[r] * (1.0f / 128.0f) + 1e-6f); }
#pragma unroll
        for (int r = 0; r < 16; ++r)
#pragma unroll
            for (int d = 0; d < 4; ++d) stg[crow(r, hi) * 128 + d * 32 + r32] = (bf16)f2bf_u(o[d][r] * ss[r]);
        asm volatile("s_waitcnt lgkmcnt(0)" ::: "memory");
#pragma unroll
        for (int i = 0; i < 8; ++i) { const int row = i * 4 + (lane >> 4), ch = lane & 15; const u32x4 v = *(const __attribute__((address_space(3))) u32x4*)(stg + row * 128 + ch * 8); *(u32x4*)(Ow + (long)row * DM + ch * 8) = v; }
    }
}
__device__ __forceinline__ void moba_unit(char* shm, int b, int h, int qb, const bf16* Q, const bf16* K, const bf16* V, bf16* O, const float* KM, const unsigned* nrm) {
    typedef Lay<64, 3> L;
    int tid_ = threadIdx.x; asm volatile("" : "+v"(tid_));
    const int tid = tid_, lane = tid & 63, r32 = lane & 31, hi = lane >> 5; const int wid = __builtin_amdgcn_readfirstlane(tid >> 6);
    const long rowbase = (long)b * SEQ; const int q0 = qb * 256;
    const float slope2 = __builtin_amdgcn_exp2f(-0.5f * (float)(h + 1)) * 1.4426950408889634f;
    const lds_ptr shm3 = (lds_ptr)shm;
    __attribute__((address_space(3))) float* wsf = (__attribute__((address_space(3))) float*)(shm3 + L::LDS_WS) + wid * 64;
    __attribute__((address_space(3))) bf16* stg = (__attribute__((address_space(3))) bf16*)(shm3 + L::LDS_OST + wid * L::OSTW);
    const bf16* Qw = Q + (rowbase + q0 + wid * 32) * DM + h * 64;
    unsigned sel = 0u;
    if (qb > 0) {
        f32x16 g = f32x16{};
        const float* km = KM + (((long)b * 16 + h) * 32 + r32) * 64 + hi * 8;
#pragma unroll
        for (int d0 = 0; d0 < 4; ++d0) {
            const bf16x8 qf = *reinterpret_cast<const bf16x8*>(&Qw[(long)r32 * DM + d0 * 16 + hi * 8]);
            const float4 x0 = *(const float4*)(km + d0 * 16), x1 = *(const float4*)(km + d0 * 16 + 4);
            const float xs[8] = {x0.x, x0.y, x0.z, x0.w, x1.x, x1.y, x1.z, x1.w};
            unsigned hw[8], lw[8];
#pragma unroll
            for (int e = 0; e < 8; ++e) { hw[e] = f2bf_u(xs[e]); lw[e] = f2bf_u(xs[e] - bf2f_u(hw[e])); }
            const u32x4 ah = {hw[0] | (hw[1] << 16), hw[2] | (hw[3] << 16), hw[4] | (hw[5] << 16), hw[6] | (hw[7] << 16)};
            const u32x4 al = {lw[0] | (lw[1] << 16), lw[2] | (lw[3] << 16), lw[4] | (lw[5] << 16), lw[6] | (lw[7] << 16)};
            g = AT_MFMA(__builtin_bit_cast(bf16x8, ah), qf, g); g = AT_MFMA(__builtin_bit_cast(bf16x8, al), qf, g);
        }
        float g0[16], g1[16];
#pragma unroll
        for (int r = 0; r < 16; ++r) { auto rr = __builtin_amdgcn_permlane32_swap(__float_as_uint(g[r]), __float_as_uint(g[r]), false, false); g0[r] = __uint_as_float(rr[0]); g1[r] = __uint_as_float(rr[1]); }
        float b0 = -INFINITY, b1 = -INFINITY, b2 = -INFINITY; int i0 = 0, i1 = 0, i2 = 0;
#pragma unroll
        for (int n = 0; n < 32; ++n) {
            const int rn = 4 * (n >> 3) + (n & 3);
            float v = ((n >> 2) & 1) ? g1[rn] : g0[rn];
            if (n >= qb) v = -INFINITY;
            if (v > b0) { b2 = b1; i2 = i1; b1 = b0; i1 = i0; b0 = v; i0 = n; }
            else if (v > b1) { b2 = b1; i2 = i1; b1 = v; i1 = n; }
            else if (v > b2) { b2 = v; i2 = n; }
        }
        if (b0 > -INFINITY) sel |= 1u << i0;
        if (b1 > -INFINITY) sel |= 1u << i1;
        if (b2 > -INFINITY) sel |= 1u << i2;
    }
    f32x16 o[2]; float l;
    float Bq; const int kt_min = __builtin_amdgcn_readfirstlane(window_kt_min(nrm, b, h, q0, slope2, Bq));
    Bq = __uint_as_float((unsigned)__builtin_amdgcn_readfirstlane((int)__float_as_uint(Bq)));
    if (Bq <= 40.0f) sweep<64, true, 3, true>(shm, Qw, K + rowbase * DM + h * 64, V + rowbase * DM + h * 64, qb, kt_min, slope2, Bq, sel, o, l);
    else sweep<64, true, 3, false>(shm, Qw, K + rowbase * DM + h * 64, V + rowbase * DM + h * 64, qb, kt_min, slope2, Bq, sel, o, l);
    int lane_e = lane; asm volatile("" : "+v"(lane_e));
    { const int lane = lane_e, r32 = lane & 31, hi = lane >> 5;
    if (hi == 0) wsf[32 + r32] = l;
    asm volatile("s_waitcnt lgkmcnt(0)" ::: "memory");
#pragma unroll
    for (int r = 0; r < 16; ++r) { const float rl = __builtin_amdgcn_rcpf(wsf[32 + crow(r, hi)]);
#pragma unroll
        for (int d = 0; d < 2; ++d) stg[crow(r, hi) * 64 + d * 32 + r32] = (bf16)f2bf_u(o[d][r] * rl); }
    asm volatile("s_waitcnt lgkmcnt(0)" ::: "memory");
    bf16* Ow = O + (rowbase + q0 + wid * 32) * DM + h * 64;
#pragma unroll
    for (int i = 0; i < 4; ++i) { const int row = i * 8 + (lane >> 3), ch = lane & 7; const u32x4 v = *(const __attribute__((address_space(3))) u32x4*)(stg + row * 64 + ch * 8); *(u32x4*)(Ow + (long)row * DM + ch * 8) = v; }
    }
}
#undef AT_SBAR
#undef AT_WAIT_BAR
#undef AT_MX3
#undef AT_MFMA
}

constexpr int NWAVES = 8;
constexpr int RING_OFF = 0, RING_BYTES = 131072;
constexpr int LDSCTL_OFF = RING_BYTES, MISC_OFF = LDSCTL_OFF + 320;
constexpr int LDS_BYTES = RING_BYTES + 1024;
static_assert(attn::Lay<128, 2>::BYTES <= RING_BYTES && attn::Lay<64, 3>::BYTES <= RING_BYTES && LDS_BYTES <= 163840, "LDS budget");
static_assert(MISC_OFF + 128 <= LDS_BYTES, "LDS map");

struct Frame {
    LAS unsigned char* lds; volatile LAS unsigned* MISC; gu32* ctl;
    int tid, lane, wave, vcu, G;
};
__device__ __forceinline__ float wave_sum(float v) {
#pragma unroll
    for (int o = 1; o < 64; o <<= 1) v += __shfl_xor(v, o);
    return v;
}
__device__ __forceinline__ float bf2f(unsigned h) { return __builtin_bit_cast(float, h << 16); }

__device__ __forceinline__ void p0_transpose_item(const float* W, int K, int N, bf16* WT, LAS float* scr, int item, int lane, const float* gk, int gmask, float cmul, int qcols, float qscale) {
    const int nblk = N / 32, kb = item / nblk, nb = item % nblk, k0 = 64 * kb, n0 = 32 * nb;
    const float cs = cmul * ((n0 < qcols) ? qscale : 1.0f);
#pragma unroll 8
    for (int i = 0; i < 32; ++i) { const int kk = 2 * i + (lane >> 5); const float g = gk ? gk[(k0 + kk) & gmask] : 1.0f; scr[kk * 33 + (lane & 31)] = W[(size_t)(k0 + kk) * N + n0 + (lane & 31)] * (g * cs); }
    LDS_WAIT(); asm volatile("" ::: "memory");
    const int c = lane & 7;
#pragma unroll
    for (int j = 0; j < 4; ++j) { const int n = (lane >> 3) + 8 * j; const LAS float* s = scr + (8 * c) * 33 + n;
        v4u o; o.x = pk2(s[0 * 33], s[1 * 33]); o.y = pk2(s[2 * 33], s[3 * 33]); o.z = pk2(s[4 * 33], s[5 * 33]); o.w = pk2(s[6 * 33], s[7 * 33]);
        *(GAS v4u*)(WT + (size_t)(n0 + n) * K + k0 + 8 * c) = o; }
    LDS_WAIT(); asm volatile("" ::: "memory");
}
__device__ __forceinline__ void p0_x_row2(const float* xrow, bf16* hrow, float* ssq, int lane) {
    f32x4 v[2][4];
#pragma unroll
    for (int r = 0; r < 2; ++r)
#pragma unroll
        for (int j = 0; j < 4; ++j) v[r][j] = ((const GAS f32x4*)(xrow + (size_t)r * D) + lane)[64 * j];
#pragma unroll
    for (int r = 0; r < 2; ++r) { GAS unsigned long long* h8 = (GAS unsigned long long*)(hrow + (size_t)r * D) + lane; float s[4];
#pragma unroll
        for (int j = 0; j < 4; ++j) { h8[64 * j] = (unsigned long long)pk2(v[r][j].x, v[r][j].y) | ((unsigned long long)pk2(v[r][j].z, v[r][j].w) << 32);
            s[j] = wave_sum((v[r][j].x * v[r][j].x + v[r][j].y * v[r][j].y) + (v[r][j].z * v[r][j].z + v[r][j].w * v[r][j].w)); }
        if (lane < 16) { const int j = lane >> 2; const float sj = j == 0 ? s[0] : j == 1 ? s[1] : j == 2 ? s[2] : s[3]; ssq[r * 16 + lane] = (lane & 3) == 0 ? sj : 0.f; } }
}
__device__ __forceinline__ void final_row(float* orow, const float* ssq, const float* g, int lane) {
    const float rs = pg8::row_rstd16(ssq, 0);
    GAS f32x4* orr = (GAS f32x4*)orow + lane; const GAS f32x4* gr = (const GAS f32x4*)g + lane;
#pragma unroll
    for (int j = 0; j < 4; ++j) { f32x4 v = orr[64 * j]; const f32x4 gv = gr[64 * j]; v = v * rs * gv; orr[64 * j] = v; }
}

__device__ __forceinline__ void diff_attn_unit_simple(LAS unsigned char* lds, int b, int h, int qblk, const bf16* Q, const bf16* K, const bf16* V, bf16* O, float lam, int tid) {
    LAS float* Ks = (LAS float*)lds; LAS float* Vs = (LAS float*)(lds + 64 * 65 * 4);
    const int qi = tid >> 2, part = tid & 3, q0 = qblk * 128, t = q0 + qi;
    const size_t rowbase = (size_t)b * T;
    const float slope2 = exp2f(-(float)(h + 1)) * LOG2E;
    float ores[32], o0[32], l0 = 0.f;
#pragma unroll 1
    for (int m = 0; m < 2; ++m) {
        float q[16];
        { const bf16* qp = Q + (rowbase + t) * D + h * 128 + m * 64 + part * 16;
#pragma unroll
          for (int i = 0; i < 16; ++i) q[i] = bf2f(qp[i]); }
        float mrun = NEG_BIG, l = 0.f, o[32];
#pragma unroll
        for (int e = 0; e < 32; ++e) o[e] = 0.f;
        const int nkt = q0 / 64 + 2;
        for (int kt = 0; kt < nkt; ++kt) {
            const int kb = kt * 64;
            __syncthreads();
            { const int key = tid >> 3, seg = tid & 7;
              const bf16* kp = K + (rowbase + kb + key) * D + h * 128 + m * 64 + seg * 8;
#pragma unroll
              for (int i = 0; i < 8; ++i) Ks[key * 65 + seg * 8 + i] = bf2f(kp[i]);
              const bf16* vp = V + (rowbase + kb + key) * D + h * 128 + seg * 16;
#pragma unroll
              for (int i = 0; i < 16; ++i) Vs[key * 129 + seg * 16 + i] = bf2f(vp[i]); }
            __syncthreads();
            for (int key = 0; key < 64; ++key) {
                float s = 0.f;
#pragma unroll
                for (int i = 0; i < 16; ++i) s = fmaf(q[i], Ks[key * 65 + part * 16 + i], s);
                s += __shfl_xor(s, 1); s += __shfl_xor(s, 2);
                const int kpos = kb + key;
                s += slope2 * (float)(kpos - t);
                if (kpos > t) s = -INFINITY;
                const float mn = fmaxf(mrun, s);
                const float alpha = exp2f(mrun - mn), p = exp2f(s - mn);
                mrun = mn; l = l * alpha + p;
#pragma unroll
                for (int e = 0; e < 32; ++e) o[e] = fmaf(p, Vs[key * 129 + part * 32 + e], o[e] * alpha);
            }
        }
        if (m == 0) {
#pragma unroll
            for (int e = 0; e < 32; ++e) o0[e] = o[e];
            l0 = l;
        } else {
            const float i0 = 1.0f / l0, i1 = lam / l;
#pragma unroll
            for (int e = 0; e < 32; ++e) ores[e] = o0[e] * i0 - o[e] * i1;
        }
    }
    float ss = 0.f;
#pragma unroll
    for (int e = 0; e < 32; ++e) ss = fmaf(ores[e], ores[e], ss);
    ss += __shfl_xor(ss, 1); ss += __shfl_xor(ss, 2);
    const float rs = 1.0f / sqrtf(ss * (1.0f / 128.0f) + RMS_EPS);
    bf16* op = O + (rowbase + t) * D + h * 128 + part * 32;
#pragma unroll
    for (int e = 0; e < 32; e += 2) *(unsigned*)(op + e) = pk2(ores[e] * rs, ores[e + 1] * rs);
    __syncthreads();
}
__device__ __forceinline__ void moba_unit_simple(int b, int h, int qblk, const bf16* Q, const bf16* K, const bf16* V, bf16* O, const float* KM, int tid) {
    const int qi = tid >> 2, part = tid & 3, q0 = qblk * 128, t = q0 + qi, j = q0 / 256;
    const size_t rowbase = (size_t)b * T;
    const float slope2 = exp2f(-0.5f * (float)(h + 1)) * LOG2E;
    float q[16];
    { const bf16* qp = Q + (rowbase + t) * D + h * 64 + part * 16;
#pragma unroll
      for (int i = 0; i < 16; ++i) q[i] = bf2f(qp[i]); }
    float b0 = -INFINITY, b1 = -INFINITY, b2 = -INFINITY; int i0 = 0, i1 = 0, i2 = 0;
    for (int n = 0; n < j; ++n) {
        const float* km = KM + (((size_t)b * 16 + h) * 32 + n) * 64 + part * 16;
        float g = 0.f;
#pragma unroll
        for (int i = 0; i < 16; ++i) g = fmaf(q[i], km[i], g);
        g += __shfl_xor(g, 1); g += __shfl_xor(g, 2);
        if (g > b0) { b2 = b1; i2 = i1; b1 = b0; i1 = i0; b0 = g; i0 = n; }
        else if (g > b1) { b2 = b1; i2 = i1; b1 = g; i1 = n; }
        else if (g > b2) { b2 = g; i2 = n; }
    }
    const int nsel = j < 3 ? j : 3;
    float mrun = NEG_BIG, l = 0.f, o[16];
#pragma unroll
    for (int e = 0; e < 16; ++e) o[e] = 0.f;
    for (int seg = 0; seg <= nsel; ++seg) {
        const int blk = seg == 0 ? j : (seg == 1 ? i0 : (seg == 2 ? i1 : i2));
        const int kb = blk * 256;
        for (int key = 0; key < 256; ++key) {
            const int kpos = kb + key;
            const bf16* kp = K + (rowbase + kpos) * D + h * 64 + part * 16;
            float s = 0.f;
#pragma unroll
            for (int i = 0; i < 16; ++i) s = fmaf(q[i], bf2f(kp[i]), s);
            s += __shfl_xor(s, 1); s += __shfl_xor(s, 2);
            s += slope2 * (float)(kpos - t);
            if (kpos > t) s = -INFINITY;
            const float mn = fmaxf(mrun, s);
            const float alpha = exp2f(mrun - mn), p = exp2f(s - mn);
            mrun = mn; l = l * alpha + p;
            const bf16* vp = V + (rowbase + kpos) * D + h * 64 + part * 16;
#pragma unroll
            for (int e = 0; e < 16; ++e) o[e] = fmaf(p, bf2f(vp[e]), o[e] * alpha);
        }
    }
    const float il = 1.0f / l;
    bf16* op = O + (rowbase + t) * D + h * 64 + part * 16;
#pragma unroll
    for (int e = 0; e < 16; e += 2) *(unsigned*)(op + e) = pk2(o[e] * il, o[e + 1] * il);
}

#define REP_QKV 1
#define REP_DIFF 1
#define REP_MOBA 1
#define REP_FF1 1
#define REP_PRO 1
#define REP_BAR 1
struct Args { const float* in[10]; float* out; unsigned char* ws; };
__global__ void __launch_bounds__(NWAVES * 64, 2) fwd_kernel(Args args) {
    extern __shared__ __attribute__((aligned(16))) unsigned char lds[];
    Frame F;
    F.lds = (LAS unsigned char*)lds;
    F.MISC = (volatile LAS unsigned*)(F.lds + MISC_OFF);
    F.tid = threadIdx.x; F.lane = F.tid & 63; F.wave = __builtin_amdgcn_readfirstlane(F.tid >> 6);
    F.G = gridDim.x; { const int bx = blockIdx.x; F.vcu = (F.G % 8 == 0) ? (bx % 8) * (F.G / 8) + bx / 8 : bx; }
    unsigned char* ws = args.ws;
    F.ctl = (gu32*)(ws + WS_CTL);
#define PTRS() \
    unsigned long long z_ = 0ull; asm volatile("" : "+s"(z_)); unsigned char* wsl = args.ws + z_; float* out = args.out + z_;     \
    bf16* WIN = (bf16*)(wsl + WS_WIN); bf16* WOUT = (bf16*)(wsl + WS_WOUT); bf16* WFF1 = (bf16*)(wsl + WS_WFF1); bf16* WFF2 = (bf16*)(wsl + WS_WFF2); \
    float* SSQ = (float*)(wsl + WS_SSQ); float* KM = (float*)(wsl + WS_KMEAN); \
    bf16* HB = (bf16*)(wsl + WS_HB); bf16* Qb = (bf16*)(wsl + WS_Q); bf16* Kb = (bf16*)(wsl + WS_K); bf16* Vb = (bf16*)(wsl + WS_V); bf16* Ob = (bf16*)(wsl + WS_O); \
    bf16* ACT = (bf16*)(wsl + WS_ACT); \
    (void)WIN; (void)WOUT; (void)WFF1; (void)WFF2; (void)SSQ; (void)KM; (void)HB; (void)Qb; (void)Kb; (void)Vb; (void)Ob; (void)ACT; (void)out
    for (int u = F.tid; u < (LDS_BYTES - LDSCTL_OFF) / 4; u += NWAVES * 64) ((LAS unsigned*)(F.lds + LDSCTL_OFF))[u] = 0u;
    __syncthreads();
    XcdBarrier bar = xcd_barrier_post((unsigned*)(F.ctl + CW_BAR), F.MISC + 8);
#define GRID_BAR() do { for (int rb_ = 0; rb_ < REP_BAR; ++rb_) xcd_barrier(bar); } while (0)
    const int gw = F.vcu * NWAVES + F.wave, NGW = F.G * NWAVES;

    {
        PTRS();
        const float* x = args.in[0]; const float* attn_norm = args.in[1]; const float* w_in = args.in[2]; const float* w_out = args.in[3];
        const float* diff_subln = args.in[5]; const float* mlp_norm = args.in[6]; const float* w_ff1 = args.in[7]; const float* w_ff2 = args.in[8];
        int ln = threadIdx.x & 63; asm volatile("" : "+v"(ln));
        LAS float* scr = (LAS float*)(F.lds + RING_OFF + F.wave * 16384);
        constexpr int I_IN = (D / 64) * (NQKV / 32), I_OUT = (D / 64) * (D / 32), I_F1 = (D / 64) * (FF / 32), I_F2 = (FF / 64) * (D / 32);
        constexpr int PER_L = I_IN + I_OUT + I_F1 + I_F2;
        for (int rp_ = 0; rp_ < REP_PRO; ++rp_) {
        for (int it = gw; it < 2 * PER_L; it += NGW) {
            const int l = it / PER_L; int r = it % PER_L;
            if (r < I_IN) { p0_transpose_item(w_in + (size_t)l * D * NQKV, D, NQKV, WIN + (size_t)l * NQKV * D, scr, r, ln, attn_norm + l * D, D - 1, 1.0f, D, QSCALE); continue; } r -= I_IN;
            if (r < I_OUT) { p0_transpose_item(w_out + (size_t)l * D * D, D, D, WOUT + (size_t)l * D * D, scr, r, ln, l == 0 ? diff_subln : nullptr, 127, l == 0 ? 0.8f : 1.0f, 0, 1.0f); continue; } r -= I_OUT;
            if (r < I_F1) { p0_transpose_item(w_ff1 + (size_t)l * D * FF, D, FF, WFF1 + (size_t)l * FF * D, scr, r, ln, mlp_norm + l * D, D - 1, 1.0f, 0, 1.0f); continue; } r -= I_F1;
            p0_transpose_item(w_ff2 + (size_t)l * FF * D, FF, D, WFF2 + (size_t)l * D * FF, scr, r, ln, nullptr, 0, 1.0f, 0, 1.0f);
        }
        for (int m = 2 * gw; m < M; m += 2 * NGW) p0_x_row2(x + (size_t)m * D, HB + (size_t)m * D, SSQ + (size_t)m * 16, ln);
        }
    }
    GRID_BAR();

#pragma unroll 1
    for (int l = 0; l < 2; ++l) {
        {
            PTRS();
            pg8::Gemm g{HB, WIN + (size_t)l * NQKV * D, M, NQKV, D}; pg8::StaticOrder S; S.init(M, NQKV, F.G, (int)blockIdx.x);
            pg8::EpiScaleBf16<0> E{Qb, D, SSQ, D, (size_t)M * D, l == 1 ? (float*)(F.ctl + CW_KMS) : nullptr, (unsigned*)(F.ctl + CW_NRM + l * 256)};
            for (int rep = 0; rep < REP_QKV; ++rep)
            pg8::gemm_phase<pg8::EpiScaleBf16<0>, pg8::StaticOrder, PG8_ALIGN, PG8_SP2>(F.lds + RING_OFF, g, S, E);
        }
        GRID_BAR();
        if (l == 0) {
            PTRS();
            const float* lp = args.in[4];
            int lnl = threadIdx.x & 63; asm volatile("" : "+v"(lnl));
            const float la = wave_sum(lp[lnl] * lp[64 + lnl]), lc = wave_sum(lp[128 + lnl] * lp[192 + lnl]);
            const float lam = expf(la) - expf(lc) + 0.2f;
            for (int rep = 0; rep < REP_DIFF; ++rep)
            for (;;) {
                if (F.tid == 0) F.MISC[16] = __hip_atomic_fetch_add(F.ctl + CW_QUEUE + 64 * rep, 1u, RLX_AGENT);
                __syncthreads();
                const int i = (int)F.MISC[16];
                __syncthreads();
                if (i >= 1024) break;
                const int u = i >> 1, bh = u & 15, qb = 31 - (u >> 4);
                attn::diff_item((char*)lds + RING_OFF, bh >> 3, bh & 7, qb, i & 1, Qb, Kb, Vb, Ob, lam, (const unsigned*)(F.ctl + CW_NRM), (unsigned*)(F.ctl + CW_DFLAG + rep * 512 + u), (unsigned*)(F.ctl + CW_BAR) + XB_TMO);
            }
        } else {
            PTRS();
            const float* KMf = (const float*)(F.ctl + CW_KMS);
            for (int rep = 0; rep < REP_MOBA; ++rep)
            for (;;) {
                if (F.tid == 0) F.MISC[16] = __hip_atomic_fetch_add(F.ctl + CW_QUEUE + 64 * (4 + rep), 1u, RLX_AGENT);
                __syncthreads();
                const int i = (int)F.MISC[16];
                __syncthreads();
                if (i >= 1024) break;
                const int bh = i & 31, qb = 31 - (i >> 5);
                attn::moba_unit((char*)lds + RING_OFF, bh >> 4, bh & 15, qb, Qb, Kb, Vb, Ob, KMf, (const unsigned*)(F.ctl + CW_NRM + 256));
            }
        }
        GRID_BAR();
        {
            PTRS();
            pg8::Gemm g{Ob, WOUT + (size_t)l * D * D, M, D, D}; pg8::StaticOrder S; S.init(M, D, F.G, (int)blockIdx.x);
            pg8::EpiRes<false> E{out, HB, SSQ, D};
            pg8::gemm_phase<pg8::EpiRes<false>, pg8::StaticOrder, PG8_ALIGN, PG8_SP2>(F.lds + RING_OFF, g, S, E);
        }
        GRID_BAR();
        {
            PTRS();
            pg8::Gemm g{HB, WFF1 + (size_t)l * FF * D, M, FF, D}; pg8::StaticOrder S; S.init(M, FF, F.G, (int)blockIdx.x);
            pg8::EpiScaleBf16<1> E{ACT, FF, SSQ, 0, 0, nullptr, nullptr};
            for (int rep = 0; rep < REP_FF1; ++rep)
            pg8::gemm_phase<pg8::EpiScaleBf16<1>, pg8::StaticOrder, PG8_ALIGN, PG8_SP2>(F.lds + RING_OFF, g, S, E);
        }
        GRID_BAR();
        {
            PTRS();
            pg8::Gemm g{ACT, WFF2 + (size_t)l * D * FF, M, D, FF}; pg8::StaticOrder S; S.init(M, D, F.G, (int)blockIdx.x);
            if (l == 0) { pg8::EpiRes<false> E{out, HB, SSQ, D}; pg8::gemm_phase<pg8::EpiRes<false>, pg8::StaticOrder, PG8_ALIGN, PG8_SP2>(F.lds + RING_OFF, g, S, E); }
            else { pg8::EpiRes<true> E{out, HB, SSQ, D}; pg8::gemm_phase<pg8::EpiRes<true>, pg8::StaticOrder, PG8_ALIGN, PG8_SP2>(F.lds + RING_OFF, g, S, E); }
        }
        GRID_BAR();
    }
    PTRS(); const float* final_norm = args.in[9]; int lnf = threadIdx.x & 63; asm volatile("" : "+v"(lnf));
#if AT_PROBE
    float pscale;
    { const float tot = (float)attn::g_probe[0], a1 = (float)attn::g_probe[1], nst = (float)attn::g_probe[2];
      float xv = AT_PROBE == 1 ? a1 / tot : AT_PROBE == 2 ? (tot / nst) * (1.0f / 10000.0f) : AT_PROBE == 3 ? (float)attn::g_probe[3] / tot : (float)attn::g_probe[4] / tot;
      xv = floorf(xv * AT_PROBE_Q + 0.5f) * (1.0f / AT_PROBE_Q);
      pscale = 1.0f + 0.1f + 0.9f * xv; }
#endif
    for (int m = gw; m < M; m += NGW) final_row(out + (size_t)m * D, SSQ + (size_t)m * 16, final_norm, lnf);
#if AT_PROBE
    __syncthreads();
    for (int m = gw; m < M; m += NGW) { GAS f32x4* orr = (GAS f32x4*)(out + (size_t)m * D) + F.lane;
        for (int j = 0; j < 4; ++j) orr[64 * j] = orr[64 * j] * pscale; }
#endif
    if (xb_ld((unsigned*)(F.ctl + CW_BAR) + XB_TMO) != 0u && blockIdx.x == 0) { const float qn = __builtin_nanf(""); for (int i = F.tid; i < 4096; i += NWAVES * 64) out[i] = qn; }
}

extern "C" void kernel_launch(void* const* d_in, const int* in_sizes, int n_in, void* d_out, int out_size, void* d_ws, size_t ws_size, hipStream_t stream) {
    static int grid = 0;
    if (grid == 0) {
        if (n_in != 10 || in_sizes[0] != M * D || out_size != M * D || ws_size < WS_END) { fprintf(stderr, "kernel_launch: unexpected shapes (n_in %d out %d ws %zu); nothing launched\n", n_in, out_size, ws_size); grid = -1; return; }
        int dev = 0, cus = 0, per_cu = 0;
        if (hipGetDevice(&dev) != hipSuccess || hipDeviceGetAttribute(&cus, hipDeviceAttributeMultiprocessorCount, dev) != hipSuccess) { fprintf(stderr, "kernel_launch: device query failed\n"); grid = -1; return; }
        if (hipFuncSetAttribute((const void*)fwd_kernel, hipFuncAttributeMaxDynamicSharedMemorySize, LDS_BYTES) != hipSuccess) { fprintf(stderr, "kernel_launch: hipFuncSetAttribute failed\n"); grid = -1; return; }
        if (hipOccupancyMaxActiveBlocksPerMultiprocessor(&per_cu, (const void*)fwd_kernel, NWAVES * 64, LDS_BYTES) != hipSuccess || per_cu < 1) { fprintf(stderr, "kernel_launch: occupancy query reports %d workgroups per CU\n", per_cu); per_cu = 1; }
        (void)hipGetLastError();
        grid = cus;
    }
    if (grid < 0) return;
    if (hipMemsetAsync((char*)d_ws + WS_CTL, 0, CTL_ZERO_BYTES, stream) != hipSuccess) { fprintf(stderr, "kernel_launch: hipMemsetAsync failed\n"); return; }
    Args a{};
    for (int i = 0; i < 10; ++i) a.in[i] = (const float*)d_in[i];
    a.out = (float*)d_out; a.ws = (unsigned char*)d_ws;
    hipLaunchKernelGGL(fwd_kernel, dim3(grid), dim3(NWAVES * 64), LDS_BYTES, stream, a);
    const hipError_t le = hipPeekAtLastError();
    if (le != hipSuccess) fprintf(stderr, "kernel_launch: launch failed: %s\n", hipGetErrorName(le));
}
```

```cpp
#include <hip/hip_runtime.h>
#include <cstdio>
#include <cstdint>
#define AT_PROBE 0
#define AT_PROBE_WAVE 0
#define AT_PROBE_Q 16.0f
#define AT_PROBE_DV 128

constexpr int BATCH = 2, T = 8192, D = 1024, M = BATCH * T, FF = 4096, NQKV = 3 * D;
constexpr float RMS_EPS = 1e-6f;
constexpr float LOG2E = 1.4426950408889634f;
constexpr float QSCALE = 0.125f * LOG2E;
constexpr float NEG_BIG = -1e30f;

constexpr size_t MiB = 1u << 20;
constexpr size_t WS_CTL = 0, CTL_ZERO_BYTES = 1 * MiB;
constexpr size_t WS_WIN = 1 * MiB;
constexpr size_t WS_WOUT = 13 * MiB;
constexpr size_t WS_WFF1 = 17 * MiB;
constexpr size_t WS_WFF2 = 33 * MiB;
constexpr size_t WS_SSQ = 49 * MiB;
constexpr size_t WS_KMEAN = 50 * MiB;
constexpr size_t WS_HB = 51 * MiB;
constexpr size_t WS_Q = 83 * MiB, WS_K = 115 * MiB, WS_V = 147 * MiB, WS_O = 179 * MiB;
constexpr size_t WS_ACT = 83 * MiB;
constexpr size_t WS_END = 211 * MiB;
constexpr int CW_TMO = 0, CW_CODE = 1, CW_BAR = 4096;
constexpr int CW_NRM = 8192;
constexpr int CW_DFLAG = 12288;
constexpr int CW_KMS = 32768;
constexpr int CW_QUEUE = 9216;
namespace pg8 {
#define PG8_LAS __attribute__((address_space(3)))
typedef unsigned short bf16_t;
typedef short bf16x8 __attribute__((ext_vector_type(8)));
typedef float f32x4 __attribute__((ext_vector_type(4)));
typedef unsigned u32x4 __attribute__((ext_vector_type(4)));
constexpr int BM = 256, BK = 64, HALF = 128, HTB = HALF * BK * 2  , STAGE_BYTES = 8 * HTB, NXCD = 8, WGM = 8;

__host__ __device__ __forceinline__ int lds_byte(int r, int c) { const int st = (r >> 4) * 2 + (c >> 5), rr = r & 15, cc = c & 31, ob = rr * 64 + cc * 2; return st * 1024 + (ob ^ (((ob >> 9) & 1) << 5)); }
__host__ __device__ __forceinline__ void stage_rc(int b, int& R, int& C) { const int st = b / 1024, sb = b % 1024, swz = sb ^ (((sb >> 9) & 1) << 5); R = (st >> 1) * 16 + swz / 64; C = (st & 1) * 32 + (swz % 64) / 2; }
__host__ __device__ __forceinline__ int perm32(int rho) { const int n = rho >> 4, i = rho & 15; return 8 * (i >> 2) + 4 * n + (i & 3); }

struct Unit { int pm, pn; };
struct Gemm { const bf16_t* A; const bf16_t* Bt; int M, N, K; };

struct StaticOrder {
    int nM, nN, nwg, G, c;
    __host__ __device__ void init(int M, int N, int G_, int c_) { nM = M / BM; nN = N / BM; nwg = nM * nN; G = G_; c = c_; }
    __host__ __device__ bool next(int i, Unit& u) const {
        const long L = (long)i * G + c; if (L >= nwg) return false;
        int wgid = (int)L; { const int q = nwg / NXCD, r = nwg % NXCD, xcd = wgid % NXCD, off = wgid / NXCD; wgid = (xcd < r ? xcd * (q + 1) : r * (q + 1) + (xcd - r) * q) + off; }
        const int nig = WGM * nN, gid = wgid / nig, fm = gid * WGM, gsz = (nM - fm) < WGM ? (nM - fm) : WGM;
        u.pm = fm + ((wgid % nig) % gsz); u.pn = (wgid % nig) / gsz; return true;
    }
    __device__ __forceinline__ void a_ready(const Unit&) const {}
    __device__ __forceinline__ void done(const Unit&) const {}
};


__device__ __forceinline__ unsigned cvt_pk_bf16(float lo, float hi) { unsigned r; asm volatile("v_cvt_pk_bf16_f32 %0, %1, %2" : "=v"(r) : "v"(lo), "v"(hi)); return r; }
__device__ __forceinline__ float row_rstd16(const float* SSQ, int row) {
    const f32x4* p = (const f32x4*)(SSQ + (size_t)row * 16);
    const f32x4 a = p[0], b = p[1], c = p[2], d = p[3];
    const float s = ((a[0] + a[1]) + (a[2] + a[3])) + ((b[0] + b[1]) + (b[2] + b[3])) + ((c[0] + c[1]) + (c[2] + c[3])) + ((d[0] + d[1]) + (d[2] + d[3]));
    return 1.0f / sqrtf(s * (1.0f / 1024.0f) + 1e-6f);
}
template <int ACT> struct EpiScaleBf16 {
    static constexpr bool PERM = true, AFTER_DRAIN = false;
    bf16_t* O; int ldc; const float* SSQ; int split_cols; size_t split_stride;
    float* KMS;
    unsigned* NRM;
    __device__ __forceinline__ void operator()(const f32x4 (&acc)[2][2][4][2], const Unit& u, int wr, int wc, int fr, int fq) const {
        const int row0 = u.pm * BM + wr * 64 + fr; int colt = u.pn * BM; bf16_t* base = O; int t = 0;
        if (split_cols) { t = colt / split_cols; base += (size_t)t * split_stride; colt -= t * split_cols; }
        const int col0 = colt + wc * 32 + 8 * fq;
        const int lane = fq * 16 + fr; float myrs[2];
#pragma unroll
        for (int ai = 0; ai < 2; ++ai) myrs[ai] = row_rstd16(SSQ, u.pm * BM + wr * 64 + ai * HALF + lane);
        asm volatile("" : "+v"(myrs[0]), "+v"(myrs[1]));
        float mx[2] = {0.f, 0.f};
        f32x4 ks[2][2] = {{{0.f, 0.f, 0.f, 0.f}, {0.f, 0.f, 0.f, 0.f}}, {{0.f, 0.f, 0.f, 0.f}, {0.f, 0.f, 0.f, 0.f}}};
#pragma unroll
        for (int ai = 0; ai < 2; ++ai)
#pragma unroll
            for (int m = 0; m < 4; ++m) { const int row = row0 + ai * HALF + m * 16; const float rs = __shfl(myrs[ai], m * 16 + fr); bf16_t* rowp = base + (size_t)row * ldc + col0;
#pragma unroll
                for (int bj = 0; bj < 2; ++bj) { f32x4 v0 = acc[ai][bj][m][0] * rs, v1 = acc[ai][bj][m][1] * rs;
                    if (ACT == 1) {
#pragma unroll
                        for (int e = 0; e < 4; ++e) { const float a = __builtin_fmaxf(v0[e], 0.f), b = __builtin_fmaxf(v1[e], 0.f); v0[e] = a * a; v1[e] = b * b; } }
                    if (ACT == 0 && KMS && t == 1) { ks[bj][0] += v0; ks[bj][1] += v1; }
                    if (ACT == 0 && NRM && t < 2) { float q = (v0[0] * v0[0] + v0[1] * v0[1]) + (v0[2] * v0[2] + v0[3] * v0[3]) + (v1[0] * v1[0] + v1[1] * v1[1]) + (v1[2] * v1[2] + v1[3] * v1[3]);
                        q += __shfl_xor(q, 16); q += __shfl_xor(q, 32); mx[bj] = __builtin_fmaxf(mx[bj], q); }
                    u32x4 w; w.x = cvt_pk_bf16(v0[0], v0[1]); w.y = cvt_pk_bf16(v0[2], v0[3]); w.z = cvt_pk_bf16(v1[0], v1[1]); w.w = cvt_pk_bf16(v1[2], v1[3]);
                    *(u32x4*)(rowp + bj * HALF) = w; } }
        if (ACT == 0 && KMS && t == 1) {
#pragma unroll
            for (int bj = 0; bj < 2; ++bj)
#pragma unroll
                for (int n = 0; n < 2; ++n)
#pragma unroll
                    for (int e = 0; e < 4; ++e) { float q = ks[bj][n][e];
#pragma unroll
                        for (int o = 1; o < 16; o <<= 1) q += __shfl_xor(q, o);
                        const int col = colt + bj * HALF + wc * 32 + 8 * fq + 4 * n + e;
                        if (fr == 0) atomicAdd(KMS + ((((size_t)(u.pm >> 5) * 16 + (col >> 6)) * 32 + (u.pm & 31)) * 64 + (col & 63)), q * (1.0f / 256.0f)); }
        }
        if (ACT == 0 && NRM && t < 2) {
#pragma unroll
            for (int bj = 0; bj < 2; ++bj) { float q = mx[bj];
#pragma unroll
                for (int o = 1; o < 16; o <<= 1) q = __builtin_fmaxf(q, __shfl_xor(q, o));
                const int col = colt + bj * HALF + wc * 32;
                if (lane == 0) atomicMax(NRM + (((t * 2 + (u.pm >> 5)) * 16 + (col >> 6)) * 2 + ((col >> 5) & 1)), __float_as_uint(q)); }
        }
    }
};
template <bool LAST> struct EpiRes {
    static constexpr bool PERM = false, AFTER_DRAIN = false;
    float* out; bf16_t* HB; float* SSQ; int ldc;
    __device__ __forceinline__ void operator()(const f32x4 (&acc)[2][2][4][2], const Unit& u, int wr, int wc, int fr, int fq) const {
        typedef unsigned u32x2v __attribute__((ext_vector_type(2)));
        const int col0 = u.pn * BM + wc * 32 + 4 * fq;
#pragma unroll
        for (int ai = 0; ai < 2; ++ai)
#pragma unroll
            for (int m = 0; m < 4; ++m) { const int row = u.pm * BM + ai * HALF + wr * 64 + m * 16 + fr; const size_t off = (size_t)row * ldc + col0; float s = 0.f;
#pragma unroll
                for (int bj = 0; bj < 2; ++bj)
#pragma unroll
                    for (int n = 0; n < 2; ++n) { const size_t o2 = off + bj * HALF + n * 16; const u32x2v hb = *(const u32x2v*)(HB + o2);
                        f32x4 h = acc[ai][bj][m][n];
                        h[0] += __builtin_bit_cast(float, hb.x << 16); h[1] += __builtin_bit_cast(float, hb.x & 0xffff0000u); h[2] += __builtin_bit_cast(float, hb.y << 16); h[3] += __builtin_bit_cast(float, hb.y & 0xffff0000u);
                        if (LAST) *(f32x4*)(out + o2) = h;
                        else { u32x2v w; w.x = cvt_pk_bf16(h[0], h[1]); w.y = cvt_pk_bf16(h[2], h[3]); *(u32x2v*)(HB + o2) = w; }
                        s += (h[0] * h[0] + h[1] * h[1]) + (h[2] * h[2] + h[3] * h[3]); }
                s += __shfl_xor(s, 16); s += __shfl_xor(s, 32);
                if (fq == 0) SSQ[(size_t)row * 16 + u.pn * 4 + wc] = s;
                if (m & 1) asm volatile("" ::: "memory"); }
    }
};
template <class Epi, class Sched, bool ALIGN_EPI = false, bool SP2 = false>
__device__ __forceinline__ void gemm_phase(PG8_LAS unsigned char* lds, const Gemm g, const Sched& S, const Epi& E) {
    int tid_ = threadIdx.x; asm volatile("" : "+v"(tid_));
    const int tid = tid_, wid = __builtin_amdgcn_readfirstlane(tid >> 6), lane = tid & 63, wr = wid >> 2, wc = wid & 3, fr = lane & 15, fq = lane >> 4;
    const int K = g.K, nt = K / BK;
    unsigned voffA[2], voffB[2];
#pragma unroll
    for (int i = 0; i < 2; ++i) { int R, C; stage_rc(tid * 16 + i * 8192, R, C); const int Rb = Epi::PERM ? ((R & ~31) + perm32(R & 31)) : R;
        voffA[i] = (unsigned)(R * K + C) * 2u; voffB[i] = (unsigned)(Rb * K + C) * 2u; }
    const size_t kstep = (size_t)(BK * 2);
    const size_t hstep = (size_t)HALF * K * 2;
    const size_t tstep = 2 * hstep;
    const unsigned ldsw = (unsigned)wid * 1024u;
    const int aoff = lds_byte(wr * 64 + fr, fq * 8), boff = lds_byte(wc * 32 + fr, fq * 8);
#define PG8_SA(b, h) (((b) * 2 + (h)) * HTB)
#define PG8_SB(b, h) ((4 + (b) * 2 + (h)) * HTB)
#define PG8_STAGE(bufoff, gbase, voff) do { _Pragma("unroll") for (int _i = 0; _i < 2; ++_i) \
        __builtin_amdgcn_global_load_lds((const unsigned*)((const char*)(gbase) + (voff)[_i]), (PG8_LAS unsigned*)(lds + (bufoff) + ldsw + _i * 8192), 16, 0, 0); } while (0)
#define PG8_LDA(dst, b, h) do { _Pragma("unroll") for (int m = 0; m < 4; ++m) _Pragma("unroll") for (int k = 0; k < 2; ++k) dst[m][k] = *(const PG8_LAS bf16x8*)(lds + PG8_SA(b, h) + aoff + m * 2048 + k * 1024); } while (0)
#define PG8_LDB(dst, b, h) do { _Pragma("unroll") for (int n = 0; n < 2; ++n) _Pragma("unroll") for (int k = 0; k < 2; ++k) dst[n][k] = *(const PG8_LAS bf16x8*)(lds + PG8_SB(b, h) + boff + n * 2048 + k * 1024); } while (0)
#define PG8_MMA(ai, bj, At, Bt) do { __builtin_amdgcn_s_setprio(1); _Pragma("unroll") for (int m = 0; m < 4; ++m) _Pragma("unroll") for (int n = 0; n < 2; ++n) _Pragma("unroll") for (int k = 0; k < 2; ++k) \
        acc[ai][bj][m][n] = __builtin_amdgcn_mfma_f32_16x16x32_bf16(Bt[n][k], At[m][k], acc[ai][bj][m][n], 0, 0, 0); __builtin_amdgcn_s_setprio(0); } while (0)
#define PG8_WAIT_V(n) asm volatile("s_waitcnt vmcnt(" #n ")" ::: "memory")
#define PG8_WAIT_L(n) asm volatile("s_waitcnt lgkmcnt(" #n ")" ::: "memory")
#define PG8_BAR __builtin_amdgcn_s_barrier()
#define PG8_SCHED __builtin_amdgcn_sched_barrier(0)
    Unit cur, nxt; int ui = 0;
    if (!S.next(0, cur)) return;
    f32x4 acc[2][2][4][2];
#pragma unroll
    for (int a = 0; a < 2; ++a)
#pragma unroll
        for (int b = 0; b < 2; ++b)
#pragma unroll
            for (int m = 0; m < 4; ++m)
#pragma unroll
                for (int n = 0; n < 2; ++n) acc[a][b][m][n] = (f32x4){0.f, 0.f, 0.f, 0.f};
    bf16x8 At[4][2], B0[2][2], B1[2][2];
    const char* cA = (const char*)g.A + (size_t)cur.pm * tstep; const char* cB = (const char*)g.Bt + (size_t)cur.pn * tstep;
    S.a_ready(cur);
    if constexpr (SP2) {
        PG8_STAGE(PG8_SB(0, 0), cB, voffB); PG8_STAGE(PG8_SB(0, 1), cB + hstep, voffB); PG8_STAGE(PG8_SA(0, 0), cA, voffA); PG8_STAGE(PG8_SA(0, 1), cA + hstep, voffA);
        if (wr == 1) PG8_BAR;
        PG8_WAIT_V(2); PG8_BAR;
        PG8_STAGE(PG8_SB(1, 0), cB + kstep, voffB); PG8_STAGE(PG8_SA(1, 0), cA + kstep, voffA); PG8_STAGE(PG8_SB(1, 1), cB + hstep + kstep, voffB);
        PG8_WAIT_V(6); PG8_BAR;
    } else {
        PG8_STAGE(PG8_SB(0, 0), cB, voffB); PG8_STAGE(PG8_SA(0, 0), cA, voffA); PG8_STAGE(PG8_SB(0, 1), cB + hstep, voffB); PG8_STAGE(PG8_SA(0, 1), cA + hstep, voffA);
        if (wr == 1) PG8_BAR;
        PG8_WAIT_V(4); PG8_BAR;
        PG8_STAGE(PG8_SB(1, 0), cB + kstep, voffB); PG8_STAGE(PG8_SA(1, 0), cA + kstep, voffA); PG8_STAGE(PG8_SB(1, 1), cB + hstep + kstep, voffB);
        PG8_WAIT_V(6); PG8_BAR;
    }
    for (;;) {
        const bool has_next = S.next(ui + 1, nxt);
        const char* nA = has_next ? (const char*)g.A + (size_t)nxt.pm * tstep : cA; const char* nB = has_next ? (const char*)g.Bt + (size_t)nxt.pn * tstep : cB;
        for (int t = 0; t < nt; t += 2) {
            const bool last = (t == nt - 2);
            const char* a1 = cA + (size_t)(t + 1) * kstep;
            const char* a2 = last ? nA : cA + (size_t)(t + 2) * kstep; const char* b2 = last ? nB : cB + (size_t)(t + 2) * kstep;
            const char* a3 = a2 + kstep; const char* b3 = b2 + kstep;
            if (last && has_next) S.a_ready(nxt);
            if constexpr (SP2) {
            PG8_LDB(B0, 0, 0); PG8_LDB(B1, 0, 1); PG8_SCHED; PG8_LDA(At, 0, 0); PG8_STAGE(PG8_SA(1, 1), a1 + hstep, voffA);
            PG8_WAIT_V(8); PG8_WAIT_L(0); PG8_BAR; PG8_MMA(0, 0, At, B0); PG8_MMA(0, 1, At, B1); PG8_BAR; PG8_SCHED;
            PG8_LDA(At, 0, 1); PG8_STAGE(PG8_SB(0, 0), b2, voffB); PG8_STAGE(PG8_SB(0, 1), b2 + hstep, voffB); PG8_STAGE(PG8_SA(0, 0), a2, voffA);
            PG8_WAIT_V(8); PG8_WAIT_L(0); PG8_BAR; PG8_MMA(1, 0, At, B0); PG8_MMA(1, 1, At, B1); PG8_BAR; PG8_SCHED;
            PG8_LDB(B0, 1, 0); PG8_LDB(B1, 1, 1); PG8_SCHED; PG8_LDA(At, 1, 0); PG8_STAGE(PG8_SA(0, 1), a2 + hstep, voffA);
            PG8_WAIT_V(8); PG8_WAIT_L(0); PG8_BAR; PG8_MMA(0, 0, At, B0); PG8_MMA(0, 1, At, B1); PG8_BAR; PG8_SCHED;
            PG8_LDA(At, 1, 1); PG8_STAGE(PG8_SB(1, 0), b3, voffB); PG8_STAGE(PG8_SB(1, 1), b3 + hstep, voffB); PG8_STAGE(PG8_SA(1, 0), a3, voffA);
            PG8_WAIT_V(8); PG8_WAIT_L(0); PG8_BAR; PG8_MMA(1, 0, At, B0); PG8_MMA(1, 1, At, B1); PG8_BAR; PG8_SCHED;
            } else {
            PG8_LDB(B0, 0, 0); PG8_SCHED; PG8_LDA(At, 0, 0); PG8_STAGE(PG8_SA(1, 1), a1 + hstep, voffA);
            PG8_WAIT_L(8); PG8_BAR; PG8_WAIT_L(0); PG8_MMA(0, 0, At, B0); PG8_BAR; PG8_SCHED;
            PG8_LDB(B1, 0, 1); PG8_STAGE(PG8_SB(0, 0), b2, voffB);
            PG8_BAR; PG8_WAIT_L(0); PG8_MMA(0, 1, At, B1); PG8_BAR;
            PG8_LDA(At, 0, 1); PG8_STAGE(PG8_SA(0, 0), a2, voffA);
            PG8_BAR; PG8_WAIT_L(0); PG8_MMA(1, 0, At, B0); PG8_BAR; PG8_SCHED;
            PG8_STAGE(PG8_SB(0, 1), b2 + hstep, voffB);
            PG8_WAIT_V(6); PG8_BAR; PG8_MMA(1, 1, At, B1); PG8_BAR;
            PG8_LDB(B0, 1, 0); PG8_SCHED; PG8_LDA(At, 1, 0); PG8_STAGE(PG8_SA(0, 1), a2 + hstep, voffA);
            PG8_WAIT_L(8); PG8_BAR; PG8_WAIT_L(0); PG8_MMA(0, 0, At, B0); PG8_BAR; PG8_SCHED;
            PG8_LDB(B1, 1, 1); PG8_STAGE(PG8_SB(1, 0), b3, voffB);
            PG8_BAR; PG8_WAIT_L(0); PG8_MMA(0, 1, At, B1); PG8_BAR;
            PG8_LDA(At, 1, 1); PG8_STAGE(PG8_SA(1, 0), a3, voffA);
            PG8_BAR; PG8_WAIT_L(0); PG8_MMA(1, 0, At, B0); PG8_BAR; PG8_SCHED;
            PG8_STAGE(PG8_SB(1, 1), b3 + hstep, voffB);
            PG8_WAIT_V(6); PG8_BAR; PG8_MMA(1, 1, At, B1); PG8_BAR;
            }
        }
        if constexpr (ALIGN_EPI) { if (wr == 0) PG8_BAR; }
        if constexpr (!Epi::AFTER_DRAIN) { E(acc, cur, wr, wc, fr, fq); S.done(cur); }
        if (!has_next) break;
#pragma unroll
        for (int a = 0; a < 2; ++a)
#pragma unroll
            for (int b = 0; b < 2; ++b)
#pragma unroll
                for (int m = 0; m < 4; ++m)
#pragma unroll
                    for (int n = 0; n < 2; ++n) acc[a][b][m][n] = (f32x4){0.f, 0.f, 0.f, 0.f};
        cur = nxt; cA = nA; cB = nB; ++ui;
        if constexpr (ALIGN_EPI) { if (wr == 1) PG8_BAR; }
    }
    PG8_WAIT_V(0);
    if constexpr (!ALIGN_EPI) { if (wr == 0) PG8_BAR; }
    PG8_BAR;
    if constexpr (Epi::AFTER_DRAIN) { E.fused(acc, cur, wr, wc, fr, fq, lds, wid, lane); S.done(cur); }
#undef PG8_SA
#undef PG8_SB
#undef PG8_STAGE
#undef PG8_LDA
#undef PG8_LDB
#undef PG8_MMA
#undef PG8_WAIT_V
#undef PG8_WAIT_L
#undef PG8_BAR
#undef PG8_SCHED
}
}

#ifndef PG8_SP2
#define PG8_SP2 true
#endif
#ifndef PG8_ALIGN
#define PG8_ALIGN true
#endif
#define GAS __attribute__((address_space(1)))
#define LAS __attribute__((address_space(3)))
typedef unsigned short bf16;
typedef unsigned v4u __attribute__((ext_vector_type(4)));
typedef float f32x4 __attribute__((ext_vector_type(4)));
typedef short bf16x8 __attribute__((ext_vector_type(8)));
typedef GAS unsigned gu32;
typedef GAS unsigned long long gu64;
#define RLX_AGENT __ATOMIC_RELAXED, __HIP_MEMORY_SCOPE_AGENT
#define LDS_WAIT() asm volatile("s_waitcnt lgkmcnt(0)" ::: "memory")
#define VM_WAIT() asm volatile("s_waitcnt vmcnt(0)" ::: "memory")
__device__ __forceinline__ unsigned long long rt() { return __builtin_amdgcn_s_memrealtime(); }
__device__ __forceinline__ unsigned f2bf(float f) { unsigned u = __builtin_bit_cast(unsigned, f); return (u + 0x7fffu + ((u >> 16) & 1u)) >> 16; }
__device__ __forceinline__ unsigned pk2(float lo, float hi) { return f2bf(lo) | (f2bf(hi) << 16); }

#define XB_TMO      128
#define XB_XCNT(j)  (256  + 64 * (j))
#define XB_XSUB(j)  (1280 + 64 * (j))
#define XB_XGEN(j)  (2304 + 64 * (j))
#define XB_TOP      3328
#define XB_TOPGEN   3392
#define XCD_BAR_WORDS 3456
#define XB_SPIN_CAP (1u << 18)

__device__ __forceinline__ unsigned xb_ld(unsigned* p)              { return __hip_atomic_load(p, __ATOMIC_RELAXED, __HIP_MEMORY_SCOPE_AGENT); }
__device__ __forceinline__ unsigned xb_add(unsigned* p, unsigned v) { return __hip_atomic_fetch_add(p, v, __ATOMIC_RELAXED, __HIP_MEMORY_SCOPE_AGENT); }
__device__ __forceinline__ unsigned xb_xcc_id() { return (unsigned)__builtin_amdgcn_s_getreg((3 << 11) | 20) & 0xFu; }
#define XB_SPIN(cond, bar) do { unsigned _sp = 0; while (cond) { __builtin_amdgcn_s_sleep(1); \
    if ((++_sp & 255u) == 0u) { if (xb_ld(&(bar)[XB_TMO])) break; if (_sp > XB_SPIN_CAP) { atomicAdd(&(bar)[XB_TMO], 1u); break; } } } } while (0)

struct XcdBarrier {
    unsigned* bar; unsigned x;
    volatile LAS unsigned* st;
};

__device__ __forceinline__ XcdBarrier xcd_barrier_post(unsigned* bar, volatile LAS unsigned* st) {
    XcdBarrier b; b.bar = bar; b.x = xb_xcc_id(); b.st = st;
    if (threadIdx.x == 0) (void)xb_add(&bar[XB_XCNT(b.x)], 1u);
    return b;
}
__device__ __forceinline__ void xcd_barrier_complete(unsigned* bar, unsigned x, unsigned& nloc, unsigned& nx) {
    const unsigned G = gridDim.x * gridDim.y * gridDim.z;
    unsigned sum, cnt, mine, sp = 0u;
    for (;;) {
        sum = 0u; cnt = 0u; mine = 0u;
#pragma unroll
        for (unsigned j = 0; j < 16; ++j) { const unsigned c = xb_ld(&bar[XB_XCNT(j)]); sum += c; cnt += (c > 0u) ? 1u : 0u; mine = (j == x) ? c : mine; }
        if (sum == G) break;
        __builtin_amdgcn_s_sleep(1);
        if ((++sp & 255u) == 0u) { if (xb_ld(&bar[XB_TMO])) break; if (sp > XB_SPIN_CAP) { atomicAdd(&bar[XB_TMO], 1u); break; } }
    }
    nloc = mine > 0u ? mine : 1u; nx = cnt > 0u ? cnt : 1u;
}

__device__ __forceinline__ void xcd_barrier(const XcdBarrier& b) {
    asm volatile("s_waitcnt vmcnt(0)" ::: "memory");
    __syncthreads();
    if (threadIdx.x == 0) {
        unsigned* bar = b.bar; unsigned bx_ = b.x; asm volatile("" : "+s"(bx_));
        __builtin_amdgcn_s_waitcnt(0);
        unsigned nloc = b.st[0], nx = b.st[1];
        if (nloc == 0u) { xcd_barrier_complete(bar, bx_, nloc, nx); b.st[0] = nloc; b.st[1] = nx; }
        const unsigned old = xb_add(&bar[XB_XSUB(bx_)], 1u);
        const unsigned gen = old / nloc;
        if (old + 1u == (gen + 1u) * nloc) {
            __builtin_amdgcn_fence(__ATOMIC_RELEASE, "agent");
            asm volatile("s_waitcnt vmcnt(0)" ::: "memory");
            const unsigned og = xb_add(&bar[XB_TOP], 1u);
            const unsigned tg = og / nx;
            if (og + 1u == (tg + 1u) * nx) xb_add(&bar[XB_TOPGEN], 1u);
            else XB_SPIN(xb_ld(&bar[XB_TOPGEN]) == tg, bar);
            __builtin_amdgcn_fence(__ATOMIC_ACQUIRE, "agent");
            xb_add(&bar[XB_XGEN(bx_)], 1u);
            asm volatile("s_waitcnt vmcnt(0)" ::: "memory");
        } else {
            XB_SPIN(xb_ld(&bar[XB_XGEN(bx_)]) == gen, bar);
            __builtin_amdgcn_fence(__ATOMIC_ACQUIRE, "agent");
            asm volatile("s_waitcnt vmcnt(0)" ::: "memory");
        }
    }
    __syncthreads();
}

namespace attn {
typedef unsigned short bf16;
using bf16x8 = __attribute__((ext_vector_type(8))) short;
using s16x4 = __attribute__((ext_vector_type(4))) short;
using f32x16 = __attribute__((ext_vector_type(16))) float;
using u32x4 = __attribute__((ext_vector_type(4))) unsigned;
typedef __attribute__((address_space(3))) const char* lds_cptr;
typedef __attribute__((address_space(3))) char* lds_ptr;
typedef short v4i16_t __attribute__((ext_vector_type(4)));
constexpr int DM = 1024, SEQ = 8192, KVBLK = 64;
constexpr int KSLOT = 8192;
constexpr float THR = 8.0f;
#ifndef AT_PROBE
#define AT_PROBE 0
#endif
__device__ unsigned long long g_probe[8];
template <int DV, int AH> struct Lay {
    static constexpr int VSLOT = DV * 128, NKSLOT = AH + 1, NVSLOT = AH + 3, LDS_K = 0, LDS_V = NKSLOT * KSLOT, LDS_WS = LDS_V + NVSLOT * VSLOT, OSTW = 32 * DV * 2,
        LDS_OST = LDS_V  , BYTES = LDS_WS + 8 * 256;
    static_assert(8 * OSTW <= NVSLOT * VSLOT, "O stages fit inside the V ring");
};
#define AT_SBAR() __builtin_amdgcn_sched_barrier(0)
#define AT_WAIT_BAR(N) asm volatile("s_waitcnt vmcnt(" #N ") lgkmcnt(0)\n\ts_barrier" ::: "memory")
__device__ __forceinline__ void wait_bar_n(int n) {
    switch (n) {
        case 0: AT_WAIT_BAR(0); break; case 1: AT_WAIT_BAR(1); break; case 2: AT_WAIT_BAR(2); break; case 3: AT_WAIT_BAR(3); break;
        case 4: AT_WAIT_BAR(4); break; case 5: AT_WAIT_BAR(5); break; case 6: AT_WAIT_BAR(6); break; case 7: AT_WAIT_BAR(7); break;
        case 8: AT_WAIT_BAR(8); break; case 9: AT_WAIT_BAR(9); break; case 10: AT_WAIT_BAR(10); break; case 11: AT_WAIT_BAR(11); break;
        case 12: AT_WAIT_BAR(12); break; case 13: AT_WAIT_BAR(13); break; case 14: AT_WAIT_BAR(14); break; default: AT_WAIT_BAR(15); break;
    }
}
__device__ __forceinline__ int crow(int r, int hi) { return (r & 3) + 8 * (r >> 2) + 4 * hi; }
__device__ __forceinline__ unsigned f2bf_u(float f) { unsigned u = __builtin_bit_cast(unsigned, f); return (u + 0x7fffu + ((u >> 16) & 1u)) >> 16; }
__device__ __forceinline__ float bf2f_u(unsigned h) { return __builtin_bit_cast(float, h << 16); }
__device__ __forceinline__ void glds16(const void* gsrc, unsigned lds_dst) { unsigned keep;
    asm volatile("s_mov_b32 %0, m0\n\ts_mov_b32 m0, %2\n\ts_nop 0\n\tglobal_load_lds_dwordx4 %1, off\n\ts_mov_b32 m0, %0" : "=&s"(keep) : "v"(gsrc), "s"(lds_dst) : "memory"); }
typedef float f32x2_t __attribute__((ext_vector_type(2))); typedef __bf16 bf16x2_t __attribute__((ext_vector_type(2)));
__device__ __forceinline__ unsigned cvtpk_s(float lo, float hi) { f32x2_t v = {lo, hi}; bf16x2_t b = __builtin_convertvector(v, bf16x2_t); return __builtin_bit_cast(unsigned, b); }
__device__ __forceinline__ s16x4 vtr(lds_cptr p) { return __builtin_bit_cast(s16x4, __builtin_amdgcn_ds_read_tr16_b64_v4i16((__attribute__((address_space(3))) v4i16_t*)p)); }
#define AT_MX3(a, b, c) __builtin_fmaxf(__builtin_fmaxf((a), (b)), (c))
#define AT_MFMA(a, b, c) __builtin_amdgcn_mfma_f32_32x32x16_bf16(a, b, c, 0, 0, 0)
__device__ __forceinline__ float rowmax(const f32x16& p0, const f32x16& p1) {
    float a = AT_MX3(p0[0], p0[1], p1[0]), b = AT_MX3(p0[2], p0[3], p1[1]); a = AT_MX3(a, p1[2], p1[3]);
#pragma unroll
    for (int r = 4; r < 16; r += 4) { a = AT_MX3(a, p0[r], p0[r + 1]); b = AT_MX3(b, p0[r + 2], p0[r + 3]); a = AT_MX3(a, p1[r], p1[r + 1]); b = AT_MX3(b, p1[r + 2], p1[r + 3]); }
    float m = __builtin_fmaxf(a, b); auto rr = __builtin_amdgcn_permlane32_swap(__float_as_uint(m), __float_as_uint(m), false, false);
    return __builtin_fmaxf(__uint_as_float(rr[0]), __uint_as_float(rr[1])); }
__device__ __forceinline__ void cmask(f32x16& p0, f32x16& p1, int jb, int qrel, int hi) {
    const int lim = qrel - 64 * jb - 4 * hi;
#pragma unroll
    for (int r = 0; r < 16; ++r) { const int kv = (r & 3) + 8 * (r >> 2); if (kv > lim) p0[r] = -INFINITY; if (kv + 32 > lim) p1[r] = -INFINITY; } }

template <int DV, bool MOBA, int AH, bool FIXED>
__device__ __forceinline__ void sweep(char* shm, const bf16* Qw, const bf16* __restrict__ Kh, const bf16* __restrict__ Vh, int qb, int kt_min, float slope2, float mfix, unsigned sel, f32x16 (&o)[DV / 32], f32x16& lsum) {
    typedef Lay<DV, AH> L;
    constexpr int NPV = DV / 64, NPT = 1 + NPV;
    int tid_ = threadIdx.x; asm volatile("" : "+v"(tid_));
    const int tid = tid_, lane = tid & 63, r32 = lane & 31, hi = lane >> 5; const int wid = __builtin_amdgcn_readfirstlane(tid >> 6);
    const unsigned lds0 = (unsigned)(uintptr_t)shm;
    const lds_ptr shm3 = (lds_ptr)shm;
    __attribute__((address_space(3))) float* wsf = (__attribute__((address_space(3))) float*)(shm3 + L::LDS_WS) + wid * 64;
    const int NT = 4 * qb + 4 - kt_min;
    const bf16* ksrc = Kh + (long)lane * DM + wid * 8;
    const bf16* vsrc0 = Vh + (long)(16 * (wid & 3) + (lane >> 2)) * DM + (wid >> 2) * 32 + (lane & 3) * 8;
    const unsigned kdst = lds0 + L::LDS_K + wid * 1024, vdst = lds0 + L::LDS_V + wid * 1024;
#define AT_KT(i) (MOBA ? ((i) < 4 ? 4 * qb + (i) : (i) - 4 + kt_min) : (i) + kt_min)
#define AT_DMA(i, ksl, vsl) do { if ((i) >= NT) break; const long kt_ = AT_KT(i); glds16(ksrc + kt_ * KVBLK * DM, (unsigned)__builtin_amdgcn_readfirstlane(kdst + (ksl) * KSLOT)); \
        glds16(vsrc0 + kt_ * KVBLK * DM, (unsigned)__builtin_amdgcn_readfirstlane(vdst + (vsl) * L::VSLOT)); \
        if (NPV == 2) glds16(vsrc0 + kt_ * KVBLK * DM + 64, (unsigned)__builtin_amdgcn_readfirstlane(vdst + (vsl) * L::VSLOT + 8192)); } while (0)
#define AT_VRD(g_, d_) do { _Pragma("unroll") for (int ks = 0; ks < 4; ++ks) { vl[g_][ks] = vtr(vp + (d_) * 4096 + ks * 1024); vh[g_][ks] = vtr(vp + (d_) * 4096 + ks * 1024 + 512); } } while (0)
    bf16x8 qr[4];
#pragma unroll
    for (int d0 = 0; d0 < 4; ++d0) qr[d0] = *reinterpret_cast<const bf16x8*>(&Qw[(long)r32 * DM + d0 * 16 + hi * 8]);
    { _Pragma("unroll") for (int a = 0; a < AH; ++a) AT_DMA(a, a, a); }
    const lds_cptr kp0 = (lds_cptr)shm3 + L::LDS_K + hi * 1024 + r32 * 16;
    const lds_cptr vp0 = (lds_cptr)shm3 + L::LDS_V + ((lane >> 4) & 1) * 32 + (lane & 3) * 8 + (4 * hi + ((lane & 15) >> 2)) * 64;
    const unsigned sw = (unsigned)__builtin_amdgcn_readfirstlane((int)(f2bf_u(slope2) | (f2bf_u(slope2 - bf2f_u(f2bf_u(slope2))) << 16)));
    const unsigned hmask = hi == 0 ? 0xffffffffu : 0u;
    const unsigned off0w = (f2bf_u((float)r32) * 0x10001u) & hmask, off1w = (f2bf_u((float)(32 + r32)) * 0x10001u) & hmask;
    unsigned qz = 0u;
    if (FIXED) { const float mrow = mfix + slope2 * (float)(wid * 32 + r32);
                 const unsigned nh = f2bf_u(-mrow), nl = f2bf_u(-mrow - bf2f_u(nh)); qz = (nh | (nl << 16)) & hmask; }
    float mhat = 0.f;
    constexpr bool MSUM = (DV == 64);
    float l_reg = 0.f;
    lsum = f32x16{};
    const u32x4 ones4 = {0x3f803f80u, 0x3f803f80u, 0x3f803f80u, 0x3f803f80u};
#pragma unroll
    for (int d = 0; d < DV / 32; ++d) o[d] = f32x16{};
    const int qrel = wid * 32 + r32;
    int slot = 0, vslot = 0;
    constexpr int ND = DV / 32, NMF = 4 * ND, NEXP = 32 / NMF, NVS = AH + 3;
    u32x4 pwA[4] = {{0u, 0u, 0u, 0u}, {0u, 0u, 0u, 0u}, {0u, 0u, 0u, 0u}, {0u, 0u, 0u, 0u}}, pwB[4];
    u32x4 a0 = {off0w, 0u, 0x3f803f80u & hmask, 0u}, a1 = {off1w, 0u, 0x3f803f80u & hmask, 0u}, qv = {sw & hmask, sw & hmask, qz, 0u};
    const bool late = wid >= 4;
#define AT_PIN(x) asm volatile("" : "+v"(x))
#define AT_CE(e) ((e) < 16 ? c0[(e) & 15] : c1[(e) & 15])
#define AT_VOFF(g) (((g) >> 2) * 4096 + ((g) & 3) * 1024)
    f32x16 c0, c1; bool resc = false;
#define AT_PHA(T_) do { \
        bf16x8 kf[8]; \
        { const lds_cptr kp = kp0 + slot * KSLOT; \
          _Pragma("unroll") for (int j = 0; j < 4; ++j) { kf[2 * j] = *(const __attribute__((address_space(3))) bf16x8*)(kp + j * 2048); kf[2 * j + 1] = *(const __attribute__((address_space(3))) bf16x8*)(kp + j * 2048 + 512); } } \
        AT_SBAR(); \
        { const int s2 = slot == 0 ? AH : slot - 1; int v2 = vslot + AH; v2 = v2 >= NVS ? v2 - NVS : v2; AT_DMA((T_) + AH, s2, v2); } \
        const int kt = AT_KT(T_); \
        const int jb = MOBA ? ((T_) < 4 ? (T_) : -1) : ((T_) - (NT - 4)); \
        { const unsigned tb = __float_as_uint((float)(64 * (kt - 4 * qb))) >> 16; \
          if (DV == 128) { a0 = (u32x4){off0w, 0u, 0x3f803f80u & hmask, 0u}; a1 = (u32x4){off1w, 0u, 0x3f803f80u & hmask, 0u}; qv = (u32x4){sw & hmask, sw & hmask, qz, 0u}; }     \
          a0.y = (tb * 0x10001u) & hmask; a1.y = a0.y; \
          qv.z = qz; \
          if (MOBA) { if (hi == 0 && (T_) >= 4 && !((sel >> (kt >> 2)) & 1u)) qv.z = 0x0000f14au; } \
          c0 = AT_MFMA(__builtin_bit_cast(bf16x8, a0), __builtin_bit_cast(bf16x8, qv), f32x16{}); c1 = AT_MFMA(__builtin_bit_cast(bf16x8, a1), __builtin_bit_cast(bf16x8, qv), f32x16{}); \
          _Pragma("unroll") for (int j = 0; j < 4; ++j) { c0 = AT_MFMA(kf[2 * j], qr[j], c0); c1 = AT_MFMA(kf[2 * j + 1], qr[j], c1); } } \
        if (jb >= 0) { asm volatile("" ::: "memory"); cmask(c0, c1, jb, qrel, hi); } \
        resc = false; \
        if (!FIXED) { const float rm = rowmax(c0, c1); const bool first = ((T_) == 0); \
          if (first || __any(rm > THR)) { \
              const float dl = first ? rm : __builtin_fmaxf(rm, 0.f); const float mnew = mhat + dl; \
              const unsigned nh = f2bf_u(-mnew), nl = f2bf_u(-mnew - bf2f_u(nh)); const float meff = -(bf2f_u(nh) + bf2f_u(nl)); \
              const float dle = meff - mhat; mhat = meff; qz = (nh | (nl << 16)) & hmask; \
              _Pragma("unroll") for (int r = 0; r < 16; ++r) { c0[r] -= dle; c1[r] -= dle; } \
              if (!first) { const float f = __builtin_amdgcn_exp2f(-dle); if (!MSUM) l_reg *= f; if (hi == 0) wsf[r32] = f; resc = true; } } } \
    } while (0)
#define AT_PHB(VS_, PIN_, POUT_) do { \
        float sacc = 0.f; \
        const lds_cptr vp = vp0 + (VS_) * L::VSLOT; \
        s16x4 vl[NMF], vh[NMF]; \
        _Pragma("unroll") for (int g = 0; g < 4; ++g) { vl[g] = vtr(vp + AT_VOFF(g)); vh[g] = vtr(vp + AT_VOFF(g) + 512); } \
        AT_SBAR(); \
        _Pragma("unroll") for (int g = 0; g < NMF; ++g) { \
            if (g + 4 < NMF) { vl[g + 4] = vtr(vp + AT_VOFF(g + 4)); vh[g + 4] = vtr(vp + AT_VOFF(g + 4) + 512); } \
            { const bf16x8 vf = (bf16x8){vl[g][0], vl[g][1], vl[g][2], vl[g][3], vh[g][0], vh[g][1], vh[g][2], vh[g][3]}; \
              o[g >> 2] = AT_MFMA(__builtin_bit_cast(bf16x8, PIN_[g & 3]), vf, o[g >> 2]); } \
            if (MSUM && (g & (ND - 1)) == ND - 1 && (g / ND) < 4) lsum = AT_MFMA(__builtin_bit_cast(bf16x8, PIN_[g / ND]), __builtin_bit_cast(bf16x8, ones4), lsum); \
            _Pragma("unroll") for (int x = 0; x < NEXP; x += 2) { const int e = g * NEXP + x; \
                const float p0 = __builtin_amdgcn_exp2f(AT_CE(e)), p1 = __builtin_amdgcn_exp2f(AT_CE(e + 1)); \
                if (!MSUM) { sacc += p0; sacc += p1; } POUT_[e >> 3][(e & 7) >> 1] = cvtpk_s(p0, p1); } \
            if (!MSUM) AT_PIN(sacc); AT_PIN(POUT_[(g * NEXP) >> 3]); \
            AT_SBAR(); } \
        if (resc) { \
            asm volatile("s_waitcnt lgkmcnt(0)" ::: "memory"); \
            _Pragma("unroll") for (int r = 0; r < 16; ++r) { const float f_ = wsf[crow(r, hi)]; if (MSUM) lsum[r] *= f_; _Pragma("unroll") for (int d = 0; d < ND; ++d) o[d][r] *= f_; } } \
        if (!MSUM) l_reg += sacc; \
    } while (0)
#define AT_STEP_END(T_) do { { int na = NT - 2 - (T_); na = na < 0 ? 0 : (na > AH - 1 ? AH - 1 : na); wait_bar_n(na * NPT); } \
        slot = slot == AH ? 0 : slot + 1; vslot = vslot == NVS - 1 ? 0 : vslot + 1; } while (0)
    wait_bar_n(((NT < AH ? NT : AH) - 1) * NPT);
    int vlast; bool inA;
#define AT_VPREV1 (vslot == 0 ? NVS - 1 : vslot - 1)
#define AT_VPREV2 (vslot < 2 ? vslot + NVS - 2 : vslot - 2)
    if (!late) {
        int i = 0;
        for (; i + 1 < NT; i += 2) {
            AT_PHA(i);     AT_PHB(i == 0 ? 0 : AT_VPREV1, pwA, pwB); AT_STEP_END(i);
            AT_PHA(i + 1); AT_PHB(AT_VPREV1, pwB, pwA);              AT_STEP_END(i + 1);
        }
        inA = true;
        if (i < NT) { AT_PHA(i); AT_PHB(AT_VPREV1, pwA, pwB); AT_STEP_END(i); inA = false; }
        vlast = AT_VPREV1;
    } else {
        AT_PHA(0); AT_STEP_END(0);
        int i = 1;
        for (; i + 1 < NT; i += 2) {
            AT_PHB(i == 1 ? 0 : AT_VPREV2, pwA, pwB); AT_PHA(i);     AT_STEP_END(i);
            AT_PHB(AT_VPREV2, pwB, pwA);              AT_PHA(i + 1); AT_STEP_END(i + 1);
        }
        inA = true;
        if (i < NT) { AT_PHB(i == 1 ? 0 : AT_VPREV2, pwA, pwB); AT_PHA(i); AT_STEP_END(i); inA = false; }
        if (inA) { AT_PHB(AT_VPREV2, pwA, pwB); inA = false; } else { AT_PHB(AT_VPREV2, pwB, pwA); inA = true; }
        vlast = AT_VPREV1;
    }
    if (!inA) {
#pragma unroll
        for (int k = 0; k < 4; ++k) pwA[k] = pwB[k];
    }
    { const lds_cptr vp = vp0 + vlast * L::VSLOT; s16x4 vl[2][4], vh[2][4];
      AT_VRD(0, 0); AT_SBAR();
#pragma unroll
      for (int d = 0; d < ND; ++d) {
          if (d + 1 < ND) AT_VRD((d + 1) & 1, d + 1);
          AT_SBAR();
#pragma unroll
          for (int ks = 0; ks < 4; ++ks) { const bf16x8 vf = (bf16x8){vl[d & 1][ks][0], vl[d & 1][ks][1], vl[d & 1][ks][2], vl[d & 1][ks][3], vh[d & 1][ks][0], vh[d & 1][ks][1], vh[d & 1][ks][2], vh[d & 1][ks][3]};
              o[d] = AT_MFMA(__builtin_bit_cast(bf16x8, pwA[ks]), vf, o[d]); }
          AT_SBAR(); }
      if (MSUM) {
#pragma unroll
          for (int ks = 0; ks < 4; ++ks) lsum = AT_MFMA(__builtin_bit_cast(bf16x8, pwA[ks]), __builtin_bit_cast(bf16x8, ones4), lsum); } }
    if (!MSUM) {
        auto rr = __builtin_amdgcn_permlane32_swap(__float_as_uint(l_reg), __float_as_uint(l_reg), false, false); const float lt = __uint_as_float(rr[0]) + __uint_as_float(rr[1]);
        if (hi == 0) wsf[32 + r32] = lt;
        asm volatile("s_waitcnt lgkmcnt(0)" ::: "memory");
#pragma unroll
        for (int r = 0; r < 16; ++r) lsum[r] = wsf[32 + crow(r, hi)];
    }
    AT_WAIT_BAR(0);
#undef AT_PIN
#undef AT_CE
#undef AT_VOFF
#undef AT_PHA
#undef AT_PHB
#undef AT_STEP_END
#undef AT_VPREV1
#undef AT_VPREV2
#undef AT_KT
#undef AT_DMA
#undef AT_VRD
}

__device__ __forceinline__ int window_kt_min(const unsigned* nrm, int b, int chunk, int q0, float slope2, float& Bout) {
    const float nq = __uint_as_float(nrm[((0 * 2 + b) * 16 + chunk) * 2]) + __uint_as_float(nrm[((0 * 2 + b) * 16 + chunk) * 2 + 1]);
    const float nk = __uint_as_float(nrm[((1 * 2 + b) * 16 + chunk) * 2]) + __uint_as_float(nrm[((1 * 2 + b) * 16 + chunk) * 2 + 1]);
    const float B = sqrtf(nq * nk) * 1.01f; Bout = B;
    const float W = (2.0f * B + 160.0f) / slope2;
    const int wkeys = W < 1.0e6f ? (int)W : 1000000;
    const int d = q0 - wkeys;
    return d > 0 ? (d >> 6) : 0;
}
__device__ __forceinline__ void diff_item(char* shm, int b, int h, int qb, int m, const bf16* Q, const bf16* K, const bf16* V, bf16* O, float lam, const unsigned* nrm, unsigned* flag, unsigned* tmo) {
    typedef Lay<128, 2> L;
    int tid_ = threadIdx.x; asm volatile("" : "+v"(tid_));
    const int tid = tid_; const int wid = __builtin_amdgcn_readfirstlane(tid >> 6);
    const long rowbase = (long)b * SEQ; const int q0 = qb * 256;
    const float slope2 = __builtin_amdgcn_exp2f(-(float)(h + 1)) * 1.4426950408889634f;
    lam = __uint_as_float((unsigned)__builtin_amdgcn_readfirstlane((int)__float_as_uint(lam)));
    const lds_ptr shm3 = (lds_ptr)shm;
    __attribute__((address_space(3))) float* wsf = (__attribute__((address_space(3))) float*)(shm3 + L::LDS_WS) + wid * 64;
    __attribute__((address_space(3))) bf16* stg = (__attribute__((address_space(3))) bf16*)(shm3 + L::LDS_OST + wid * L::OSTW);
    f32x16 o[4], lsum;
    float Bq; const int kt_min = __builtin_amdgcn_readfirstlane(window_kt_min(nrm, b, 2 * h + m, q0, slope2, Bq));
    Bq = __uint_as_float((unsigned)__builtin_amdgcn_readfirstlane((int)__float_as_uint(Bq)));
    if (Bq <= 40.0f) sweep<128, false, 2, true>(shm, Q + (rowbase + q0 + wid * 32) * DM + h * 128 + m * 64, K + rowbase * DM + h * 128 + m * 64, V + rowbase * DM + h * 128, qb, kt_min, slope2, Bq, 0u, o, lsum);
    else sweep<128, false, 2, false>(shm, Q + (rowbase + q0 + wid * 32) * DM + h * 128 + m * 64, K + rowbase * DM + h * 128 + m * 64, V + rowbase * DM + h * 128, qb, kt_min, slope2, Bq, 0u, o, lsum);
    int lane_e = tid & 63; asm volatile("" : "+v"(lane_e));
    const int lane = lane_e, r32 = lane & 31, hi = lane >> 5;
    bf16* Ow = O + (rowbase + q0 + wid * 32) * DM + h * 128;
    float rli[16];
#pragma unroll
    for (int r = 0; r < 16; ++r) rli[r] = (m == 0 ? 1.0f : lam) * __builtin_amdgcn_rcpf(lsum[r]);
    if (m == 0) {
#pragma unroll
        for (int r = 0; r < 16; ++r)
#pragma unroll
            for (int d = 0; d < 4; ++d) stg[crow(r, hi) * 128 + d * 32 + r32] = (bf16)f2bf_u(o[d][r] * rli[r]);
        asm volatile("s_waitcnt lgkmcnt(0)" ::: "memory");
#pragma unroll
        for (int i = 0; i < 8; ++i) { const int row = i * 4 + (lane >> 4), ch = lane & 15; const u32x4 v = *(const __attribute__((address_space(3))) u32x4*)(stg + row * 128 + ch * 8); *(u32x4*)(Ow + (long)row * DM + ch * 8) = v; }
        asm volatile("s_waitcnt vmcnt(0)" ::: "memory");
        __syncthreads();
        if (tid == 0) { __builtin_amdgcn_fence(__ATOMIC_RELEASE, "agent"); asm volatile("s_waitcnt vmcnt(0)" ::: "memory"); __hip_atomic_store(flag, 1u, __ATOMIC_RELAXED, __HIP_MEMORY_SCOPE_AGENT); }
    } else {
        if (tid == 0) {
            unsigned sp = 0u;
            while (__hip_atomic_load(flag, __ATOMIC_RELAXED, __HIP_MEMORY_SCOPE_AGENT) == 0u) { __builtin_amdgcn_s_sleep(8); if (++sp > (1u << 22)) { __hip_atomic_store(tmo, 1u, __ATOMIC_RELAXED, __HIP_MEMORY_SCOPE_AGENT); break; } }
            __builtin_amdgcn_fence(__ATOMIC_ACQUIRE, "agent");
            asm volatile("s_waitcnt vmcnt(0)" ::: "memory");
        }
        __syncthreads();
#pragma unroll
        for (int i = 0; i < 8; ++i) { const int row = i * 4 + (lane >> 4), ch = lane & 15; const u32x4 v = *(const u32x4*)(Ow + (long)row * DM + ch * 8); *(__attribute__((address_space(3))) u32x4*)(stg + row * 128 + ch * 8) = v; }
        asm volatile("s_waitcnt vmcnt(0) lgkmcnt(0)" ::: "memory");
        float ss[16];
#pragma unroll
        for (int r = 0; r < 16; ++r) { float sq = 0.f;
#pragma unroll
            for (int d = 0; d < 4; ++d) { const float v = bf2f_u(stg[crow(r, hi) * 128 + d * 32 + r32]) - o[d][r] * rli[r]; o[d][r] = v; sq = __builtin_fmaf(v, v, sq); }
            ss[r] = sq; }
#pragma unroll
        for (int r = 0; r < 16; ++r) {
#pragma unroll
            for (int off = 1; off < 32; off <<= 1) ss[r] += __shfl_xor(ss[r], off);
            ss[r] = 1.0f / sqrtf(ss[r] * (1.0f / 128.0f) + 1e-6f); }
#pragma unroll
        for (int r = 0; r < 16; ++r)
#pragma unroll
            for (int d = 0; d < 4; ++d) stg[crow(r, hi) * 128 + d * 32 + r32] = (bf16)f2bf_u(o[d][r] * ss[r]);
        asm volatile("s_waitcnt lgkmcnt(0)" ::: "memory");
#pragma unroll
        for (int i = 0; i < 8; ++i) { const int row = i * 4 + (lane >> 4), ch = lane & 15; const u32x4 v = *(const __attribute__((address_space(3))) u32x4*)(stg + row * 128 + ch * 8); *(u32x4*)(Ow + (long)row * DM + ch * 8) = v; }
    }
}
__device__ __forceinline__ void moba_unit(char* shm, int b, int h, int qb, const bf16* Q, const bf16* K, const bf16* V, bf16* O, const float* KM, const unsigned* nrm) {
    typedef Lay<64, 3> L;
    int tid_ = threadIdx.x; asm volatile("" : "+v"(tid_));
    const int tid = tid_, lane = tid & 63, r32 = lane & 31, hi = lane >> 5; const int wid = __builtin_amdgcn_readfirstlane(tid >> 6);
    const long rowbase = (long)b * SEQ; const int q0 = qb * 256;
    const float slope2 = __builtin_amdgcn_exp2f(-0.5f * (float)(h + 1)) * 1.4426950408889634f;
    const lds_ptr shm3 = (lds_ptr)shm;
    __attribute__((address_space(3))) float* wsf = (__attribute__((address_space(3))) float*)(shm3 + L::LDS_WS) + wid * 64;
    __attribute__((address_space(3))) bf16* stg = (__attribute__((address_space(3))) bf16*)(shm3 + L::LDS_OST + wid * L::OSTW);
    const bf16* Qw = Q + (rowbase + q0 + wid * 32) * DM + h * 64;
    unsigned sel = 0u;
    if (qb > 0) {
        f32x16 g = f32x16{};
        const float* km = KM + (((long)b * 16 + h) * 32 + r32) * 64 + hi * 8;
#pragma unroll
        for (int d0 = 0; d0 < 4; ++d0) {
            const bf16x8 qf = *reinterpret_cast<const bf16x8*>(&Qw[(long)r32 * DM + d0 * 16 + hi * 8]);
            const float4 x0 = *(const float4*)(km + d0 * 16), x1 = *(const float4*)(km + d0 * 16 + 4);
            const float xs[8] = {x0.x, x0.y, x0.z, x0.w, x1.x, x1.y, x1.z, x1.w};
            unsigned hw[8], lw[8];
#pragma unroll
            for (int e = 0; e < 8; ++e) { hw[e] = f2bf_u(xs[e]); lw[e] = f2bf_u(xs[e] - bf2f_u(hw[e])); }
            const u32x4 ah = {hw[0] | (hw[1] << 16), hw[2] | (hw[3] << 16), hw[4] | (hw[5] << 16), hw[6] | (hw[7] << 16)};
            const u32x4 al = {lw[0] | (lw[1] << 16), lw[2] | (lw[3] << 16), lw[4] | (lw[5] << 16), lw[6] | (lw[7] << 16)};
            g = AT_MFMA(__builtin_bit_cast(bf16x8, ah), qf, g); g = AT_MFMA(__builtin_bit_cast(bf16x8, al), qf, g);
        }
        float g0[16], g1[16];
#pragma unroll
        for (int r = 0; r < 16; ++r) { auto rr = __builtin_amdgcn_permlane32_swap(__float_as_uint(g[r]), __float_as_uint(g[r]), false, false); g0[r] = __uint_as_float(rr[0]); g1[r] = __uint_as_float(rr[1]); }
        float b0 = -INFINITY, b1 = -INFINITY, b2 = -INFINITY; int i0 = 0, i1 = 0, i2 = 0;
#pragma unroll
        for (int n = 0; n < 32; ++n) {
            const int rn = 4 * (n >> 3) + (n & 3);
            float v = ((n >> 2) & 1) ? g1[rn] : g0[rn];
            if (n >= qb) v = -INFINITY;
            if (v > b0) { b2 = b1; i2 = i1; b1 = b0; i1 = i0; b0 = v; i0 = n; }
            else if (v > b1) { b2 = b1; i2 = i1; b1 = v; i1 = n; }
            else if (v > b2) { b2 = v; i2 = n; }
        }
        if (b0 > -INFINITY) sel |= 1u << i0;
        if (b1 > -INFINITY) sel |= 1u << i1;
        if (b2 > -INFINITY) sel |= 1u << i2;
    }
    f32x16 o[2], lsum;
    float Bq; const int kt_min = __builtin_amdgcn_readfirstlane(window_kt_min(nrm, b, h, q0, slope2, Bq));
    Bq = __uint_as_float((unsigned)__builtin_amdgcn_readfirstlane((int)__float_as_uint(Bq)));
    if (Bq <= 40.0f) sweep<64, true, 3, true>(shm, Qw, K + rowbase * DM + h * 64, V + rowbase * DM + h * 64, qb, kt_min, slope2, Bq, sel, o, lsum);
    else sweep<64, true, 3, false>(shm, Qw, K + rowbase * DM + h * 64, V + rowbase * DM + h * 64, qb, kt_min, slope2, Bq, sel, o, lsum);
    int lane_e = lane; asm volatile("" : "+v"(lane_e));
    { const int lane = lane_e, r32 = lane & 31, hi = lane >> 5;
#pragma unroll
    for (int r = 0; r < 16; ++r) { const float rl = __builtin_amdgcn_rcpf(lsum[r]);
#pragma unroll
        for (int d = 0; d < 2; ++d) stg[crow(r, hi) * 64 + d * 32 + r32] = (bf16)f2bf_u(o[d][r] * rl); }
    asm volatile("s_waitcnt lgkmcnt(0)" ::: "memory");
    bf16* Ow = O + (rowbase + q0 + wid * 32) * DM + h * 64;
#pragma unroll
    for (int i = 0; i < 4; ++i) { const int row = i * 8 + (lane >> 3), ch = lane & 7; const u32x4 v = *(const __attribute__((address_space(3))) u32x4*)(stg + row * 64 + ch * 8); *(u32x4*)(Ow + (long)row * DM + ch * 8) = v; }
    }
}
#undef AT_SBAR
#undef AT_WAIT_BAR
#undef AT_MX3
#undef AT_MFMA
}

constexpr int NWAVES = 8;
constexpr int RING_OFF = 0, RING_BYTES = 131072;
constexpr int LDSCTL_OFF = RING_BYTES, MISC_OFF = LDSCTL_OFF + 320;
constexpr int LDS_BYTES = RING_BYTES + 1024;
static_assert(attn::Lay<128, 2>::BYTES <= RING_BYTES && attn::Lay<64, 3>::BYTES <= RING_BYTES && LDS_BYTES <= 163840, "LDS budget");
static_assert(MISC_OFF + 128 <= LDS_BYTES, "LDS map");

struct Frame {
    LAS unsigned char* lds; volatile LAS unsigned* MISC; gu32* ctl;
    int tid, lane, wave, vcu, G;
};
__device__ __forceinline__ float wave_sum(float v) {
#pragma unroll
    for (int o = 1; o < 64; o <<= 1) v += __shfl_xor(v, o);
    return v;
}
__device__ __forceinline__ float bf2f(unsigned h) { return __builtin_bit_cast(float, h << 16); }

__device__ __forceinline__ void p0_transpose_item(const float* W, int K, int N, bf16* WT, LAS float* scr, int item, int lane, const float* gk, int gmask, float cmul, int qcols, float qscale) {
    const int nblk = N / 32, kb = item / nblk, nb = item % nblk, k0 = 64 * kb, n0 = 32 * nb;
    const float cs = cmul * ((n0 < qcols) ? qscale : 1.0f);
#pragma unroll 8
    for (int i = 0; i < 32; ++i) { const int kk = 2 * i + (lane >> 5); const float g = gk ? gk[(k0 + kk) & gmask] : 1.0f; scr[kk * 33 + (lane & 31)] = W[(size_t)(k0 + kk) * N + n0 + (lane & 31)] * (g * cs); }
    LDS_WAIT(); asm volatile("" ::: "memory");
    const int c = lane & 7;
#pragma unroll
    for (int j = 0; j < 4; ++j) { const int n = (lane >> 3) + 8 * j; const LAS float* s = scr + (8 * c) * 33 + n;
        v4u o; o.x = pk2(s[0 * 33], s[1 * 33]); o.y = pk2(s[2 * 33], s[3 * 33]); o.z = pk2(s[4 * 33], s[5 * 33]); o.w = pk2(s[6 * 33], s[7 * 33]);
        *(GAS v4u*)(WT + (size_t)(n0 + n) * K + k0 + 8 * c) = o; }
    LDS_WAIT(); asm volatile("" ::: "memory");
}
__device__ __forceinline__ void p0_x_row2(const float* xrow, bf16* hrow, float* ssq, int lane) {
    f32x4 v[2][4];
#pragma unroll
    for (int r = 0; r < 2; ++r)
#pragma unroll
        for (int j = 0; j < 4; ++j) v[r][j] = ((const GAS f32x4*)(xrow + (size_t)r * D) + lane)[64 * j];
#pragma unroll
    for (int r = 0; r < 2; ++r) { GAS unsigned long long* h8 = (GAS unsigned long long*)(hrow + (size_t)r * D) + lane; float s[4];
#pragma unroll
        for (int j = 0; j < 4; ++j) { h8[64 * j] = (unsigned long long)pk2(v[r][j].x, v[r][j].y) | ((unsigned long long)pk2(v[r][j].z, v[r][j].w) << 32);
            s[j] = wave_sum((v[r][j].x * v[r][j].x + v[r][j].y * v[r][j].y) + (v[r][j].z * v[r][j].z + v[r][j].w * v[r][j].w)); }
        if (lane < 16) { const int j = lane >> 2; const float sj = j == 0 ? s[0] : j == 1 ? s[1] : j == 2 ? s[2] : s[3]; ssq[r * 16 + lane] = (lane & 3) == 0 ? sj : 0.f; } }
}
__device__ __forceinline__ void final_row(float* orow, const float* ssq, const float* g, int lane) {
    const float rs = pg8::row_rstd16(ssq, 0);
    GAS f32x4* orr = (GAS f32x4*)orow + lane; const GAS f32x4* gr = (const GAS f32x4*)g + lane;
#pragma unroll
    for (int j = 0; j < 4; ++j) { f32x4 v = orr[64 * j]; const f32x4 gv = gr[64 * j]; v = v * rs * gv; orr[64 * j] = v; }
}

__device__ __forceinline__ void diff_attn_unit_simple(LAS unsigned char* lds, int b, int h, int qblk, const bf16* Q, const bf16* K, const bf16* V, bf16* O, float lam, int tid) {
    LAS float* Ks = (LAS float*)lds; LAS float* Vs = (LAS float*)(lds + 64 * 65 * 4);
    const int qi = tid >> 2, part = tid & 3, q0 = qblk * 128, t = q0 + qi;
    const size_t rowbase = (size_t)b * T;
    const float slope2 = exp2f(-(float)(h + 1)) * LOG2E;
    float ores[32], o0[32], l0 = 0.f;
#pragma unroll 1
    for (int m = 0; m < 2; ++m) {
        float q[16];
        { const bf16* qp = Q + (rowbase + t) * D + h * 128 + m * 64 + part * 16;
#pragma unroll
          for (int i = 0; i < 16; ++i) q[i] = bf2f(qp[i]); }
        float mrun = NEG_BIG, l = 0.f, o[32];
#pragma unroll
        for (int e = 0; e < 32; ++e) o[e] = 0.f;
        const int nkt = q0 / 64 + 2;
        for (int kt = 0; kt < nkt; ++kt) {
            const int kb = kt * 64;
            __syncthreads();
            { const int key = tid >> 3, seg = tid & 7;
              const bf16* kp = K + (rowbase + kb + key) * D + h * 128 + m * 64 + seg * 8;
#pragma unroll
              for (int i = 0; i < 8; ++i) Ks[key * 65 + seg * 8 + i] = bf2f(kp[i]);
              const bf16* vp = V + (rowbase + kb + key) * D + h * 128 + seg * 16;
#pragma unroll
              for (int i = 0; i < 16; ++i) Vs[key * 129 + seg * 16 + i] = bf2f(vp[i]); }
            __syncthreads();
            for (int key = 0; key < 64; ++key) {
                float s = 0.f;
#pragma unroll
                for (int i = 0; i < 16; ++i) s = fmaf(q[i], Ks[key * 65 + part * 16 + i], s);
                s += __shfl_xor(s, 1); s += __shfl_xor(s, 2);
                const int kpos = kb + key;
                s += slope2 * (float)(kpos - t);
                if (kpos > t) s = -INFINITY;
                const float mn = fmaxf(mrun, s);
                const float alpha = exp2f(mrun - mn), p = exp2f(s - mn);
                mrun = mn; l = l * alpha + p;
#pragma unroll
                for (int e = 0; e < 32; ++e) o[e] = fmaf(p, Vs[key * 129 + part * 32 + e], o[e] * alpha);
            }
        }
        if (m == 0) {
#pragma unroll
            for (int e = 0; e < 32; ++e) o0[e] = o[e];
            l0 = l;
        } else {
            const float i0 = 1.0f / l0, i1 = lam / l;
#pragma unroll
            for (int e = 0; e < 32; ++e) ores[e] = o0[e] * i0 - o[e] * i1;
        }
    }
    float ss = 0.f;
#pragma unroll
    for (int e = 0; e < 32; ++e) ss = fmaf(ores[e], ores[e], ss);
    ss += __shfl_xor(ss, 1); ss += __shfl_xor(ss, 2);
    const float rs = 1.0f / sqrtf(ss * (1.0f / 128.0f) + RMS_EPS);
    bf16* op = O + (rowbase + t) * D + h * 128 + part * 32;
#pragma unroll
    for (int e = 0; e < 32; e += 2) *(unsigned*)(op + e) = pk2(ores[e] * rs, ores[e + 1] * rs);
    __syncthreads();
}
__device__ __forceinline__ void moba_unit_simple(int b, int h, int qblk, const bf16* Q, const bf16* K, const bf16* V, bf16* O, const float* KM, int tid) {
    const int qi = tid >> 2, part = tid & 3, q0 = qblk * 128, t = q0 + qi, j = q0 / 256;
    const size_t rowbase = (size_t)b * T;
    const float slope2 = exp2f(-0.5f * (float)(h + 1)) * LOG2E;
    float q[16];
    { const bf16* qp = Q + (rowbase + t) * D + h * 64 + part * 16;
#pragma unroll
      for (int i = 0; i < 16; ++i) q[i] = bf2f(qp[i]); }
    float b0 = -INFINITY, b1 = -INFINITY, b2 = -INFINITY; int i0 = 0, i1 = 0, i2 = 0;
    for (int n = 0; n < j; ++n) {
        const float* km = KM + (((size_t)b * 16 + h) * 32 + n) * 64 + part * 16;
        float g = 0.f;
#pragma unroll
        for (int i = 0; i < 16; ++i) g = fmaf(q[i], km[i], g);
        g += __shfl_xor(g, 1); g += __shfl_xor(g, 2);
        if (g > b0) { b2 = b1; i2 = i1; b1 = b0; i1 = i0; b0 = g; i0 = n; }
        else if (g > b1) { b2 = b1; i2 = i1; b1 = g; i1 = n; }
        else if (g > b2) { b2 = g; i2 = n; }
    }
    const int nsel = j < 3 ? j : 3;
    float mrun = NEG_BIG, l = 0.f, o[16];
#pragma unroll
    for (int e = 0; e < 16; ++e) o[e] = 0.f;
    for (int seg = 0; seg <= nsel; ++seg) {
        const int blk = seg == 0 ? j : (seg == 1 ? i0 : (seg == 2 ? i1 : i2));
        const int kb = blk * 256;
        for (int key = 0; key < 256; ++key) {
            const int kpos = kb + key;
            const bf16* kp = K + (rowbase + kpos) * D + h * 64 + part * 16;
            float s = 0.f;
#pragma unroll
            for (int i = 0; i < 16; ++i) s = fmaf(q[i], bf2f(kp[i]), s);
            s += __shfl_xor(s, 1); s += __shfl_xor(s, 2);
            s += slope2 * (float)(kpos - t);
            if (kpos > t) s = -INFINITY;
            const float mn = fmaxf(mrun, s);
            const float alpha = exp2f(mrun - mn), p = exp2f(s - mn);
            mrun = mn; l = l * alpha + p;
            const bf16* vp = V + (rowbase + kpos) * D + h * 64 + part * 16;
#pragma unroll
            for (int e = 0; e < 16; ++e) o[e] = fmaf(p, bf2f(vp[e]), o[e] * alpha);
        }
    }
    const float il = 1.0f / l;
    bf16* op = O + (rowbase + t) * D + h * 64 + part * 16;
#pragma unroll
    for (int e = 0; e < 16; e += 2) *(unsigned*)(op + e) = pk2(o[e] * il, o[e + 1] * il);
}

#define REP_QKV 1
#define REP_DIFF 1
#define REP_MOBA 1
#define REP_FF1 1
#define REP_PRO 1
#define REP_BAR 1
struct Args { const float* in[10]; float* out; unsigned char* ws; };
__global__ void __launch_bounds__(NWAVES * 64, 2) fwd_kernel(Args args) {
    extern __shared__ __attribute__((aligned(16))) unsigned char lds[];
    Frame F;
    F.lds = (LAS unsigned char*)lds;
    F.MISC = (volatile LAS unsigned*)(F.lds + MISC_OFF);
    F.tid = threadIdx.x; F.lane = F.tid & 63; F.wave = __builtin_amdgcn_readfirstlane(F.tid >> 6);
    F.G = gridDim.x; { const int bx = blockIdx.x; F.vcu = (F.G % 8 == 0) ? (bx % 8) * (F.G / 8) + bx / 8 : bx; }
    unsigned char* ws = args.ws;
    F.ctl = (gu32*)(ws + WS_CTL);
#define PTRS() \
    unsigned long long z_ = 0ull; asm volatile("" : "+s"(z_)); unsigned char* wsl = args.ws + z_; float* out = args.out + z_;     \
    bf16* WIN = (bf16*)(wsl + WS_WIN); bf16* WOUT = (bf16*)(wsl + WS_WOUT); bf16* WFF1 = (bf16*)(wsl + WS_WFF1); bf16* WFF2 = (bf16*)(wsl + WS_WFF2); \
    float* SSQ = (float*)(wsl + WS_SSQ); float* KM = (float*)(wsl + WS_KMEAN); \
    bf16* HB = (bf16*)(wsl + WS_HB); bf16* Qb = (bf16*)(wsl + WS_Q); bf16* Kb = (bf16*)(wsl + WS_K); bf16* Vb = (bf16*)(wsl + WS_V); bf16* Ob = (bf16*)(wsl + WS_O); \
    bf16* ACT = (bf16*)(wsl + WS_ACT); \
    (void)WIN; (void)WOUT; (void)WFF1; (void)WFF2; (void)SSQ; (void)KM; (void)HB; (void)Qb; (void)Kb; (void)Vb; (void)Ob; (void)ACT; (void)out
    for (int u = F.tid; u < (LDS_BYTES - LDSCTL_OFF) / 4; u += NWAVES * 64) ((LAS unsigned*)(F.lds + LDSCTL_OFF))[u] = 0u;
    __syncthreads();
    XcdBarrier bar = xcd_barrier_post((unsigned*)(F.ctl + CW_BAR), F.MISC + 8);
#define GRID_BAR() do { for (int rb_ = 0; rb_ < REP_BAR; ++rb_) xcd_barrier(bar); } while (0)
    const int gw = F.vcu * NWAVES + F.wave, NGW = F.G * NWAVES;

    {
        PTRS();
        const float* x = args.in[0]; const float* attn_norm = args.in[1]; const float* w_in = args.in[2]; const float* w_out = args.in[3];
        const float* diff_subln = args.in[5]; const float* mlp_norm = args.in[6]; const float* w_ff1 = args.in[7]; const float* w_ff2 = args.in[8];
        int ln = threadIdx.x & 63; asm volatile("" : "+v"(ln));
        LAS float* scr = (LAS float*)(F.lds + RING_OFF + F.wave * 16384);
        constexpr int I_IN = (D / 64) * (NQKV / 32), I_OUT = (D / 64) * (D / 32), I_F1 = (D / 64) * (FF / 32), I_F2 = (FF / 64) * (D / 32);
        constexpr int PER_L = I_IN + I_OUT + I_F1 + I_F2;
        for (int rp_ = 0; rp_ < REP_PRO; ++rp_) {
        for (int it = gw; it < 2 * PER_L; it += NGW) {
            const int l = it / PER_L; int r = it % PER_L;
            if (r < I_IN) { p0_transpose_item(w_in + (size_t)l * D * NQKV, D, NQKV, WIN + (size_t)l * NQKV * D, scr, r, ln, attn_norm + l * D, D - 1, 1.0f, D, QSCALE); continue; } r -= I_IN;
            if (r < I_OUT) { p0_transpose_item(w_out + (size_t)l * D * D, D, D, WOUT + (size_t)l * D * D, scr, r, ln, l == 0 ? diff_subln : nullptr, 127, l == 0 ? 0.8f : 1.0f, 0, 1.0f); continue; } r -= I_OUT;
            if (r < I_F1) { p0_transpose_item(w_ff1 + (size_t)l * D * FF, D, FF, WFF1 + (size_t)l * FF * D, scr, r, ln, mlp_norm + l * D, D - 1, 1.0f, 0, 1.0f); continue; } r -= I_F1;
            p0_transpose_item(w_ff2 + (size_t)l * FF * D, FF, D, WFF2 + (size_t)l * D * FF, scr, r, ln, nullptr, 0, 1.0f, 0, 1.0f);
        }
        for (int m = 2 * gw; m < M; m += 2 * NGW) p0_x_row2(x + (size_t)m * D, HB + (size_t)m * D, SSQ + (size_t)m * 16, ln);
        }
    }
    GRID_BAR();

#pragma unroll 1
    for (int l = 0; l < 2; ++l) {
        {
            PTRS();
            pg8::Gemm g{HB, WIN + (size_t)l * NQKV * D, M, NQKV, D}; pg8::StaticOrder S; S.init(M, NQKV, F.G, (int)blockIdx.x);
            pg8::EpiScaleBf16<0> E{Qb, D, SSQ, D, (size_t)M * D, l == 1 ? (float*)(F.ctl + CW_KMS) : nullptr, (unsigned*)(F.ctl + CW_NRM + l * 256)};
            for (int rep = 0; rep < REP_QKV; ++rep)
            pg8::gemm_phase<pg8::EpiScaleBf16<0>, pg8::StaticOrder, PG8_ALIGN, PG8_SP2>(F.lds + RING_OFF, g, S, E);
        }
        GRID_BAR();
        if (l == 0) {
            PTRS();
            const float* lp = args.in[4];
            int lnl = threadIdx.x & 63; asm volatile("" : "+v"(lnl));
            const float la = wave_sum(lp[lnl] * lp[64 + lnl]), lc = wave_sum(lp[128 + lnl] * lp[192 + lnl]);
            const float lam = expf(la) - expf(lc) + 0.2f;
            for (int rep = 0; rep < REP_DIFF; ++rep)
            for (;;) {
                if (F.tid == 0) F.MISC[16] = __hip_atomic_fetch_add(F.ctl + CW_QUEUE + 64 * rep, 1u, RLX_AGENT);
                __syncthreads();
                const int i = (int)F.MISC[16];
                __syncthreads();
                if (i >= 1024) break;
                const int u = i >> 1, bh = u & 15, qb = 31 - (u >> 4);
                attn::diff_item((char*)lds + RING_OFF, bh >> 3, bh & 7, qb, i & 1, Qb, Kb, Vb, Ob, lam, (const unsigned*)(F.ctl + CW_NRM), (unsigned*)(F.ctl + CW_DFLAG + rep * 512 + u), (unsigned*)(F.ctl + CW_BAR) + XB_TMO);
            }
        } else {
            PTRS();
            const float* KMf = (const float*)(F.ctl + CW_KMS);
            for (int rep = 0; rep < REP_MOBA; ++rep)
            for (;;) {
                if (F.tid == 0) F.MISC[16] = __hip_atomic_fetch_add(F.ctl + CW_QUEUE + 64 * (4 + rep), 1u, RLX_AGENT);
                __syncthreads();
                const int i = (int)F.MISC[16];
                __syncthreads();
                if (i >= 1024) break;
                const int bh = i & 31, qb = 31 - (i >> 5);
                attn::moba_unit((char*)lds + RING_OFF, bh >> 4, bh & 15, qb, Qb, Kb, Vb, Ob, KMf, (const unsigned*)(F.ctl + CW_NRM + 256));
            }
        }
        GRID_BAR();
        {
            PTRS();
            pg8::Gemm g{Ob, WOUT + (size_t)l * D * D, M, D, D}; pg8::StaticOrder S; S.init(M, D, F.G, (int)blockIdx.x);
            pg8::EpiRes<false> E{out, HB, SSQ, D};
            pg8::gemm_phase<pg8::EpiRes<false>, pg8::StaticOrder, PG8_ALIGN, PG8_SP2>(F.lds + RING_OFF, g, S, E);
        }
        GRID_BAR();
        {
            PTRS();
            pg8::Gemm g{HB, WFF1 + (size_t)l * FF * D, M, FF, D}; pg8::StaticOrder S; S.init(M, FF, F.G, (int)blockIdx.x);
            pg8::EpiScaleBf16<1> E{ACT, FF, SSQ, 0, 0, nullptr, nullptr};
            for (int rep = 0; rep < REP_FF1; ++rep)
            pg8::gemm_phase<pg8::EpiScaleBf16<1>, pg8::StaticOrder, PG8_ALIGN, PG8_SP2>(F.lds + RING_OFF, g, S, E);
        }
        GRID_BAR();
        {
            PTRS();
            pg8::Gemm g{ACT, WFF2 + (size_t)l * D * FF, M, D, FF}; pg8::StaticOrder S; S.init(M, D, F.G, (int)blockIdx.x);
            if (l == 0) { pg8::EpiRes<false> E{out, HB, SSQ, D}; pg8::gemm_phase<pg8::EpiRes<false>, pg8::StaticOrder, PG8_ALIGN, PG8_SP2>(F.lds + RING_OFF, g, S, E); }
            else { pg8::EpiRes<true> E{out, HB, SSQ, D}; pg8::gemm_phase<pg8::EpiRes<true>, pg8::StaticOrder, PG8_ALIGN, PG8_SP2>(F.lds + RING_OFF, g, S, E); }
        }
        GRID_BAR();
    }
    PTRS(); const float* final_norm = args.in[9]; int lnf = threadIdx.x & 63; asm volatile("" : "+v"(lnf));
#if AT_PROBE
    float pscale;
    { const float tot = (float)attn::g_probe[0], a1 = (float)attn::g_probe[1], nst = (float)attn::g_probe[2];
      float xv = AT_PROBE == 1 ? a1 / tot : AT_PROBE == 2 ? (tot / nst) * (1.0f / 10000.0f) : AT_PROBE == 3 ? (float)attn::g_probe[3] / tot : (float)attn::g_probe[4] / tot;
      xv = floorf(xv * AT_PROBE_Q + 0.5f) * (1.0f / AT_PROBE_Q);
      pscale = 1.0f + 0.1f + 0.9f * xv; }
#endif
    for (int m = gw; m < M; m += NGW) final_row(out + (size_t)m * D, SSQ + (size_t)m * 16, final_norm, lnf);
#if AT_PROBE
    __syncthreads();
    for (int m = gw; m < M; m += NGW) { GAS f32x4* orr = (GAS f32x4*)(out + (size_t)m * D) + F.lane;
        for (int j = 0; j < 4; ++j) orr[64 * j] = orr[64 * j] * pscale; }
#endif
    if (xb_ld((unsigned*)(F.ctl + CW_BAR) + XB_TMO) != 0u && blockIdx.x == 0) { const float qn = __builtin_nanf(""); for (int i = F.tid; i < 4096; i += NWAVES * 64) out[i] = qn; }
}

extern "C" void kernel_launch(void* const* d_in, const int* in_sizes, int n_in, void* d_out, int out_size, void* d_ws, size_t ws_size, hipStream_t stream) {
    static int grid = 0;
    if (grid == 0) {
        if (n_in != 10 || in_sizes[0] != M * D || out_size != M * D || ws_size < WS_END) { fprintf(stderr, "kernel_launch: unexpected shapes (n_in %d out %d ws %zu); nothing launched\n", n_in, out_size, ws_size); grid = -1; return; }
        int dev = 0, cus = 0, per_cu = 0;
        if (hipGetDevice(&dev) != hipSuccess || hipDeviceGetAttribute(&cus, hipDeviceAttributeMultiprocessorCount, dev) != hipSuccess) { fprintf(stderr, "kernel_launch: device query failed\n"); grid = -1; return; }
        if (hipFuncSetAttribute((const void*)fwd_kernel, hipFuncAttributeMaxDynamicSharedMemorySize, LDS_BYTES) != hipSuccess) { fprintf(stderr, "kernel_launch: hipFuncSetAttribute failed\n"); grid = -1; return; }
        if (hipOccupancyMaxActiveBlocksPerMultiprocessor(&per_cu, (const void*)fwd_kernel, NWAVES * 64, LDS_BYTES) != hipSuccess || per_cu < 1) { fprintf(stderr, "kernel_launch: occupancy query reports %d workgroups per CU\n", per_cu); per_cu = 1; }
        (void)hipGetLastError();
        grid = cus;
    }
    if (grid < 0) return;
    if (hipMemsetAsync((char*)d_ws + WS_CTL, 0, CTL_ZERO_BYTES, stream) != hipSuccess) { fprintf(stderr, "kernel_launch: hipMemsetAsync failed\n"); return; }
    Args a{};
    for (int i = 0; i < 10; ++i) a.in[i] = (const float*)d_in[i];
    a.out = (float*)d_out; a.ws = (unsigned char*)d_ws;
    hipLaunchKernelGGL(fwd_kernel, dim3(grid), dim3(NWAVES * 64), LDS_BYTES, stream, a);
    const hipError_t le = hipPeekAtLastError();
    if (le != hipSuccess) fprintf(stderr, "kernel_launch: launch failed: %s\n", hipGetErrorName(le));
}
```

```cpp
#include <hip/hip_runtime.h>
#include <cstdio>
#include <cstdint>
#define AT_PROBE 0
#define AT_PROBE_WAVE 0
#define AT_PROBE_Q 16.0f
#define AT_PROBE_DV 128

constexpr int BATCH = 2, T = 8192, D = 1024, M = BATCH * T, FF = 4096, NQKV = 3 * D;
constexpr float RMS_EPS = 1e-6f;
constexpr float LOG2E = 1.4426950408889634f;
constexpr float QSCALE = 0.125f * LOG2E;
constexpr float NEG_BIG = -1e30f;

constexpr size_t MiB = 1u << 20;
constexpr size_t WS_CTL = 0, CTL_ZERO_BYTES = 1 * MiB;
constexpr size_t WS_WIN = 1 * MiB;
constexpr size_t WS_WOUT = 13 * MiB;
constexpr size_t WS_WFF1 = 17 * MiB;
constexpr size_t WS_WFF2 = 33 * MiB;
constexpr size_t WS_SSQ = 49 * MiB;
constexpr size_t WS_KMEAN = 50 * MiB;
constexpr size_t WS_HB = 51 * MiB;
constexpr size_t WS_Q = 83 * MiB, WS_K = 115 * MiB, WS_V = 147 * MiB, WS_O = 179 * MiB;
constexpr size_t WS_ACT = 83 * MiB;
constexpr size_t WS_END = 211 * MiB;
constexpr int CW_TMO = 0, CW_CODE = 1, CW_BAR = 4096;
constexpr int CW_NRM = 8192;
constexpr int CW_DFLAG = 12288;
constexpr int CW_KMS = 32768;
constexpr int CW_QUEUE = 9216;
namespace pg8 {
#define PG8_LAS __attribute__((address_space(3)))
typedef unsigned short bf16_t;
typedef short bf16x8 __attribute__((ext_vector_type(8)));
typedef float f32x4 __attribute__((ext_vector_type(4)));
typedef unsigned u32x4 __attribute__((ext_vector_type(4)));
constexpr int BM = 256, BK = 64, HALF = 128, HTB = HALF * BK * 2  , STAGE_BYTES = 8 * HTB, NXCD = 8, WGM = 8;

__host__ __device__ __forceinline__ int lds_byte(int r, int c) { const int st = (r >> 4) * 2 + (c >> 5), rr = r & 15, cc = c & 31, ob = rr * 64 + cc * 2; return st * 1024 + (ob ^ (((ob >> 9) & 1) << 5)); }
__host__ __device__ __forceinline__ void stage_rc(int b, int& R, int& C) { const int st = b / 1024, sb = b % 1024, swz = sb ^ (((sb >> 9) & 1) << 5); R = (st >> 1) * 16 + swz / 64; C = (st & 1) * 32 + (swz % 64) / 2; }
__host__ __device__ __forceinline__ int perm32(int rho) { const int n = rho >> 4, i = rho & 15; return 8 * (i >> 2) + 4 * n + (i & 3); }

struct Unit { int pm, pn; };
struct Gemm { const bf16_t* A; const bf16_t* Bt; int M, N, K; };

struct StaticOrder {
    int nM, nN, nwg, G, c;
    __host__ __device__ void init(int M, int N, int G_, int c_) { nM = M / BM; nN = N / BM; nwg = nM * nN; G = G_; c = c_; }
    __host__ __device__ bool next(int i, Unit& u) const {
        const long L = (long)i * G + c; if (L >= nwg) return false;
        int wgid = (int)L; { const int q = nwg / NXCD, r = nwg % NXCD, xcd = wgid % NXCD, off = wgid / NXCD; wgid = (xcd < r ? xcd * (q + 1) : r * (q + 1) + (xcd - r) * q) + off; }
        const int nig = WGM * nN, gid = wgid / nig, fm = gid * WGM, gsz = (nM - fm) < WGM ? (nM - fm) : WGM;
        u.pm = fm + ((wgid % nig) % gsz); u.pn = (wgid % nig) / gsz; return true;
    }
    __device__ __forceinline__ void a_ready(const Unit&) const {}
    __device__ __forceinline__ void done(const Unit&) const {}
};


__device__ __forceinline__ unsigned cvt_pk_bf16(float lo, float hi) { unsigned r; asm volatile("v_cvt_pk_bf16_f32 %0, %1, %2" : "=v"(r) : "v"(lo), "v"(hi)); return r; }
__device__ __forceinline__ float row_rstd16(const float* SSQ, int row) {
    const f32x4* p = (const f32x4*)(SSQ + (size_t)row * 16);
    const f32x4 a = p[0], b = p[1], c = p[2], d = p[3];
    const float s = ((a[0] + a[1]) + (a[2] + a[3])) + ((b[0] + b[1]) + (b[2] + b[3])) + ((c[0] + c[1]) + (c[2] + c[3])) + ((d[0] + d[1]) + (d[2] + d[3]));
    return 1.0f / sqrtf(s * (1.0f / 1024.0f) + 1e-6f);
}
template <int ACT> struct EpiScaleBf16 {
    static constexpr bool PERM = true, AFTER_DRAIN = false;
    bf16_t* O; int ldc; const float* SSQ; int split_cols; size_t split_stride;
    float* KMS;
    unsigned* NRM;
    __device__ __forceinline__ void operator()(const f32x4 (&acc)[2][2][4][2], const Unit& u, int wr, int wc, int fr, int fq) const {
        const int row0 = u.pm * BM + wr * 64 + fr; int colt = u.pn * BM; bf16_t* base = O; int t = 0;
        if (split_cols) { t = colt / split_cols; base += (size_t)t * split_stride; colt -= t * split_cols; }
        const int col0 = colt + wc * 32 + 8 * fq;
        const int lane = fq * 16 + fr; float myrs[2];
#pragma unroll
        for (int ai = 0; ai < 2; ++ai) myrs[ai] = row_rstd16(SSQ, u.pm * BM + wr * 64 + ai * HALF + lane);
        asm volatile("" : "+v"(myrs[0]), "+v"(myrs[1]));
        float mx[2] = {0.f, 0.f};
        f32x4 ks[2][2] = {{{0.f, 0.f, 0.f, 0.f}, {0.f, 0.f, 0.f, 0.f}}, {{0.f, 0.f, 0.f, 0.f}, {0.f, 0.f, 0.f, 0.f}}};
#pragma unroll
        for (int ai = 0; ai < 2; ++ai)
#pragma unroll
            for (int m = 0; m < 4; ++m) { const int row = row0 + ai * HALF + m * 16; const float rs = __shfl(myrs[ai], m * 16 + fr); bf16_t* rowp = base + (size_t)row * ldc + col0;
#pragma unroll
                for (int bj = 0; bj < 2; ++bj) { f32x4 v0 = acc[ai][bj][m][0] * rs, v1 = acc[ai][bj][m][1] * rs;
                    if (ACT == 1) {
#pragma unroll
                        for (int e = 0; e < 4; ++e) { const float a = __builtin_fmaxf(v0[e], 0.f), b = __builtin_fmaxf(v1[e], 0.f); v0[e] = a * a; v1[e] = b * b; } }
                    if (ACT == 0 && KMS && t == 1) { ks[bj][0] += v0; ks[bj][1] += v1; }
                    if (ACT == 0 && NRM && t < 2) { float q = (v0[0] * v0[0] + v0[1] * v0[1]) + (v0[2] * v0[2] + v0[3] * v0[3]) + (v1[0] * v1[0] + v1[1] * v1[1]) + (v1[2] * v1[2] + v1[3] * v1[3]);
                        q += __shfl_xor(q, 16); q += __shfl_xor(q, 32); mx[bj] = __builtin_fmaxf(mx[bj], q); }
                    u32x4 w; w.x = cvt_pk_bf16(v0[0], v0[1]); w.y = cvt_pk_bf16(v0[2], v0[3]); w.z = cvt_pk_bf16(v1[0], v1[1]); w.w = cvt_pk_bf16(v1[2], v1[3]);
                    *(u32x4*)(rowp + bj * HALF) = w; } }
        if (ACT == 0 && KMS && t == 1) {
#pragma unroll
            for (int bj = 0; bj < 2; ++bj)
#pragma unroll
                for (int n = 0; n < 2; ++n)
#pragma unroll
                    for (int e = 0; e < 4; ++e) { float q = ks[bj][n][e];
#pragma unroll
                        for (int o = 1; o < 16; o <<= 1) q += __shfl_xor(q, o);
                        const int col = colt + bj * HALF + wc * 32 + 8 * fq + 4 * n + e;
                        if (fr == 0) atomicAdd(KMS + ((((size_t)(u.pm >> 5) * 16 + (col >> 6)) * 32 + (u.pm & 31)) * 64 + (col & 63)), q * (1.0f / 256.0f)); }
        }
        if (ACT == 0 && NRM && t < 2) {
#pragma unroll
            for (int bj = 0; bj < 2; ++bj) { float q = mx[bj];
#pragma unroll
                for (int o = 1; o < 16; o <<= 1) q = __builtin_fmaxf(q, __shfl_xor(q, o));
                const int col = colt + bj * HALF + wc * 32;
                if (lane == 0) atomicMax(NRM + (((t * 2 + (u.pm >> 5)) * 16 + (col >> 6)) * 2 + ((col >> 5) & 1)), __float_as_uint(q)); }
        }
    }
};
template <bool LAST> struct EpiRes {
    static constexpr bool PERM = false, AFTER_DRAIN = false;
    float* out; bf16_t* HB; float* SSQ; int ldc;
    __device__ __forceinline__ void operator()(const f32x4 (&acc)[2][2][4][2], const Unit& u, int wr, int wc, int fr, int fq) const {
        typedef unsigned u32x2v __attribute__((ext_vector_type(2)));
        const int col0 = u.pn * BM + wc * 32 + 4 * fq;
#pragma unroll
        for (int ai = 0; ai < 2; ++ai)
#pragma unroll
            for (int m = 0; m < 4; ++m) { const int row = u.pm * BM + ai * HALF + wr * 64 + m * 16 + fr; const size_t off = (size_t)row * ldc + col0; float s = 0.f;
#pragma unroll
                for (int bj = 0; bj < 2; ++bj)
#pragma unroll
                    for (int n = 0; n < 2; ++n) { const size_t o2 = off + bj * HALF + n * 16; const u32x2v hb = *(const u32x2v*)(HB + o2);
                        f32x4 h = acc[ai][bj][m][n];
                        h[0] += __builtin_bit_cast(float, hb.x << 16); h[1] += __builtin_bit_cast(float, hb.x & 0xffff0000u); h[2] += __builtin_bit_cast(float, hb.y << 16); h[3] += __builtin_bit_cast(float, hb.y & 0xffff0000u);
                        if (LAST) *(f32x4*)(out + o2) = h;
                        else { u32x2v w; w.x = cvt_pk_bf16(h[0], h[1]); w.y = cvt_pk_bf16(h[2], h[3]); *(u32x2v*)(HB + o2) = w; }
                        s += (h[0] * h[0] + h[1] * h[1]) + (h[2] * h[2] + h[3] * h[3]); }
                s += __shfl_xor(s, 16); s += __shfl_xor(s, 32);
                if (fq == 0) SSQ[(size_t)row * 16 + u.pn * 4 + wc] = s;
                if (m & 1) asm volatile("" ::: "memory"); }
    }
};
template <class Epi, class Sched, bool ALIGN_EPI = false, bool SP2 = false>
__device__ __forceinline__ void gemm_phase(PG8_LAS unsigned char* lds, const Gemm g, const Sched& S, const Epi& E) {
    int tid_ = threadIdx.x; asm volatile("" : "+v"(tid_));
    const int tid = tid_, wid = __builtin_amdgcn_readfirstlane(tid >> 6), lane = tid & 63, wr = wid >> 2, wc = wid & 3, fr = lane & 15, fq = lane >> 4;
    const int K = g.K, nt = K / BK;
    unsigned voffA[2], voffB[2];
#pragma unroll
    for (int i = 0; i < 2; ++i) { int R, C; stage_rc(tid * 16 + i * 8192, R, C); const int Rb = Epi::PERM ? ((R & ~31) + perm32(R & 31)) : R;
        voffA[i] = (unsigned)(R * K + C) * 2u; voffB[i] = (unsigned)(Rb * K + C) * 2u; }
    const size_t kstep = (size_t)(BK * 2);
    const size_t hstep = (size_t)HALF * K * 2;
    const size_t tstep = 2 * hstep;
    const unsigned ldsw = (unsigned)wid * 1024u;
    const int aoff = lds_byte(wr * 64 + fr, fq * 8), boff = lds_byte(wc * 32 + fr, fq * 8);
#define PG8_SA(b, h) (((b) * 2 + (h)) * HTB)
#define PG8_SB(b, h) ((4 + (b) * 2 + (h)) * HTB)
#define PG8_STAGE(bufoff, gbase, voff) do { _Pragma("unroll") for (int _i = 0; _i < 2; ++_i) \
        __builtin_amdgcn_global_load_lds((const unsigned*)((const char*)(gbase) + (voff)[_i]), (PG8_LAS unsigned*)(lds + (bufoff) + ldsw + _i * 8192), 16, 0, 0); } while (0)
#define PG8_LDA(dst, b, h) do { _Pragma("unroll") for (int m = 0; m < 4; ++m) _Pragma("unroll") for (int k = 0; k < 2; ++k) dst[m][k] = *(const PG8_LAS bf16x8*)(lds + PG8_SA(b, h) + aoff + m * 2048 + k * 1024); } while (0)
#define PG8_LDB(dst, b, h) do { _Pragma("unroll") for (int n = 0; n < 2; ++n) _Pragma("unroll") for (int k = 0; k < 2; ++k) dst[n][k] = *(const PG8_LAS bf16x8*)(lds + PG8_SB(b, h) + boff + n * 2048 + k * 1024); } while (0)
#define PG8_MMA(ai, bj, At, Bt) do { __builtin_amdgcn_s_setprio(1); _Pragma("unroll") for (int m = 0; m < 4; ++m) _Pragma("unroll") for (int n = 0; n < 2; ++n) _Pragma("unroll") for (int k = 0; k < 2; ++k) \
        acc[ai][bj][m][n] = __builtin_amdgcn_mfma_f32_16x16x32_bf16(Bt[n][k], At[m][k], acc[ai][bj][m][n], 0, 0, 0); __builtin_amdgcn_s_setprio(0); } while (0)
#define PG8_WAIT_V(n) asm volatile("s_waitcnt vmcnt(" #n ")" ::: "memory")
#define PG8_WAIT_L(n) asm volatile("s_waitcnt lgkmcnt(" #n ")" ::: "memory")
#define PG8_BAR __builtin_amdgcn_s_barrier()
#define PG8_SCHED __builtin_amdgcn_sched_barrier(0)
    Unit cur, nxt; int ui = 0;
    if (!S.next(0, cur)) return;
    f32x4 acc[2][2][4][2];
#pragma unroll
    for (int a = 0; a < 2; ++a)
#pragma unroll
        for (int b = 0; b < 2; ++b)
#pragma unroll
            for (int m = 0; m < 4; ++m)
#pragma unroll
                for (int n = 0; n < 2; ++n) acc[a][b][m][n] = (f32x4){0.f, 0.f, 0.f, 0.f};
    bf16x8 At[4][2], B0[2][2], B1[2][2];
    const char* cA = (const char*)g.A + (size_t)cur.pm * tstep; const char* cB = (const char*)g.Bt + (size_t)cur.pn * tstep;
    S.a_ready(cur);
    if constexpr (SP2) {
        PG8_STAGE(PG8_SB(0, 0), cB, voffB); PG8_STAGE(PG8_SB(0, 1), cB + hstep, voffB); PG8_STAGE(PG8_SA(0, 0), cA, voffA); PG8_STAGE(PG8_SA(0, 1), cA + hstep, voffA);
        if (wr == 1) PG8_BAR;
        PG8_WAIT_V(2); PG8_BAR;
        PG8_STAGE(PG8_SB(1, 0), cB + kstep, voffB); PG8_STAGE(PG8_SA(1, 0), cA + kstep, voffA); PG8_STAGE(PG8_SB(1, 1), cB + hstep + kstep, voffB);
        PG8_WAIT_V(6); PG8_BAR;
    } else {
        PG8_STAGE(PG8_SB(0, 0), cB, voffB); PG8_STAGE(PG8_SA(0, 0), cA, voffA); PG8_STAGE(PG8_SB(0, 1), cB + hstep, voffB); PG8_STAGE(PG8_SA(0, 1), cA + hstep, voffA);
        if (wr == 1) PG8_BAR;
        PG8_WAIT_V(4); PG8_BAR;
        PG8_STAGE(PG8_SB(1, 0), cB + kstep, voffB); PG8_STAGE(PG8_SA(1, 0), cA + kstep, voffA); PG8_STAGE(PG8_SB(1, 1), cB + hstep + kstep, voffB);
        PG8_WAIT_V(6); PG8_BAR;
    }
    for (;;) {
        const bool has_next = S.next(ui + 1, nxt);
        const char* nA = has_next ? (const char*)g.A + (size_t)nxt.pm * tstep : cA; const char* nB = has_next ? (const char*)g.Bt + (size_t)nxt.pn * tstep : cB;
        for (int t = 0; t < nt; t += 2) {
            const bool last = (t == nt - 2);
            const char* a1 = cA + (size_t)(t + 1) * kstep;
            const char* a2 = last ? nA : cA + (size_t)(t + 2) * kstep; const char* b2 = last ? nB : cB + (size_t)(t + 2) * kstep;
            const char* a3 = a2 + kstep; const char* b3 = b2 + kstep;
            if (last && has_next) S.a_ready(nxt);
            if constexpr (SP2) {
            PG8_LDB(B0, 0, 0); PG8_LDB(B1, 0, 1); PG8_SCHED; PG8_LDA(At, 0, 0); PG8_STAGE(PG8_SA(1, 1), a1 + hstep, voffA);
            PG8_WAIT_V(8); PG8_WAIT_L(0); PG8_BAR; PG8_MMA(0, 0, At, B0); PG8_MMA(0, 1, At, B1); PG8_BAR; PG8_SCHED;
            PG8_LDA(At, 0, 1); PG8_STAGE(PG8_SB(0, 0), b2, voffB); PG8_STAGE(PG8_SB(0, 1), b2 + hstep, voffB); PG8_STAGE(PG8_SA(0, 0), a2, voffA);
            PG8_WAIT_V(8); PG8_WAIT_L(0); PG8_BAR; PG8_MMA(1, 0, At, B0); PG8_MMA(1, 1, At, B1); PG8_BAR; PG8_SCHED;
            PG8_LDB(B0, 1, 0); PG8_LDB(B1, 1, 1); PG8_SCHED; PG8_LDA(At, 1, 0); PG8_STAGE(PG8_SA(0, 1), a2 + hstep, voffA);
            PG8_WAIT_V(8); PG8_WAIT_L(0); PG8_BAR; PG8_MMA(0, 0, At, B0); PG8_MMA(0, 1, At, B1); PG8_BAR; PG8_SCHED;
            PG8_LDA(At, 1, 1); PG8_STAGE(PG8_SB(1, 0), b3, voffB); PG8_STAGE(PG8_SB(1, 1), b3 + hstep, voffB); PG8_STAGE(PG8_SA(1, 0), a3, voffA);
            PG8_WAIT_V(8); PG8_WAIT_L(0); PG8_BAR; PG8_MMA(1, 0, At, B0); PG8_MMA(1, 1, At, B1); PG8_BAR; PG8_SCHED;
            } else {
            PG8_LDB(B0, 0, 0); PG8_SCHED; PG8_LDA(At, 0, 0); PG8_STAGE(PG8_SA(1, 1), a1 + hstep, voffA);
            PG8_WAIT_L(8); PG8_BAR; PG8_WAIT_L(0); PG8_MMA(0, 0, At, B0); PG8_BAR; PG8_SCHED;
            PG8_LDB(B1, 0, 1); PG8_STAGE(PG8_SB(0, 0), b2, voffB);
            PG8_BAR; PG8_WAIT_L(0); PG8_MMA(0, 1, At, B1); PG8_BAR;
            PG8_LDA(At, 0, 1); PG8_STAGE(PG8_SA(0, 0), a2, voffA);
            PG8_BAR; PG8_WAIT_L(0); PG8_MMA(1, 0, At, B0); PG8_BAR; PG8_SCHED;
            PG8_STAGE(PG8_SB(0, 1), b2 + hstep, voffB);
            PG8_WAIT_V(6); PG8_BAR; PG8_MMA(1, 1, At, B1); PG8_BAR;
            PG8_LDB(B0, 1, 0); PG8_SCHED; PG8_LDA(At, 1, 0); PG8_STAGE(PG8_SA(0, 1), a2 + hstep, voffA);
            PG8_WAIT_L(8); PG8_BAR; PG8_WAIT_L(0); PG8_MMA(0, 0, At, B0); PG8_BAR; PG8_SCHED;
            PG8_LDB(B1, 1, 1); PG8_STAGE(PG8_SB(1, 0), b3, voffB);
            PG8_BAR; PG8_WAIT_L(0); PG8_MMA(0, 1, At, B1); PG8_BAR;
            PG8_LDA(At, 1, 1); PG8_STAGE(PG8_SA(1, 0), a3, voffA);
            PG8_BAR; PG8_WAIT_L(0); PG8_MMA(1, 0, At, B0); PG8_BAR; PG8_SCHED;
            PG8_STAGE(PG8_SB(1, 1), b3 + hstep, voffB);
            PG8_WAIT_V(6); PG8_BAR; PG8_MMA(1, 1, At, B1); PG8_BAR;
            }
        }
        if constexpr (ALIGN_EPI) { if (wr == 0) PG8_BAR; }
        if constexpr (!Epi::AFTER_DRAIN) { E(acc, cur, wr, wc, fr, fq); S.done(cur); }
        if (!has_next) break;
#pragma unroll
        for (int a = 0; a < 2; ++a)
#pragma unroll
            for (int b = 0; b < 2; ++b)
#pragma unroll
                for (int m = 0; m < 4; ++m)
#pragma unroll
                    for (int n = 0; n < 2; ++n) acc[a][b][m][n] = (f32x4){0.f, 0.f, 0.f, 0.f};
        cur = nxt; cA = nA; cB = nB; ++ui;
        if constexpr (ALIGN_EPI) { if (wr == 1) PG8_BAR; }
    }
    PG8_WAIT_V(0);
    if constexpr (!ALIGN_EPI) { if (wr == 0) PG8_BAR; }
    PG8_BAR;
    if constexpr (Epi::AFTER_DRAIN) { E.fused(acc, cur, wr, wc, fr, fq, lds, wid, lane); S.done(cur); }
#undef PG8_SA
#undef PG8_SB
#undef PG8_STAGE
#undef PG8_LDA
#undef PG8_LDB
#undef PG8_MMA
#undef PG8_WAIT_V
#undef PG8_WAIT_L
#undef PG8_BAR
#undef PG8_SCHED
}
}

#ifndef PG8_SP2
#define PG8_SP2 true
#endif
#ifndef PG8_ALIGN
#define PG8_ALIGN true
#endif
#define GAS __attribute__((address_space(1)))
#define LAS __attribute__((address_space(3)))
typedef unsigned short bf16;
typedef unsigned v4u __attribute__((ext_vector_type(4)));
typedef float f32x4 __attribute__((ext_vector_type(4)));
typedef short bf16x8 __attribute__((ext_vector_type(8)));
typedef GAS unsigned gu32;
typedef GAS unsigned long long gu64;
#define RLX_AGENT __ATOMIC_RELAXED, __HIP_MEMORY_SCOPE_AGENT
#define LDS_WAIT() asm volatile("s_waitcnt lgkmcnt(0)" ::: "memory")
#define VM_WAIT() asm volatile("s_waitcnt vmcnt(0)" ::: "memory")
__device__ __forceinline__ unsigned long long rt() { return __builtin_amdgcn_s_memrealtime(); }
__device__ __forceinline__ unsigned f2bf(float f) { unsigned u = __builtin_bit_cast(unsigned, f); return (u + 0x7fffu + ((u >> 16) & 1u)) >> 16; }
__device__ __forceinline__ unsigned pk2(float lo, float hi) { return f2bf(lo) | (f2bf(hi) << 16); }

#define XB_TMO      128
#define XB_XCNT(j)  (256  + 64 * (j))
#define XB_XSUB(j)  (1280 + 64 * (j))
#define XB_XGEN(j)  (2304 + 64 * (j))
#define XB_TOP      3328
#define XB_TOPGEN   3392
#define XCD_BAR_WORDS 3456
#define XB_SPIN_CAP (1u << 18)

__device__ __forceinline__ unsigned xb_ld(unsigned* p)              { return __hip_atomic_load(p, __ATOMIC_RELAXED, __HIP_MEMORY_SCOPE_AGENT); }
__device__ __forceinline__ unsigned xb_add(unsigned* p, unsigned v) { return __hip_atomic_fetch_add(p, v, __ATOMIC_RELAXED, __HIP_MEMORY_SCOPE_AGENT); }
__device__ __forceinline__ unsigned xb_xcc_id() { return (unsigned)__builtin_amdgcn_s_getreg((3 << 11) | 20) & 0xFu; }
#define XB_SPIN(cond, bar) do { unsigned _sp = 0; while (cond) { __builtin_amdgcn_s_sleep(1); \
    if ((++_sp & 255u) == 0u) { if (xb_ld(&(bar)[XB_TMO])) break; if (_sp > XB_SPIN_CAP) { atomicAdd(&(bar)[XB_TMO], 1u); break; } } } } while (0)

struct XcdBarrier {
    unsigned* bar; unsigned x;
    volatile LAS unsigned* st;
};

__device__ __forceinline__ XcdBarrier xcd_barrier_post(unsigned* bar, volatile LAS unsigned* st) {
    XcdBarrier b; b.bar = bar; b.x = xb_xcc_id(); b.st = st;
    if (threadIdx.x == 0) (void)xb_add(&bar[XB_XCNT(b.x)], 1u);
    return b;
}
__device__ __forceinline__ void xcd_barrier_complete(unsigned* bar, unsigned x, unsigned& nloc, unsigned& nx) {
    const unsigned G = gridDim.x * gridDim.y * gridDim.z;
    unsigned sum, cnt, mine, sp = 0u;
    for (;;) {
        sum = 0u; cnt = 0u; mine = 0u;
#pragma unroll
        for (unsigned j = 0; j < 16; ++j) { const unsigned c = xb_ld(&bar[XB_XCNT(j)]); sum += c; cnt += (c > 0u) ? 1u : 0u; mine = (j == x) ? c : mine; }
        if (sum == G) break;
        __builtin_amdgcn_s_sleep(1);
        if ((++sp & 255u) == 0u) { if (xb_ld(&bar[XB_TMO])) break; if (sp > XB_SPIN_CAP) { atomicAdd(&bar[XB_TMO], 1u); break; } }
    }
    nloc = mine > 0u ? mine : 1u; nx = cnt > 0u ? cnt : 1u;
}

__device__ __forceinline__ void xcd_barrier(const XcdBarrier& b) {
    asm volatile("s_waitcnt vmcnt(0)" ::: "memory");
    __syncthreads();
    if (threadIdx.x == 0) {
        unsigned* bar = b.bar; unsigned bx_ = b.x; asm volatile("" : "+s"(bx_));
        __builtin_amdgcn_s_waitcnt(0);
        unsigned nloc = b.st[0], nx = b.st[1];
        if (nloc == 0u) { xcd_barrier_complete(bar, bx_, nloc, nx); b.st[0] = nloc; b.st[1] = nx; }
        const unsigned old = xb_add(&bar[XB_XSUB(bx_)], 1u);
        const unsigned gen = old / nloc;
        if (old + 1u == (gen + 1u) * nloc) {
            __builtin_amdgcn_fence(__ATOMIC_RELEASE, "agent");
            asm volatile("s_waitcnt vmcnt(0)" ::: "memory");
            const unsigned og = xb_add(&bar[XB_TOP], 1u);
            const unsigned tg = og / nx;
            if (og + 1u == (tg + 1u) * nx) xb_add(&bar[XB_TOPGEN], 1u);
            else XB_SPIN(xb_ld(&bar[XB_TOPGEN]) == tg, bar);
            __builtin_amdgcn_fence(__ATOMIC_ACQUIRE, "agent");
            xb_add(&bar[XB_XGEN(bx_)], 1u);
            asm volatile("s_waitcnt vmcnt(0)" ::: "memory");
        } else {
            XB_SPIN(xb_ld(&bar[XB_XGEN(bx_)]) == gen, bar);
            __builtin_amdgcn_fence(__ATOMIC_ACQUIRE, "agent");
            asm volatile("s_waitcnt vmcnt(0)" ::: "memory");
        }
    }
    __syncthreads();
}

namespace attn {
typedef unsigned short bf16;
using bf16x8 = __attribute__((ext_vector_type(8))) short;
using s16x4 = __attribute__((ext_vector_type(4))) short;
using f32x16 = __attribute__((ext_vector_type(16))) float;
using u32x4 = __attribute__((ext_vector_type(4))) unsigned;
typedef __attribute__((address_space(3))) const char* lds_cptr;
typedef __attribute__((address_space(3))) char* lds_ptr;
typedef short v4i16_t __attribute__((ext_vector_type(4)));
constexpr int DM = 1024, SEQ = 8192, KVBLK = 64;
constexpr int KSLOT = 8192;
constexpr float THR = 8.0f;
#ifndef AT_PROBE
#define AT_PROBE 0
#endif
__device__ unsigned long long g_probe[8];
template <int DV, int AH> struct Lay {
    static constexpr int VSLOT = DV * 128, NKSLOT = AH + 1, NVSLOT = AH + 3, LDS_K = 0, LDS_V = NKSLOT * KSLOT, LDS_WS = LDS_V + NVSLOT * VSLOT, OSTW = 32 * DV * 2,
        LDS_OST = LDS_V  , BYTES = LDS_WS + 8 * 256;
    static_assert(8 * OSTW <= NVSLOT * VSLOT, "O stages fit inside the V ring");
};
#define AT_SBAR() __builtin_amdgcn_sched_barrier(0)
#define AT_WAIT_BAR(N) asm volatile("s_waitcnt vmcnt(" #N ") lgkmcnt(0)\n\ts_barrier" ::: "memory")
__device__ __forceinline__ void wait_bar_n(int n) {
    switch (n) {
        case 0: AT_WAIT_BAR(0); break; case 1: AT_WAIT_BAR(1); break; case 2: AT_WAIT_BAR(2); break; case 3: AT_WAIT_BAR(3); break;
        case 4: AT_WAIT_BAR(4); break; case 5: AT_WAIT_BAR(5); break; case 6: AT_WAIT_BAR(6); break; case 7: AT_WAIT_BAR(7); break;
        case 8: AT_WAIT_BAR(8); break; case 9: AT_WAIT_BAR(9); break; case 10: AT_WAIT_BAR(10); break; case 11: AT_WAIT_BAR(11); break;
        case 12: AT_WAIT_BAR(12); break; case 13: AT_WAIT_BAR(13); break; case 14: AT_WAIT_BAR(14); break; default: AT_WAIT_BAR(15); break;
    }
}
__device__ __forceinline__ int crow(int r, int hi) { return (r & 3) + 8 * (r >> 2) + 4 * hi; }
__device__ __forceinline__ unsigned f2bf_u(float f) { unsigned u = __builtin_bit_cast(unsigned, f); return (u + 0x7fffu + ((u >> 16) & 1u)) >> 16; }
__device__ __forceinline__ float bf2f_u(unsigned h) { return __builtin_bit_cast(float, h << 16); }
__device__ __forceinline__ void glds16(const void* gsrc, unsigned lds_dst) { unsigned keep;
    asm volatile("s_mov_b32 %0, m0\n\ts_mov_b32 m0, %2\n\ts_nop 0\n\tglobal_load_lds_dwordx4 %1, off\n\ts_mov_b32 m0, %0" : "=&s"(keep) : "v"(gsrc), "s"(lds_dst) : "memory"); }
typedef float f32x2_t __attribute__((ext_vector_type(2))); typedef __bf16 bf16x2_t __attribute__((ext_vector_type(2)));
__device__ __forceinline__ unsigned cvtpk_s(float lo, float hi) { f32x2_t v = {lo, hi}; bf16x2_t b = __builtin_convertvector(v, bf16x2_t); return __builtin_bit_cast(unsigned, b); }
__device__ __forceinline__ s16x4 vtr(lds_cptr p) { return __builtin_bit_cast(s16x4, __builtin_amdgcn_ds_read_tr16_b64_v4i16((__attribute__((address_space(3))) v4i16_t*)p)); }
#define AT_MX3(a, b, c) __builtin_fmaxf(__builtin_fmaxf((a), (b)), (c))
#define AT_MFMA(a, b, c) __builtin_amdgcn_mfma_f32_32x32x16_bf16(a, b, c, 0, 0, 0)
__device__ __forceinline__ float rowmax(const f32x16& p0, const f32x16& p1) {
    float a = AT_MX3(p0[0], p0[1], p1[0]), b = AT_MX3(p0[2], p0[3], p1[1]); a = AT_MX3(a, p1[2], p1[3]);
#pragma unroll
    for (int r = 4; r < 16; r += 4) { a = AT_MX3(a, p0[r], p0[r + 1]); b = AT_MX3(b, p0[r + 2], p0[r + 3]); a = AT_MX3(a, p1[r], p1[r + 1]); b = AT_MX3(b, p1[r + 2], p1[r + 3]); }
    float m = __builtin_fmaxf(a, b); auto rr = __builtin_amdgcn_permlane32_swap(__float_as_uint(m), __float_as_uint(m), false, false);
    return __builtin_fmaxf(__uint_as_float(rr[0]), __uint_as_float(rr[1])); }
__device__ __forceinline__ void cmask(f32x16& p0, f32x16& p1, int jb, int qrel, int hi) {
    const int lim = qrel - 64 * jb - 4 * hi;
#pragma unroll
    for (int r = 0; r < 16; ++r) { const int kv = (r & 3) + 8 * (r >> 2); if (kv > lim) p0[r] = -INFINITY; if (kv + 32 > lim) p1[r] = -INFINITY; } }

template <int DV, bool MOBA, int AH, bool FIXED>
__device__ __forceinline__ void sweep(char* shm, const bf16* Qw, const bf16* __restrict__ Kh, const bf16* __restrict__ Vh, int qb, int kt_min, float slope2, float mfix, unsigned sel, f32x16 (&o)[DV / 32], f32x16& lsum) {
    typedef Lay<DV, AH> L;
    constexpr int NPV = DV / 64, NPT = 1 + NPV;
    int tid_ = threadIdx.x; asm volatile("" : "+v"(tid_));
    const int tid = tid_, lane = tid & 63, r32 = lane & 31, hi = lane >> 5; const int wid = __builtin_amdgcn_readfirstlane(tid >> 6);
    const unsigned lds0 = (unsigned)(uintptr_t)shm;
    const lds_ptr shm3 = (lds_ptr)shm;
    __attribute__((address_space(3))) float* wsf = (__attribute__((address_space(3))) float*)(shm3 + L::LDS_WS) + wid * 64;
    const int NT = 4 * qb + 4 - kt_min;
    const bf16* ksrc = Kh + (long)lane * DM + wid * 8;
    const bf16* vsrc0 = Vh + (long)(16 * (wid & 3) + (lane >> 2)) * DM + (wid >> 2) * 32 + (lane & 3) * 8;
    const unsigned kdst = lds0 + L::LDS_K + wid * 1024, vdst = lds0 + L::LDS_V + wid * 1024;
#define AT_KT(i) (MOBA ? ((i) < 4 ? 4 * qb + (i) : (i) - 4 + kt_min) : (i) + kt_min)
#define AT_DMA(i, ksl, vsl) do { if ((i) >= NT) break; const long kt_ = AT_KT(i); glds16(ksrc + kt_ * KVBLK * DM, (unsigned)__builtin_amdgcn_readfirstlane(kdst + (ksl) * KSLOT)); \
        glds16(vsrc0 + kt_ * KVBLK * DM, (unsigned)__builtin_amdgcn_readfirstlane(vdst + (vsl) * L::VSLOT)); \
        if (NPV == 2) glds16(vsrc0 + kt_ * KVBLK * DM + 64, (unsigned)__builtin_amdgcn_readfirstlane(vdst + (vsl) * L::VSLOT + 8192)); } while (0)
#define AT_VRD(g_, d_) do { _Pragma("unroll") for (int ks = 0; ks < 4; ++ks) { vl[g_][ks] = vtr(vp + (d_) * 4096 + ks * 1024); vh[g_][ks] = vtr(vp + (d_) * 4096 + ks * 1024 + 512); } } while (0)
    bf16x8 qr[4];
#pragma unroll
    for (int d0 = 0; d0 < 4; ++d0) qr[d0] = *reinterpret_cast<const bf16x8*>(&Qw[(long)r32 * DM + d0 * 16 + hi * 8]);
    { _Pragma("unroll") for (int a = 0; a < AH; ++a) AT_DMA(a, a, a); }
    const lds_cptr kp0 = (lds_cptr)shm3 + L::LDS_K + hi * 1024 + r32 * 16;
    const lds_cptr vp0 = (lds_cptr)shm3 + L::LDS_V + ((lane >> 4) & 1) * 32 + (lane & 3) * 8 + (4 * hi + ((lane & 15) >> 2)) * 64;
    const unsigned sw = (unsigned)__builtin_amdgcn_readfirstlane((int)(f2bf_u(slope2) | (f2bf_u(slope2 - bf2f_u(f2bf_u(slope2))) << 16)));
    const unsigned hmask = hi == 0 ? 0xffffffffu : 0u;
    const unsigned off0w = (f2bf_u((float)r32) * 0x10001u) & hmask, off1w = (f2bf_u((float)(32 + r32)) * 0x10001u) & hmask;
    unsigned qz = 0u;
    if (FIXED) { const float mrow = mfix + slope2 * (float)(wid * 32 + r32);
                 const unsigned nh = f2bf_u(-mrow), nl = f2bf_u(-mrow - bf2f_u(nh)); qz = (nh | (nl << 16)) & hmask; }
    float mhat = 0.f;
    constexpr bool KPRE = (DV == 64);
    constexpr bool MSUM = (DV == 64);
    float l_reg = 0.f;
    lsum = f32x16{};
    const u32x4 ones4 = {0x3f803f80u, 0x3f803f80u, 0x3f803f80u, 0x3f803f80u};
#pragma unroll
    for (int d = 0; d < DV / 32; ++d) o[d] = f32x16{};
    const int qrel = wid * 32 + r32;
    int slot = 0, vslot = 0;
    constexpr int ND = DV / 32, NMF = 4 * ND, NEXP = 32 / NMF, NVS = AH + 3, PFD = (DV == 64 ? 8 : 6);
    u32x4 pwA[4] = {{0u, 0u, 0u, 0u}, {0u, 0u, 0u, 0u}, {0u, 0u, 0u, 0u}, {0u, 0u, 0u, 0u}}, pwB[4];
    u32x4 a0 = {off0w, 0u, 0x3f803f80u & hmask, 0u}, a1 = {off1w, 0u, 0x3f803f80u & hmask, 0u}, qv = {sw & hmask, sw & hmask, qz, 0u};
    const bool late = !KPRE && wid >= 4;
#define AT_PIN(x) asm volatile("" : "+v"(x))
#define AT_CE(e) ((e) < 16 ? c0[(e) & 15] : c1[(e) & 15])
#define AT_VOFF(g) (((g) >> 2) * 4096 + ((g) & 3) * 1024)
    f32x16 c0, c1; bool resc = false;
    bf16x8 kf[8];
#define AT_KRD(j_, SL_) do { const lds_cptr kp_ = kp0 + (SL_) * KSLOT; kf[2 * (j_)] = *(const __attribute__((address_space(3))) bf16x8*)(kp_ + (j_) * 2048); kf[2 * (j_) + 1] = *(const __attribute__((address_space(3))) bf16x8*)(kp_ + (j_) * 2048 + 512); } while (0)
#if AT_PROBE
    const bool prb = (blockIdx.x == 0) && (wid == AT_PROBE_WAVE) && (DV == AT_PROBE_DV) && FIXED; unsigned long long pt0 = 0, pacc[6] = {0, 0, 0, 0, 0, 0}, ps0 = 0, ps1 = 0;
#define AT_STAMP(x) do { AT_SBAR(); asm volatile("s_memtime %0\n\ts_waitcnt lgkmcnt(0)" : "=s"(x) :: "memory"); AT_SBAR(); } while (0)
#define AT_SEC(k) do { AT_STAMP(ps1); pacc[k] += ps1 - ps0; ps0 = ps1; } while (0)
    AT_STAMP(pt0); ps0 = pt0;
#else
#define AT_STAMP(x) do { } while (0)
#define AT_SEC(k) do { } while (0)
#endif
#define AT_PHA(T_) do { \
        if (!KPRE) { \
            _Pragma("unroll") for (int j = 0; j < 4; ++j) AT_KRD(j, slot); \
            AT_SBAR(); \
            { const int s2 = slot == 0 ? AH : slot - 1; int v2 = vslot + AH; v2 = v2 >= NVS ? v2 - NVS : v2; AT_DMA((T_) + AH, s2, v2); } } \
        AT_SEC(0); \
        const int kt = AT_KT(T_); \
        const int jb = MOBA ? ((T_) < 4 ? (T_) : -1) : ((T_) - (NT - 4)); \
        { const unsigned tb = __float_as_uint((float)(64 * (kt - 4 * qb))) >> 16; \
          if (DV == 128) { a0 = (u32x4){off0w, 0u, 0x3f803f80u & hmask, 0u}; a1 = (u32x4){off1w, 0u, 0x3f803f80u & hmask, 0u}; qv = (u32x4){sw & hmask, sw & hmask, qz, 0u}; }     \
          a0.y = (tb * 0x10001u) & hmask; a1.y = a0.y; \
          qv.z = qz; \
          if (MOBA) { if (hi == 0 && (T_) >= 4 && !((sel >> (kt >> 2)) & 1u)) qv.z = 0x0000f14au; } \
          c0 = AT_MFMA(__builtin_bit_cast(bf16x8, a0), __builtin_bit_cast(bf16x8, qv), f32x16{}); c1 = AT_MFMA(__builtin_bit_cast(bf16x8, a1), __builtin_bit_cast(bf16x8, qv), f32x16{}); \
          _Pragma("unroll") for (int j = 0; j < 4; ++j) { c0 = AT_MFMA(kf[2 * j], qr[j], c0); c1 = AT_MFMA(kf[2 * j + 1], qr[j], c1); } } \
        if (jb >= 0) { asm volatile("" ::: "memory"); cmask(c0, c1, jb, qrel, hi); } \
        AT_PIN(c0); AT_PIN(c1); AT_SEC(1); \
        resc = false; \
        if (!FIXED) { const float rm = rowmax(c0, c1); const bool first = ((T_) == 0); \
          if (first || __any(rm > THR)) { \
              const float dl = first ? rm : __builtin_fmaxf(rm, 0.f); const float mnew = mhat + dl; \
              const unsigned nh = f2bf_u(-mnew), nl = f2bf_u(-mnew - bf2f_u(nh)); const float meff = -(bf2f_u(nh) + bf2f_u(nl)); \
              const float dle = meff - mhat; mhat = meff; qz = (nh | (nl << 16)) & hmask; \
              _Pragma("unroll") for (int r = 0; r < 16; ++r) { c0[r] -= dle; c1[r] -= dle; } \
              if (!first) { const float f = __builtin_amdgcn_exp2f(-dle); if (!MSUM) l_reg *= f; if (hi == 0) wsf[r32] = f; resc = true; } } } \
    } while (0)
#define AT_PHB(VS_, PIN_, POUT_, TN_) do { \
        float sacc = 0.f; \
        const lds_cptr vp = vp0 + (VS_) * L::VSLOT; \
        s16x4 vl[NMF], vh[NMF]; \
        _Pragma("unroll") for (int g = 0; g < PFD; ++g) { vl[g] = vtr(vp + AT_VOFF(g)); vh[g] = vtr(vp + AT_VOFF(g) + 512); } \
        AT_SBAR(); \
        _Pragma("unroll") for (int g = 0; g < NMF; ++g) { \
            if (g + PFD < NMF) { vl[g + PFD] = vtr(vp + AT_VOFF(g + PFD)); vh[g + PFD] = vtr(vp + AT_VOFF(g + PFD) + 512); } \
            { const bf16x8 vf = (bf16x8){vl[g][0], vl[g][1], vl[g][2], vl[g][3], vh[g][0], vh[g][1], vh[g][2], vh[g][3]}; \
              o[g >> 2] = AT_MFMA(__builtin_bit_cast(bf16x8, PIN_[g & 3]), vf, o[g >> 2]); } \
            if (KPRE && g < 4) AT_KRD(g, (slot == AH ? 0 : slot + 1));                                     \
            if (KPRE && g == 5) { const int s2 = slot == 0 ? AH : slot - 1; int v2 = vslot + AH; v2 = v2 >= NVS ? v2 - NVS : v2; AT_DMA(TN_, s2, v2); } \
            if (MSUM && (g & (ND - 1)) == ND - 1 && (g / ND) < 4) lsum = AT_MFMA(__builtin_bit_cast(bf16x8, PIN_[g / ND]), __builtin_bit_cast(bf16x8, ones4), lsum); \
            _Pragma("unroll") for (int x = 0; x < NEXP; x += 2) { const int e = g * NEXP + x; \
                const float p0 = __builtin_amdgcn_exp2f(AT_CE(e)), p1 = __builtin_amdgcn_exp2f(AT_CE(e + 1)); \
                if (!MSUM) { sacc += p0; sacc += p1; } POUT_[e >> 3][(e & 7) >> 1] = cvtpk_s(p0, p1); } \
            if (!MSUM) AT_PIN(sacc); AT_PIN(POUT_[(g * NEXP) >> 3]); \
            AT_SBAR(); } \
        if (resc) { \
            asm volatile("s_waitcnt lgkmcnt(0)" ::: "memory"); \
            _Pragma("unroll") for (int r = 0; r < 16; ++r) { const float f_ = wsf[crow(r, hi)]; if (MSUM) lsum[r] *= f_; _Pragma("unroll") for (int d = 0; d < ND; ++d) o[d][r] *= f_; } } \
        if (!MSUM) l_reg += sacc; \
        AT_PIN(POUT_[3]); AT_SEC(2); \
    } while (0)
#define AT_STEP_END(T_) do { { int na = NT - (KPRE ? 3 : 2) - (T_); na = na < 0 ? 0 : (na > AH - (KPRE ? 2 : 1) ? AH - (KPRE ? 2 : 1) : na); wait_bar_n(na * NPT); }     \
        slot = slot == AH ? 0 : slot + 1; vslot = vslot == NVS - 1 ? 0 : vslot + 1; AT_SEC(3); } while (0)
    wait_bar_n(((NT < AH ? NT : AH) - (KPRE ? 2 : 1)) * NPT);
    asm volatile("s_waitcnt vmcnt(0)" ::: "memory");
    asm volatile("" : "+v"(qr[0]), "+v"(qr[1]), "+v"(qr[2]), "+v"(qr[3]));
    if (KPRE) { _Pragma("unroll") for (int j = 0; j < 4; ++j) AT_KRD(j, 0); }
    int vlast; bool inA;
#define AT_VPREV1 (vslot == 0 ? NVS - 1 : vslot - 1)
#define AT_VPREV2 (vslot < 2 ? vslot + NVS - 2 : vslot - 2)
    if (!late) {
        int i = 0;
        for (; i + 1 < NT; i += 2) {
            AT_PHA(i);     AT_PHB(i == 0 ? 0 : AT_VPREV1, pwA, pwB, i + AH); AT_STEP_END(i);
            AT_PHA(i + 1); AT_PHB(AT_VPREV1, pwB, pwA, i + 1 + AH);      AT_STEP_END(i + 1);
        }
        inA = true;
        if (i < NT) { AT_PHA(i); AT_PHB(AT_VPREV1, pwA, pwB, i + AH); AT_STEP_END(i); inA = false; }
        vlast = AT_VPREV1;
    } else {
        AT_PHA(0); AT_STEP_END(0);
        int i = 1;
        for (; i + 1 < NT; i += 2) {
            AT_PHB(i == 1 ? 0 : AT_VPREV2, pwA, pwB, 0); AT_PHA(i);     AT_STEP_END(i);
            AT_PHB(AT_VPREV2, pwB, pwA, 0);              AT_PHA(i + 1); AT_STEP_END(i + 1);
        }
        inA = true;
        if (i < NT) { AT_PHB(i == 1 ? 0 : AT_VPREV2, pwA, pwB, 0); AT_PHA(i); AT_STEP_END(i); inA = false; }
        if (inA) { AT_PHB(AT_VPREV2, pwA, pwB, 0); inA = false; } else { AT_PHB(AT_VPREV2, pwB, pwA, 0); inA = true; }
        vlast = AT_VPREV1;
    }
#if AT_PROBE
    if (prb && lane == 0) { g_probe[0] += ps0 - pt0; g_probe[1] += pacc[0]; g_probe[2] += pacc[1]; g_probe[3] += pacc[2]; g_probe[4] += pacc[3]; g_probe[5] += (unsigned long long)NT; }
#endif
    if (!inA) {
#pragma unroll
        for (int k = 0; k < 4; ++k) pwA[k] = pwB[k];
    }
    { const lds_cptr vp = vp0 + vlast * L::VSLOT; s16x4 vl[2][4], vh[2][4];
      AT_VRD(0, 0); AT_SBAR();
#pragma unroll
      for (int d = 0; d < ND; ++d) {
          if (d + 1 < ND) AT_VRD((d + 1) & 1, d + 1);
          AT_SBAR();
#pragma unroll
          for (int ks = 0; ks < 4; ++ks) { const bf16x8 vf = (bf16x8){vl[d & 1][ks][0], vl[d & 1][ks][1], vl[d & 1][ks][2], vl[d & 1][ks][3], vh[d & 1][ks][0], vh[d & 1][ks][1], vh[d & 1][ks][2], vh[d & 1][ks][3]};
              o[d] = AT_MFMA(__builtin_bit_cast(bf16x8, pwA[ks]), vf, o[d]); }
          AT_SBAR(); }
      if (MSUM) {
#pragma unroll
          for (int ks = 0; ks < 4; ++ks) lsum = AT_MFMA(__builtin_bit_cast(bf16x8, pwA[ks]), __builtin_bit_cast(bf16x8, ones4), lsum); } }
    if (!MSUM) {
        auto rr = __builtin_amdgcn_permlane32_swap(__float_as_uint(l_reg), __float_as_uint(l_reg), false, false); const float lt = __uint_as_float(rr[0]) + __uint_as_float(rr[1]);
        if (hi == 0) wsf[32 + r32] = lt;
        asm volatile("s_waitcnt lgkmcnt(0)" ::: "memory");
#pragma unroll
        for (int r = 0; r < 16; ++r) lsum[r] = wsf[32 + crow(r, hi)];
    }
    AT_WAIT_BAR(0);
#undef AT_PIN
#undef AT_CE
#undef AT_VOFF
#undef AT_PHA
#undef AT_PHB
#undef AT_STEP_END
#undef AT_KRD
#undef AT_STAMP
#undef AT_SEC
#undef AT_VPREV1
#undef AT_VPREV2
#undef AT_KT
#undef AT_DMA
#undef AT_VRD
}

__device__ __forceinline__ int window_kt_min(const unsigned* nrm, int b, int chunk, int q0, float slope2, float& Bout) {
    const float nq = __uint_as_float(nrm[((0 * 2 + b) * 16 + chunk) * 2]) + __uint_as_float(nrm[((0 * 2 + b) * 16 + chunk) * 2 + 1]);
    const float nk = __uint_as_float(nrm[((1 * 2 + b) * 16 + chunk) * 2]) + __uint_as_float(nrm[((1 * 2 + b) * 16 + chunk) * 2 + 1]);
    const float B = sqrtf(nq * nk) * 1.01f; Bout = B;
    const float W = (2.0f * B + 160.0f) / slope2;
    const int wkeys = W < 1.0e6f ? (int)W : 1000000;
    const int d = q0 - wkeys;
    return d > 0 ? (d >> 6) : 0;
}
__device__ __forceinline__ void diff_item(char* shm, int b, int h, int qb, int m, const bf16* Q, const bf16* K, const bf16* V, bf16* O, float lam, const unsigned* nrm, unsigned* flag, unsigned* tmo) {
    typedef Lay<128, 2> L;
    int tid_ = threadIdx.x; asm volatile("" : "+v"(tid_));
    const int tid = tid_; const int wid = __builtin_amdgcn_readfirstlane(tid >> 6);
    const long rowbase = (long)b * SEQ; const int q0 = qb * 256;
    const float slope2 = __builtin_amdgcn_exp2f(-(float)(h + 1)) * 1.4426950408889634f;
    lam = __uint_as_float((unsigned)__builtin_amdgcn_readfirstlane((int)__float_as_uint(lam)));
    const lds_ptr shm3 = (lds_ptr)shm;
    __attribute__((address_space(3))) float* wsf = (__attribute__((address_space(3))) float*)(shm3 + L::LDS_WS) + wid * 64;
    __attribute__((address_space(3))) bf16* stg = (__attribute__((address_space(3))) bf16*)(shm3 + L::LDS_OST + wid * L::OSTW);
    f32x16 o[4], lsum;
    float Bq; const int kt_min = __builtin_amdgcn_readfirstlane(window_kt_min(nrm, b, 2 * h + m, q0, slope2, Bq));
    Bq = __uint_as_float((unsigned)__builtin_amdgcn_readfirstlane((int)__float_as_uint(Bq)));
    if (Bq <= 40.0f) sweep<128, false, 2, true>(shm, Q + (rowbase + q0 + wid * 32) * DM + h * 128 + m * 64, K + rowbase * DM + h * 128 + m * 64, V + rowbase * DM + h * 128, qb, kt_min, slope2, Bq, 0u, o, lsum);
    else sweep<128, false, 2, false>(shm, Q + (rowbase + q0 + wid * 32) * DM + h * 128 + m * 64, K + rowbase * DM + h * 128 + m * 64, V + rowbase * DM + h * 128, qb, kt_min, slope2, Bq, 0u, o, lsum);
    int lane_e = tid & 63; asm volatile("" : "+v"(lane_e));
    const int lane = lane_e, r32 = lane & 31, hi = lane >> 5;
    bf16* Ow = O + (rowbase + q0 + wid * 32) * DM + h * 128;
    float rli[16];
#pragma unroll
    for (int r = 0; r < 16; ++r) rli[r] = (m == 0 ? 1.0f : lam) * __builtin_amdgcn_rcpf(lsum[r]);
    if (m == 0) {
#pragma unroll
        for (int r = 0; r < 16; ++r)
#pragma unroll
            for (int d = 0; d < 4; ++d) stg[crow(r, hi) * 128 + d * 32 + r32] = (bf16)f2bf_u(o[d][r] * rli[r]);
        asm volatile("s_waitcnt lgkmcnt(0)" ::: "memory");
#pragma unroll
        for (int i = 0; i < 8; ++i) { const int row = i * 4 + (lane >> 4), ch = lane & 15; const u32x4 v = *(const __attribute__((address_space(3))) u32x4*)(stg + row * 128 + ch * 8); *(u32x4*)(Ow + (long)row * DM + ch * 8) = v; }
        asm volatile("s_waitcnt vmcnt(0)" ::: "memory");
        __syncthreads();
        if (tid == 0) { __builtin_amdgcn_fence(__ATOMIC_RELEASE, "agent"); asm volatile("s_waitcnt vmcnt(0)" ::: "memory"); __hip_atomic_store(flag, 1u, __ATOMIC_RELAXED, __HIP_MEMORY_SCOPE_AGENT); }
    } else {
        if (tid == 0) {
            unsigned sp = 0u;
            while (__hip_atomic_load(flag, __ATOMIC_RELAXED, __HIP_MEMORY_SCOPE_AGENT) == 0u) { __builtin_amdgcn_s_sleep(8); if (++sp > (1u << 22)) { __hip_atomic_store(tmo, 1u, __ATOMIC_RELAXED, __HIP_MEMORY_SCOPE_AGENT); break; } }
            __builtin_amdgcn_fence(__ATOMIC_ACQUIRE, "agent");
            asm volatile("s_waitcnt vmcnt(0)" ::: "memory");
        }
        __syncthreads();
#pragma unroll
        for (int i = 0; i < 8; ++i) { const int row = i * 4 + (lane >> 4), ch = lane & 15; const u32x4 v = *(const u32x4*)(Ow + (long)row * DM + ch * 8); *(__attribute__((address_space(3))) u32x4*)(stg + row * 128 + ch * 8) = v; }
        asm volatile("s_waitcnt vmcnt(0) lgkmcnt(0)" ::: "memory");
        float ss[16];
#pragma unroll
        for (int r = 0; r < 16; ++r) { float sq = 0.f;
#pragma unroll
            for (int d = 0; d < 4; ++d) { const float v = bf2f_u(stg[crow(r, hi) * 128 + d * 32 + r32]) - o[d][r] * rli[r]; o[d][r] = v; sq = __builtin_fmaf(v, v, sq); }
            ss[r] = sq; }
#pragma unroll
        for (int r = 0; r < 16; ++r) {
#pragma unroll
            for (int off = 1; off < 32; off <<= 1) ss[r] += __shfl_xor(ss[r], off);
            ss[r] = 1.0f / sqrtf(ss[r] * (1.0f / 128.0f) + 1e-6f); }
#pragma unroll
        for (int r = 0; r < 16; ++r)
#pragma unroll
            for (int d = 0; d < 4; ++d) stg[crow(r, hi) * 128 + d * 32 + r32] = (bf16)f2bf_u(o[d][r] * ss[r]);
        asm volatile("s_waitcnt lgkmcnt(0)" ::: "memory");
#pragma unroll
        for (int i = 0; i < 8; ++i) { const int row = i * 4 + (lane >> 4), ch = lane & 15; const u32x4 v = *(const __attribute__((address_space(3))) u32x4*)(stg + row * 128 + ch * 8); *(u32x4*)(Ow + (long)row * DM + ch * 8) = v; }
    }
}
__device__ __forceinline__ void moba_unit(char* shm, int b, int h, int qb, const bf16* Q, const bf16* K, const bf16* V, bf16* O, const float* KM, const unsigned* nrm) {
    typedef Lay<64, 4> L;
    int tid_ = threadIdx.x; asm volatile("" : "+v"(tid_));
    const int tid = tid_, lane = tid & 63, r32 = lane & 31, hi = lane >> 5; const int wid = __builtin_amdgcn_readfirstlane(tid >> 6);
    const long rowbase = (long)b * SEQ; const int q0 = qb * 256;
    const float slope2 = __builtin_amdgcn_exp2f(-0.5f * (float)(h + 1)) * 1.4426950408889634f;
    const lds_ptr shm3 = (lds_ptr)shm;
    __attribute__((address_space(3))) float* wsf = (__attribute__((address_space(3))) float*)(shm3 + L::LDS_WS) + wid * 64;
    __attribute__((address_space(3))) bf16* stg = (__attribute__((address_space(3))) bf16*)(shm3 + L::LDS_OST + wid * L::OSTW);
    const bf16* Qw = Q + (rowbase + q0 + wid * 32) * DM + h * 64;
    unsigned sel = 0u;
    if (qb > 0) {
        f32x16 g = f32x16{};
        const float* km = KM + (((long)b * 16 + h) * 32 + r32) * 64 + hi * 8;
#pragma unroll
        for (int d0 = 0; d0 < 4; ++d0) {
            const bf16x8 qf = *reinterpret_cast<const bf16x8*>(&Qw[(long)r32 * DM + d0 * 16 + hi * 8]);
            const float4 x0 = *(const float4*)(km + d0 * 16), x1 = *(const float4*)(km + d0 * 16 + 4);
            const float xs[8] = {x0.x, x0.y, x0.z, x0.w, x1.x, x1.y, x1.z, x1.w};
            unsigned hw[8], lw[8];
#pragma unroll
            for (int e = 0; e < 8; ++e) { hw[e] = f2bf_u(xs[e]); lw[e] = f2bf_u(xs[e] - bf2f_u(hw[e])); }
            const u32x4 ah = {hw[0] | (hw[1] << 16), hw[2] | (hw[3] << 16), hw[4] | (hw[5] << 16), hw[6] | (hw[7] << 16)};
            const u32x4 al = {lw[0] | (lw[1] << 16), lw[2] | (lw[3] << 16), lw[4] | (lw[5] << 16), lw[6] | (lw[7] << 16)};
            g = AT_MFMA(__builtin_bit_cast(bf16x8, ah), qf, g); g = AT_MFMA(__builtin_bit_cast(bf16x8, al), qf, g);
        }
        float g0[16], g1[16];
#pragma unroll
        for (int r = 0; r < 16; ++r) { auto rr = __builtin_amdgcn_permlane32_swap(__float_as_uint(g[r]), __float_as_uint(g[r]), false, false); g0[r] = __uint_as_float(rr[0]); g1[r] = __uint_as_float(rr[1]); }
        float b0 = -INFINITY, b1 = -INFINITY, b2 = -INFINITY; int i0 = 0, i1 = 0, i2 = 0;
#pragma unroll
        for (int n = 0; n < 32; ++n) {
            const int rn = 4 * (n >> 3) + (n & 3);
            float v = ((n >> 2) & 1) ? g1[rn] : g0[rn];
            if (n >= qb) v = -INFINITY;
            if (v > b0) { b2 = b1; i2 = i1; b1 = b0; i1 = i0; b0 = v; i0 = n; }
            else if (v > b1) { b2 = b1; i2 = i1; b1 = v; i1 = n; }
            else if (v > b2) { b2 = v; i2 = n; }
        }
        if (b0 > -INFINITY) sel |= 1u << i0;
        if (b1 > -INFINITY) sel |= 1u << i1;
        if (b2 > -INFINITY) sel |= 1u << i2;
    }
    f32x16 o[2], lsum;
    float Bq; const int kt_min = __builtin_amdgcn_readfirstlane(window_kt_min(nrm, b, h, q0, slope2, Bq));
    Bq = __uint_as_float((unsigned)__builtin_amdgcn_readfirstlane((int)__float_as_uint(Bq)));
    if (Bq <= 40.0f) sweep<64, true, 4, true>(shm, Qw, K + rowbase * DM + h * 64, V + rowbase * DM + h * 64, qb, kt_min, slope2, Bq, sel, o, lsum);
    else sweep<64, true, 4, false>(shm, Qw, K + rowbase * DM + h * 64, V + rowbase * DM + h * 64, qb, kt_min, slope2, Bq, sel, o, lsum);
    int lane_e = lane; asm volatile("" : "+v"(lane_e));
    { const int lane = lane_e, r32 = lane & 31, hi = lane >> 5;
#pragma unroll
    for (int r = 0; r < 16; ++r) { const float rl = __builtin_amdgcn_rcpf(lsum[r]);
#pragma unroll
        for (int d = 0; d < 2; ++d) stg[crow(r, hi) * 64 + d * 32 + r32] = (bf16)f2bf_u(o[d][r] * rl); }
    asm volatile("s_waitcnt lgkmcnt(0)" ::: "memory");
    bf16* Ow = O + (rowbase + q0 + wid * 32) * DM + h * 64;
#pragma unroll
    for (int i = 0; i < 4; ++i) { const int row = i * 8 + (lane >> 3), ch = lane & 7; const u32x4 v = *(const __attribute__((address_space(3))) u32x4*)(stg + row * 64 + ch * 8); *(u32x4*)(Ow + (long)row * DM + ch * 8) = v; }
    }
}
#undef AT_SBAR
#undef AT_WAIT_BAR
#undef AT_MX3
#undef AT_MFMA
}

constexpr int NWAVES = 8;
constexpr int RING_OFF = 0, RING_BYTES = 131072;
constexpr int LDSCTL_OFF = RING_BYTES, MISC_OFF = LDSCTL_OFF + 320;
constexpr int LDS_BYTES = RING_BYTES + 1024;
static_assert(attn::Lay<128, 2>::BYTES <= RING_BYTES && attn::Lay<64, 4>::BYTES <= RING_BYTES && LDS_BYTES <= 163840, "LDS budget");
static_assert(MISC_OFF + 128 <= LDS_BYTES, "LDS map");

struct Frame {
    LAS unsigned char* lds; volatile LAS unsigned* MISC; gu32* ctl;
    int tid, lane, wave, vcu, G;
};
__device__ __forceinline__ float wave_sum(float v) {
#pragma unroll
    for (int o = 1; o < 64; o <<= 1) v += __shfl_xor(v, o);
    return v;
}
__device__ __forceinline__ float bf2f(unsigned h) { return __builtin_bit_cast(float, h << 16); }

__device__ __forceinline__ void p0_transpose_item(const float* W, int K, int N, bf16* WT, LAS float* scr, int item, int lane, const float* gk, int gmask, float cmul, int qcols, float qscale) {
    const int nblk = N / 32, kb = item / nblk, nb = item % nblk, k0 = 64 * kb, n0 = 32 * nb;
    const float cs = cmul * ((n0 < qcols) ? qscale : 1.0f);
#pragma unroll 8
    for (int i = 0; i < 32; ++i) { const int kk = 2 * i + (lane >> 5); const float g = gk ? gk[(k0 + kk) & gmask] : 1.0f; scr[kk * 33 + (lane & 31)] = W[(size_t)(k0 + kk) * N + n0 + (lane & 31)] * (g * cs); }
    LDS_WAIT(); asm volatile("" ::: "memory");
    const int c = lane & 7;
#pragma unroll
    for (int j = 0; j < 4; ++j) { const int n = (lane >> 3) + 8 * j; const LAS float* s = scr + (8 * c) * 33 + n;
        v4u o; o.x = pk2(s[0 * 33], s[1 * 33]); o.y = pk2(s[2 * 33], s[3 * 33]); o.z = pk2(s[4 * 33], s[5 * 33]); o.w = pk2(s[6 * 33], s[7 * 33]);
        *(GAS v4u*)(WT + (size_t)(n0 + n) * K + k0 + 8 * c) = o; }
    LDS_WAIT(); asm volatile("" ::: "memory");
}
__device__ __forceinline__ void p0_x_row2(const float* xrow, bf16* hrow, float* ssq, int lane) {
    f32x4 v[2][4];
#pragma unroll
    for (int r = 0; r < 2; ++r)
#pragma unroll
        for (int j = 0; j < 4; ++j) v[r][j] = ((const GAS f32x4*)(xrow + (size_t)r * D) + lane)[64 * j];
#pragma unroll
    for (int r = 0; r < 2; ++r) { GAS unsigned long long* h8 = (GAS unsigned long long*)(hrow + (size_t)r * D) + lane; float s[4];
#pragma unroll
        for (int j = 0; j < 4; ++j) { h8[64 * j] = (unsigned long long)pk2(v[r][j].x, v[r][j].y) | ((unsigned long long)pk2(v[r][j].z, v[r][j].w) << 32);
            s[j] = wave_sum((v[r][j].x * v[r][j].x + v[r][j].y * v[r][j].y) + (v[r][j].z * v[r][j].z + v[r][j].w * v[r][j].w)); }
        if (lane < 16) { const int j = lane >> 2; const float sj = j == 0 ? s[0] : j == 1 ? s[1] : j == 2 ? s[2] : s[3]; ssq[r * 16 + lane] = (lane & 3) == 0 ? sj : 0.f; } }
}
__device__ __forceinline__ void final_row(float* orow, const float* ssq, const float* g, int lane) {
    const float rs = pg8::row_rstd16(ssq, 0);
    GAS f32x4* orr = (GAS f32x4*)orow + lane; const GAS f32x4* gr = (const GAS f32x4*)g + lane;
#pragma unroll
    for (int j = 0; j < 4; ++j) { f32x4 v = orr[64 * j]; const f32x4 gv = gr[64 * j]; v = v * rs * gv; orr[64 * j] = v; }
}

__device__ __forceinline__ void diff_attn_unit_simple(LAS unsigned char* lds, int b, int h, int qblk, const bf16* Q, const bf16* K, const bf16* V, bf16* O, float lam, int tid) {
    LAS float* Ks = (LAS float*)lds; LAS float* Vs = (LAS float*)(lds + 64 * 65 * 4);
    const int qi = tid >> 2, part = tid & 3, q0 = qblk * 128, t = q0 + qi;
    const size_t rowbase = (size_t)b * T;
    const float slope2 = exp2f(-(float)(h + 1)) * LOG2E;
    float ores[32], o0[32], l0 = 0.f;
#pragma unroll 1
    for (int m = 0; m < 2; ++m) {
        float q[16];
        { const bf16* qp = Q + (rowbase + t) * D + h * 128 + m * 64 + part * 16;
#pragma unroll
          for (int i = 0; i < 16; ++i) q[i] = bf2f(qp[i]); }
        float mrun = NEG_BIG, l = 0.f, o[32];
#pragma unroll
        for (int e = 0; e < 32; ++e) o[e] = 0.f;
        const int nkt = q0 / 64 + 2;
        for (int kt = 0; kt < nkt; ++kt) {
            const int kb = kt * 64;
            __syncthreads();
            { const int key = tid >> 3, seg = tid & 7;
              const bf16* kp = K + (rowbase + kb + key) * D + h * 128 + m * 64 + seg * 8;
#pragma unroll
              for (int i = 0; i < 8; ++i) Ks[key * 65 + seg * 8 + i] = bf2f(kp[i]);
              const bf16* vp = V + (rowbase + kb + key) * D + h * 128 + seg * 16;
#pragma unroll
              for (int i = 0; i < 16; ++i) Vs[key * 129 + seg * 16 + i] = bf2f(vp[i]); }
            __syncthreads();
            for (int key = 0; key < 64; ++key) {
                float s = 0.f;
#pragma unroll
                for (int i = 0; i < 16; ++i) s = fmaf(q[i], Ks[key * 65 + part * 16 + i], s);
                s += __shfl_xor(s, 1); s += __shfl_xor(s, 2);
                const int kpos = kb + key;
                s += slope2 * (float)(kpos - t);
                if (kpos > t) s = -INFINITY;
                const float mn = fmaxf(mrun, s);
                const float alpha = exp2f(mrun - mn), p = exp2f(s - mn);
                mrun = mn; l = l * alpha + p;
#pragma unroll
                for (int e = 0; e < 32; ++e) o[e] = fmaf(p, Vs[key * 129 + part * 32 + e], o[e] * alpha);
            }
        }
        if (m == 0) {
#pragma unroll
            for (int e = 0; e < 32; ++e) o0[e] = o[e];
            l0 = l;
        } else {
            const float i0 = 1.0f / l0, i1 = lam / l;
#pragma unroll
            for (int e = 0; e < 32; ++e) ores[e] = o0[e] * i0 - o[e] * i1;
        }
    }
    float ss = 0.f;
#pragma unroll
    for (int e = 0; e < 32; ++e) ss = fmaf(ores[e], ores[e], ss);
    ss += __shfl_xor(ss, 1); ss += __shfl_xor(ss, 2);
    const float rs = 1.0f / sqrtf(ss * (1.0f / 128.0f) + RMS_EPS);
    bf16* op = O + (rowbase + t) * D + h * 128 + part * 32;
#pragma unroll
    for (int e = 0; e < 32; e += 2) *(unsigned*)(op + e) = pk2(ores[e] * rs, ores[e + 1] * rs);
    __syncthreads();
}
__device__ __forceinline__ void moba_unit_simple(int b, int h, int qblk, const bf16* Q, const bf16* K, const bf16* V, bf16* O, const float* KM, int tid) {
    const int qi = tid >> 2, part = tid & 3, q0 = qblk * 128, t = q0 + qi, j = q0 / 256;
    const size_t rowbase = (size_t)b * T;
    const float slope2 = exp2f(-0.5f * (float)(h + 1)) * LOG2E;
    float q[16];
    { const bf16* qp = Q + (rowbase + t) * D + h * 64 + part * 16;
#pragma unroll
      for (int i = 0; i < 16; ++i) q[i] = bf2f(qp[i]); }
    float b0 = -INFINITY, b1 = -INFINITY, b2 = -INFINITY; int i0 = 0, i1 = 0, i2 = 0;
    for (int n = 0; n < j; ++n) {
        const float* km = KM + (((size_t)b * 16 + h) * 32 + n) * 64 + part * 16;
        float g = 0.f;
#pragma unroll
        for (int i = 0; i < 16; ++i) g = fmaf(q[i], km[i], g);
        g += __shfl_xor(g, 1); g += __shfl_xor(g, 2);
        if (g > b0) { b2 = b1; i2 = i1; b1 = b0; i1 = i0; b0 = g; i0 = n; }
        else if (g > b1) { b2 = b1; i2 = i1; b1 = g; i1 = n; }
        else if (g > b2) { b2 = g; i2 = n; }
    }
    const int nsel = j < 3 ? j : 3;
    float mrun = NEG_BIG, l = 0.f, o[16];
#pragma unroll
    for (int e = 0; e < 16; ++e) o[e] = 0.f;
    for (int seg = 0; seg <= nsel; ++seg) {
        const int blk = seg == 0 ? j : (seg == 1 ? i0 : (seg == 2 ? i1 : i2));
        const int kb = blk * 256;
        for (int key = 0; key < 256; ++key) {
            const int kpos = kb + key;
            const bf16* kp = K + (rowbase + kpos) * D + h * 64 + part * 16;
            float s = 0.f;
#pragma unroll
            for (int i = 0; i < 16; ++i) s = fmaf(q[i], bf2f(kp[i]), s);
            s += __shfl_xor(s, 1); s += __shfl_xor(s, 2);
            s += slope2 * (float)(kpos - t);
            if (kpos > t) s = -INFINITY;
            const float mn = fmaxf(mrun, s);
            const float alpha = exp2f(mrun - mn), p = exp2f(s - mn);
            mrun = mn; l = l * alpha + p;
            const bf16* vp = V + (rowbase + kpos) * D + h * 64 + part * 16;
#pragma unroll
            for (int e = 0; e < 16; ++e) o[e] = fmaf(p, bf2f(vp[e]), o[e] * alpha);
        }
    }
    const float il = 1.0f / l;
    bf16* op = O + (rowbase + t) * D + h * 64 + part * 16;
#pragma unroll
    for (int e = 0; e < 16; e += 2) *(unsigned*)(op + e) = pk2(o[e] * il, o[e + 1] * il);
}

#define REP_QKV 1
#define REP_DIFF 1
#define REP_MOBA 1
#define REP_FF1 1
#define REP_PRO 1
#define REP_BAR 1
struct Args { const float* in[10]; float* out; unsigned char* ws; };
__global__ void __launch_bounds__(NWAVES * 64, 2) fwd_kernel(Args args) {
    extern __shared__ __attribute__((aligned(16))) unsigned char lds[];
    Frame F;
    F.lds = (LAS unsigned char*)lds;
    F.MISC = (volatile LAS unsigned*)(F.lds + MISC_OFF);
    F.tid = threadIdx.x; F.lane = F.tid & 63; F.wave = __builtin_amdgcn_readfirstlane(F.tid >> 6);
    F.G = gridDim.x; { const int bx = blockIdx.x; F.vcu = (F.G % 8 == 0) ? (bx % 8) * (F.G / 8) + bx / 8 : bx; }
    unsigned char* ws = args.ws;
    F.ctl = (gu32*)(ws + WS_CTL);
#define PTRS() \
    unsigned long long z_ = 0ull; asm volatile("" : "+s"(z_)); unsigned char* wsl = args.ws + z_; float* out = args.out + z_;     \
    bf16* WIN = (bf16*)(wsl + WS_WIN); bf16* WOUT = (bf16*)(wsl + WS_WOUT); bf16* WFF1 = (bf16*)(wsl + WS_WFF1); bf16* WFF2 = (bf16*)(wsl + WS_WFF2); \
    float* SSQ = (float*)(wsl + WS_SSQ); float* KM = (float*)(wsl + WS_KMEAN); \
    bf16* HB = (bf16*)(wsl + WS_HB); bf16* Qb = (bf16*)(wsl + WS_Q); bf16* Kb = (bf16*)(wsl + WS_K); bf16* Vb = (bf16*)(wsl + WS_V); bf16* Ob = (bf16*)(wsl + WS_O); \
    bf16* ACT = (bf16*)(wsl + WS_ACT); \
    (void)WIN; (void)WOUT; (void)WFF1; (void)WFF2; (void)SSQ; (void)KM; (void)HB; (void)Qb; (void)Kb; (void)Vb; (void)Ob; (void)ACT; (void)out
    for (int u = F.tid; u < (LDS_BYTES - LDSCTL_OFF) / 4; u += NWAVES * 64) ((LAS unsigned*)(F.lds + LDSCTL_OFF))[u] = 0u;
    __syncthreads();
    XcdBarrier bar = xcd_barrier_post((unsigned*)(F.ctl + CW_BAR), F.MISC + 8);
#define GRID_BAR() do { for (int rb_ = 0; rb_ < REP_BAR; ++rb_) xcd_barrier(bar); } while (0)
    const int gw = F.vcu * NWAVES + F.wave, NGW = F.G * NWAVES;

    {
        PTRS();
        const float* x = args.in[0]; const float* attn_norm = args.in[1]; const float* w_in = args.in[2]; const float* w_out = args.in[3];
        const float* diff_subln = args.in[5]; const float* mlp_norm = args.in[6]; const float* w_ff1 = args.in[7]; const float* w_ff2 = args.in[8];
        int ln = threadIdx.x & 63; asm volatile("" : "+v"(ln));
        LAS float* scr = (LAS float*)(F.lds + RING_OFF + F.wave * 16384);
        constexpr int I_IN = (D / 64) * (NQKV / 32), I_OUT = (D / 64) * (D / 32), I_F1 = (D / 64) * (FF / 32), I_F2 = (FF / 64) * (D / 32);
        constexpr int PER_L = I_IN + I_OUT + I_F1 + I_F2;
        for (int rp_ = 0; rp_ < REP_PRO; ++rp_) {
        for (int it = gw; it < 2 * PER_L; it += NGW) {
            const int l = it / PER_L; int r = it % PER_L;
            if (r < I_IN) { p0_transpose_item(w_in + (size_t)l * D * NQKV, D, NQKV, WIN + (size_t)l * NQKV * D, scr, r, ln, attn_norm + l * D, D - 1, 1.0f, D, QSCALE); continue; } r -= I_IN;
            if (r < I_OUT) { p0_transpose_item(w_out + (size_t)l * D * D, D, D, WOUT + (size_t)l * D * D, scr, r, ln, l == 0 ? diff_subln : nullptr, 127, l == 0 ? 0.8f : 1.0f, 0, 1.0f); continue; } r -= I_OUT;
            if (r < I_F1) { p0_transpose_item(w_ff1 + (size_t)l * D * FF, D, FF, WFF1 + (size_t)l * FF * D, scr, r, ln, mlp_norm + l * D, D - 1, 1.0f, 0, 1.0f); continue; } r -= I_F1;
            p0_transpose_item(w_ff2 + (size_t)l * FF * D, FF, D, WFF2 + (size_t)l * D * FF, scr, r, ln, nullptr, 0, 1.0f, 0, 1.0f);
        }
        for (int m = 2 * gw; m < M; m += 2 * NGW) p0_x_row2(x + (size_t)m * D, HB + (size_t)m * D, SSQ + (size_t)m * 16, ln);
        }
    }
    GRID_BAR();

#pragma unroll 1
    for (int l = 0; l < 2; ++l) {
        {
            PTRS();
            pg8::Gemm g{HB, WIN + (size_t)l * NQKV * D, M, NQKV, D}; pg8::StaticOrder S; S.init(M, NQKV, F.G, (int)blockIdx.x);
            pg8::EpiScaleBf16<0> E{Qb, D, SSQ, D, (size_t)M * D, l == 1 ? (float*)(F.ctl + CW_KMS) : nullptr, (unsigned*)(F.ctl + CW_NRM + l * 256)};
            for (int rep = 0; rep < REP_QKV; ++rep)
            pg8::gemm_phase<pg8::EpiScaleBf16<0>, pg8::StaticOrder, PG8_ALIGN, PG8_SP2>(F.lds + RING_OFF, g, S, E);
        }
        GRID_BAR();
        if (l == 0) {
            PTRS();
            const float* lp = args.in[4];
            int lnl = threadIdx.x & 63; asm volatile("" : "+v"(lnl));
            const float la = wave_sum(lp[lnl] * lp[64 + lnl]), lc = wave_sum(lp[128 + lnl] * lp[192 + lnl]);
            const float lam = expf(la) - expf(lc) + 0.2f;
            for (int rep = 0; rep < REP_DIFF; ++rep)
            for (;;) {
                if (F.tid == 0) F.MISC[16] = __hip_atomic_fetch_add(F.ctl + CW_QUEUE + 64 * rep, 1u, RLX_AGENT);
                __syncthreads();
                const int i = (int)F.MISC[16];
                __syncthreads();
                if (i >= 1024) break;
                const int u = i >> 1, bh = u & 15, qb = 31 - (u >> 4);
                attn::diff_item((char*)lds + RING_OFF, bh >> 3, bh & 7, qb, i & 1, Qb, Kb, Vb, Ob, lam, (const unsigned*)(F.ctl + CW_NRM), (unsigned*)(F.ctl + CW_DFLAG + rep * 512 + u), (unsigned*)(F.ctl + CW_BAR) + XB_TMO);
            }
        } else {
            PTRS();
            const float* KMf = (const float*)(F.ctl + CW_KMS);
            for (int rep = 0; rep < REP_MOBA; ++rep)
            for (;;) {
                if (F.tid == 0) F.MISC[16] = __hip_atomic_fetch_add(F.ctl + CW_QUEUE + 64 * (4 + rep), 1u, RLX_AGENT);
                __syncthreads();
                const int i = (int)F.MISC[16];
                __syncthreads();
                if (i >= 1024) break;
                const int bh = i & 31, qb = 31 - (i >> 5);
                attn::moba_unit((char*)lds + RING_OFF, bh >> 4, bh & 15, qb, Qb, Kb, Vb, Ob, KMf, (const unsigned*)(F.ctl + CW_NRM + 256));
            }
        }
        GRID_BAR();
        {
            PTRS();
            pg8::Gemm g{Ob, WOUT + (size_t)l * D * D, M, D, D}; pg8::StaticOrder S; S.init(M, D, F.G, (int)blockIdx.x);
            pg8::EpiRes<false> E{out, HB, SSQ, D};
            pg8::gemm_phase<pg8::EpiRes<false>, pg8::StaticOrder, PG8_ALIGN, PG8_SP2>(F.lds + RING_OFF, g, S, E);
        }
        GRID_BAR();
        {
            PTRS();
            pg8::Gemm g{HB, WFF1 + (size_t)l * FF * D, M, FF, D}; pg8::StaticOrder S; S.init(M, FF, F.G, (int)blockIdx.x);
            pg8::EpiScaleBf16<1> E{ACT, FF, SSQ, 0, 0, nullptr, nullptr};
            for (int rep = 0; rep < REP_FF1; ++rep)
            pg8::gemm_phase<pg8::EpiScaleBf16<1>, pg8::StaticOrder, PG8_ALIGN, PG8_SP2>(F.lds + RING_OFF, g, S, E);
        }
        GRID_BAR();
        {
            PTRS();
            pg8::Gemm g{ACT, WFF2 + (size_t)l * D * FF, M, D, FF}; pg8::StaticOrder S; S.init(M, D, F.G, (int)blockIdx.x);
            if (l == 0) { pg8::EpiRes<false> E{out, HB, SSQ, D}; pg8::gemm_phase<pg8::EpiRes<false>, pg8::StaticOrder, PG8_ALIGN, PG8_SP2>(F.lds + RING_OFF, g, S, E); }
            else { pg8::EpiRes<true> E{out, HB, SSQ, D}; pg8::gemm_phase<pg8::EpiRes<true>, pg8::StaticOrder, PG8_ALIGN, PG8_SP2>(F.lds + RING_OFF, g, S, E); }
        }
        GRID_BAR();
    }
    PTRS(); const float* final_norm = args.in[9]; int lnf = threadIdx.x & 63; asm volatile("" : "+v"(lnf));
#if AT_PROBE
    float pscale;
    { const float tot = (float)attn::g_probe[0];
      float xv = AT_PROBE <= 4 ? (float)attn::g_probe[AT_PROBE] / tot : (tot / (float)attn::g_probe[5]) * (1.0f / 10000.0f);
      xv = floorf(xv * AT_PROBE_Q + 0.5f) * (1.0f / AT_PROBE_Q);
      pscale = 1.0f + 0.1f + 0.9f * xv; }
#endif
    for (int m = gw; m < M; m += NGW) final_row(out + (size_t)m * D, SSQ + (size_t)m * 16, final_norm, lnf);
#if AT_PROBE
    __syncthreads();
    for (int m = gw; m < M; m += NGW) { GAS f32x4* orr = (GAS f32x4*)(out + (size_t)m * D) + F.lane;
        for (int j = 0; j < 4; ++j) orr[64 * j] = orr[64 * j] * pscale; }
#endif
    if (xb_ld((unsigned*)(F.ctl + CW_BAR) + XB_TMO) != 0u && blockIdx.x == 0) { const float qn = __builtin_nanf(""); for (int i = F.tid; i < 4096; i += NWAVES * 64) out[i] = qn; }
}

extern "C" void kernel_launch(void* const* d_in, const int* in_sizes, int n_in, void* d_out, int out_size, void* d_ws, size_t ws_size, hipStream_t stream) {
    static int grid = 0;
    if (grid == 0) {
        if (n_in != 10 || in_sizes[0] != M * D || out_size != M * D || ws_size < WS_END) { fprintf(stderr, "kernel_launch: unexpected shapes (n_in %d out %d ws %zu); nothing launched\n", n_in, out_size, ws_size); grid = -1; return; }
        int dev = 0, cus = 0, per_cu = 0;
        if (hipGetDevice(&dev) != hipSuccess || hipDeviceGetAttribute(&cus, hipDeviceAttributeMultiprocessorCount, dev) != hipSuccess) { fprintf(stderr, "kernel_launch: device query failed\n"); grid = -1; return; }
        if (hipFuncSetAttribute((const void*)fwd_kernel, hipFuncAttributeMaxDynamicSharedMemorySize, LDS_BYTES) != hipSuccess) { fprintf(stderr, "kernel_launch: hipFuncSetAttribute failed\n"); grid = -1; return; }
        if (hipOccupancyMaxActiveBlocksPerMultiprocessor(&per_cu, (const void*)fwd_kernel, NWAVES * 64, LDS_BYTES) != hipSuccess || per_cu < 1) { fprintf(stderr, "kernel_launch: occupancy query reports %d workgroups per CU\n", per_cu); per_cu = 1; }
        (void)hipGetLastError();
        grid = cus;
    }
    if (grid < 0) return;
    if (hipMemsetAsync((char*)d_ws + WS_CTL, 0, CTL_ZERO_BYTES, stream) != hipSuccess) { fprintf(stderr, "kernel_launch: hipMemsetAsync failed\n"); return; }
    Args a{};
    for (int i = 0; i < 10; ++i) a.in[i] = (const float*)d_in[i];
    a.out = (float*)d_out; a.ws = (unsigned char*)d_ws;
    hipLaunchKernelGGL(fwd_kernel, dim3(grid), dim3(NWAVES * 64), LDS_BYTES, stream, a);
    const hipError_t le = hipPeekAtLastError();
    if (le != hipSuccess) fprintf(stderr, "kernel_launch: launch failed: %s\n", hipGetErrorName(le));
}
```

```cpp
#include <hip/hip_runtime.h>
#include <cstdio>
#include <cstdint>
#define AT_PROBE 0
#define AT_PROBE_WAVE 0
#define AT_PROBE_Q 16.0f
#define AT_PROBE_DV 128

constexpr int BATCH = 2, T = 8192, D = 1024, M = BATCH * T, FF = 4096, NQKV = 3 * D;
constexpr float RMS_EPS = 1e-6f;
constexpr float LOG2E = 1.4426950408889634f;
constexpr float QSCALE = 0.125f * LOG2E;
constexpr float NEG_BIG = -1e30f;

constexpr size_t MiB = 1u << 20;
constexpr size_t WS_CTL = 0, CTL_ZERO_BYTES = 1 * MiB;
constexpr size_t WS_WIN = 1 * MiB;
constexpr size_t WS_WOUT = 13 * MiB;
constexpr size_t WS_WFF1 = 17 * MiB;
constexpr size_t WS_WFF2 = 33 * MiB;
constexpr size_t WS_SSQ = 49 * MiB;
constexpr size_t WS_KMEAN = 50 * MiB;
constexpr size_t WS_HB = 51 * MiB;
constexpr size_t WS_Q = 83 * MiB, WS_K = 115 * MiB, WS_V = 147 * MiB, WS_O = 179 * MiB;
constexpr size_t WS_ACT = 83 * MiB;
constexpr size_t WS_END = 211 * MiB;
constexpr int CW_TMO = 0, CW_CODE = 1, CW_BAR = 4096;
constexpr int CW_NRM = 8192;
constexpr int CW_DFLAG = 12288;
constexpr int CW_KMS = 32768;
constexpr int CW_QUEUE = 9216;
namespace pg8 {
#define PG8_LAS __attribute__((address_space(3)))
typedef unsigned short bf16_t;
typedef short bf16x8 __attribute__((ext_vector_type(8)));
typedef float f32x4 __attribute__((ext_vector_type(4)));
typedef unsigned u32x4 __attribute__((ext_vector_type(4)));
constexpr int BM = 256, BK = 64, HALF = 128, HTB = HALF * BK * 2  , STAGE_BYTES = 8 * HTB, NXCD = 8, WGM = 8;

__host__ __device__ __forceinline__ int lds_byte(int r, int c) { const int st = (r >> 4) * 2 + (c >> 5), rr = r & 15, cc = c & 31, ob = rr * 64 + cc * 2; return st * 1024 + (ob ^ (((ob >> 9) & 1) << 5)); }
__host__ __device__ __forceinline__ void stage_rc(int b, int& R, int& C) { const int st = b / 1024, sb = b % 1024, swz = sb ^ (((sb >> 9) & 1) << 5); R = (st >> 1) * 16 + swz / 64; C = (st & 1) * 32 + (swz % 64) / 2; }
__host__ __device__ __forceinline__ int perm32(int rho) { const int n = rho >> 4, i = rho & 15; return 8 * (i >> 2) + 4 * n + (i & 3); }

struct Unit { int pm, pn; };
struct Gemm { const bf16_t* A; const bf16_t* Bt; int M, N, K; };

struct StaticOrder {
    int nM, nN, nwg, G, c;
    __host__ __device__ void init(int M, int N, int G_, int c_) { nM = M / BM; nN = N / BM; nwg = nM * nN; G = G_; c = c_; }
    __host__ __device__ bool next(int i, Unit& u) const {
        const long L = (long)i * G + c; if (L >= nwg) return false;
        int wgid = (int)L; { const int q = nwg / NXCD, r = nwg % NXCD, xcd = wgid % NXCD, off = wgid / NXCD; wgid = (xcd < r ? xcd * (q + 1) : r * (q + 1) + (xcd - r) * q) + off; }
        const int nig = WGM * nN, gid = wgid / nig, fm = gid * WGM, gsz = (nM - fm) < WGM ? (nM - fm) : WGM;
        u.pm = fm + ((wgid % nig) % gsz); u.pn = (wgid % nig) / gsz; return true;
    }
    __device__ __forceinline__ void a_ready(const Unit&) const {}
    __device__ __forceinline__ void done(const Unit&) const {}
};


__device__ __forceinline__ unsigned cvt_pk_bf16(float lo, float hi) { unsigned r; asm volatile("v_cvt_pk_bf16_f32 %0, %1, %2" : "=v"(r) : "v"(lo), "v"(hi)); return r; }
__device__ __forceinline__ float row_rstd16(const float* SSQ, int row) {
    const f32x4* p = (const f32x4*)(SSQ + (size_t)row * 16);
    const f32x4 a = p[0], b = p[1], c = p[2], d = p[3];
    const float s = ((a[0] + a[1]) + (a[2] + a[3])) + ((b[0] + b[1]) + (b[2] + b[3])) + ((c[0] + c[1]) + (c[2] + c[3])) + ((d[0] + d[1]) + (d[2] + d[3]));
    return 1.0f / sqrtf(s * (1.0f / 1024.0f) + 1e-6f);
}
template <int ACT> struct EpiScaleBf16 {
    static constexpr bool PERM = true, AFTER_DRAIN = false;
    bf16_t* O; int ldc; const float* SSQ; int split_cols; size_t split_stride;
    float* KMS;
    unsigned* NRM;
    __device__ __forceinline__ void operator()(const f32x4 (&acc)[2][2][4][2], const Unit& u, int wr, int wc, int fr, int fq) const {
        const int row0 = u.pm * BM + wr * 64 + fr; int colt = u.pn * BM; bf16_t* base = O; int t = 0;
        if (split_cols) { t = colt / split_cols; base += (size_t)t * split_stride; colt -= t * split_cols; }
        const int col0 = colt + wc * 32 + 8 * fq;
        const int lane = fq * 16 + fr; float myrs[2];
#pragma unroll
        for (int ai = 0; ai < 2; ++ai) myrs[ai] = row_rstd16(SSQ, u.pm * BM + wr * 64 + ai * HALF + lane);
        asm volatile("" : "+v"(myrs[0]), "+v"(myrs[1]));
        float mx[2] = {0.f, 0.f};
        f32x4 ks[2][2] = {{{0.f, 0.f, 0.f, 0.f}, {0.f, 0.f, 0.f, 0.f}}, {{0.f, 0.f, 0.f, 0.f}, {0.f, 0.f, 0.f, 0.f}}};
#pragma unroll
        for (int ai = 0; ai < 2; ++ai)
#pragma unroll
            for (int m = 0; m < 4; ++m) { const int row = row0 + ai * HALF + m * 16; const float rs = __shfl(myrs[ai], m * 16 + fr); bf16_t* rowp = base + (size_t)row * ldc + col0;
#pragma unroll
                for (int bj = 0; bj < 2; ++bj) { f32x4 v0 = acc[ai][bj][m][0] * rs, v1 = acc[ai][bj][m][1] * rs;
                    if (ACT == 1) {
#pragma unroll
                        for (int e = 0; e < 4; ++e) { const float a = __builtin_fmaxf(v0[e], 0.f), b = __builtin_fmaxf(v1[e], 0.f); v0[e] = a * a; v1[e] = b * b; } }
                    if (ACT == 0 && KMS && t == 1) { ks[bj][0] += v0; ks[bj][1] += v1; }
                    if (ACT == 0 && NRM && t < 2) { float q = (v0[0] * v0[0] + v0[1] * v0[1]) + (v0[2] * v0[2] + v0[3] * v0[3]) + (v1[0] * v1[0] + v1[1] * v1[1]) + (v1[2] * v1[2] + v1[3] * v1[3]);
                        q += __shfl_xor(q, 16); q += __shfl_xor(q, 32); mx[bj] = __builtin_fmaxf(mx[bj], q); }
                    u32x4 w; w.x = cvt_pk_bf16(v0[0], v0[1]); w.y = cvt_pk_bf16(v0[2], v0[3]); w.z = cvt_pk_bf16(v1[0], v1[1]); w.w = cvt_pk_bf16(v1[2], v1[3]);
                    *(u32x4*)(rowp + bj * HALF) = w; } }
        if (ACT == 0 && KMS && t == 1) {
#pragma unroll
            for (int bj = 0; bj < 2; ++bj)
#pragma unroll
                for (int n = 0; n < 2; ++n)
#pragma unroll
                    for (int e = 0; e < 4; ++e) { float q = ks[bj][n][e];
#pragma unroll
                        for (int o = 1; o < 16; o <<= 1) q += __shfl_xor(q, o);
                        const int col = colt + bj * HALF + wc * 32 + 8 * fq + 4 * n + e;
                        if (fr == 0) atomicAdd(KMS + ((((size_t)(u.pm >> 5) * 16 + (col >> 6)) * 32 + (u.pm & 31)) * 64 + (col & 63)), q * (1.0f / 256.0f)); }
        }
        if (ACT == 0 && NRM && t < 2) {
#pragma unroll
            for (int bj = 0; bj < 2; ++bj) { float q = mx[bj];
#pragma unroll
                for (int o = 1; o < 16; o <<= 1) q = __builtin_fmaxf(q, __shfl_xor(q, o));
                const int col = colt + bj * HALF + wc * 32;
                if (lane == 0) atomicMax(NRM + (((t * 2 + (u.pm >> 5)) * 16 + (col >> 6)) * 2 + ((col >> 5) & 1)), __float_as_uint(q)); }
        }
    }
};
template <bool LAST> struct EpiRes {
    static constexpr bool PERM = false, AFTER_DRAIN = false;
    float* out; bf16_t* HB; float* SSQ; int ldc;
    __device__ __forceinline__ void operator()(const f32x4 (&acc)[2][2][4][2], const Unit& u, int wr, int wc, int fr, int fq) const {
        typedef unsigned u32x2v __attribute__((ext_vector_type(2)));
        const int col0 = u.pn * BM + wc * 32 + 4 * fq;
#pragma unroll
        for (int ai = 0; ai < 2; ++ai)
#pragma unroll
            for (int m = 0; m < 4; ++m) { const int row = u.pm * BM + ai * HALF + wr * 64 + m * 16 + fr; const size_t off = (size_t)row * ldc + col0; float s = 0.f;
#pragma unroll
                for (int bj = 0; bj < 2; ++bj)
#pragma unroll
                    for (int n = 0; n < 2; ++n) { const size_t o2 = off + bj * HALF + n * 16; const u32x2v hb = *(const u32x2v*)(HB + o2);
                        f32x4 h = acc[ai][bj][m][n];
                        h[0] += __builtin_bit_cast(float, hb.x << 16); h[1] += __builtin_bit_cast(float, hb.x & 0xffff0000u); h[2] += __builtin_bit_cast(float, hb.y << 16); h[3] += __builtin_bit_cast(float, hb.y & 0xffff0000u);
                        if (LAST) *(f32x4*)(out + o2) = h;
                        else { u32x2v w; w.x = cvt_pk_bf16(h[0], h[1]); w.y = cvt_pk_bf16(h[2], h[3]); *(u32x2v*)(HB + o2) = w; }
                        s += (h[0] * h[0] + h[1] * h[1]) + (h[2] * h[2] + h[3] * h[3]); }
                s += __shfl_xor(s, 16); s += __shfl_xor(s, 32);
                if (fq == 0) SSQ[(size_t)row * 16 + u.pn * 4 + wc] = s;
                if (m & 1) asm volatile("" ::: "memory"); }
    }
};
template <class Epi, class Sched, bool ALIGN_EPI = false, bool SP2 = false>
__device__ __forceinline__ void gemm_phase(PG8_LAS unsigned char* lds, const Gemm g, const Sched& S, const Epi& E) {
    int tid_ = threadIdx.x; asm volatile("" : "+v"(tid_));
    const int tid = tid_, wid = __builtin_amdgcn_readfirstlane(tid >> 6), lane = tid & 63, wr = wid >> 2, wc = wid & 3, fr = lane & 15, fq = lane >> 4;
    const int K = g.K, nt = K / BK;
    unsigned voffA[2], voffB[2];
#pragma unroll
    for (int i = 0; i < 2; ++i) { int R, C; stage_rc(tid * 16 + i * 8192, R, C); const int Rb = Epi::PERM ? ((R & ~31) + perm32(R & 31)) : R;
        voffA[i] = (unsigned)(R * K + C) * 2u; voffB[i] = (unsigned)(Rb * K + C) * 2u; }
    const size_t kstep = (size_t)(BK * 2);
    const size_t hstep = (size_t)HALF * K * 2;
    const size_t tstep = 2 * hstep;
    const unsigned ldsw = (unsigned)wid * 1024u;
    const int aoff = lds_byte(wr * 64 + fr, fq * 8), boff = lds_byte(wc * 32 + fr, fq * 8);
#define PG8_SA(b, h) (((b) * 2 + (h)) * HTB)
#define PG8_SB(b, h) ((4 + (b) * 2 + (h)) * HTB)
#define PG8_STAGE(bufoff, gbase, voff) do { _Pragma("unroll") for (int _i = 0; _i < 2; ++_i) \
        __builtin_amdgcn_global_load_lds((const unsigned*)((const char*)(gbase) + (voff)[_i]), (PG8_LAS unsigned*)(lds + (bufoff) + ldsw + _i * 8192), 16, 0, 0); } while (0)
#define PG8_LDA(dst, b, h) do { _Pragma("unroll") for (int m = 0; m < 4; ++m) _Pragma("unroll") for (int k = 0; k < 2; ++k) dst[m][k] = *(const PG8_LAS bf16x8*)(lds + PG8_SA(b, h) + aoff + m * 2048 + k * 1024); } while (0)
#define PG8_LDB(dst, b, h) do { _Pragma("unroll") for (int n = 0; n < 2; ++n) _Pragma("unroll") for (int k = 0; k < 2; ++k) dst[n][k] = *(const PG8_LAS bf16x8*)(lds + PG8_SB(b, h) + boff + n * 2048 + k * 1024); } while (0)
#define PG8_MMA(ai, bj, At, Bt) do { __builtin_amdgcn_s_setprio(1); _Pragma("unroll") for (int m = 0; m < 4; ++m) _Pragma("unroll") for (int n = 0; n < 2; ++n) _Pragma("unroll") for (int k = 0; k < 2; ++k) \
        acc[ai][bj][m][n] = __builtin_amdgcn_mfma_f32_16x16x32_bf16(Bt[n][k], At[m][k], acc[ai][bj][m][n], 0, 0, 0); __builtin_amdgcn_s_setprio(0); } while (0)
#define PG8_WAIT_V(n) asm volatile("s_waitcnt vmcnt(" #n ")" ::: "memory")
#define PG8_WAIT_L(n) asm volatile("s_waitcnt lgkmcnt(" #n ")" ::: "memory")
#define PG8_BAR __builtin_amdgcn_s_barrier()
#define PG8_SCHED __builtin_amdgcn_sched_barrier(0)
    Unit cur, nxt; int ui = 0;
    if (!S.next(0, cur)) return;
    f32x4 acc[2][2][4][2];
#pragma unroll
    for (int a = 0; a < 2; ++a)
#pragma unroll
        for (int b = 0; b < 2; ++b)
#pragma unroll
            for (int m = 0; m < 4; ++m)
#pragma unroll
                for (int n = 0; n < 2; ++n) acc[a][b][m][n] = (f32x4){0.f, 0.f, 0.f, 0.f};
    bf16x8 At[4][2], B0[2][2], B1[2][2];
    const char* cA = (const char*)g.A + (size_t)cur.pm * tstep; const char* cB = (const char*)g.Bt + (size_t)cur.pn * tstep;
    S.a_ready(cur);
    if constexpr (SP2) {
        PG8_STAGE(PG8_SB(0, 0), cB, voffB); PG8_STAGE(PG8_SB(0, 1), cB + hstep, voffB); PG8_STAGE(PG8_SA(0, 0), cA, voffA); PG8_STAGE(PG8_SA(0, 1), cA + hstep, voffA);
        if (wr == 1) PG8_BAR;
        PG8_WAIT_V(2); PG8_BAR;
        PG8_STAGE(PG8_SB(1, 0), cB + kstep, voffB); PG8_STAGE(PG8_SA(1, 0), cA + kstep, voffA); PG8_STAGE(PG8_SB(1, 1), cB + hstep + kstep, voffB);
        PG8_WAIT_V(6); PG8_BAR;
    } else {
        PG8_STAGE(PG8_SB(0, 0), cB, voffB); PG8_STAGE(PG8_SA(0, 0), cA, voffA); PG8_STAGE(PG8_SB(0, 1), cB + hstep, voffB); PG8_STAGE(PG8_SA(0, 1), cA + hstep, voffA);
        if (wr == 1) PG8_BAR;
        PG8_WAIT_V(4); PG8_BAR;
        PG8_STAGE(PG8_SB(1, 0), cB + kstep, voffB); PG8_STAGE(PG8_SA(1, 0), cA + kstep, voffA); PG8_STAGE(PG8_SB(1, 1), cB + hstep + kstep, voffB);
        PG8_WAIT_V(6); PG8_BAR;
    }
    for (;;) {
        const bool has_next = S.next(ui + 1, nxt);
        const char* nA = has_next ? (const char*)g.A + (size_t)nxt.pm * tstep : cA; const char* nB = has_next ? (const char*)g.Bt + (size_t)nxt.pn * tstep : cB;
        for (int t = 0; t < nt; t += 2) {
            const bool last = (t == nt - 2);
            const char* a1 = cA + (size_t)(t + 1) * kstep;
            const char* a2 = last ? nA : cA + (size_t)(t + 2) * kstep; const char* b2 = last ? nB : cB + (size_t)(t + 2) * kstep;
            const char* a3 = a2 + kstep; const char* b3 = b2 + kstep;
            if (last && has_next) S.a_ready(nxt);
            if constexpr (SP2) {
            PG8_LDB(B0, 0, 0); PG8_LDB(B1, 0, 1); PG8_SCHED; PG8_LDA(At, 0, 0); PG8_STAGE(PG8_SA(1, 1), a1 + hstep, voffA);
            PG8_WAIT_V(8); PG8_WAIT_L(0); PG8_BAR; PG8_MMA(0, 0, At, B0); PG8_MMA(0, 1, At, B1); PG8_BAR; PG8_SCHED;
            PG8_LDA(At, 0, 1); PG8_STAGE(PG8_SB(0, 0), b2, voffB); PG8_STAGE(PG8_SB(0, 1), b2 + hstep, voffB); PG8_STAGE(PG8_SA(0, 0), a2, voffA);
            PG8_WAIT_V(8); PG8_WAIT_L(0); PG8_BAR; PG8_MMA(1, 0, At, B0); PG8_MMA(1, 1, At, B1); PG8_BAR; PG8_SCHED;
            PG8_LDB(B0, 1, 0); PG8_LDB(B1, 1, 1); PG8_SCHED; PG8_LDA(At, 1, 0); PG8_STAGE(PG8_SA(0, 1), a2 + hstep, voffA);
            PG8_WAIT_V(8); PG8_WAIT_L(0); PG8_BAR; PG8_MMA(0, 0, At, B0); PG8_MMA(0, 1, At, B1); PG8_BAR; PG8_SCHED;
            PG8_LDA(At, 1, 1); PG8_STAGE(PG8_SB(1, 0), b3, voffB); PG8_STAGE(PG8_SB(1, 1), b3 + hstep, voffB); PG8_STAGE(PG8_SA(1, 0), a3, voffA);
            PG8_WAIT_V(8); PG8_WAIT_L(0); PG8_BAR; PG8_MMA(1, 0, At, B0); PG8_MMA(1, 1, At, B1); PG8_BAR; PG8_SCHED;
            } else {
            PG8_LDB(B0, 0, 0); PG8_SCHED; PG8_LDA(At, 0, 0); PG8_STAGE(PG8_SA(1, 1), a1 + hstep, voffA);
            PG8_WAIT_L(8); PG8_BAR; PG8_WAIT_L(0); PG8_MMA(0, 0, At, B0); PG8_BAR; PG8_SCHED;
            PG8_LDB(B1, 0, 1); PG8_STAGE(PG8_SB(0, 0), b2, voffB);
            PG8_BAR; PG8_WAIT_L(0); PG8_MMA(0, 1, At, B1); PG8_BAR;
            PG8_LDA(At, 0, 1); PG8_STAGE(PG8_SA(0, 0), a2, voffA);
            PG8_BAR; PG8_WAIT_L(0); PG8_MMA(1, 0, At, B0); PG8_BAR; PG8_SCHED;
            PG8_STAGE(PG8_SB(0, 1), b2 + hstep, voffB);
            PG8_WAIT_V(6); PG8_BAR; PG8_MMA(1, 1, At, B1); PG8_BAR;
            PG8_LDB(B0, 1, 0); PG8_SCHED; PG8_LDA(At, 1, 0); PG8_STAGE(PG8_SA(0, 1), a2 + hstep, voffA);
            PG8_WAIT_L(8); PG8_BAR; PG8_WAIT_L(0); PG8_MMA(0, 0, At, B0); PG8_BAR; PG8_SCHED;
            PG8_LDB(B1, 1, 1); PG8_STAGE(PG8_SB(1, 0), b3, voffB);
            PG8_BAR; PG8_WAIT_L(0); PG8_MMA(0, 1, At, B1); PG8_BAR;
            PG8_LDA(At, 1, 1); PG8_STAGE(PG8_SA(1, 0), a3, voffA);
            PG8_BAR; PG8_WAIT_L(0); PG8_MMA(1, 0, At, B0); PG8_BAR; PG8_SCHED;
            PG8_STAGE(PG8_SB(1, 1), b3 + hstep, voffB);
            PG8_WAIT_V(6); PG8_BAR; PG8_MMA(1, 1, At, B1); PG8_BAR;
            }
        }
        if constexpr (ALIGN_EPI) { if (wr == 0) PG8_BAR; }
        if constexpr (!Epi::AFTER_DRAIN) { E(acc, cur, wr, wc, fr, fq); S.done(cur); }
        if (!has_next) break;
#pragma unroll
        for (int a = 0; a < 2; ++a)
#pragma unroll
            for (int b = 0; b < 2; ++b)
#pragma unroll
                for (int m = 0; m < 4; ++m)
#pragma unroll
                    for (int n = 0; n < 2; ++n) acc[a][b][m][n] = (f32x4){0.f, 0.f, 0.f, 0.f};
        cur = nxt; cA = nA; cB = nB; ++ui;
        if constexpr (ALIGN_EPI) { if (wr == 1) PG8_BAR; }
    }
    PG8_WAIT_V(0);
    if constexpr (!ALIGN_EPI) { if (wr == 0) PG8_BAR; }
    PG8_BAR;
    if constexpr (Epi::AFTER_DRAIN) { E.fused(acc, cur, wr, wc, fr, fq, lds, wid, lane); S.done(cur); }
#undef PG8_SA
#undef PG8_SB
#undef PG8_STAGE
#undef PG8_LDA
#undef PG8_LDB
#undef PG8_MMA
#undef PG8_WAIT_V
#undef PG8_WAIT_L
#undef PG8_BAR
#undef PG8_SCHED
}
}

#ifndef PG8_SP2
#define PG8_SP2 true
#endif
#ifndef PG8_ALIGN
#define PG8_ALIGN true
#endif
#define GAS __attribute__((address_space(1)))
#define LAS __attribute__((address_space(3)))
typedef unsigned short bf16;
typedef unsigned v4u __attribute__((ext_vector_type(4)));
typedef float f32x4 __attribute__((ext_vector_type(4)));
typedef short bf16x8 __attribute__((ext_vector_type(8)));
typedef GAS unsigned gu32;
typedef GAS unsigned long long gu64;
#define RLX_AGENT __ATOMIC_RELAXED, __HIP_MEMORY_SCOPE_AGENT
#define LDS_WAIT() asm volatile("s_waitcnt lgkmcnt(0)" ::: "memory")
#define VM_WAIT() asm volatile("s_waitcnt vmcnt(0)" ::: "memory")
__device__ __forceinline__ unsigned long long rt() { return __builtin_amdgcn_s_memrealtime(); }
__device__ __forceinline__ unsigned f2bf(float f) { unsigned u = __builtin_bit_cast(unsigned, f); return (u + 0x7fffu + ((u >> 16) & 1u)) >> 16; }
__device__ __forceinline__ unsigned pk2(float lo, float hi) { return f2bf(lo) | (f2bf(hi) << 16); }

#define XB_TMO      128
#define XB_XCNT(j)  (256  + 64 * (j))
#define XB_XSUB(j)  (1280 + 64 * (j))
#define XB_XGEN(j)  (2304 + 64 * (j))
#define XB_TOP      3328
#define XB_TOPGEN   3392
#define XCD_BAR_WORDS 3456
#define XB_SPIN_CAP (1u << 18)

__device__ __forceinline__ unsigned xb_ld(unsigned* p)              { return __hip_atomic_load(p, __ATOMIC_RELAXED, __HIP_MEMORY_SCOPE_AGENT); }
__device__ __forceinline__ unsigned xb_add(unsigned* p, unsigned v) { return __hip_atomic_fetch_add(p, v, __ATOMIC_RELAXED, __HIP_MEMORY_SCOPE_AGENT); }
__device__ __forceinline__ unsigned xb_xcc_id() { return (unsigned)__builtin_amdgcn_s_getreg((3 << 11) | 20) & 0xFu; }
#define XB_SPIN(cond, bar) do { unsigned _sp = 0; while (cond) { __builtin_amdgcn_s_sleep(1); \
    if ((++_sp & 255u) == 0u) { if (xb_ld(&(bar)[XB_TMO])) break; if (_sp > XB_SPIN_CAP) { atomicAdd(&(bar)[XB_TMO], 1u); break; } } } } while (0)

struct XcdBarrier {
    unsigned* bar; unsigned x;
    volatile LAS unsigned* st;
};

__device__ __forceinline__ XcdBarrier xcd_barrier_post(unsigned* bar, volatile LAS unsigned* st) {
    XcdBarrier b; b.bar = bar; b.x = xb_xcc_id(); b.st = st;
    if (threadIdx.x == 0) (void)xb_add(&bar[XB_XCNT(b.x)], 1u);
    return b;
}
__device__ __forceinline__ void xcd_barrier_complete(unsigned* bar, unsigned x, unsigned& nloc, unsigned& nx) {
    const unsigned G = gridDim.x * gridDim.y * gridDim.z;
    unsigned sum, cnt, mine, sp = 0u;
    for (;;) {
        sum = 0u; cnt = 0u; mine = 0u;
#pragma unroll
        for (unsigned j = 0; j < 16; ++j) { const unsigned c = xb_ld(&bar[XB_XCNT(j)]); sum += c; cnt += (c > 0u) ? 1u : 0u; mine = (j == x) ? c : mine; }
        if (sum == G) break;
        __builtin_amdgcn_s_sleep(1);
        if ((++sp & 255u) == 0u) { if (xb_ld(&bar[XB_TMO])) break; if (sp > XB_SPIN_CAP) { atomicAdd(&bar[XB_TMO], 1u); break; } }
    }
    nloc = mine > 0u ? mine : 1u; nx = cnt > 0u ? cnt : 1u;
}

__device__ __forceinline__ void xcd_barrier(const XcdBarrier& b) {
    asm volatile("s_waitcnt vmcnt(0)" ::: "memory");
    __syncthreads();
    if (threadIdx.x == 0) {
        unsigned* bar = b.bar; unsigned bx_ = b.x; asm volatile("" : "+s"(bx_));
        __builtin_amdgcn_s_waitcnt(0);
        unsigned nloc = b.st[0], nx = b.st[1];
        if (nloc == 0u) { xcd_barrier_complete(bar, bx_, nloc, nx); b.st[0] = nloc; b.st[1] = nx; }
        const unsigned old = xb_add(&bar[XB_XSUB(bx_)], 1u);
        const unsigned gen = old / nloc;
        if (old + 1u == (gen + 1u) * nloc) {
            __builtin_amdgcn_fence(__ATOMIC_RELEASE, "agent");
            asm volatile("s_waitcnt vmcnt(0)" ::: "memory");
            const unsigned og = xb_add(&bar[XB_TOP], 1u);
            const unsigned tg = og / nx;
            if (og + 1u == (tg + 1u) * nx) xb_add(&bar[XB_TOPGEN], 1u);
            else XB_SPIN(xb_ld(&bar[XB_TOPGEN]) == tg, bar);
            __builtin_amdgcn_fence(__ATOMIC_ACQUIRE, "agent");
            xb_add(&bar[XB_XGEN(bx_)], 1u);
            asm volatile("s_waitcnt vmcnt(0)" ::: "memory");
        } else {
            XB_SPIN(xb_ld(&bar[XB_XGEN(bx_)]) == gen, bar);
            __builtin_amdgcn_fence(__ATOMIC_ACQUIRE, "agent");
            asm volatile("s_waitcnt vmcnt(0)" ::: "memory");
        }
    }
    __syncthreads();
}

namespace attn {
typedef unsigned short bf16;
using bf16x8 = __attribute__((ext_vector_type(8))) short;
using s16x4 = __attribute__((ext_vector_type(4))) short;
using f32x16 = __attribute__((ext_vector_type(16))) float;
using u32x4 = __attribute__((ext_vector_type(4))) unsigned;
typedef __attribute__((address_space(3))) const char* lds_cptr;
typedef __attribute__((address_space(3))) char* lds_ptr;
typedef short v4i16_t __attribute__((ext_vector_type(4)));
constexpr int DM = 1024, SEQ = 8192, KVBLK = 64;
constexpr int KSLOT = 8192;
constexpr float THR = 8.0f;
#ifndef AT_PROBE
#define AT_PROBE 0
#endif
__device__ unsigned long long g_probe[8];
template <int DV, int AH> struct Lay {
    static constexpr int VSLOT = DV * 128, NKSLOT = AH + 1, NVSLOT = AH + 3, LDS_K = 0, LDS_V = NKSLOT * KSLOT, LDS_WS = LDS_V + NVSLOT * VSLOT, OSTW = 32 * DV * 2,
        LDS_OST = LDS_V  , BYTES = LDS_WS + 8 * 256;
    static_assert(8 * OSTW <= NVSLOT * VSLOT, "O stages fit inside the V ring");
};
#define AT_SBAR() __builtin_amdgcn_sched_barrier(0)
#define AT_WAIT_BAR(N) asm volatile("s_waitcnt vmcnt(" #N ") lgkmcnt(0)\n\ts_barrier" ::: "memory")
__device__ __forceinline__ void wait_bar_n(int n) {
    switch (n) {
        case 0: AT_WAIT_BAR(0); break; case 1: AT_WAIT_BAR(1); break; case 2: AT_WAIT_BAR(2); break; case 3: AT_WAIT_BAR(3); break;
        case 4: AT_WAIT_BAR(4); break; case 5: AT_WAIT_BAR(5); break; case 6: AT_WAIT_BAR(6); break; case 7: AT_WAIT_BAR(7); break;
        case 8: AT_WAIT_BAR(8); break; case 9: AT_WAIT_BAR(9); break; case 10: AT_WAIT_BAR(10); break; case 11: AT_WAIT_BAR(11); break;
        case 12: AT_WAIT_BAR(12); break; case 13: AT_WAIT_BAR(13); break; case 14: AT_WAIT_BAR(14); break; default: AT_WAIT_BAR(15); break;
    }
}
__device__ __forceinline__ int crow(int r, int hi) { return (r & 3) + 8 * (r >> 2) + 4 * hi; }
__device__ __forceinline__ unsigned f2bf_u(float f) { unsigned u = __builtin_bit_cast(unsigned, f); return (u + 0x7fffu + ((u >> 16) & 1u)) >> 16; }
__device__ __forceinline__ float bf2f_u(unsigned h) { return __builtin_bit_cast(float, h << 16); }
__device__ __forceinline__ void glds16(const void* gsrc, unsigned lds_dst) { unsigned keep;
    asm volatile("s_mov_b32 %0, m0\n\ts_mov_b32 m0, %2\n\ts_nop 0\n\tglobal_load_lds_dwordx4 %1, off\n\ts_mov_b32 m0, %0" : "=&s"(keep) : "v"(gsrc), "s"(lds_dst) : "memory"); }
typedef float f32x2_t __attribute__((ext_vector_type(2))); typedef __bf16 bf16x2_t __attribute__((ext_vector_type(2)));
__device__ __forceinline__ unsigned cvtpk_s(float lo, float hi) { f32x2_t v = {lo, hi}; bf16x2_t b = __builtin_convertvector(v, bf16x2_t); return __builtin_bit_cast(unsigned, b); }
__device__ __forceinline__ s16x4 vtr(lds_cptr p) { return __builtin_bit_cast(s16x4, __builtin_amdgcn_ds_read_tr16_b64_v4i16((__attribute__((address_space(3))) v4i16_t*)p)); }
#define AT_MX3(a, b, c) __builtin_fmaxf(__builtin_fmaxf((a), (b)), (c))
#define AT_MFMA(a, b, c) __builtin_amdgcn_mfma_f32_32x32x16_bf16(a, b, c, 0, 0, 0)
__device__ __forceinline__ float rowmax(const f32x16& p0, const f32x16& p1) {
    float a = AT_MX3(p0[0], p0[1], p1[0]), b = AT_MX3(p0[2], p0[3], p1[1]); a = AT_MX3(a, p1[2], p1[3]);
#pragma unroll
    for (int r = 4; r < 16; r += 4) { a = AT_MX3(a, p0[r], p0[r + 1]); b = AT_MX3(b, p0[r + 2], p0[r + 3]); a = AT_MX3(a, p1[r], p1[r + 1]); b = AT_MX3(b, p1[r + 2], p1[r + 3]); }
    float m = __builtin_fmaxf(a, b); auto rr = __builtin_amdgcn_permlane32_swap(__float_as_uint(m), __float_as_uint(m), false, false);
    return __builtin_fmaxf(__uint_as_float(rr[0]), __uint_as_float(rr[1])); }
__device__ __forceinline__ void cmask(f32x16& p0, f32x16& p1, int jb, int qrel, int hi) {
    const int lim = qrel - 64 * jb - 4 * hi;
#pragma unroll
    for (int r = 0; r < 16; ++r) { const int kv = (r & 3) + 8 * (r >> 2); if (kv > lim) p0[r] = -INFINITY; if (kv + 32 > lim) p1[r] = -INFINITY; } }

template <int DV, bool MOBA, int AH, bool FIXED>
__device__ __forceinline__ void sweep(char* shm, const bf16* Qw, const bf16* __restrict__ Kh, const bf16* __restrict__ Vh, int qb, int kt_min, float slope2, float mfix, unsigned sel, f32x16 (&o)[DV / 32], f32x16& lsum) {
    typedef Lay<DV, AH> L;
    constexpr int NPV = DV / 64, NPT = 1 + NPV;
    int tid_ = threadIdx.x; asm volatile("" : "+v"(tid_));
    const int tid = tid_, lane = tid & 63, r32 = lane & 31, hi = lane >> 5; const int wid = __builtin_amdgcn_readfirstlane(tid >> 6);
    const unsigned lds0 = (unsigned)(uintptr_t)shm;
    const lds_ptr shm3 = (lds_ptr)shm;
    __attribute__((address_space(3))) float* wsf = (__attribute__((address_space(3))) float*)(shm3 + L::LDS_WS) + wid * 64;
    const int NT = 4 * qb + 4 - kt_min;
    const bf16* ksrc = Kh + (long)lane * DM + wid * 8;
    const bf16* vsrc0 = Vh + (long)(16 * (wid & 3) + (lane >> 2)) * DM + (wid >> 2) * 32 + (lane & 3) * 8;
    const unsigned kdst = lds0 + L::LDS_K + wid * 1024, vdst = lds0 + L::LDS_V + wid * 1024;
#define AT_KT(i) (MOBA ? ((i) < 4 ? 4 * qb + (i) : (i) - 4 + kt_min) : (i) + kt_min)
#define AT_DMA(i, ksl, vsl) do { if ((i) >= NT) break; const long kt_ = AT_KT(i); glds16(ksrc + kt_ * KVBLK * DM, (unsigned)__builtin_amdgcn_readfirstlane(kdst + (ksl) * KSLOT)); \
        glds16(vsrc0 + kt_ * KVBLK * DM, (unsigned)__builtin_amdgcn_readfirstlane(vdst + (vsl) * L::VSLOT)); \
        if (NPV == 2) glds16(vsrc0 + kt_ * KVBLK * DM + 64, (unsigned)__builtin_amdgcn_readfirstlane(vdst + (vsl) * L::VSLOT + 8192)); } while (0)
#define AT_VRD(g_, d_) do { _Pragma("unroll") for (int ks = 0; ks < 4; ++ks) { vl[g_][ks] = vtr(vp + (d_) * 4096 + ks * 1024); vh[g_][ks] = vtr(vp + (d_) * 4096 + ks * 1024 + 512); } } while (0)
    bf16x8 qr[4];
#pragma unroll
    for (int d0 = 0; d0 < 4; ++d0) qr[d0] = *reinterpret_cast<const bf16x8*>(&Qw[(long)r32 * DM + d0 * 16 + hi * 8]);
    { _Pragma("unroll") for (int a = 0; a < AH; ++a) AT_DMA(a, a, a); }
    const lds_cptr kp0 = (lds_cptr)shm3 + L::LDS_K + hi * 1024 + r32 * 16;
    const lds_cptr vp0 = (lds_cptr)shm3 + L::LDS_V + ((lane >> 4) & 1) * 32 + (lane & 3) * 8 + (4 * hi + ((lane & 15) >> 2)) * 64;
    const unsigned sw = (unsigned)__builtin_amdgcn_readfirstlane((int)(f2bf_u(slope2) | (f2bf_u(slope2 - bf2f_u(f2bf_u(slope2))) << 16)));
    const unsigned hmask = hi == 0 ? 0xffffffffu : 0u;
    const unsigned off0w = (f2bf_u((float)r32) * 0x10001u) & hmask, off1w = (f2bf_u((float)(32 + r32)) * 0x10001u) & hmask;
    unsigned qz = 0u;
    if (FIXED) { const float mrow = mfix + slope2 * (float)(wid * 32 + r32);
                 const unsigned nh = f2bf_u(-mrow), nl = f2bf_u(-mrow - bf2f_u(nh)); qz = (nh | (nl << 16)) & hmask; }
    float mhat = 0.f;
    constexpr bool KPRE = (DV == 64);
    constexpr bool MSUM = (DV == 64);
    float l_reg = 0.f;
    lsum = f32x16{};
    const u32x4 ones4 = {0x3f803f80u, 0x3f803f80u, 0x3f803f80u, 0x3f803f80u};
#pragma unroll
    for (int d = 0; d < DV / 32; ++d) o[d] = f32x16{};
    const int qrel = wid * 32 + r32;
    int slot = 0, vslot = 0;
    constexpr int ND = DV / 32, NMF = 4 * ND, NEXP = 32 / NMF, NVS = AH + 3, PFD = (DV == 64 ? 8 : 6);
    u32x4 pwA[4] = {{0u, 0u, 0u, 0u}, {0u, 0u, 0u, 0u}, {0u, 0u, 0u, 0u}, {0u, 0u, 0u, 0u}}, pwB[4];
    u32x4 a0 = {off0w, 0u, 0x3f803f80u & hmask, 0u}, a1 = {off1w, 0u, 0x3f803f80u & hmask, 0u}, qv = {sw & hmask, sw & hmask, qz, 0u};
    const bool late = !KPRE && wid >= 4;
#define AT_PIN(x) asm volatile("" : "+v"(x))
#define AT_CE(e) ((e) < 16 ? c0[(e) & 15] : c1[(e) & 15])
#define AT_VOFF(g) (((g) >> 2) * 4096 + ((g) & 3) * 1024)
    f32x16 c0, c1; bool resc = false;
    bf16x8 kf[8];
#define AT_KRD(j_, SL_) do { const lds_cptr kp_ = kp0 + (SL_) * KSLOT; kf[2 * (j_)] = *(const __attribute__((address_space(3))) bf16x8*)(kp_ + (j_) * 2048); kf[2 * (j_) + 1] = *(const __attribute__((address_space(3))) bf16x8*)(kp_ + (j_) * 2048 + 512); } while (0)
#if AT_PROBE
    const bool prb = (blockIdx.x == 0) && (wid == AT_PROBE_WAVE) && (DV == AT_PROBE_DV) && FIXED; unsigned long long pt0 = 0, pacc[6] = {0, 0, 0, 0, 0, 0}, ps0 = 0, ps1 = 0;
#define AT_STAMP(x) do { AT_SBAR(); asm volatile("s_memtime %0\n\ts_waitcnt lgkmcnt(0)" : "=s"(x) :: "memory"); AT_SBAR(); } while (0)
#define AT_SEC(k) do { AT_STAMP(ps1); pacc[k] += ps1 - ps0; ps0 = ps1; } while (0)
    AT_STAMP(pt0); ps0 = pt0;
#else
#define AT_STAMP(x) do { } while (0)
#define AT_SEC(k) do { } while (0)
#endif
#define AT_PHA(T_) do { \
        if (!KPRE) { \
            _Pragma("unroll") for (int j = 0; j < 4; ++j) AT_KRD(j, slot); \
            AT_SBAR(); } \
        AT_SEC(0); \
        const int kt = AT_KT(T_); \
        const int jb = MOBA ? ((T_) < 4 ? (T_) : -1) : ((T_) - (NT - 4)); \
        { const unsigned tb = __float_as_uint((float)(64 * (kt - 4 * qb))) >> 16; \
          if (DV == 128) { a0 = (u32x4){off0w, 0u, 0x3f803f80u & hmask, 0u}; a1 = (u32x4){off1w, 0u, 0x3f803f80u & hmask, 0u}; qv = (u32x4){sw & hmask, sw & hmask, qz, 0u}; }     \
          a0.y = (tb * 0x10001u) & hmask; a1.y = a0.y; \
          qv.z = qz; \
          if (MOBA) { if (hi == 0 && (T_) >= 4 && !((sel >> (kt >> 2)) & 1u)) qv.z = 0x0000f14au; } \
          c0 = AT_MFMA(__builtin_bit_cast(bf16x8, a0), __builtin_bit_cast(bf16x8, qv), f32x16{}); c1 = AT_MFMA(__builtin_bit_cast(bf16x8, a1), __builtin_bit_cast(bf16x8, qv), f32x16{}); \
          _Pragma("unroll") for (int j = 0; j < 4; ++j) { c0 = AT_MFMA(kf[2 * j], qr[j], c0); c1 = AT_MFMA(kf[2 * j + 1], qr[j], c1); } } \
        if (jb >= 0) { asm volatile("" ::: "memory"); cmask(c0, c1, jb, qrel, hi); } \
        AT_PIN(c0); AT_PIN(c1); AT_SEC(1); \
        resc = false; \
        if (!FIXED) { const float rm = rowmax(c0, c1); const bool first = ((T_) == 0); \
          if (first || __any(rm > THR)) { \
              const float dl = first ? rm : __builtin_fmaxf(rm, 0.f); const float mnew = mhat + dl; \
              const unsigned nh = f2bf_u(-mnew), nl = f2bf_u(-mnew - bf2f_u(nh)); const float meff = -(bf2f_u(nh) + bf2f_u(nl)); \
              const float dle = meff - mhat; mhat = meff; qz = (nh | (nl << 16)) & hmask; \
              _Pragma("unroll") for (int r = 0; r < 16; ++r) { c0[r] -= dle; c1[r] -= dle; } \
              if (!first) { const float f = __builtin_amdgcn_exp2f(-dle); if (!MSUM) l_reg *= f; if (hi == 0) wsf[r32] = f; resc = true; } } } \
    } while (0)
#define AT_PHB(VS_, PIN_, POUT_, TN_) do { \
        float sacc = 0.f; \
        const lds_cptr vp = vp0 + (VS_) * L::VSLOT; \
        s16x4 vl[NMF], vh[NMF]; \
        _Pragma("unroll") for (int g = 0; g < PFD; ++g) { vl[g] = vtr(vp + AT_VOFF(g)); vh[g] = vtr(vp + AT_VOFF(g) + 512); } \
        AT_SBAR(); \
        _Pragma("unroll") for (int g = 0; g < NMF; ++g) { \
            if (g + PFD < NMF) { vl[g + PFD] = vtr(vp + AT_VOFF(g + PFD)); vh[g + PFD] = vtr(vp + AT_VOFF(g + PFD) + 512); } \
            { const bf16x8 vf = (bf16x8){vl[g][0], vl[g][1], vl[g][2], vl[g][3], vh[g][0], vh[g][1], vh[g][2], vh[g][3]}; \
              o[g >> 2] = AT_MFMA(__builtin_bit_cast(bf16x8, PIN_[g & 3]), vf, o[g >> 2]); } \
            if (KPRE && g < 4) AT_KRD(g, (slot == AH ? 0 : slot + 1));                                     \
            if (g == (KPRE ? 5 : 9)) { const int s2 = slot == 0 ? AH : slot - 1; int v2 = vslot + AH; v2 = v2 >= NVS ? v2 - NVS : v2; AT_DMA(TN_, s2, v2); }     \
            if (MSUM && (g & (ND - 1)) == ND - 1 && (g / ND) < 4) lsum = AT_MFMA(__builtin_bit_cast(bf16x8, PIN_[g / ND]), __builtin_bit_cast(bf16x8, ones4), lsum); \
            _Pragma("unroll") for (int x = 0; x < NEXP; x += 2) { const int e = g * NEXP + x; \
                const float p0 = __builtin_amdgcn_exp2f(AT_CE(e)), p1 = __builtin_amdgcn_exp2f(AT_CE(e + 1)); \
                if (!MSUM) { sacc += p0; sacc += p1; } POUT_[e >> 3][(e & 7) >> 1] = cvtpk_s(p0, p1); } \
            if (!MSUM) AT_PIN(sacc); AT_PIN(POUT_[(g * NEXP) >> 3]); \
            AT_SBAR(); } \
        if (resc) { \
            asm volatile("s_waitcnt lgkmcnt(0)" ::: "memory"); \
            _Pragma("unroll") for (int r = 0; r < 16; ++r) { const float f_ = wsf[crow(r, hi)]; if (MSUM) lsum[r] *= f_; _Pragma("unroll") for (int d = 0; d < ND; ++d) o[d][r] *= f_; } } \
        if (!MSUM) l_reg += sacc; \
        AT_PIN(POUT_[3]); AT_SEC(2); \
    } while (0)
#define AT_STEP_END(T_) do { { int na = NT - (KPRE ? 3 : 2) - (T_); na = na < 0 ? 0 : (na > AH - (KPRE ? 2 : 1) ? AH - (KPRE ? 2 : 1) : na); wait_bar_n(na * NPT); }     \
        slot = slot == AH ? 0 : slot + 1; vslot = vslot == NVS - 1 ? 0 : vslot + 1; AT_SEC(3); } while (0)
    wait_bar_n(((NT < AH ? NT : AH) - (KPRE ? 2 : 1)) * NPT);
    asm volatile("s_waitcnt vmcnt(0)" ::: "memory");
    asm volatile("" : "+v"(qr[0]), "+v"(qr[1]), "+v"(qr[2]), "+v"(qr[3]));
    if (KPRE) { _Pragma("unroll") for (int j = 0; j < 4; ++j) AT_KRD(j, 0); }
    int vlast; bool inA;
#define AT_VPREV1 (vslot == 0 ? NVS - 1 : vslot - 1)
#define AT_VPREV2 (vslot < 2 ? vslot + NVS - 2 : vslot - 2)
    if (!late) {
        int i = 0;
        for (; i + 1 < NT; i += 2) {
            AT_PHA(i);     AT_PHB(i == 0 ? 0 : AT_VPREV1, pwA, pwB, i + AH); AT_STEP_END(i);
            AT_PHA(i + 1); AT_PHB(AT_VPREV1, pwB, pwA, i + 1 + AH);      AT_STEP_END(i + 1);
        }
        inA = true;
        if (i < NT) { AT_PHA(i); AT_PHB(AT_VPREV1, pwA, pwB, i + AH); AT_STEP_END(i); inA = false; }
        vlast = AT_VPREV1;
    } else {
        { const int s2 = slot == 0 ? AH : slot - 1; int v2 = vslot + AH; v2 = v2 >= NVS ? v2 - NVS : v2; AT_DMA(AH, s2, v2); }
        AT_PHA(0); AT_STEP_END(0);
        int i = 1;
        for (; i + 1 < NT; i += 2) {
            AT_PHB(i == 1 ? 0 : AT_VPREV2, pwA, pwB, i + AH); AT_PHA(i);     AT_STEP_END(i);
            AT_PHB(AT_VPREV2, pwB, pwA, i + 1 + AH);      AT_PHA(i + 1); AT_STEP_END(i + 1);
        }
        inA = true;
        if (i < NT) { AT_PHB(i == 1 ? 0 : AT_VPREV2, pwA, pwB, i + AH); AT_PHA(i); AT_STEP_END(i); inA = false; }
        if (inA) { AT_PHB(AT_VPREV2, pwA, pwB, NT); inA = false; } else { AT_PHB(AT_VPREV2, pwB, pwA, NT); inA = true; }
        vlast = AT_VPREV1;
    }
#if AT_PROBE
    if (prb && lane == 0) { g_probe[0] += ps0 - pt0; g_probe[1] += pacc[0]; g_probe[2] += pacc[1]; g_probe[3] += pacc[2]; g_probe[4] += pacc[3]; g_probe[5] += (unsigned long long)NT; }
#endif
    if (!inA) {
#pragma unroll
        for (int k = 0; k < 4; ++k) pwA[k] = pwB[k];
    }
    { const lds_cptr vp = vp0 + vlast * L::VSLOT; s16x4 vl[2][4], vh[2][4];
      AT_VRD(0, 0); AT_SBAR();
#pragma unroll
      for (int d = 0; d < ND; ++d) {
          if (d + 1 < ND) AT_VRD((d + 1) & 1, d + 1);
          AT_SBAR();
#pragma unroll
          for (int ks = 0; ks < 4; ++ks) { const bf16x8 vf = (bf16x8){vl[d & 1][ks][0], vl[d & 1][ks][1], vl[d & 1][ks][2], vl[d & 1][ks][3], vh[d & 1][ks][0], vh[d & 1][ks][1], vh[d & 1][ks][2], vh[d & 1][ks][3]};
              o[d] = AT_MFMA(__builtin_bit_cast(bf16x8, pwA[ks]), vf, o[d]); }
          AT_SBAR(); }
      if (MSUM) {
#pragma unroll
          for (int ks = 0; ks < 4; ++ks) lsum = AT_MFMA(__builtin_bit_cast(bf16x8, pwA[ks]), __builtin_bit_cast(bf16x8, ones4), lsum); } }
    if (!MSUM) {
        auto rr = __builtin_amdgcn_permlane32_swap(__float_as_uint(l_reg), __float_as_uint(l_reg), false, false); const float lt = __uint_as_float(rr[0]) + __uint_as_float(rr[1]);
        if (hi == 0) wsf[32 + r32] = lt;
        asm volatile("s_waitcnt lgkmcnt(0)" ::: "memory");
#pragma unroll
        for (int r = 0; r < 16; ++r) lsum[r] = wsf[32 + crow(r, hi)];
    }
    AT_WAIT_BAR(0);
#undef AT_PIN
#undef AT_CE
#undef AT_VOFF
#undef AT_PHA
#undef AT_PHB
#undef AT_STEP_END
#undef AT_KRD
#undef AT_STAMP
#undef AT_SEC
#undef AT_VPREV1
#undef AT_VPREV2
#undef AT_KT
#undef AT_DMA
#undef AT_VRD
}

__device__ __forceinline__ int window_kt_min(const unsigned* nrm, int b, int chunk, int q0, float slope2, float& Bout) {
    const float nq = __uint_as_float(nrm[((0 * 2 + b) * 16 + chunk) * 2]) + __uint_as_float(nrm[((0 * 2 + b) * 16 + chunk) * 2 + 1]);
    const float nk = __uint_as_float(nrm[((1 * 2 + b) * 16 + chunk) * 2]) + __uint_as_float(nrm[((1 * 2 + b) * 16 + chunk) * 2 + 1]);
    const float B = sqrtf(nq * nk) * 1.01f; Bout = B;
    const float W = (2.0f * B + 160.0f) / slope2;
    const int wkeys = W < 1.0e6f ? (int)W : 1000000;
    const int d = q0 - wkeys;
    return d > 0 ? (d >> 6) : 0;
}
__device__ __forceinline__ void diff_item(char* shm, int b, int h, int qb, int m, const bf16* Q, const bf16* K, const bf16* V, bf16* O, float lam, const unsigned* nrm, unsigned* flag, unsigned* tmo) {
    typedef Lay<128, 2> L;
    int tid_ = threadIdx.x; asm volatile("" : "+v"(tid_));
    const int tid = tid_; const int wid = __builtin_amdgcn_readfirstlane(tid >> 6);
    const long rowbase = (long)b * SEQ; const int q0 = qb * 256;
    const float slope2 = __builtin_amdgcn_exp2f(-(float)(h + 1)) * 1.4426950408889634f;
    lam = __uint_as_float((unsigned)__builtin_amdgcn_readfirstlane((int)__float_as_uint(lam)));
    const lds_ptr shm3 = (lds_ptr)shm;
    __attribute__((address_space(3))) float* wsf = (__attribute__((address_space(3))) float*)(shm3 + L::LDS_WS) + wid * 64;
    __attribute__((address_space(3))) bf16* stg = (__attribute__((address_space(3))) bf16*)(shm3 + L::LDS_OST + wid * L::OSTW);
    f32x16 o[4], lsum;
    float Bq; const int kt_min = __builtin_amdgcn_readfirstlane(window_kt_min(nrm, b, 2 * h + m, q0, slope2, Bq));
    Bq = __uint_as_float((unsigned)__builtin_amdgcn_readfirstlane((int)__float_as_uint(Bq)));
    if (Bq <= 40.0f) sweep<128, false, 2, true>(shm, Q + (rowbase + q0 + wid * 32) * DM + h * 128 + m * 64, K + rowbase * DM + h * 128 + m * 64, V + rowbase * DM + h * 128, qb, kt_min, slope2, Bq, 0u, o, lsum);
    else sweep<128, false, 2, false>(shm, Q + (rowbase + q0 + wid * 32) * DM + h * 128 + m * 64, K + rowbase * DM + h * 128 + m * 64, V + rowbase * DM + h * 128, qb, kt_min, slope2, Bq, 0u, o, lsum);
    int lane_e = tid & 63; asm volatile("" : "+v"(lane_e));
    const int lane = lane_e, r32 = lane & 31, hi = lane >> 5;
    bf16* Ow = O + (rowbase + q0 + wid * 32) * DM + h * 128;
    float rli[16];
#pragma unroll
    for (int r = 0; r < 16; ++r) rli[r] = (m == 0 ? 1.0f : lam) * __builtin_amdgcn_rcpf(lsum[r]);
    if (m == 0) {
#pragma unroll
        for (int r = 0; r < 16; ++r)
#pragma unroll
            for (int d = 0; d < 4; ++d) stg[crow(r, hi) * 128 + d * 32 + r32] = (bf16)f2bf_u(o[d][r] * rli[r]);
        asm volatile("s_waitcnt lgkmcnt(0)" ::: "memory");
#pragma unroll
        for (int i = 0; i < 8; ++i) { const int row = i * 4 + (lane >> 4), ch = lane & 15; const u32x4 v = *(const __attribute__((address_space(3))) u32x4*)(stg + row * 128 + ch * 8); *(u32x4*)(Ow + (long)row * DM + ch * 8) = v; }
        asm volatile("s_waitcnt vmcnt(0)" ::: "memory");
        __syncthreads();
        if (tid == 0) { __builtin_amdgcn_fence(__ATOMIC_RELEASE, "agent"); asm volatile("s_waitcnt vmcnt(0)" ::: "memory"); __hip_atomic_store(flag, 1u, __ATOMIC_RELAXED, __HIP_MEMORY_SCOPE_AGENT); }
    } else {
        if (tid == 0) {
            unsigned sp = 0u;
            while (__hip_atomic_load(flag, __ATOMIC_RELAXED, __HIP_MEMORY_SCOPE_AGENT) == 0u) { __builtin_amdgcn_s_sleep(8); if (++sp > (1u << 22)) { __hip_atomic_store(tmo, 1u, __ATOMIC_RELAXED, __HIP_MEMORY_SCOPE_AGENT); break; } }
            __builtin_amdgcn_fence(__ATOMIC_ACQUIRE, "agent");
            asm volatile("s_waitcnt vmcnt(0)" ::: "memory");
        }
        __syncthreads();
#pragma unroll
        for (int i = 0; i < 8; ++i) { const int row = i * 4 + (lane >> 4), ch = lane & 15; const u32x4 v = *(const u32x4*)(Ow + (long)row * DM + ch * 8); *(__attribute__((address_space(3))) u32x4*)(stg + row * 128 + ch * 8) = v; }
        asm volatile("s_waitcnt vmcnt(0) lgkmcnt(0)" ::: "memory");
        float ss[16];
#pragma unroll
        for (int r = 0; r < 16; ++r) { float sq = 0.f;
#pragma unroll
            for (int d = 0; d < 4; ++d) { const float v = bf2f_u(stg[crow(r, hi) * 128 + d * 32 + r32]) - o[d][r] * rli[r]; o[d][r] = v; sq = __builtin_fmaf(v, v, sq); }
            ss[r] = sq; }
#pragma unroll
        for (int r = 0; r < 16; ++r) {
#pragma unroll
            for (int off = 1; off < 32; off <<= 1) ss[r] += __shfl_xor(ss[r], off);
            ss[r] = 1.0f / sqrtf(ss[r] * (1.0f / 128.0f) + 1e-6f); }
#pragma unroll
        for (int r = 0; r < 16; ++r)
#pragma unroll
            for (int d = 0; d < 4; ++d) stg[crow(r, hi) * 128 + d * 32 + r32] = (bf16)f2bf_u(o[d][r] * ss[r]);
        asm volatile("s_waitcnt lgkmcnt(0)" ::: "memory");
#pragma unroll
        for (int i = 0; i < 8; ++i) { const int row = i * 4 + (lane >> 4), ch = lane & 15; const u32x4 v = *(const __attribute__((address_space(3))) u32x4*)(stg + row * 128 + ch * 8); *(u32x4*)(Ow + (long)row * DM + ch * 8) = v; }
    }
}
__device__ __forceinline__ void moba_unit(char* shm, int b, int h, int qb, const bf16* Q, const bf16* K, const bf16* V, bf16* O, const float* KM, const unsigned* nrm) {
    typedef Lay<64, 4> L;
    int tid_ = threadIdx.x; asm volatile("" : "+v"(tid_));
    const int tid = tid_, lane = tid & 63, r32 = lane & 31, hi = lane >> 5; const int wid = __builtin_amdgcn_readfirstlane(tid >> 6);
    const long rowbase = (long)b * SEQ; const int q0 = qb * 256;
    const float slope2 = __builtin_amdgcn_exp2f(-0.5f * (float)(h + 1)) * 1.4426950408889634f;
    const lds_ptr shm3 = (lds_ptr)shm;
    __attribute__((address_space(3))) float* wsf = (__attribute__((address_space(3))) float*)(shm3 + L::LDS_WS) + wid * 64;
    __attribute__((address_space(3))) bf16* stg = (__attribute__((address_space(3))) bf16*)(shm3 + L::LDS_OST + wid * L::OSTW);
    const bf16* Qw = Q + (rowbase + q0 + wid * 32) * DM + h * 64;
    unsigned sel = 0u;
    if (qb > 0) {
        f32x16 g = f32x16{};
        const float* km = KM + (((long)b * 16 + h) * 32 + r32) * 64 + hi * 8;
#pragma unroll
        for (int d0 = 0; d0 < 4; ++d0) {
            const bf16x8 qf = *reinterpret_cast<const bf16x8*>(&Qw[(long)r32 * DM + d0 * 16 + hi * 8]);
            const float4 x0 = *(const float4*)(km + d0 * 16), x1 = *(const float4*)(km + d0 * 16 + 4);
            const float xs[8] = {x0.x, x0.y, x0.z, x0.w, x1.x, x1.y, x1.z, x1.w};
            unsigned hw[8], lw[8];
#pragma unroll
            for (int e = 0; e < 8; ++e) { hw[e] = f2bf_u(xs[e]); lw[e] = f2bf_u(xs[e] - bf2f_u(hw[e])); }
            const u32x4 ah = {hw[0] | (hw[1] << 16), hw[2] | (hw[3] << 16), hw[4] | (hw[5] << 16), hw[6] | (hw[7] << 16)};
            const u32x4 al = {lw[0] | (lw[1] << 16), lw[2] | (lw[3] << 16), lw[4] | (lw[5] << 16), lw[6] | (lw[7] << 16)};
            g = AT_MFMA(__builtin_bit_cast(bf16x8, ah), qf, g); g = AT_MFMA(__builtin_bit_cast(bf16x8, al), qf, g);
        }
        float g0[16], g1[16];
#pragma unroll
        for (int r = 0; r < 16; ++r) { auto rr = __builtin_amdgcn_permlane32_swap(__float_as_uint(g[r]), __float_as_uint(g[r]), false, false); g0[r] = __uint_as_float(rr[0]); g1[r] = __uint_as_float(rr[1]); }
        float b0 = -INFINITY, b1 = -INFINITY, b2 = -INFINITY; int i0 = 0, i1 = 0, i2 = 0;
#pragma unroll
        for (int n = 0; n < 32; ++n) {
            const int rn = 4 * (n >> 3) + (n & 3);
            float v = ((n >> 2) & 1) ? g1[rn] : g0[rn];
            if (n >= qb) v = -INFINITY;
            if (v > b0) { b2 = b1; i2 = i1; b1 = b0; i1 = i0; b0 = v; i0 = n; }
            else if (v > b1) { b2 = b1; i2 = i1; b1 = v; i1 = n; }
            else if (v > b2) { b2 = v; i2 = n; }
        }
        if (b0 > -INFINITY) sel |= 1u << i0;
        if (b1 > -INFINITY) sel |= 1u << i1;
        if (b2 > -INFINITY) sel |= 1u << i2;
    }
    f32x16 o[2], lsum;
    float Bq; const int kt_min = __builtin_amdgcn_readfirstlane(window_kt_min(nrm, b, h, q0, slope2, Bq));
    Bq = __uint_as_float((unsigned)__builtin_amdgcn_readfirstlane((int)__float_as_uint(Bq)));
    if (Bq <= 40.0f) sweep<64, true, 4, true>(shm, Qw, K + rowbase * DM + h * 64, V + rowbase * DM + h * 64, qb, kt_min, slope2, Bq, sel, o, lsum);
    else sweep<64, true, 4, false>(shm, Qw, K + rowbase * DM + h * 64, V + rowbase * DM + h * 64, qb, kt_min, slope2, Bq, sel, o, lsum);
    int lane_e = lane; asm volatile("" : "+v"(lane_e));
    { const int lane = lane_e, r32 = lane & 31, hi = lane >> 5;
#pragma unroll
    for (int r = 0; r < 16; ++r) { const float rl = __builtin_amdgcn_rcpf(lsum[r]);
#pragma unroll
        for (int d = 0; d < 2; ++d) stg[crow(r, hi) * 64 + d * 32 + r32] = (bf16)f2bf_u(o[d][r] * rl); }
    asm volatile("s_waitcnt lgkmcnt(0)" ::: "memory");
    bf16* Ow = O + (rowbase + q0 + wid * 32) * DM + h * 64;
#pragma unroll
    for (int i = 0; i < 4; ++i) { const int row = i * 8 + (lane >> 3), ch = lane & 7; const u32x4 v = *(const __attribute__((address_space(3))) u32x4*)(stg + row * 64 + ch * 8); *(u32x4*)(Ow + (long)row * DM + ch * 8) = v; }
    }
}
#undef AT_SBAR
#undef AT_WAIT_BAR
#undef AT_MX3
#undef AT_MFMA
}

constexpr int NWAVES = 8;
constexpr int RING_OFF = 0, RING_BYTES = 131072;
constexpr int LDSCTL_OFF = RING_BYTES, MISC_OFF = LDSCTL_OFF + 320;
constexpr int LDS_BYTES = RING_BYTES + 1024;
static_assert(attn::Lay<128, 2>::BYTES <= RING_BYTES && attn::Lay<64, 4>::BYTES <= RING_BYTES && LDS_BYTES <= 163840, "LDS budget");
static_assert(MISC_OFF + 128 <= LDS_BYTES, "LDS map");

struct Frame {
    LAS unsigned char* lds; volatile LAS unsigned* MISC; gu32* ctl;
    int tid, lane, wave, vcu, G;
};
__device__ __forceinline__ float wave_sum(float v) {
#pragma unroll
    for (int o = 1; o < 64; o <<= 1) v += __shfl_xor(v, o);
    return v;
}
__device__ __forceinline__ float bf2f(unsigned h) { return __builtin_bit_cast(float, h << 16); }

__device__ __forceinline__ void p0_transpose_item(const float* W, int K, int N, bf16* WT, LAS float* scr, int item, int lane, const float* gk, int gmask, float cmul, int qcols, float qscale) {
    const int nblk = N / 32, kb = item / nblk, nb = item % nblk, k0 = 64 * kb, n0 = 32 * nb;
    const float cs = cmul * ((n0 < qcols) ? qscale : 1.0f);
#pragma unroll 8
    for (int i = 0; i < 32; ++i) { const int kk = 2 * i + (lane >> 5); const float g = gk ? gk[(k0 + kk) & gmask] : 1.0f; scr[kk * 33 + (lane & 31)] = W[(size_t)(k0 + kk) * N + n0 + (lane & 31)] * (g * cs); }
    LDS_WAIT(); asm volatile("" ::: "memory");
    const int c = lane & 7;
#pragma unroll
    for (int j = 0; j < 4; ++j) { const int n = (lane >> 3) + 8 * j; const LAS float* s = scr + (8 * c) * 33 + n;
        v4u o; o.x = pk2(s[0 * 33], s[1 * 33]); o.y = pk2(s[2 * 33], s[3 * 33]); o.z = pk2(s[4 * 33], s[5 * 33]); o.w = pk2(s[6 * 33], s[7 * 33]);
        *(GAS v4u*)(WT + (size_t)(n0 + n) * K + k0 + 8 * c) = o; }
    LDS_WAIT(); asm volatile("" ::: "memory");
}
__device__ __forceinline__ void p0_x_row2(const float* xrow, bf16* hrow, float* ssq, int lane) {
    f32x4 v[2][4];
#pragma unroll
    for (int r = 0; r < 2; ++r)
#pragma unroll
        for (int j = 0; j < 4; ++j) v[r][j] = ((const GAS f32x4*)(xrow + (size_t)r * D) + lane)[64 * j];
#pragma unroll
    for (int r = 0; r < 2; ++r) { GAS unsigned long long* h8 = (GAS unsigned long long*)(hrow + (size_t)r * D) + lane; float s[4];
#pragma unroll
        for (int j = 0; j < 4; ++j) { h8[64 * j] = (unsigned long long)pk2(v[r][j].x, v[r][j].y) | ((unsigned long long)pk2(v[r][j].z, v[r][j].w) << 32);
            s[j] = wave_sum((v[r][j].x * v[r][j].x + v[r][j].y * v[r][j].y) + (v[r][j].z * v[r][j].z + v[r][j].w * v[r][j].w)); }
        if (lane < 16) { const int j = lane >> 2; const float sj = j == 0 ? s[0] : j == 1 ? s[1] : j == 2 ? s[2] : s[3]; ssq[r * 16 + lane] = (lane & 3) == 0 ? sj : 0.f; } }
}
__device__ __forceinline__ void final_row(const bf16* hrow, float* orow, const float* ssq, const float* g, int lane) {
    const float rs = pg8::row_rstd16(ssq, 0);
#pragma unroll
    for (int j = 0; j < 2; ++j) {
        const v4u hb = *((const GAS v4u*)(hrow + 512 * j) + lane);
        const GAS f32x4* gr = (const GAS f32x4*)(g + 512 * j) + 2 * lane; GAS f32x4* orr = (GAS f32x4*)(orow + 512 * j) + 2 * lane;
        f32x4 a = {bf2f(hb.x & 0xffffu), bf2f(hb.x >> 16), bf2f(hb.y & 0xffffu), bf2f(hb.y >> 16)}, b = {bf2f(hb.z & 0xffffu), bf2f(hb.z >> 16), bf2f(hb.w & 0xffffu), bf2f(hb.w >> 16)};
        orr[0] = a * rs * gr[0]; orr[1] = b * rs * gr[1];
    }
}

__device__ __forceinline__ void diff_attn_unit_simple(LAS unsigned char* lds, int b, int h, int qblk, const bf16* Q, const bf16* K, const bf16* V, bf16* O, float lam, int tid) {
    LAS float* Ks = (LAS float*)lds; LAS float* Vs = (LAS float*)(lds + 64 * 65 * 4);
    const int qi = tid >> 2, part = tid & 3, q0 = qblk * 128, t = q0 + qi;
    const size_t rowbase = (size_t)b * T;
    const float slope2 = exp2f(-(float)(h + 1)) * LOG2E;
    float ores[32], o0[32], l0 = 0.f;
#pragma unroll 1
    for (int m = 0; m < 2; ++m) {
        float q[16];
        { const bf16* qp = Q + (rowbase + t) * D + h * 128 + m * 64 + part * 16;
#pragma unroll
          for (int i = 0; i < 16; ++i) q[i] = bf2f(qp[i]); }
        float mrun = NEG_BIG, l = 0.f, o[32];
#pragma unroll
        for (int e = 0; e < 32; ++e) o[e] = 0.f;
        const int nkt = q0 / 64 + 2;
        for (int kt = 0; kt < nkt; ++kt) {
            const int kb = kt * 64;
            __syncthreads();
            { const int key = tid >> 3, seg = tid & 7;
              const bf16* kp = K + (rowbase + kb + key) * D + h * 128 + m * 64 + seg * 8;
#pragma unroll
              for (int i = 0; i < 8; ++i) Ks[key * 65 + seg * 8 + i] = bf2f(kp[i]);
              const bf16* vp = V + (rowbase + kb + key) * D + h * 128 + seg * 16;
#pragma unroll
              for (int i = 0; i < 16; ++i) Vs[key * 129 + seg * 16 + i] = bf2f(vp[i]); }
            __syncthreads();
            for (int key = 0; key < 64; ++key) {
                float s = 0.f;
#pragma unroll
                for (int i = 0; i < 16; ++i) s = fmaf(q[i], Ks[key * 65 + part * 16 + i], s);
                s += __shfl_xor(s, 1); s += __shfl_xor(s, 2);
                const int kpos = kb + key;
                s += slope2 * (float)(kpos - t);
                if (kpos > t) s = -INFINITY;
                const float mn = fmaxf(mrun, s);
                const float alpha = exp2f(mrun - mn), p = exp2f(s - mn);
                mrun = mn; l = l * alpha + p;
#pragma unroll
                for (int e = 0; e < 32; ++e) o[e] = fmaf(p, Vs[key * 129 + part * 32 + e], o[e] * alpha);
            }
        }
        if (m == 0) {
#pragma unroll
            for (int e = 0; e < 32; ++e) o0[e] = o[e];
            l0 = l;
        } else {
            const float i0 = 1.0f / l0, i1 = lam / l;
#pragma unroll
            for (int e = 0; e < 32; ++e) ores[e] = o0[e] * i0 - o[e] * i1;
        }
    }
    float ss = 0.f;
#pragma unroll
    for (int e = 0; e < 32; ++e) ss = fmaf(ores[e], ores[e], ss);
    ss += __shfl_xor(ss, 1); ss += __shfl_xor(ss, 2);
    const float rs = 1.0f / sqrtf(ss * (1.0f / 128.0f) + RMS_EPS);
    bf16* op = O + (rowbase + t) * D + h * 128 + part * 32;
#pragma unroll
    for (int e = 0; e < 32; e += 2) *(unsigned*)(op + e) = pk2(ores[e] * rs, ores[e + 1] * rs);
    __syncthreads();
}
__device__ __forceinline__ void moba_unit_simple(int b, int h, int qblk, const bf16* Q, const bf16* K, const bf16* V, bf16* O, const float* KM, int tid) {
    const int qi = tid >> 2, part = tid & 3, q0 = qblk * 128, t = q0 + qi, j = q0 / 256;
    const size_t rowbase = (size_t)b * T;
    const float slope2 = exp2f(-0.5f * (float)(h + 1)) * LOG2E;
    float q[16];
    { const bf16* qp = Q + (rowbase + t) * D + h * 64 + part * 16;
#pragma unroll
      for (int i = 0; i < 16; ++i) q[i] = bf2f(qp[i]); }
    float b0 = -INFINITY, b1 = -INFINITY, b2 = -INFINITY; int i0 = 0, i1 = 0, i2 = 0;
    for (int n = 0; n < j; ++n) {
        const float* km = KM + (((size_t)b * 16 + h) * 32 + n) * 64 + part * 16;
        float g = 0.f;
#pragma unroll
        for (int i = 0; i < 16; ++i) g = fmaf(q[i], km[i], g);
        g += __shfl_xor(g, 1); g += __shfl_xor(g, 2);
        if (g > b0) { b2 = b1; i2 = i1; b1 = b0; i1 = i0; b0 = g; i0 = n; }
        else if (g > b1) { b2 = b1; i2 = i1; b1 = g; i1 = n; }
        else if (g > b2) { b2 = g; i2 = n; }
    }
    const int nsel = j < 3 ? j : 3;
    float mrun = NEG_BIG, l = 0.f, o[16];
#pragma unroll
    for (int e = 0; e < 16; ++e) o[e] = 0.f;
    for (int seg = 0; seg <= nsel; ++seg) {
        const int blk = seg == 0 ? j : (seg == 1 ? i0 : (seg == 2 ? i1 : i2));
        const int kb = blk * 256;
        for (int key = 0; key < 256; ++key) {
            const int kpos = kb + key;
            const bf16* kp = K + (rowbase + kpos) * D + h * 64 + part * 16;
            float s = 0.f;
#pragma unroll
            for (int i = 0; i < 16; ++i) s = fmaf(q[i], bf2f(kp[i]), s);
            s += __shfl_xor(s, 1); s += __shfl_xor(s, 2);
            s += slope2 * (float)(kpos - t);
            if (kpos > t) s = -INFINITY;
            const float mn = fmaxf(mrun, s);
            const float alpha = exp2f(mrun - mn), p = exp2f(s - mn);
            mrun = mn; l = l * alpha + p;
            const bf16* vp = V + (rowbase + kpos) * D + h * 64 + part * 16;
#pragma unroll
            for (int e = 0; e < 16; ++e) o[e] = fmaf(p, bf2f(vp[e]), o[e] * alpha);
        }
    }
    const float il = 1.0f / l;
    bf16* op = O + (rowbase + t) * D + h * 64 + part * 16;
#pragma unroll
    for (int e = 0; e < 16; e += 2) *(unsigned*)(op + e) = pk2(o[e] * il, o[e + 1] * il);
}

#define REP_QKV 1
#define REP_DIFF 1
#define REP_MOBA 1
#define REP_FF1 1
#define REP_PRO 1
#define REP_BAR 1
struct Args { const float* in[10]; float* out; unsigned char* ws; };
__global__ void __launch_bounds__(NWAVES * 64, 2) fwd_kernel(Args args) {
    extern __shared__ __attribute__((aligned(16))) unsigned char lds[];
    Frame F;
    F.lds = (LAS unsigned char*)lds;
    F.MISC = (volatile LAS unsigned*)(F.lds + MISC_OFF);
    F.tid = threadIdx.x; F.lane = F.tid & 63; F.wave = __builtin_amdgcn_readfirstlane(F.tid >> 6);
    F.G = gridDim.x; { const int bx = blockIdx.x; F.vcu = (F.G % 8 == 0) ? (bx % 8) * (F.G / 8) + bx / 8 : bx; }
    unsigned char* ws = args.ws;
    F.ctl = (gu32*)(ws + WS_CTL);
#define PTRS() \
    unsigned long long z_ = 0ull; asm volatile("" : "+s"(z_)); unsigned char* wsl = args.ws + z_; float* out = args.out + z_;     \
    bf16* WIN = (bf16*)(wsl + WS_WIN); bf16* WOUT = (bf16*)(wsl + WS_WOUT); bf16* WFF1 = (bf16*)(wsl + WS_WFF1); bf16* WFF2 = (bf16*)(wsl + WS_WFF2); \
    float* SSQ = (float*)(wsl + WS_SSQ); float* KM = (float*)(wsl + WS_KMEAN); \
    bf16* HB = (bf16*)(wsl + WS_HB); bf16* Qb = (bf16*)(wsl + WS_Q); bf16* Kb = (bf16*)(wsl + WS_K); bf16* Vb = (bf16*)(wsl + WS_V); bf16* Ob = (bf16*)(wsl + WS_O); \
    bf16* ACT = (bf16*)(wsl + WS_ACT); \
    (void)WIN; (void)WOUT; (void)WFF1; (void)WFF2; (void)SSQ; (void)KM; (void)HB; (void)Qb; (void)Kb; (void)Vb; (void)Ob; (void)ACT; (void)out
    for (int u = F.tid; u < (LDS_BYTES - LDSCTL_OFF) / 4; u += NWAVES * 64) ((LAS unsigned*)(F.lds + LDSCTL_OFF))[u] = 0u;
    __syncthreads();
    XcdBarrier bar = xcd_barrier_post((unsigned*)(F.ctl + CW_BAR), F.MISC + 8);
#define GRID_BAR() do { for (int rb_ = 0; rb_ < REP_BAR; ++rb_) xcd_barrier(bar); } while (0)
    const int gw = F.vcu * NWAVES + F.wave, NGW = F.G * NWAVES;

    {
        PTRS();
        const float* x = args.in[0]; const float* attn_norm = args.in[1]; const float* w_in = args.in[2]; const float* w_out = args.in[3];
        const float* diff_subln = args.in[5]; const float* mlp_norm = args.in[6]; const float* w_ff1 = args.in[7]; const float* w_ff2 = args.in[8];
        int ln = threadIdx.x & 63; asm volatile("" : "+v"(ln));
        LAS float* scr = (LAS float*)(F.lds + RING_OFF + F.wave * 16384);
        constexpr int I_IN = (D / 64) * (NQKV / 32), I_OUT = (D / 64) * (D / 32), I_F1 = (D / 64) * (FF / 32), I_F2 = (FF / 64) * (D / 32);
        constexpr int PER_L = I_IN + I_OUT + I_F1 + I_F2;
        for (int rp_ = 0; rp_ < REP_PRO; ++rp_) {
        for (int it = gw; it < 2 * PER_L; it += NGW) {
            const int l = it / PER_L; int r = it % PER_L;
            if (r < I_IN) { p0_transpose_item(w_in + (size_t)l * D * NQKV, D, NQKV, WIN + (size_t)l * NQKV * D, scr, r, ln, attn_norm + l * D, D - 1, 1.0f, D, QSCALE); continue; } r -= I_IN;
            if (r < I_OUT) { p0_transpose_item(w_out + (size_t)l * D * D, D, D, WOUT + (size_t)l * D * D, scr, r, ln, l == 0 ? diff_subln : nullptr, 127, l == 0 ? 0.8f : 1.0f, 0, 1.0f); continue; } r -= I_OUT;
            if (r < I_F1) { p0_transpose_item(w_ff1 + (size_t)l * D * FF, D, FF, WFF1 + (size_t)l * FF * D, scr, r, ln, mlp_norm + l * D, D - 1, 1.0f, 0, 1.0f); continue; } r -= I_F1;
            p0_transpose_item(w_ff2 + (size_t)l * FF * D, FF, D, WFF2 + (size_t)l * D * FF, scr, r, ln, nullptr, 0, 1.0f, 0, 1.0f);
        }
        for (int m = 2 * gw; m < M; m += 2 * NGW) p0_x_row2(x + (size_t)m * D, HB + (size_t)m * D, SSQ + (size_t)m * 16, ln);
        }
    }
    GRID_BAR();

#pragma unroll 1
    for (int l = 0; l < 2; ++l) {
        {
            PTRS();
            pg8::Gemm g{HB, WIN + (size_t)l * NQKV * D, M, NQKV, D}; pg8::StaticOrder S; S.init(M, NQKV, F.G, (int)blockIdx.x);
            pg8::EpiScaleBf16<0> E{Qb, D, SSQ, D, (size_t)M * D, l == 1 ? (float*)(F.ctl + CW_KMS) : nullptr, (unsigned*)(F.ctl + CW_NRM + l * 256)};
            for (int rep = 0; rep < REP_QKV; ++rep)
            pg8::gemm_phase<pg8::EpiScaleBf16<0>, pg8::StaticOrder, PG8_ALIGN, PG8_SP2>(F.lds + RING_OFF, g, S, E);
        }
        GRID_BAR();
        if (l == 0) {
            PTRS();
            const float* lp = args.in[4];
            int lnl = threadIdx.x & 63; asm volatile("" : "+v"(lnl));
            const float la = wave_sum(lp[lnl] * lp[64 + lnl]), lc = wave_sum(lp[128 + lnl] * lp[192 + lnl]);
            const float lam = expf(la) - expf(lc) + 0.2f;
            for (int rep = 0; rep < REP_DIFF; ++rep)
            for (;;) {
                if (F.tid == 0) F.MISC[16] = __hip_atomic_fetch_add(F.ctl + CW_QUEUE + 64 * rep, 1u, RLX_AGENT);
                __syncthreads();
                const int i = (int)F.MISC[16];
                __syncthreads();
                if (i >= 1024) break;
                const int u = i >> 1, bh = u & 15, qb = 31 - (u >> 4);
                attn::diff_item((char*)lds + RING_OFF, bh >> 3, bh & 7, qb, i & 1, Qb, Kb, Vb, Ob, lam, (const unsigned*)(F.ctl + CW_NRM), (unsigned*)(F.ctl + CW_DFLAG + rep * 512 + u), (unsigned*)(F.ctl + CW_BAR) + XB_TMO);
            }
        } else {
            PTRS();
            const float* KMf = (const float*)(F.ctl + CW_KMS);
            for (int rep = 0; rep < REP_MOBA; ++rep)
            for (;;) {
                if (F.tid == 0) F.MISC[16] = __hip_atomic_fetch_add(F.ctl + CW_QUEUE + 64 * (4 + rep), 1u, RLX_AGENT);
                __syncthreads();
                const int i = (int)F.MISC[16];
                __syncthreads();
                if (i >= 1024) break;
                const int bh = i & 31, qb = 31 - (i >> 5);
                attn::moba_unit((char*)lds + RING_OFF, bh >> 4, bh & 15, qb, Qb, Kb, Vb, Ob, KMf, (const unsigned*)(F.ctl + CW_NRM + 256));
            }
        }
        GRID_BAR();
        {
            PTRS();
            pg8::Gemm g{Ob, WOUT + (size_t)l * D * D, M, D, D}; pg8::StaticOrder S; S.init(M, D, F.G, (int)blockIdx.x);
            pg8::EpiRes<false> E{out, HB, SSQ, D};
            pg8::gemm_phase<pg8::EpiRes<false>, pg8::StaticOrder, PG8_ALIGN, PG8_SP2>(F.lds + RING_OFF, g, S, E);
        }
        GRID_BAR();
        {
            PTRS();
            pg8::Gemm g{HB, WFF1 + (size_t)l * FF * D, M, FF, D}; pg8::StaticOrder S; S.init(M, FF, F.G, (int)blockIdx.x);
            pg8::EpiScaleBf16<1> E{ACT, FF, SSQ, 0, 0, nullptr, nullptr};
            for (int rep = 0; rep < REP_FF1; ++rep)
            pg8::gemm_phase<pg8::EpiScaleBf16<1>, pg8::StaticOrder, PG8_ALIGN, PG8_SP2>(F.lds + RING_OFF, g, S, E);
        }
        GRID_BAR();
        {
            PTRS();
            pg8::Gemm g{ACT, WFF2 + (size_t)l * D * FF, M, D, FF}; pg8::StaticOrder S; S.init(M, D, F.G, (int)blockIdx.x);
            pg8::EpiRes<false> E{out, HB, SSQ, D}; pg8::gemm_phase<pg8::EpiRes<false>, pg8::StaticOrder, PG8_ALIGN, PG8_SP2>(F.lds + RING_OFF, g, S, E);
        }
        GRID_BAR();
    }
    PTRS(); const float* final_norm = args.in[9]; int lnf = threadIdx.x & 63; asm volatile("" : "+v"(lnf));
#if AT_PROBE
    float pscale;
    { const float tot = (float)attn::g_probe[0];
      float xv = AT_PROBE <= 4 ? (float)attn::g_probe[AT_PROBE] / tot : (tot / (float)attn::g_probe[5]) * (1.0f / 10000.0f);
      xv = floorf(xv * AT_PROBE_Q + 0.5f) * (1.0f / AT_PROBE_Q);
      pscale = 1.0f + 0.1f + 0.9f * xv; }
#endif
    for (int m = gw; m < M; m += NGW) final_row(HB + (size_t)m * D, out + (size_t)m * D, SSQ + (size_t)m * 16, final_norm, lnf);
#if AT_PROBE
    __syncthreads();
    for (int m = gw; m < M; m += NGW) { GAS f32x4* orr = (GAS f32x4*)(out + (size_t)m * D) + F.lane;
        for (int j = 0; j < 4; ++j) orr[64 * j] = orr[64 * j] * pscale; }
#endif
    if (xb_ld((unsigned*)(F.ctl + CW_BAR) + XB_TMO) != 0u && blockIdx.x == 0) { const float qn = __builtin_nanf(""); for (int i = F.tid; i < 4096; i += NWAVES * 64) out[i] = qn; }
}

extern "C" void kernel_launch(void* const* d_in, const int* in_sizes, int n_in, void* d_out, int out_size, void* d_ws, size_t ws_size, hipStream_t stream) {
    static int grid = 0;
    if (grid == 0) {
        if (n_in != 10 || in_sizes[0] != M * D || out_size != M * D || ws_size < WS_END) { fprintf(stderr, "kernel_launch: unexpected shapes (n_in %d out %d ws %zu); nothing launched\n", n_in, out_size, ws_size); grid = -1; return; }
        int dev = 0, cus = 0, per_cu = 0;
        if (hipGetDevice(&dev) != hipSuccess || hipDeviceGetAttribute(&cus, hipDeviceAttributeMultiprocessorCount, dev) != hipSuccess) { fprintf(stderr, "kernel_launch: device query failed\n"); grid = -1; return; }
        if (hipFuncSetAttribute((const void*)fwd_kernel, hipFuncAttributeMaxDynamicSharedMemorySize, LDS_BYTES) != hipSuccess) { fprintf(stderr, "kernel_launch: hipFuncSetAttribute failed\n"); grid = -1; return; }
        if (hipOccupancyMaxActiveBlocksPerMultiprocessor(&per_cu, (const void*)fwd_kernel, NWAVES * 64, LDS_BYTES) != hipSuccess || per_cu < 1) { fprintf(stderr, "kernel_launch: occupancy query reports %d workgroups per CU\n", per_cu); per_cu = 1; }
        (void)hipGetLastError();
        grid = cus;
    }
    if (grid < 0) return;
    if (hipMemsetAsync((char*)d_ws + WS_CTL, 0, CTL_ZERO_BYTES, stream) != hipSuccess) { fprintf(stderr, "kernel_launch: hipMemsetAsync failed\n"); return; }
    Args a{};
    for (int i = 0; i < 10; ++i) a.in[i] = (const float*)d_in[i];
    a.out = (float*)d_out; a.ws = (unsigned char*)d_ws;
    hipLaunchKernelGGL(fwd_kernel, dim3(grid), dim3(NWAVES * 64), LDS_BYTES, stream, a);
    const hipError_t le = hipPeekAtLastError();
    if (le != hipSuccess) fprintf(stderr, "kernel_launch: launch failed: %s\n", hipGetErrorName(le));
}
```

```cpp
#include <hip/hip_runtime.h>
#include <cstdio>
#include <cstdint>

constexpr int BATCH = 2, T = 8192, D = 1024, M = BATCH * T, FF = 4096, NQKV = 3 * D;
constexpr float RMS_EPS = 1e-6f;
constexpr float LOG2E = 1.4426950408889634f;
constexpr float QSCALE = 0.125f * LOG2E;
constexpr float NEG_BIG = -1e30f;

constexpr size_t MiB = 1u << 20;
constexpr size_t WS_CTL = 0, CTL_ZERO_BYTES = 1 * MiB;
constexpr size_t WS_WIN = 1 * MiB;
constexpr size_t WS_WOUT = 13 * MiB;
constexpr size_t WS_WFF1 = 17 * MiB;
constexpr size_t WS_WFF2 = 33 * MiB;
constexpr size_t WS_SSQ = 49 * MiB;
constexpr size_t WS_KMEAN = 50 * MiB;
constexpr size_t WS_HB = 51 * MiB;
constexpr size_t WS_Q = 83 * MiB, WS_K = 115 * MiB, WS_V = 147 * MiB, WS_O = 179 * MiB;
constexpr size_t WS_ACT = 83 * MiB;
constexpr size_t WS_END = 211 * MiB;
constexpr int CW_TMO = 0, CW_CODE = 1, CW_BAR = 4096;
constexpr int CW_NRM = 8192;
constexpr int CW_DFLAG = 12288;
constexpr int CW_KMS = 32768;
constexpr int CW_QUEUE = 9216;
namespace pg8 {
#define PG8_LAS __attribute__((address_space(3)))
typedef unsigned short bf16_t;
typedef short bf16x8 __attribute__((ext_vector_type(8)));
typedef float f32x4 __attribute__((ext_vector_type(4)));
typedef unsigned u32x4 __attribute__((ext_vector_type(4)));
constexpr int BM = 256, BK = 64, HALF = 128, HTB = HALF * BK * 2  , STAGE_BYTES = 8 * HTB, NXCD = 8, WGM = 8;

__host__ __device__ __forceinline__ int lds_byte(int r, int c) { const int st = (r >> 4) * 2 + (c >> 5), rr = r & 15, cc = c & 31, ob = rr * 64 + cc * 2; return st * 1024 + (ob ^ (((ob >> 9) & 1) << 5)); }
__host__ __device__ __forceinline__ void stage_rc(int b, int& R, int& C) { const int st = b / 1024, sb = b % 1024, swz = sb ^ (((sb >> 9) & 1) << 5); R = (st >> 1) * 16 + swz / 64; C = (st & 1) * 32 + (swz % 64) / 2; }
__host__ __device__ __forceinline__ int perm32(int rho) { const int n = rho >> 4, i = rho & 15; return 8 * (i >> 2) + 4 * n + (i & 3); }

struct Unit { int pm, pn; };
struct Gemm { const bf16_t* A; const bf16_t* Bt; int M, N, K; };

struct StaticOrder {
    int nM, nN, nwg, G, c;
    __host__ __device__ void init(int M, int N, int G_, int c_) { nM = M / BM; nN = N / BM; nwg = nM * nN; G = G_; c = c_; }
    __host__ __device__ bool next(int i, Unit& u) const {
        const long L = (long)i * G + c; if (L >= nwg) return false;
        int wgid = (int)L; { const int q = nwg / NXCD, r = nwg % NXCD, xcd = wgid % NXCD, off = wgid / NXCD; wgid = (xcd < r ? xcd * (q + 1) : r * (q + 1) + (xcd - r) * q) + off; }
        const int nig = WGM * nN, gid = wgid / nig, fm = gid * WGM, gsz = (nM - fm) < WGM ? (nM - fm) : WGM;
        u.pm = fm + ((wgid % nig) % gsz); u.pn = (wgid % nig) / gsz; return true;
    }
    __device__ __forceinline__ void a_ready(const Unit&) const {}
    __device__ __forceinline__ void done(const Unit&) const {}
};


__device__ __forceinline__ unsigned cvt_pk_bf16(float lo, float hi) { unsigned r; asm volatile("v_cvt_pk_bf16_f32 %0, %1, %2" : "=v"(r) : "v"(lo), "v"(hi)); return r; }
__device__ __forceinline__ float row_rstd16(const float* SSQ, int row) {
    const f32x4* p = (const f32x4*)(SSQ + (size_t)row * 16);
    const f32x4 a = p[0], b = p[1], c = p[2], d = p[3];
    const float s = ((a[0] + a[1]) + (a[2] + a[3])) + ((b[0] + b[1]) + (b[2] + b[3])) + ((c[0] + c[1]) + (c[2] + c[3])) + ((d[0] + d[1]) + (d[2] + d[3]));
    return 1.0f / sqrtf(s * (1.0f / 1024.0f) + 1e-6f);
}
template <int ACT> struct EpiScaleBf16 {
    static constexpr bool PERM = true, AFTER_DRAIN = false;
    bf16_t* O; int ldc; const float* SSQ; int split_cols; size_t split_stride;
    float* KMS;
    unsigned* NRM;
    __device__ __forceinline__ void operator()(const f32x4 (&acc)[2][2][4][2], const Unit& u, int wr, int wc, int fr, int fq) const {
        const int row0 = u.pm * BM + wr * 64 + fr; int colt = u.pn * BM; bf16_t* base = O; int t = 0;
        if (split_cols) { t = colt / split_cols; base += (size_t)t * split_stride; colt -= t * split_cols; }
        const int col0 = colt + wc * 32 + 8 * fq;
        const int lane = fq * 16 + fr; float myrs[2];
#pragma unroll
        for (int ai = 0; ai < 2; ++ai) myrs[ai] = row_rstd16(SSQ, u.pm * BM + wr * 64 + ai * HALF + lane);
        asm volatile("" : "+v"(myrs[0]), "+v"(myrs[1]));
        float mx[2] = {0.f, 0.f};
        f32x4 ks[2][2] = {{{0.f, 0.f, 0.f, 0.f}, {0.f, 0.f, 0.f, 0.f}}, {{0.f, 0.f, 0.f, 0.f}, {0.f, 0.f, 0.f, 0.f}}};
#pragma unroll
        for (int ai = 0; ai < 2; ++ai)
#pragma unroll
            for (int m = 0; m < 4; ++m) { const int row = row0 + ai * HALF + m * 16; const float rs = __shfl(myrs[ai], m * 16 + fr); bf16_t* rowp = base + (size_t)row * ldc + col0;
#pragma unroll
                for (int bj = 0; bj < 2; ++bj) { f32x4 v0 = acc[ai][bj][m][0] * rs, v1 = acc[ai][bj][m][1] * rs;
                    if (ACT == 1) {
#pragma unroll
                        for (int e = 0; e < 4; ++e) { const float a = __builtin_fmaxf(v0[e], 0.f), b = __builtin_fmaxf(v1[e], 0.f); v0[e] = a * a; v1[e] = b * b; } }
                    if (ACT == 0 && KMS && t == 1) { ks[bj][0] += v0; ks[bj][1] += v1; }
                    if (ACT == 0 && NRM && t < 2) { float q = (v0[0] * v0[0] + v0[1] * v0[1]) + (v0[2] * v0[2] + v0[3] * v0[3]) + (v1[0] * v1[0] + v1[1] * v1[1]) + (v1[2] * v1[2] + v1[3] * v1[3]);
                        q += __shfl_xor(q, 16); q += __shfl_xor(q, 32); mx[bj] = __builtin_fmaxf(mx[bj], q); }
                    u32x4 w; w.x = cvt_pk_bf16(v0[0], v0[1]); w.y = cvt_pk_bf16(v0[2], v0[3]); w.z = cvt_pk_bf16(v1[0], v1[1]); w.w = cvt_pk_bf16(v1[2], v1[3]);
                    *(u32x4*)(rowp + bj * HALF) = w; } }
        if (ACT == 0 && KMS && t == 1) {
#pragma unroll
            for (int bj = 0; bj < 2; ++bj)
#pragma unroll
                for (int n = 0; n < 2; ++n)
#pragma unroll
                    for (int e = 0; e < 4; ++e) { float q = ks[bj][n][e];
#pragma unroll
                        for (int o = 1; o < 16; o <<= 1) q += __shfl_xor(q, o);
                        const int col = colt + bj * HALF + wc * 32 + 8 * fq + 4 * n + e;
                        if (fr == 0) atomicAdd(KMS + ((((size_t)(u.pm >> 5) * 16 + (col >> 6)) * 32 + (u.pm & 31)) * 64 + (col & 63)), q * (1.0f / 256.0f)); }
        }
        if (ACT == 0 && NRM && t < 2) {
#pragma unroll
            for (int bj = 0; bj < 2; ++bj) { float q = mx[bj];
#pragma unroll
                for (int o = 1; o < 16; o <<= 1) q = __builtin_fmaxf(q, __shfl_xor(q, o));
                const int col = colt + bj * HALF + wc * 32;
                if (lane == 0) atomicMax(NRM + (((t * 2 + (u.pm >> 5)) * 16 + (col >> 6)) * 2 + ((col >> 5) & 1)), __float_as_uint(q)); }
        }
    }
};
template <bool LAST> struct EpiRes {
    static constexpr bool PERM = false, AFTER_DRAIN = false;
    float* out; bf16_t* HB; float* SSQ; int ldc;
    __device__ __forceinline__ void operator()(const f32x4 (&acc)[2][2][4][2], const Unit& u, int wr, int wc, int fr, int fq) const {
        typedef unsigned u32x2v __attribute__((ext_vector_type(2)));
        const int col0 = u.pn * BM + wc * 32 + 4 * fq;
#pragma unroll
        for (int ai = 0; ai < 2; ++ai)
#pragma unroll
            for (int m = 0; m < 4; ++m) { const int row = u.pm * BM + ai * HALF + wr * 64 + m * 16 + fr; const size_t off = (size_t)row * ldc + col0; float s = 0.f;
#pragma unroll
                for (int bj = 0; bj < 2; ++bj)
#pragma unroll
                    for (int n = 0; n < 2; ++n) { const size_t o2 = off + bj * HALF + n * 16; const u32x2v hb = *(const u32x2v*)(HB + o2);
                        f32x4 h = acc[ai][bj][m][n];
                        h[0] += __builtin_bit_cast(float, hb.x << 16); h[1] += __builtin_bit_cast(float, hb.x & 0xffff0000u); h[2] += __builtin_bit_cast(float, hb.y << 16); h[3] += __builtin_bit_cast(float, hb.y & 0xffff0000u);
                        if (LAST) *(f32x4*)(out + o2) = h;
                        else { u32x2v w; w.x = cvt_pk_bf16(h[0], h[1]); w.y = cvt_pk_bf16(h[2], h[3]); *(u32x2v*)(HB + o2) = w; }
                        s += (h[0] * h[0] + h[1] * h[1]) + (h[2] * h[2] + h[3] * h[3]); }
                s += __shfl_xor(s, 16); s += __shfl_xor(s, 32);
                if (fq == 0) SSQ[(size_t)row * 16 + u.pn * 4 + wc] = s;
                if (m & 1) asm volatile("" ::: "memory"); }
    }
};
template <class Epi, class Sched, bool ALIGN_EPI = false, bool SP2 = false>
__device__ __forceinline__ void gemm_phase(PG8_LAS unsigned char* lds, const Gemm g, const Sched& S, const Epi& E) {
    int tid_ = threadIdx.x; asm volatile("" : "+v"(tid_));
    const int tid = tid_, wid = __builtin_amdgcn_readfirstlane(tid >> 6), lane = tid & 63, wr = wid >> 2, wc = wid & 3, fr = lane & 15, fq = lane >> 4;
    const int K = g.K, nt = K / BK;
    unsigned voffA[2], voffB[2];
#pragma unroll
    for (int i = 0; i < 2; ++i) { int R, C; stage_rc(tid * 16 + i * 8192, R, C); const int Rb = Epi::PERM ? ((R & ~31) + perm32(R & 31)) : R;
        voffA[i] = (unsigned)(R * K + C) * 2u; voffB[i] = (unsigned)(Rb * K + C) * 2u; }
    const size_t kstep = (size_t)(BK * 2);
    const size_t hstep = (size_t)HALF * K * 2;
    const size_t tstep = 2 * hstep;
    const unsigned ldsw = (unsigned)wid * 1024u;
    const int aoff = lds_byte(wr * 64 + fr, fq * 8), boff = lds_byte(wc * 32 + fr, fq * 8);
#define PG8_SA(b, h) (((b) * 2 + (h)) * HTB)
#define PG8_SB(b, h) ((4 + (b) * 2 + (h)) * HTB)
#define PG8_STAGE(bufoff, gbase, voff) do { _Pragma("unroll") for (int _i = 0; _i < 2; ++_i) \
        __builtin_amdgcn_global_load_lds((const unsigned*)((const char*)(gbase) + (voff)[_i]), (PG8_LAS unsigned*)(lds + (bufoff) + ldsw + _i * 8192), 16, 0, 0); } while (0)
#define PG8_LDA(dst, b, h) do { _Pragma("unroll") for (int m = 0; m < 4; ++m) _Pragma("unroll") for (int k = 0; k < 2; ++k) dst[m][k] = *(const PG8_LAS bf16x8*)(lds + PG8_SA(b, h) + aoff + m * 2048 + k * 1024); } while (0)
#define PG8_LDB(dst, b, h) do { _Pragma("unroll") for (int n = 0; n < 2; ++n) _Pragma("unroll") for (int k = 0; k < 2; ++k) dst[n][k] = *(const PG8_LAS bf16x8*)(lds + PG8_SB(b, h) + boff + n * 2048 + k * 1024); } while (0)
#define PG8_MMA(ai, bj, At, Bt) do { __builtin_amdgcn_s_setprio(1); _Pragma("unroll") for (int m = 0; m < 4; ++m) _Pragma("unroll") for (int n = 0; n < 2; ++n) _Pragma("unroll") for (int k = 0; k < 2; ++k) \
        acc[ai][bj][m][n] = __builtin_amdgcn_mfma_f32_16x16x32_bf16(Bt[n][k], At[m][k], acc[ai][bj][m][n], 0, 0, 0); __builtin_amdgcn_s_setprio(0); } while (0)
#define PG8_WAIT_V(n) asm volatile("s_waitcnt vmcnt(" #n ")" ::: "memory")
#define PG8_WAIT_L(n) asm volatile("s_waitcnt lgkmcnt(" #n ")" ::: "memory")
#define PG8_BAR __builtin_amdgcn_s_barrier()
#define PG8_SCHED __builtin_amdgcn_sched_barrier(0)
    Unit cur, nxt; int ui = 0;
    if (!S.next(0, cur)) return;
    f32x4 acc[2][2][4][2];
#pragma unroll
    for (int a = 0; a < 2; ++a)
#pragma unroll
        for (int b = 0; b < 2; ++b)
#pragma unroll
            for (int m = 0; m < 4; ++m)
#pragma unroll
                for (int n = 0; n < 2; ++n) acc[a][b][m][n] = (f32x4){0.f, 0.f, 0.f, 0.f};
    bf16x8 At[4][2], B0[2][2], B1[2][2];
    const char* cA = (const char*)g.A + (size_t)cur.pm * tstep; const char* cB = (const char*)g.Bt + (size_t)cur.pn * tstep;
    S.a_ready(cur);
    if constexpr (SP2) {
        PG8_STAGE(PG8_SB(0, 0), cB, voffB); PG8_STAGE(PG8_SB(0, 1), cB + hstep, voffB); PG8_STAGE(PG8_SA(0, 0), cA, voffA); PG8_STAGE(PG8_SA(0, 1), cA + hstep, voffA);
        if (wr == 1) PG8_BAR;
        PG8_WAIT_V(2); PG8_BAR;
        PG8_STAGE(PG8_SB(1, 0), cB + kstep, voffB); PG8_STAGE(PG8_SA(1, 0), cA + kstep, voffA); PG8_STAGE(PG8_SB(1, 1), cB + hstep + kstep, voffB);
        PG8_WAIT_V(6); PG8_BAR;
    } else {
        PG8_STAGE(PG8_SB(0, 0), cB, voffB); PG8_STAGE(PG8_SA(0, 0), cA, voffA); PG8_STAGE(PG8_SB(0, 1), cB + hstep, voffB); PG8_STAGE(PG8_SA(0, 1), cA + hstep, voffA);
        if (wr == 1) PG8_BAR;
        PG8_WAIT_V(4); PG8_BAR;
        PG8_STAGE(PG8_SB(1, 0), cB + kstep, voffB); PG8_STAGE(PG8_SA(1, 0), cA + kstep, voffA); PG8_STAGE(PG8_SB(1, 1), cB + hstep + kstep, voffB);
        PG8_WAIT_V(6); PG8_BAR;
    }
    for (;;) {
        const bool has_next = S.next(ui + 1, nxt);
        const char* nA = has_next ? (const char*)g.A + (size_t)nxt.pm * tstep : cA; const char* nB = has_next ? (const char*)g.Bt + (size_t)nxt.pn * tstep : cB;
        for (int t = 0; t < nt; t += 2) {
            const bool last = (t == nt - 2);
            const char* a1 = cA + (size_t)(t + 1) * kstep;
            const char* a2 = last ? nA : cA + (size_t)(t + 2) * kstep; const char* b2 = last ? nB : cB + (size_t)(t + 2) * kstep;
            const char* a3 = a2 + kstep; const char* b3 = b2 + kstep;
            if (last && has_next) S.a_ready(nxt);
            if constexpr (SP2) {
            PG8_LDB(B0, 0, 0); PG8_LDB(B1, 0, 1); PG8_SCHED; PG8_LDA(At, 0, 0); PG8_STAGE(PG8_SA(1, 1), a1 + hstep, voffA);
            PG8_WAIT_V(8); PG8_WAIT_L(0); PG8_BAR; PG8_MMA(0, 0, At, B0); PG8_MMA(0, 1, At, B1); PG8_BAR; PG8_SCHED;
            PG8_LDA(At, 0, 1); PG8_STAGE(PG8_SB(0, 0), b2, voffB); PG8_STAGE(PG8_SB(0, 1), b2 + hstep, voffB); PG8_STAGE(PG8_SA(0, 0), a2, voffA);
            PG8_WAIT_V(8); PG8_WAIT_L(0); PG8_BAR; PG8_MMA(1, 0, At, B0); PG8_MMA(1, 1, At, B1); PG8_BAR; PG8_SCHED;
            PG8_LDB(B0, 1, 0); PG8_LDB(B1, 1, 1); PG8_SCHED; PG8_LDA(At, 1, 0); PG8_STAGE(PG8_SA(0, 1), a2 + hstep, voffA);
            PG8_WAIT_V(8); PG8_WAIT_L(0); PG8_BAR; PG8_MMA(0, 0, At, B0); PG8_MMA(0, 1, At, B1); PG8_BAR; PG8_SCHED;
            PG8_LDA(At, 1, 1); PG8_STAGE(PG8_SB(1, 0), b3, voffB); PG8_STAGE(PG8_SB(1, 1), b3 + hstep, voffB); PG8_STAGE(PG8_SA(1, 0), a3, voffA);
            PG8_WAIT_V(8); PG8_WAIT_L(0); PG8_BAR; PG8_MMA(1, 0, At, B0); PG8_MMA(1, 1, At, B1); PG8_BAR; PG8_SCHED;
            } else {
            PG8_LDB(B0, 0, 0); PG8_SCHED; PG8_LDA(At, 0, 0); PG8_STAGE(PG8_SA(1, 1), a1 + hstep, voffA);
            PG8_WAIT_L(8); PG8_BAR; PG8_WAIT_L(0); PG8_MMA(0, 0, At, B0); PG8_BAR; PG8_SCHED;
            PG8_LDB(B1, 0, 1); PG8_STAGE(PG8_SB(0, 0), b2, voffB);
            PG8_BAR; PG8_WAIT_L(0); PG8_MMA(0, 1, At, B1); PG8_BAR;
            PG8_LDA(At, 0, 1); PG8_STAGE(PG8_SA(0, 0), a2, voffA);
            PG8_BAR; PG8_WAIT_L(0); PG8_MMA(1, 0, At, B0); PG8_BAR; PG8_SCHED;
            PG8_STAGE(PG8_SB(0, 1), b2 + hstep, voffB);
            PG8_WAIT_V(6); PG8_BAR; PG8_MMA(1, 1, At, B1); PG8_BAR;
            PG8_LDB(B0, 1, 0); PG8_SCHED; PG8_LDA(At, 1, 0); PG8_STAGE(PG8_SA(0, 1), a2 + hstep, voffA);
            PG8_WAIT_L(8); PG8_BAR; PG8_WAIT_L(0); PG8_MMA(0, 0, At, B0); PG8_BAR; PG8_SCHED;
            PG8_LDB(B1, 1, 1); PG8_STAGE(PG8_SB(1, 0), b3, voffB);
            PG8_BAR; PG8_WAIT_L(0); PG8_MMA(0, 1, At, B1); PG8_BAR;
            PG8_LDA(At, 1, 1); PG8_STAGE(PG8_SA(1, 0), a3, voffA);
            PG8_BAR; PG8_WAIT_L(0); PG8_MMA(1, 0, At, B0); PG8_BAR; PG8_SCHED;
            PG8_STAGE(PG8_SB(1, 1), b3 + hstep, voffB);
            PG8_WAIT_V(6); PG8_BAR; PG8_MMA(1, 1, At, B1); PG8_BAR;
            }
        }
        if constexpr (ALIGN_EPI) { if (wr == 0) PG8_BAR; }
        if constexpr (!Epi::AFTER_DRAIN) { E(acc, cur, wr, wc, fr, fq); S.done(cur); }
        if (!has_next) break;
#pragma unroll
        for (int a = 0; a < 2; ++a)
#pragma unroll
            for (int b = 0; b < 2; ++b)
#pragma unroll
                for (int m = 0; m < 4; ++m)
#pragma unroll
                    for (int n = 0; n < 2; ++n) acc[a][b][m][n] = (f32x4){0.f, 0.f, 0.f, 0.f};
        cur = nxt; cA = nA; cB = nB; ++ui;
        if constexpr (ALIGN_EPI) { if (wr == 1) PG8_BAR; }
    }
    PG8_WAIT_V(0);
    if constexpr (!ALIGN_EPI) { if (wr == 0) PG8_BAR; }
    PG8_BAR;
    if constexpr (Epi::AFTER_DRAIN) { E.fused(acc, cur, wr, wc, fr, fq, lds, wid, lane); S.done(cur); }
#undef PG8_SA
#undef PG8_SB
#undef PG8_STAGE
#undef PG8_LDA
#undef PG8_LDB
#undef PG8_MMA
#undef PG8_WAIT_V
#undef PG8_WAIT_L
#undef PG8_BAR
#undef PG8_SCHED
}
}

#ifndef PG8_SP2
#define PG8_SP2 true
#endif
#ifndef PG8_ALIGN
#define PG8_ALIGN true
#endif
#define GAS __attribute__((address_space(1)))
#define LAS __attribute__((address_space(3)))
typedef unsigned short bf16;
typedef unsigned v4u __attribute__((ext_vector_type(4)));
typedef float f32x4 __attribute__((ext_vector_type(4)));
typedef short bf16x8 __attribute__((ext_vector_type(8)));
typedef GAS unsigned gu32;
typedef GAS unsigned long long gu64;
#define RLX_AGENT __ATOMIC_RELAXED, __HIP_MEMORY_SCOPE_AGENT
#define LDS_WAIT() asm volatile("s_waitcnt lgkmcnt(0)" ::: "memory")
#define VM_WAIT() asm volatile("s_waitcnt vmcnt(0)" ::: "memory")
__device__ __forceinline__ unsigned long long rt() { return __builtin_amdgcn_s_memrealtime(); }
__device__ __forceinline__ unsigned f2bf(float f) { unsigned u = __builtin_bit_cast(unsigned, f); return (u + 0x7fffu + ((u >> 16) & 1u)) >> 16; }
__device__ __forceinline__ unsigned pk2(float lo, float hi) { return f2bf(lo) | (f2bf(hi) << 16); }

#define XB_TMO      128
#define XB_XCNT(j)  (256  + 64 * (j))
#define XB_XSUB(j)  (1280 + 64 * (j))
#define XB_XGEN(j)  (2304 + 64 * (j))
#define XB_TOP      3328
#define XB_TOPGEN   3392
#define XCD_BAR_WORDS 3456
#define XB_SPIN_CAP (1u << 18)

__device__ __forceinline__ unsigned xb_ld(unsigned* p)              { return __hip_atomic_load(p, __ATOMIC_RELAXED, __HIP_MEMORY_SCOPE_AGENT); }
__device__ __forceinline__ unsigned xb_add(unsigned* p, unsigned v) { return __hip_atomic_fetch_add(p, v, __ATOMIC_RELAXED, __HIP_MEMORY_SCOPE_AGENT); }
__device__ __forceinline__ unsigned xb_xcc_id() { return (unsigned)__builtin_amdgcn_s_getreg((3 << 11) | 20) & 0xFu; }
#define XB_SPIN(cond, bar) do { unsigned _sp = 0; while (cond) { __builtin_amdgcn_s_sleep(1); \
    if ((++_sp & 255u) == 0u) { if (xb_ld(&(bar)[XB_TMO])) break; if (_sp > XB_SPIN_CAP) { atomicAdd(&(bar)[XB_TMO], 1u); break; } } } } while (0)

struct XcdBarrier {
    unsigned* bar; unsigned x;
    volatile LAS unsigned* st;
};

__device__ __forceinline__ XcdBarrier xcd_barrier_post(unsigned* bar, volatile LAS unsigned* st) {
    XcdBarrier b; b.bar = bar; b.x = xb_xcc_id(); b.st = st;
    if (threadIdx.x == 0) (void)xb_add(&bar[XB_XCNT(b.x)], 1u);
    return b;
}
__device__ __forceinline__ void xcd_barrier_complete(unsigned* bar, unsigned x, unsigned& nloc, unsigned& nx) {
    const unsigned G = gridDim.x * gridDim.y * gridDim.z;
    unsigned sum, cnt, mine, sp = 0u;
    for (;;) {
        sum = 0u; cnt = 0u; mine = 0u;
#pragma unroll
        for (unsigned j = 0; j < 16; ++j) { const unsigned c = xb_ld(&bar[XB_XCNT(j)]); sum += c; cnt += (c > 0u) ? 1u : 0u; mine = (j == x) ? c : mine; }
        if (sum == G) break;
        __builtin_amdgcn_s_sleep(1);
        if ((++sp & 255u) == 0u) { if (xb_ld(&bar[XB_TMO])) break; if (sp > XB_SPIN_CAP) { atomicAdd(&bar[XB_TMO], 1u); break; } }
    }
    nloc = mine > 0u ? mine : 1u; nx = cnt > 0u ? cnt : 1u;
}

__device__ __forceinline__ void xcd_barrier(const XcdBarrier& b) {
    asm volatile("s_waitcnt vmcnt(0)" ::: "memory");
    __syncthreads();
    if (threadIdx.x == 0) {
        unsigned* bar = b.bar; unsigned bx_ = b.x; asm volatile("" : "+s"(bx_));
        __builtin_amdgcn_s_waitcnt(0);
        unsigned nloc = b.st[0], nx = b.st[1];
        if (nloc == 0u) { xcd_barrier_complete(bar, bx_, nloc, nx); b.st[0] = nloc; b.st[1] = nx; }
        const unsigned old = xb_add(&bar[XB_XSUB(bx_)], 1u);
        const unsigned gen = old / nloc;
        if (old + 1u == (gen + 1u) * nloc) {
            __builtin_amdgcn_fence(__ATOMIC_RELEASE, "agent");
            asm volatile("s_waitcnt vmcnt(0)" ::: "memory");
            const unsigned og = xb_add(&bar[XB_TOP], 1u);
            const unsigned tg = og / nx;
            if (og + 1u == (tg + 1u) * nx) xb_add(&bar[XB_TOPGEN], 1u);
            else XB_SPIN(xb_ld(&bar[XB_TOPGEN]) == tg, bar);
            __builtin_amdgcn_fence(__ATOMIC_ACQUIRE, "agent");
            xb_add(&bar[XB_XGEN(bx_)], 1u);
            asm volatile("s_waitcnt vmcnt(0)" ::: "memory");
        } else {
            XB_SPIN(xb_ld(&bar[XB_XGEN(bx_)]) == gen, bar);
            __builtin_amdgcn_fence(__ATOMIC_ACQUIRE, "agent");
            asm volatile("s_waitcnt vmcnt(0)" ::: "memory");
        }
    }
    __syncthreads();
}

namespace attn {
typedef unsigned short bf16;
using bf16x8 = __attribute__((ext_vector_type(8))) short;
using s16x4 = __attribute__((ext_vector_type(4))) short;
using f32x16 = __attribute__((ext_vector_type(16))) float;
using u32x4 = __attribute__((ext_vector_type(4))) unsigned;
typedef __attribute__((address_space(3))) const char* lds_cptr;
typedef __attribute__((address_space(3))) char* lds_ptr;
typedef short v4i16_t __attribute__((ext_vector_type(4)));
constexpr int DM = 1024, SEQ = 8192, KVBLK = 64;
constexpr int KSLOT = 8192;
constexpr float THR = 8.0f;
template <int DV, int AH> struct Lay {
    static constexpr int VSLOT = DV * 128, NKSLOT = AH + 1, NVSLOT = AH + 3, LDS_K = 0, LDS_V = NKSLOT * KSLOT, LDS_WS = LDS_V + NVSLOT * VSLOT, OSTW = 32 * DV * 2,
        LDS_OST = LDS_V  , BYTES = LDS_WS + 8 * 256;
    static_assert(8 * OSTW <= NVSLOT * VSLOT, "O stages fit inside the V ring");
};
#define AT_SBAR() __builtin_amdgcn_sched_barrier(0)
#define AT_WAIT_BAR(N) asm volatile("s_waitcnt vmcnt(" #N ") lgkmcnt(0)\n\ts_barrier" ::: "memory")
__device__ __forceinline__ void wait_bar_n(int n) {
    switch (n) {
        case 0: AT_WAIT_BAR(0); break; case 1: AT_WAIT_BAR(1); break; case 2: AT_WAIT_BAR(2); break; case 3: AT_WAIT_BAR(3); break;
        case 4: AT_WAIT_BAR(4); break; case 5: AT_WAIT_BAR(5); break; case 6: AT_WAIT_BAR(6); break; case 7: AT_WAIT_BAR(7); break;
        case 8: AT_WAIT_BAR(8); break; case 9: AT_WAIT_BAR(9); break; case 10: AT_WAIT_BAR(10); break; case 11: AT_WAIT_BAR(11); break;
        case 12: AT_WAIT_BAR(12); break; case 13: AT_WAIT_BAR(13); break; case 14: AT_WAIT_BAR(14); break; default: AT_WAIT_BAR(15); break;
    }
}
__device__ __forceinline__ int crow(int r, int hi) { return (r & 3) + 8 * (r >> 2) + 4 * hi; }
__device__ __forceinline__ unsigned f2bf_u(float f) { unsigned u = __builtin_bit_cast(unsigned, f); return (u + 0x7fffu + ((u >> 16) & 1u)) >> 16; }
__device__ __forceinline__ float bf2f_u(unsigned h) { return __builtin_bit_cast(float, h << 16); }
__device__ __forceinline__ void glds16(const void* gsrc, unsigned lds_dst) { unsigned keep;
    asm volatile("s_mov_b32 %0, m0\n\ts_mov_b32 m0, %2\n\ts_nop 0\n\tglobal_load_lds_dwordx4 %1, off\n\ts_mov_b32 m0, %0" : "=&s"(keep) : "v"(gsrc), "s"(lds_dst) : "memory"); }
typedef float f32x2_t __attribute__((ext_vector_type(2))); typedef __bf16 bf16x2_t __attribute__((ext_vector_type(2)));
__device__ __forceinline__ unsigned cvtpk_s(float lo, float hi) { f32x2_t v = {lo, hi}; bf16x2_t b = __builtin_convertvector(v, bf16x2_t); return __builtin_bit_cast(unsigned, b); }
__device__ __forceinline__ s16x4 vtr(lds_cptr p) { return __builtin_bit_cast(s16x4, __builtin_amdgcn_ds_read_tr16_b64_v4i16((__attribute__((address_space(3))) v4i16_t*)p)); }
#define AT_MX3(a, b, c) __builtin_fmaxf(__builtin_fmaxf((a), (b)), (c))
#define AT_MFMA(a, b, c) __builtin_amdgcn_mfma_f32_32x32x16_bf16(a, b, c, 0, 0, 0)
__device__ __forceinline__ float rowmax(const f32x16& p0, const f32x16& p1) {
    float a = AT_MX3(p0[0], p0[1], p1[0]), b = AT_MX3(p0[2], p0[3], p1[1]); a = AT_MX3(a, p1[2], p1[3]);
#pragma unroll
    for (int r = 4; r < 16; r += 4) { a = AT_MX3(a, p0[r], p0[r + 1]); b = AT_MX3(b, p0[r + 2], p0[r + 3]); a = AT_MX3(a, p1[r], p1[r + 1]); b = AT_MX3(b, p1[r + 2], p1[r + 3]); }
    float m = __builtin_fmaxf(a, b); auto rr = __builtin_amdgcn_permlane32_swap(__float_as_uint(m), __float_as_uint(m), false, false);
    return __builtin_fmaxf(__uint_as_float(rr[0]), __uint_as_float(rr[1])); }
__device__ __forceinline__ void cmask(f32x16& p0, f32x16& p1, int jb, int qrel, int hi) {
    const int lim = qrel - 64 * jb - 4 * hi;
#pragma unroll
    for (int r = 0; r < 16; ++r) { const int kv = (r & 3) + 8 * (r >> 2); if (kv > lim) p0[r] = -INFINITY; if (kv + 32 > lim) p1[r] = -INFINITY; } }

template <int DV, bool MOBA, int AH, bool FIXED>
__device__ __forceinline__ void sweep(char* shm, const bf16* Qw, const bf16* __restrict__ Kh, const bf16* __restrict__ Vh, int qb, int kt_min, float slope2, float mfix, unsigned sel, f32x16 (&o)[DV / 32], f32x16& lsum) {
    typedef Lay<DV, AH> L;
    constexpr int NPV = DV / 64, NPT = 1 + NPV;
    int tid_ = threadIdx.x; asm volatile("" : "+v"(tid_));
    const int tid = tid_, lane = tid & 63, r32 = lane & 31, hi = lane >> 5; const int wid = __builtin_amdgcn_readfirstlane(tid >> 6);
    const unsigned lds0 = (unsigned)(uintptr_t)shm;
    const lds_ptr shm3 = (lds_ptr)shm;
    __attribute__((address_space(3))) float* wsf = (__attribute__((address_space(3))) float*)(shm3 + L::LDS_WS) + wid * 64;
    const int NT = 4 * qb + 4 - kt_min;
    const bf16* ksrc = Kh + (long)lane * DM + wid * 8;
    const bf16* vsrc0 = Vh + (long)(16 * (wid & 3) + (lane >> 2)) * DM + (wid >> 2) * 32 + (lane & 3) * 8;
    const unsigned kdst = lds0 + L::LDS_K + wid * 1024, vdst = lds0 + L::LDS_V + wid * 1024;
#define AT_KT(i) (MOBA ? ((i) < 4 ? 4 * qb + (i) : (i) - 4 + kt_min) : (i) + kt_min)
#define AT_DMA(i, ksl, vsl) do { if ((i) >= NT) break; const long kt_ = AT_KT(i); glds16(ksrc + kt_ * KVBLK * DM, (unsigned)__builtin_amdgcn_readfirstlane(kdst + (ksl) * KSLOT)); \
        glds16(vsrc0 + kt_ * KVBLK * DM, (unsigned)__builtin_amdgcn_readfirstlane(vdst + (vsl) * L::VSLOT)); \
        if (NPV == 2) glds16(vsrc0 + kt_ * KVBLK * DM + 64, (unsigned)__builtin_amdgcn_readfirstlane(vdst + (vsl) * L::VSLOT + 8192)); } while (0)
#define AT_VRD(g_, d_) do { _Pragma("unroll") for (int ks = 0; ks < 4; ++ks) { vl[g_][ks] = vtr(vp + (d_) * 4096 + ks * 1024); vh[g_][ks] = vtr(vp + (d_) * 4096 + ks * 1024 + 512); } } while (0)
    bf16x8 qr[4];
#pragma unroll
    for (int d0 = 0; d0 < 4; ++d0) qr[d0] = *reinterpret_cast<const bf16x8*>(&Qw[(long)r32 * DM + d0 * 16 + hi * 8]);
    { _Pragma("unroll") for (int a = 0; a < AH; ++a) AT_DMA(a, a, a); }
    const lds_cptr kp0 = (lds_cptr)shm3 + L::LDS_K + hi * 1024 + r32 * 16;
    const lds_cptr vp0 = (lds_cptr)shm3 + L::LDS_V + ((lane >> 4) & 1) * 32 + (lane & 3) * 8 + (4 * hi + ((lane & 15) >> 2)) * 64;
    const unsigned sw = (unsigned)__builtin_amdgcn_readfirstlane((int)(f2bf_u(slope2) | (f2bf_u(slope2 - bf2f_u(f2bf_u(slope2))) << 16)));
    const unsigned hmask = hi == 0 ? 0xffffffffu : 0u;
    const unsigned off0w = (f2bf_u((float)r32) * 0x10001u) & hmask, off1w = (f2bf_u((float)(32 + r32)) * 0x10001u) & hmask;
    unsigned qz = 0u;
    if (FIXED) { const float mrow = mfix + slope2 * (float)(wid * 32 + r32);
                 const unsigned nh = f2bf_u(-mrow), nl = f2bf_u(-mrow - bf2f_u(nh)); qz = (nh | (nl << 16)) & hmask; }
    float mhat = 0.f;
    constexpr bool KPRE = (DV == 64);
    constexpr bool MSUM = (DV == 64);
    float l_reg = 0.f;
    lsum = f32x16{};
    const u32x4 ones4 = {0x3f803f80u, 0x3f803f80u, 0x3f803f80u, 0x3f803f80u};
#pragma unroll
    for (int d = 0; d < DV / 32; ++d) o[d] = f32x16{};
    const int qrel = wid * 32 + r32;
    int slot = 0, vslot = 0;
    constexpr int ND = DV / 32, NMF = 4 * ND, NEXP = 32 / NMF, NVS = AH + 3, PFD = (DV == 64 ? 8 : 6);
    u32x4 pwA[4] = {{0u, 0u, 0u, 0u}, {0u, 0u, 0u, 0u}, {0u, 0u, 0u, 0u}, {0u, 0u, 0u, 0u}}, pwB[4];
    u32x4 a0 = {off0w, 0u, 0x3f803f80u & hmask, 0u}, a1 = {off1w, 0u, 0x3f803f80u & hmask, 0u}, qv = {sw & hmask, sw & hmask, qz, 0u};
    const bool late = !KPRE && wid >= 4;
#define AT_PIN(x) asm volatile("" : "+v"(x))
#define AT_CE(e) ((e) < 16 ? c0[(e) & 15] : c1[(e) & 15])
#define AT_VOFF(g) (((g) >> 2) * 4096 + ((g) & 3) * 1024)
    f32x16 c0, c1; bool resc = false;
    bf16x8 kf[8];
#define AT_KRD(j_, SL_) do { const lds_cptr kp_ = kp0 + (SL_) * KSLOT; kf[2 * (j_)] = *(const __attribute__((address_space(3))) bf16x8*)(kp_ + (j_) * 2048); kf[2 * (j_) + 1] = *(const __attribute__((address_space(3))) bf16x8*)(kp_ + (j_) * 2048 + 512); } while (0)
#define AT_PHA(T_) do { \
        if (!KPRE) { \
            _Pragma("unroll") for (int j = 0; j < 4; ++j) AT_KRD(j, slot); \
            AT_SBAR(); } \
        const int kt = AT_KT(T_); \
        const int jb = MOBA ? ((T_) < 4 ? (T_) : -1) : ((T_) - (NT - 4)); \
        { const unsigned tb = __float_as_uint((float)(64 * (kt - 4 * qb))) >> 16; \
          if (DV == 128) { a0 = (u32x4){off0w, 0u, 0x3f803f80u & hmask, 0u}; a1 = (u32x4){off1w, 0u, 0x3f803f80u & hmask, 0u}; qv = (u32x4){sw & hmask, sw & hmask, qz, 0u}; }     \
          a0.y = (tb * 0x10001u) & hmask; a1.y = a0.y; \
          qv.z = qz; \
          if (MOBA) { if (hi == 0 && (T_) >= 4 && !((sel >> (kt >> 2)) & 1u)) qv.z = 0x0000f14au; } \
          c0 = AT_MFMA(__builtin_bit_cast(bf16x8, a0), __builtin_bit_cast(bf16x8, qv), f32x16{}); c1 = AT_MFMA(__builtin_bit_cast(bf16x8, a1), __builtin_bit_cast(bf16x8, qv), f32x16{}); \
          _Pragma("unroll") for (int j = 0; j < 4; ++j) { c0 = AT_MFMA(kf[2 * j], qr[j], c0); c1 = AT_MFMA(kf[2 * j + 1], qr[j], c1); } } \
        if (jb >= 0) { asm volatile("" ::: "memory"); cmask(c0, c1, jb, qrel, hi); } \
        resc = false; \
        if (!FIXED) { const float rm = rowmax(c0, c1); const bool first = ((T_) == 0); \
          if (first || __any(rm > THR)) { \
              const float dl = first ? rm : __builtin_fmaxf(rm, 0.f); const float mnew = mhat + dl; \
              const unsigned nh = f2bf_u(-mnew), nl = f2bf_u(-mnew - bf2f_u(nh)); const float meff = -(bf2f_u(nh) + bf2f_u(nl)); \
              const float dle = meff - mhat; mhat = meff; qz = (nh | (nl << 16)) & hmask; \
              _Pragma("unroll") for (int r = 0; r < 16; ++r) { c0[r] -= dle; c1[r] -= dle; } \
              if (!first) { const float f = __builtin_amdgcn_exp2f(-dle); if (!MSUM) l_reg *= f; if (hi == 0) wsf[r32] = f; resc = true; } } } \
    } while (0)
#define AT_PHB(VS_, PIN_, POUT_, TN_) do { \
        float sacc = 0.f; \
        const lds_cptr vp = vp0 + (VS_) * L::VSLOT; \
        s16x4 vl[NMF], vh[NMF]; \
        _Pragma("unroll") for (int g = 0; g < PFD; ++g) { vl[g] = vtr(vp + AT_VOFF(g)); vh[g] = vtr(vp + AT_VOFF(g) + 512); } \
        AT_SBAR(); \
        _Pragma("unroll") for (int g = 0; g < NMF; ++g) { \
            if (g + PFD < NMF) { vl[g + PFD] = vtr(vp + AT_VOFF(g + PFD)); vh[g + PFD] = vtr(vp + AT_VOFF(g + PFD) + 512); } \
            { const bf16x8 vf = (bf16x8){vl[g][0], vl[g][1], vl[g][2], vl[g][3], vh[g][0], vh[g][1], vh[g][2], vh[g][3]}; \
              o[g >> 2] = AT_MFMA(__builtin_bit_cast(bf16x8, PIN_[g & 3]), vf, o[g >> 2]); } \
            if (KPRE && g < 4) AT_KRD(g, (slot == AH ? 0 : slot + 1));                                     \
            if (g == (KPRE ? 5 : 9)) { const int s2 = slot == 0 ? AH : slot - 1; int v2 = vslot + AH; v2 = v2 >= NVS ? v2 - NVS : v2; AT_DMA(TN_, s2, v2); }     \
            if (MSUM && (g & (ND - 1)) == ND - 1 && (g / ND) < 4) lsum = AT_MFMA(__builtin_bit_cast(bf16x8, PIN_[g / ND]), __builtin_bit_cast(bf16x8, ones4), lsum); \
            _Pragma("unroll") for (int x = 0; x < NEXP; x += 2) { const int e = g * NEXP + x; \
                const float p0 = __builtin_amdgcn_exp2f(AT_CE(e)), p1 = __builtin_amdgcn_exp2f(AT_CE(e + 1)); \
                if (!MSUM) { sacc += p0; sacc += p1; } POUT_[e >> 3][(e & 7) >> 1] = cvtpk_s(p0, p1); } \
            if (!MSUM) AT_PIN(sacc); AT_PIN(POUT_[(g * NEXP) >> 3]); \
            AT_SBAR(); } \
        if (resc) { \
            asm volatile("s_waitcnt lgkmcnt(0)" ::: "memory"); \
            _Pragma("unroll") for (int r = 0; r < 16; ++r) { const float f_ = wsf[crow(r, hi)]; if (MSUM) lsum[r] *= f_; _Pragma("unroll") for (int d = 0; d < ND; ++d) o[d][r] *= f_; } } \
        if (!MSUM) l_reg += sacc; \
    } while (0)
#define AT_STEP_END(T_) do { { int na = NT - (KPRE ? 3 : 2) - (T_); na = na < 0 ? 0 : (na > AH - (KPRE ? 2 : 1) ? AH - (KPRE ? 2 : 1) : na); wait_bar_n(na * NPT); }     \
        slot = slot == AH ? 0 : slot + 1; vslot = vslot == NVS - 1 ? 0 : vslot + 1; } while (0)
    wait_bar_n(((NT < AH ? NT : AH) - (KPRE ? 2 : 1)) * NPT);
    asm volatile("s_waitcnt vmcnt(0)" ::: "memory");
    asm volatile("" : "+v"(qr[0]), "+v"(qr[1]), "+v"(qr[2]), "+v"(qr[3]));
    if (KPRE) { _Pragma("unroll") for (int j = 0; j < 4; ++j) AT_KRD(j, 0); }
    int vlast; bool inA;
#define AT_VPREV1 (vslot == 0 ? NVS - 1 : vslot - 1)
#define AT_VPREV2 (vslot < 2 ? vslot + NVS - 2 : vslot - 2)
    if (!late) {
        int i = 0;
        for (; i + 1 < NT; i += 2) {
            AT_PHA(i);     AT_PHB(i == 0 ? 0 : AT_VPREV1, pwA, pwB, i + AH); AT_STEP_END(i);
            AT_PHA(i + 1); AT_PHB(AT_VPREV1, pwB, pwA, i + 1 + AH);      AT_STEP_END(i + 1);
        }
        inA = true;
        if (i < NT) { AT_PHA(i); AT_PHB(AT_VPREV1, pwA, pwB, i + AH); AT_STEP_END(i); inA = false; }
        vlast = AT_VPREV1;
    } else {
        { const int s2 = slot == 0 ? AH : slot - 1; int v2 = vslot + AH; v2 = v2 >= NVS ? v2 - NVS : v2; AT_DMA(AH, s2, v2); }
        AT_PHA(0); AT_STEP_END(0);
        int i = 1;
        for (; i + 1 < NT; i += 2) {
            AT_PHB(i == 1 ? 0 : AT_VPREV2, pwA, pwB, i + AH); AT_PHA(i);     AT_STEP_END(i);
            AT_PHB(AT_VPREV2, pwB, pwA, i + 1 + AH);      AT_PHA(i + 1); AT_STEP_END(i + 1);
        }
        inA = true;
        if (i < NT) { AT_PHB(i == 1 ? 0 : AT_VPREV2, pwA, pwB, i + AH); AT_PHA(i); AT_STEP_END(i); inA = false; }
        if (inA) { AT_PHB(AT_VPREV2, pwA, pwB, NT); inA = false; } else { AT_PHB(AT_VPREV2, pwB, pwA, NT); inA = true; }
        vlast = AT_VPREV1;
    }
    if (!inA) {
#pragma unroll
        for (int k = 0; k < 4; ++k) pwA[k] = pwB[k];
    }
    { const lds_cptr vp = vp0 + vlast * L::VSLOT; s16x4 vl[2][4], vh[2][4];
      AT_VRD(0, 0); AT_SBAR();
#pragma unroll
      for (int d = 0; d < ND; ++d) {
          if (d + 1 < ND) AT_VRD((d + 1) & 1, d + 1);
          AT_SBAR();
#pragma unroll
          for (int ks = 0; ks < 4; ++ks) { const bf16x8 vf = (bf16x8){vl[d & 1][ks][0], vl[d & 1][ks][1], vl[d & 1][ks][2], vl[d & 1][ks][3], vh[d & 1][ks][0], vh[d & 1][ks][1], vh[d & 1][ks][2], vh[d & 1][ks][3]};
              o[d] = AT_MFMA(__builtin_bit_cast(bf16x8, pwA[ks]), vf, o[d]); }
          AT_SBAR(); }
      if (MSUM) {
#pragma unroll
          for (int ks = 0; ks < 4; ++ks) lsum = AT_MFMA(__builtin_bit_cast(bf16x8, pwA[ks]), __builtin_bit_cast(bf16x8, ones4), lsum); } }
    if (!MSUM) {
        auto rr = __builtin_amdgcn_permlane32_swap(__float_as_uint(l_reg), __float_as_uint(l_reg), false, false); const float lt = __uint_as_float(rr[0]) + __uint_as_float(rr[1]);
        if (hi == 0) wsf[32 + r32] = lt;
        asm volatile("s_waitcnt lgkmcnt(0)" ::: "memory");
#pragma unroll
        for (int r = 0; r < 16; ++r) lsum[r] = wsf[32 + crow(r, hi)];
    }
    AT_WAIT_BAR(0);
#undef AT_PIN
#undef AT_CE
#undef AT_VOFF
#undef AT_PHA
#undef AT_PHB
#undef AT_STEP_END
#undef AT_KRD
#undef AT_VPREV1
#undef AT_VPREV2
#undef AT_KT
#undef AT_DMA
#undef AT_VRD
}

__device__ __forceinline__ int window_kt_min(const unsigned* nrm, int b, int chunk, int q0, float slope2, float& Bout) {
    const float nq = __uint_as_float(nrm[((0 * 2 + b) * 16 + chunk) * 2]) + __uint_as_float(nrm[((0 * 2 + b) * 16 + chunk) * 2 + 1]);
    const float nk = __uint_as_float(nrm[((1 * 2 + b) * 16 + chunk) * 2]) + __uint_as_float(nrm[((1 * 2 + b) * 16 + chunk) * 2 + 1]);
    const float B = sqrtf(nq * nk) * 1.01f; Bout = B;
    const float W = (2.0f * B + 160.0f) / slope2;
    const int wkeys = W < 1.0e6f ? (int)W : 1000000;
    const int d = q0 - wkeys;
    return d > 0 ? (d >> 6) : 0;
}
__device__ __forceinline__ void diff_item(char* shm, int b, int h, int qb, int m, const bf16* Q, const bf16* K, const bf16* V, bf16* O, float lam, const unsigned* nrm, unsigned* flag, unsigned* tmo) {
    typedef Lay<128, 2> L;
    int tid_ = threadIdx.x; asm volatile("" : "+v"(tid_));
    const int tid = tid_; const int wid = __builtin_amdgcn_readfirstlane(tid >> 6);
    const long rowbase = (long)b * SEQ; const int q0 = qb * 256;
    const float slope2 = __builtin_amdgcn_exp2f(-(float)(h + 1)) * 1.4426950408889634f;
    lam = __uint_as_float((unsigned)__builtin_amdgcn_readfirstlane((int)__float_as_uint(lam)));
    const lds_ptr shm3 = (lds_ptr)shm;
    __attribute__((address_space(3))) float* wsf = (__attribute__((address_space(3))) float*)(shm3 + L::LDS_WS) + wid * 64;
    __attribute__((address_space(3))) bf16* stg = (__attribute__((address_space(3))) bf16*)(shm3 + L::LDS_OST + wid * L::OSTW);
    f32x16 o[4], lsum;
    float Bq; const int kt_min = __builtin_amdgcn_readfirstlane(window_kt_min(nrm, b, 2 * h + m, q0, slope2, Bq));
    Bq = __uint_as_float((unsigned)__builtin_amdgcn_readfirstlane((int)__float_as_uint(Bq)));
    if (Bq <= 40.0f) sweep<128, false, 2, true>(shm, Q + (rowbase + q0 + wid * 32) * DM + h * 128 + m * 64, K + rowbase * DM + h * 128 + m * 64, V + rowbase * DM + h * 128, qb, kt_min, slope2, Bq, 0u, o, lsum);
    else sweep<128, false, 2, false>(shm, Q + (rowbase + q0 + wid * 32) * DM + h * 128 + m * 64, K + rowbase * DM + h * 128 + m * 64, V + rowbase * DM + h * 128, qb, kt_min, slope2, Bq, 0u, o, lsum);
    int lane_e = tid & 63; asm volatile("" : "+v"(lane_e));
    const int lane = lane_e, r32 = lane & 31, hi = lane >> 5;
    bf16* Ow = O + (rowbase + q0 + wid * 32) * DM + h * 128;
    float rli[16];
#pragma unroll
    for (int r = 0; r < 16; ++r) rli[r] = (m == 0 ? 1.0f : lam) * __builtin_amdgcn_rcpf(lsum[r]);
    if (m == 0) {
#pragma unroll
        for (int r = 0; r < 16; ++r)
#pragma unroll
            for (int d = 0; d < 4; ++d) stg[crow(r, hi) * 128 + d * 32 + r32] = (bf16)f2bf_u(o[d][r] * rli[r]);
        asm volatile("s_waitcnt lgkmcnt(0)" ::: "memory");
#pragma unroll
        for (int i = 0; i < 8; ++i) { const int row = i * 4 + (lane >> 4), ch = lane & 15; const u32x4 v = *(const __attribute__((address_space(3))) u32x4*)(stg + row * 128 + ch * 8); *(u32x4*)(Ow + (long)row * DM + ch * 8) = v; }
        asm volatile("s_waitcnt vmcnt(0)" ::: "memory");
        __syncthreads();
        if (tid == 0) { __builtin_amdgcn_fence(__ATOMIC_RELEASE, "agent"); asm volatile("s_waitcnt vmcnt(0)" ::: "memory"); __hip_atomic_store(flag, 1u, __ATOMIC_RELAXED, __HIP_MEMORY_SCOPE_AGENT); }
    } else {
        if (tid == 0) {
            unsigned sp = 0u;
            while (__hip_atomic_load(flag, __ATOMIC_RELAXED, __HIP_MEMORY_SCOPE_AGENT) == 0u) { __builtin_amdgcn_s_sleep(8); if (++sp > (1u << 22)) { __hip_atomic_store(tmo, 1u, __ATOMIC_RELAXED, __HIP_MEMORY_SCOPE_AGENT); break; } }
            __builtin_amdgcn_fence(__ATOMIC_ACQUIRE, "agent");
            asm volatile("s_waitcnt vmcnt(0)" ::: "memory");
        }
        __syncthreads();
#pragma unroll
        for (int i = 0; i < 8; ++i) { const int row = i * 4 + (lane >> 4), ch = lane & 15; const u32x4 v = *(const u32x4*)(Ow + (long)row * DM + ch * 8); *(__attribute__((address_space(3))) u32x4*)(stg + row * 128 + ch * 8) = v; }
        asm volatile("s_waitcnt vmcnt(0) lgkmcnt(0)" ::: "memory");
        float ss[16];
#pragma unroll
        for (int r = 0; r < 16; ++r) { float sq = 0.f;
#pragma unroll
            for (int d = 0; d < 4; ++d) { const float v = bf2f_u(stg[crow(r, hi) * 128 + d * 32 + r32]) - o[d][r] * rli[r]; o[d][r] = v; sq = __builtin_fmaf(v, v, sq); }
            ss[r] = sq; }
#pragma unroll
        for (int r = 0; r < 16; ++r) {
#pragma unroll
            for (int off = 1; off < 32; off <<= 1) ss[r] += __shfl_xor(ss[r], off);
            ss[r] = 1.0f / sqrtf(ss[r] * (1.0f / 128.0f) + 1e-6f); }
#pragma unroll
        for (int r = 0; r < 16; ++r)
#pragma unroll
            for (int d = 0; d < 4; ++d) stg[crow(r, hi) * 128 + d * 32 + r32] = (bf16)f2bf_u(o[d][r] * ss[r]);
        asm volatile("s_waitcnt lgkmcnt(0)" ::: "memory");
#pragma unroll
        for (int i = 0; i < 8; ++i) { const int row = i * 4 + (lane >> 4), ch = lane & 15; const u32x4 v = *(const __attribute__((address_space(3))) u32x4*)(stg + row * 128 + ch * 8); *(u32x4*)(Ow + (long)row * DM + ch * 8) = v; }
    }
}
__device__ __forceinline__ void moba_unit(char* shm, int b, int h, int qb, const bf16* Q, const bf16* K, const bf16* V, bf16* O, const float* KM, const unsigned* nrm) {
    typedef Lay<64, 4> L;
    int tid_ = threadIdx.x; asm volatile("" : "+v"(tid_));
    const int tid = tid_, lane = tid & 63, r32 = lane & 31, hi = lane >> 5; const int wid = __builtin_amdgcn_readfirstlane(tid >> 6);
    const long rowbase = (long)b * SEQ; const int q0 = qb * 256;
    const float slope2 = __builtin_amdgcn_exp2f(-0.5f * (float)(h + 1)) * 1.4426950408889634f;
    const lds_ptr shm3 = (lds_ptr)shm;
    __attribute__((address_space(3))) float* wsf = (__attribute__((address_space(3))) float*)(shm3 + L::LDS_WS) + wid * 64;
    __attribute__((address_space(3))) bf16* stg = (__attribute__((address_space(3))) bf16*)(shm3 + L::LDS_OST + wid * L::OSTW);
    const bf16* Qw = Q + (rowbase + q0 + wid * 32) * DM + h * 64;
    unsigned sel = 0u;
    if (qb > 0) {
        f32x16 g = f32x16{};
        const float* km = KM + (((long)b * 16 + h) * 32 + r32) * 64 + hi * 8;
#pragma unroll
        for (int d0 = 0; d0 < 4; ++d0) {
            const bf16x8 qf = *reinterpret_cast<const bf16x8*>(&Qw[(long)r32 * DM + d0 * 16 + hi * 8]);
            const float4 x0 = *(const float4*)(km + d0 * 16), x1 = *(const float4*)(km + d0 * 16 + 4);
            const float xs[8] = {x0.x, x0.y, x0.z, x0.w, x1.x, x1.y, x1.z, x1.w};
            unsigned hw[8], lw[8];
#pragma unroll
            for (int e = 0; e < 8; ++e) { hw[e] = f2bf_u(xs[e]); lw[e] = f2bf_u(xs[e] - bf2f_u(hw[e])); }
            const u32x4 ah = {hw[0] | (hw[1] << 16), hw[2] | (hw[3] << 16), hw[4] | (hw[5] << 16), hw[6] | (hw[7] << 16)};
            const u32x4 al = {lw[0] | (lw[1] << 16), lw[2] | (lw[3] << 16), lw[4] | (lw[5] << 16), lw[6] | (lw[7] << 16)};
            g = AT_MFMA(__builtin_bit_cast(bf16x8, ah), qf, g); g = AT_MFMA(__builtin_bit_cast(bf16x8, al), qf, g);
        }
        float g0[16], g1[16];
#pragma unroll
        for (int r = 0; r < 16; ++r) { auto rr = __builtin_amdgcn_permlane32_swap(__float_as_uint(g[r]), __float_as_uint(g[r]), false, false); g0[r] = __uint_as_float(rr[0]); g1[r] = __uint_as_float(rr[1]); }
        float b0 = -INFINITY, b1 = -INFINITY, b2 = -INFINITY; int i0 = 0, i1 = 0, i2 = 0;
#pragma unroll
        for (int n = 0; n < 32; ++n) {
            const int rn = 4 * (n >> 3) + (n & 3);
            float v = ((n >> 2) & 1) ? g1[rn] : g0[rn];
            if (n >= qb) v = -INFINITY;
            if (v > b0) { b2 = b1; i2 = i1; b1 = b0; i1 = i0; b0 = v; i0 = n; }
            else if (v > b1) { b2 = b1; i2 = i1; b1 = v; i1 = n; }
            else if (v > b2) { b2 = v; i2 = n; }
        }
        if (b0 > -INFINITY) sel |= 1u << i0;
        if (b1 > -INFINITY) sel |= 1u << i1;
        if (b2 > -INFINITY) sel |= 1u << i2;
    }
    f32x16 o[2], lsum;
    float Bq; const int kt_min = __builtin_amdgcn_readfirstlane(window_kt_min(nrm, b, h, q0, slope2, Bq));
    Bq = __uint_as_float((unsigned)__builtin_amdgcn_readfirstlane((int)__float_as_uint(Bq)));
    if (Bq <= 40.0f) sweep<64, true, 4, true>(shm, Qw, K + rowbase * DM + h * 64, V + rowbase * DM + h * 64, qb, kt_min, slope2, Bq, sel, o, lsum);
    else sweep<64, true, 4, false>(shm, Qw, K + rowbase * DM + h * 64, V + rowbase * DM + h * 64, qb, kt_min, slope2, Bq, sel, o, lsum);
    int lane_e = lane; asm volatile("" : "+v"(lane_e));
    { const int lane = lane_e, r32 = lane & 31, hi = lane >> 5;
#pragma unroll
    for (int r = 0; r < 16; ++r) { const float rl = __builtin_amdgcn_rcpf(lsum[r]);
#pragma unroll
        for (int d = 0; d < 2; ++d) stg[crow(r, hi) * 64 + d * 32 + r32] = (bf16)f2bf_u(o[d][r] * rl); }
    asm volatile("s_waitcnt lgkmcnt(0)" ::: "memory");
    bf16* Ow = O + (rowbase + q0 + wid * 32) * DM + h * 64;
#pragma unroll
    for (int i = 0; i < 4; ++i) { const int row = i * 8 + (lane >> 3), ch = lane & 7; const u32x4 v = *(const __attribute__((address_space(3))) u32x4*)(stg + row * 64 + ch * 8); *(u32x4*)(Ow + (long)row * DM + ch * 8) = v; }
    }
}
#undef AT_SBAR
#undef AT_WAIT_BAR
#undef AT_MX3
#undef AT_MFMA
}

constexpr int NWAVES = 8;
constexpr int RING_OFF = 0, RING_BYTES = 131072;
constexpr int LDSCTL_OFF = RING_BYTES, MISC_OFF = LDSCTL_OFF + 320;
constexpr int LDS_BYTES = RING_BYTES + 1024;
static_assert(attn::Lay<128, 2>::BYTES <= RING_BYTES && attn::Lay<64, 4>::BYTES <= RING_BYTES && LDS_BYTES <= 163840, "LDS budget");
static_assert(MISC_OFF + 128 <= LDS_BYTES, "LDS map");

struct Frame {
    LAS unsigned char* lds; volatile LAS unsigned* MISC; gu32* ctl;
    int tid, lane, wave, vcu, G;
};
__device__ __forceinline__ float wave_sum(float v) {
#pragma unroll
    for (int o = 1; o < 64; o <<= 1) v += __shfl_xor(v, o);
    return v;
}
__device__ __forceinline__ float bf2f(unsigned h) { return __builtin_bit_cast(float, h << 16); }

__device__ __forceinline__ void p0_transpose_item(const float* W, int K, int N, bf16* WT, LAS float* scr, int item, int lane, const float* gk, int gmask, float cmul, int qcols, float qscale) {
    const int nblk = N / 32, kb = item / nblk, nb = item % nblk, k0 = 64 * kb, n0 = 32 * nb;
    const float cs = cmul * ((n0 < qcols) ? qscale : 1.0f);
#pragma unroll 8
    for (int i = 0; i < 32; ++i) { const int kk = 2 * i + (lane >> 5); const float g = gk ? gk[(k0 + kk) & gmask] : 1.0f; scr[kk * 33 + (lane & 31)] = W[(size_t)(k0 + kk) * N + n0 + (lane & 31)] * (g * cs); }
    LDS_WAIT(); asm volatile("" ::: "memory");
    const int c = lane & 7;
#pragma unroll
    for (int j = 0; j < 4; ++j) { const int n = (lane >> 3) + 8 * j; const LAS float* s = scr + (8 * c) * 33 + n;
        v4u o; o.x = pk2(s[0 * 33], s[1 * 33]); o.y = pk2(s[2 * 33], s[3 * 33]); o.z = pk2(s[4 * 33], s[5 * 33]); o.w = pk2(s[6 * 33], s[7 * 33]);
        *(GAS v4u*)(WT + (size_t)(n0 + n) * K + k0 + 8 * c) = o; }
    LDS_WAIT(); asm volatile("" ::: "memory");
}
__device__ __forceinline__ void p0_x_row2(const float* xrow, bf16* hrow, float* ssq, int lane) {
    f32x4 v[2][4];
#pragma unroll
    for (int r = 0; r < 2; ++r)
#pragma unroll
        for (int j = 0; j < 4; ++j) v[r][j] = ((const GAS f32x4*)(xrow + (size_t)r * D) + lane)[64 * j];
#pragma unroll
    for (int r = 0; r < 2; ++r) { GAS unsigned long long* h8 = (GAS unsigned long long*)(hrow + (size_t)r * D) + lane; float s[4];
#pragma unroll
        for (int j = 0; j < 4; ++j) { h8[64 * j] = (unsigned long long)pk2(v[r][j].x, v[r][j].y) | ((unsigned long long)pk2(v[r][j].z, v[r][j].w) << 32);
            s[j] = wave_sum((v[r][j].x * v[r][j].x + v[r][j].y * v[r][j].y) + (v[r][j].z * v[r][j].z + v[r][j].w * v[r][j].w)); }
        if (lane < 16) { const int j = lane >> 2; const float sj = j == 0 ? s[0] : j == 1 ? s[1] : j == 2 ? s[2] : s[3]; ssq[r * 16 + lane] = (lane & 3) == 0 ? sj : 0.f; } }
}
__device__ __forceinline__ void final_row(const bf16* hrow, float* orow, const float* ssq, const float* g, int lane) {
    const float rs = pg8::row_rstd16(ssq, 0);
#pragma unroll
    for (int j = 0; j < 2; ++j) {
        const v4u hb = *((const GAS v4u*)(hrow + 512 * j) + lane);
        const GAS f32x4* gr = (const GAS f32x4*)(g + 512 * j) + 2 * lane; GAS f32x4* orr = (GAS f32x4*)(orow + 512 * j) + 2 * lane;
        f32x4 a = {bf2f(hb.x & 0xffffu), bf2f(hb.x >> 16), bf2f(hb.y & 0xffffu), bf2f(hb.y >> 16)}, b = {bf2f(hb.z & 0xffffu), bf2f(hb.z >> 16), bf2f(hb.w & 0xffffu), bf2f(hb.w >> 16)};
        orr[0] = a * rs * gr[0]; orr[1] = b * rs * gr[1];
    }
}

#define REP_QKV 1
#define REP_DIFF 1
#define REP_MOBA 1
#define REP_FF1 1
#define REP_PRO 1
#define REP_BAR 1
struct Args { const float* in[10]; float* out; unsigned char* ws; };
__global__ void __launch_bounds__(NWAVES * 64, 2) fwd_kernel(Args args) {
    extern __shared__ __attribute__((aligned(16))) unsigned char lds[];
    Frame F;
    F.lds = (LAS unsigned char*)lds;
    F.MISC = (volatile LAS unsigned*)(F.lds + MISC_OFF);
    F.tid = threadIdx.x; F.lane = F.tid & 63; F.wave = __builtin_amdgcn_readfirstlane(F.tid >> 6);
    F.G = gridDim.x; { const int bx = blockIdx.x; F.vcu = (F.G % 8 == 0) ? (bx % 8) * (F.G / 8) + bx / 8 : bx; }
    unsigned char* ws = args.ws;
    F.ctl = (gu32*)(ws + WS_CTL);
#define PTRS() \
    unsigned long long z_ = 0ull; asm volatile("" : "+s"(z_)); unsigned char* wsl = args.ws + z_; float* out = args.out + z_;     \
    bf16* WIN = (bf16*)(wsl + WS_WIN); bf16* WOUT = (bf16*)(wsl + WS_WOUT); bf16* WFF1 = (bf16*)(wsl + WS_WFF1); bf16* WFF2 = (bf16*)(wsl + WS_WFF2); \
    float* SSQ = (float*)(wsl + WS_SSQ); float* KM = (float*)(wsl + WS_KMEAN); \
    bf16* HB = (bf16*)(wsl + WS_HB); bf16* Qb = (bf16*)(wsl + WS_Q); bf16* Kb = (bf16*)(wsl + WS_K); bf16* Vb = (bf16*)(wsl + WS_V); bf16* Ob = (bf16*)(wsl + WS_O); \
    bf16* ACT = (bf16*)(wsl + WS_ACT); \
    (void)WIN; (void)WOUT; (void)WFF1; (void)WFF2; (void)SSQ; (void)KM; (void)HB; (void)Qb; (void)Kb; (void)Vb; (void)Ob; (void)ACT; (void)out
    for (int u = F.tid; u < (LDS_BYTES - LDSCTL_OFF) / 4; u += NWAVES * 64) ((LAS unsigned*)(F.lds + LDSCTL_OFF))[u] = 0u;
    __syncthreads();
    XcdBarrier bar = xcd_barrier_post((unsigned*)(F.ctl + CW_BAR), F.MISC + 8);
#define GRID_BAR() do { for (int rb_ = 0; rb_ < REP_BAR; ++rb_) xcd_barrier(bar); } while (0)
    const int gw = F.vcu * NWAVES + F.wave, NGW = F.G * NWAVES;

    {
        PTRS();
        const float* x = args.in[0]; const float* attn_norm = args.in[1]; const float* w_in = args.in[2]; const float* w_out = args.in[3];
        const float* diff_subln = args.in[5]; const float* mlp_norm = args.in[6]; const float* w_ff1 = args.in[7]; const float* w_ff2 = args.in[8];
        int ln = threadIdx.x & 63; asm volatile("" : "+v"(ln));
        LAS float* scr = (LAS float*)(F.lds + RING_OFF + F.wave * 16384);
        constexpr int I_IN = (D / 64) * (NQKV / 32), I_OUT = (D / 64) * (D / 32), I_F1 = (D / 64) * (FF / 32), I_F2 = (FF / 64) * (D / 32);
        constexpr int PER_L = I_IN + I_OUT + I_F1 + I_F2;
        for (int rp_ = 0; rp_ < REP_PRO; ++rp_) {
        for (int it = gw; it < 2 * PER_L; it += NGW) {
            const int l = it / PER_L; int r = it % PER_L;
            if (r < I_IN) { p0_transpose_item(w_in + (size_t)l * D * NQKV, D, NQKV, WIN + (size_t)l * NQKV * D, scr, r, ln, attn_norm + l * D, D - 1, 1.0f, D, QSCALE); continue; } r -= I_IN;
            if (r < I_OUT) { p0_transpose_item(w_out + (size_t)l * D * D, D, D, WOUT + (size_t)l * D * D, scr, r, ln, l == 0 ? diff_subln : nullptr, 127, l == 0 ? 0.8f : 1.0f, 0, 1.0f); continue; } r -= I_OUT;
            if (r < I_F1) { p0_transpose_item(w_ff1 + (size_t)l * D * FF, D, FF, WFF1 + (size_t)l * FF * D, scr, r, ln, mlp_norm + l * D, D - 1, 1.0f, 0, 1.0f); continue; } r -= I_F1;
            p0_transpose_item(w_ff2 + (size_t)l * FF * D, FF, D, WFF2 + (size_t)l * D * FF, scr, r, ln, nullptr, 0, 1.0f, 0, 1.0f);
        }
        for (int m = 2 * gw; m < M; m += 2 * NGW) p0_x_row2(x + (size_t)m * D, HB + (size_t)m * D, SSQ + (size_t)m * 16, ln);
        }
    }
    GRID_BAR();

#pragma unroll 1
    for (int l = 0; l < 2; ++l) {
        {
            PTRS();
            pg8::Gemm g{HB, WIN + (size_t)l * NQKV * D, M, NQKV, D}; pg8::StaticOrder S; S.init(M, NQKV, F.G, (int)blockIdx.x);
            pg8::EpiScaleBf16<0> E{Qb, D, SSQ, D, (size_t)M * D, l == 1 ? (float*)(F.ctl + CW_KMS) : nullptr, (unsigned*)(F.ctl + CW_NRM + l * 256)};
            for (int rep = 0; rep < REP_QKV; ++rep)
            pg8::gemm_phase<pg8::EpiScaleBf16<0>, pg8::StaticOrder, PG8_ALIGN, PG8_SP2>(F.lds + RING_OFF, g, S, E);
        }
        GRID_BAR();
        if (l == 0) {
            PTRS();
            const float* lp = args.in[4];
            int lnl = threadIdx.x & 63; asm volatile("" : "+v"(lnl));
            const float la = wave_sum(lp[lnl] * lp[64 + lnl]), lc = wave_sum(lp[128 + lnl] * lp[192 + lnl]);
            const float lam = expf(la) - expf(lc) + 0.2f;
            for (int rep = 0; rep < REP_DIFF; ++rep)
            for (;;) {
                if (F.tid == 0) F.MISC[16] = __hip_atomic_fetch_add(F.ctl + CW_QUEUE + 64 * rep, 1u, RLX_AGENT);
                __syncthreads();
                const int i = (int)F.MISC[16];
                __syncthreads();
                if (i >= 1024) break;
                const int u = i >> 1, bh = u & 15, qb = 31 - (u >> 4);
                attn::diff_item((char*)lds + RING_OFF, bh >> 3, bh & 7, qb, i & 1, Qb, Kb, Vb, Ob, lam, (const unsigned*)(F.ctl + CW_NRM), (unsigned*)(F.ctl + CW_DFLAG + rep * 512 + u), (unsigned*)(F.ctl + CW_BAR) + XB_TMO);
            }
        } else {
            PTRS();
            const float* KMf = (const float*)(F.ctl + CW_KMS);
            for (int rep = 0; rep < REP_MOBA; ++rep)
            for (;;) {
                if (F.tid == 0) F.MISC[16] = __hip_atomic_fetch_add(F.ctl + CW_QUEUE + 64 * (4 + rep), 1u, RLX_AGENT);
                __syncthreads();
                const int i = (int)F.MISC[16];
                __syncthreads();
                if (i >= 1024) break;
                const int bh = i & 31, qb = 31 - (i >> 5);
                attn::moba_unit((char*)lds + RING_OFF, bh >> 4, bh & 15, qb, Qb, Kb, Vb, Ob, KMf, (const unsigned*)(F.ctl + CW_NRM + 256));
            }
        }
        GRID_BAR();
        {
            PTRS();
            pg8::Gemm g{Ob, WOUT + (size_t)l * D * D, M, D, D}; pg8::StaticOrder S; S.init(M, D, F.G, (int)blockIdx.x);
            pg8::EpiRes<false> E{out, HB, SSQ, D};
            pg8::gemm_phase<pg8::EpiRes<false>, pg8::StaticOrder, PG8_ALIGN, PG8_SP2>(F.lds + RING_OFF, g, S, E);
        }
        GRID_BAR();
        {
            PTRS();
            pg8::Gemm g{HB, WFF1 + (size_t)l * FF * D, M, FF, D}; pg8::StaticOrder S; S.init(M, FF, F.G, (int)blockIdx.x);
            pg8::EpiScaleBf16<1> E{ACT, FF, SSQ, 0, 0, nullptr, nullptr};
            for (int rep = 0; rep < REP_FF1; ++rep)
            pg8::gemm_phase<pg8::EpiScaleBf16<1>, pg8::StaticOrder, PG8_ALIGN, PG8_SP2>(F.lds + RING_OFF, g, S, E);
        }
        GRID_BAR();
        {
            PTRS();
            pg8::Gemm g{ACT, WFF2 + (size_t)l * D * FF, M, D, FF}; pg8::StaticOrder S; S.init(M, D, F.G, (int)blockIdx.x);
            pg8::EpiRes<false> E{out, HB, SSQ, D}; pg8::gemm_phase<pg8::EpiRes<false>, pg8::StaticOrder, PG8_ALIGN, PG8_SP2>(F.lds + RING_OFF, g, S, E);
        }
        GRID_BAR();
    }
    PTRS(); const float* final_norm = args.in[9]; int lnf = threadIdx.x & 63; asm volatile("" : "+v"(lnf));
    for (int m = gw; m < M; m += NGW) final_row(HB + (size_t)m * D, out + (size_t)m * D, SSQ + (size_t)m * 16, final_norm, lnf);
    if (xb_ld((unsigned*)(F.ctl + CW_BAR) + XB_TMO) != 0u && blockIdx.x == 0) { const float qn = __builtin_nanf(""); for (int i = F.tid; i < 4096; i += NWAVES * 64) out[i] = qn; }
}

extern "C" void kernel_launch(void* const* d_in, const int* in_sizes, int n_in, void* d_out, int out_size, void* d_ws, size_t ws_size, hipStream_t stream) {
    static int grid = 0;
    if (grid == 0) {
        if (n_in != 10 || in_sizes[0] != M * D || out_size != M * D || ws_size < WS_END) { fprintf(stderr, "kernel_launch: unexpected shapes (n_in %d out %d ws %zu); nothing launched\n", n_in, out_size, ws_size); grid = -1; return; }
        int dev = 0, cus = 0, per_cu = 0;
        if (hipGetDevice(&dev) != hipSuccess || hipDeviceGetAttribute(&cus, hipDeviceAttributeMultiprocessorCount, dev) != hipSuccess) { fprintf(stderr, "kernel_launch: device query failed\n"); grid = -1; return; }
        if (hipFuncSetAttribute((const void*)fwd_kernel, hipFuncAttributeMaxDynamicSharedMemorySize, LDS_BYTES) != hipSuccess) { fprintf(stderr, "kernel_launch: hipFuncSetAttribute failed\n"); grid = -1; return; }
        if (hipOccupancyMaxActiveBlocksPerMultiprocessor(&per_cu, (const void*)fwd_kernel, NWAVES * 64, LDS_BYTES) != hipSuccess || per_cu < 1) { fprintf(stderr, "kernel_launch: occupancy query reports %d workgroups per CU\n", per_cu); per_cu = 1; }
        (void)hipGetLastError();
        grid = cus;
    }
    if (grid < 0) return;
    if (hipMemsetAsync((char*)d_ws + WS_CTL, 0, CTL_ZERO_BYTES, stream) != hipSuccess) { fprintf(stderr, "kernel_launch: hipMemsetAsync failed\n"); return; }
    Args a{};
    for (int i = 0; i < 10; ++i) a.in[i] = (const float*)d_in[i];
    a.out = (float*)d_out; a.ws = (unsigned char*)d_ws;
    hipLaunchKernelGGL(fwd_kernel, dim3(grid), dim3(NWAVES * 64), LDS_BYTES, stream, a);
    const hipError_t le = hipPeekAtLastError();
    if (le != hipSuccess) fprintf(stderr, "kernel_launch: launch failed: %s\n", hipGetErrorName(le));
}
```

```cpp
#include <hip/hip_runtime.h>
#include <cstdio>
#include <cstdint>

constexpr int BATCH = 2, T = 8192, D = 1024, M = BATCH * T, FF = 4096, NQKV = 3 * D;
constexpr float RMS_EPS = 1e-6f;
constexpr float LOG2E = 1.4426950408889634f;
constexpr float QSCALE = 0.125f * LOG2E;
constexpr float NEG_BIG = -1e30f;

constexpr size_t MiB = 1u << 20;
constexpr size_t WS_CTL = 0, CTL_ZERO_BYTES = 1 * MiB;
constexpr size_t WS_WIN = 1 * MiB;
constexpr size_t WS_WOUT = 13 * MiB;
constexpr size_t WS_WFF1 = 17 * MiB;
constexpr size_t WS_WFF2 = 33 * MiB;
constexpr size_t WS_SSQ = 49 * MiB;
constexpr size_t WS_KMEAN = 50 * MiB;
constexpr size_t WS_HB = 51 * MiB;
constexpr size_t WS_Q = 83 * MiB, WS_K = 115 * MiB, WS_V = 147 * MiB, WS_O = 179 * MiB;
constexpr size_t WS_ACT = 83 * MiB;
constexpr size_t WS_END = 211 * MiB;
constexpr int CW_TMO = 0, CW_CODE = 1, CW_BAR = 4096;
constexpr int CW_NRM = 8192;
constexpr int CW_DFLAG = 12288;
constexpr int CW_KMS = 32768;
constexpr int CW_QUEUE = 9216;
namespace pg8 {
#define PG8_LAS __attribute__((address_space(3)))
typedef unsigned short bf16_t;
typedef short bf16x8 __attribute__((ext_vector_type(8)));
typedef float f32x4 __attribute__((ext_vector_type(4)));
typedef unsigned u32x4 __attribute__((ext_vector_type(4)));
constexpr int BM = 256, BK = 64, HALF = 128, HTB = HALF * BK * 2  , STAGE_BYTES = 8 * HTB, NXCD = 8, WGM = 8;

__host__ __device__ __forceinline__ int lds_byte(int r, int c) { const int st = (r >> 4) * 2 + (c >> 5), rr = r & 15, cc = c & 31, ob = rr * 64 + cc * 2; return st * 1024 + (ob ^ (((ob >> 9) & 1) << 5)); }
__host__ __device__ __forceinline__ void stage_rc(int b, int& R, int& C) { const int st = b / 1024, sb = b % 1024, swz = sb ^ (((sb >> 9) & 1) << 5); R = (st >> 1) * 16 + swz / 64; C = (st & 1) * 32 + (swz % 64) / 2; }
__host__ __device__ __forceinline__ int perm32(int rho) { const int n = rho >> 4, i = rho & 15; return 8 * (i >> 2) + 4 * n + (i & 3); }

struct Unit { int pm, pn; };
struct Gemm { const bf16_t* A; const bf16_t* Bt; int M, N, K; };

struct StaticOrder {
    int nM, nN, nwg, G, c;
    __host__ __device__ void init(int M, int N, int G_, int c_) { nM = M / BM; nN = N / BM; nwg = nM * nN; G = G_; c = c_; }
    __host__ __device__ bool next(int i, Unit& u) const {
        const long L = (long)i * G + c; if (L >= nwg) return false;
        int wgid = (int)L; { const int q = nwg / NXCD, r = nwg % NXCD, xcd = wgid % NXCD, off = wgid / NXCD; wgid = (xcd < r ? xcd * (q + 1) : r * (q + 1) + (xcd - r) * q) + off; }
        const int nig = WGM * nN, gid = wgid / nig, fm = gid * WGM, gsz = (nM - fm) < WGM ? (nM - fm) : WGM;
        u.pm = fm + ((wgid % nig) % gsz); u.pn = (wgid % nig) / gsz; return true;
    }
    __device__ __forceinline__ void a_ready(const Unit&) const {}
    __device__ __forceinline__ void done(const Unit&) const {}
};


__device__ __forceinline__ unsigned cvt_pk_bf16(float lo, float hi) { unsigned r; asm volatile("v_cvt_pk_bf16_f32 %0, %1, %2" : "=v"(r) : "v"(lo), "v"(hi)); return r; }
__device__ __forceinline__ float row_rstd16(const float* SSQ, int row) {
    const f32x4* p = (const f32x4*)(SSQ + (size_t)row * 16);
    const f32x4 a = p[0], b = p[1], c = p[2], d = p[3];
    const float s = ((a[0] + a[1]) + (a[2] + a[3])) + ((b[0] + b[1]) + (b[2] + b[3])) + ((c[0] + c[1]) + (c[2] + c[3])) + ((d[0] + d[1]) + (d[2] + d[3]));
    return 1.0f / sqrtf(s * (1.0f / 1024.0f) + 1e-6f);
}
template <int ACT> struct EpiScaleBf16 {
    static constexpr bool PERM = true, AFTER_DRAIN = false;
    bf16_t* O; int ldc; const float* SSQ; int split_cols; size_t split_stride;
    float* KMS;
    unsigned* NRM;
    __device__ __forceinline__ void operator()(const f32x4 (&acc)[2][2][4][2], const Unit& u, int wr, int wc, int fr, int fq) const {
        const int row0 = u.pm * BM + wr * 64 + fr; int colt = u.pn * BM; bf16_t* base = O; int t = 0;
        if (split_cols) { t = colt / split_cols; base += (size_t)t * split_stride; colt -= t * split_cols; }
        const int col0 = colt + wc * 32 + 8 * fq;
        const int lane = fq * 16 + fr; float myrs[2];
#pragma unroll
        for (int ai = 0; ai < 2; ++ai) myrs[ai] = row_rstd16(SSQ, u.pm * BM + wr * 64 + ai * HALF + lane);
        asm volatile("" : "+v"(myrs[0]), "+v"(myrs[1]));
        float mx[2] = {0.f, 0.f};
        f32x4 ks[2][2] = {{{0.f, 0.f, 0.f, 0.f}, {0.f, 0.f, 0.f, 0.f}}, {{0.f, 0.f, 0.f, 0.f}, {0.f, 0.f, 0.f, 0.f}}};
#pragma unroll
        for (int ai = 0; ai < 2; ++ai)
#pragma unroll
            for (int m = 0; m < 4; ++m) { const int row = row0 + ai * HALF + m * 16; const float rs = __shfl(myrs[ai], m * 16 + fr); bf16_t* rowp = base + (size_t)row * ldc + col0;
#pragma unroll
                for (int bj = 0; bj < 2; ++bj) { f32x4 v0 = acc[ai][bj][m][0] * rs, v1 = acc[ai][bj][m][1] * rs;
                    if (ACT == 1) {
#pragma unroll
                        for (int e = 0; e < 4; ++e) { const float a = __builtin_fmaxf(v0[e], 0.f), b = __builtin_fmaxf(v1[e], 0.f); v0[e] = a * a; v1[e] = b * b; } }
                    if (ACT == 0 && KMS && t == 1) { ks[bj][0] += v0; ks[bj][1] += v1; }
                    if (ACT == 0 && NRM && t < 2) { float q = (v0[0] * v0[0] + v0[1] * v0[1]) + (v0[2] * v0[2] + v0[3] * v0[3]) + (v1[0] * v1[0] + v1[1] * v1[1]) + (v1[2] * v1[2] + v1[3] * v1[3]);
                        q += __shfl_xor(q, 16); q += __shfl_xor(q, 32); mx[bj] = __builtin_fmaxf(mx[bj], q); }
                    u32x4 w; w.x = cvt_pk_bf16(v0[0], v0[1]); w.y = cvt_pk_bf16(v0[2], v0[3]); w.z = cvt_pk_bf16(v1[0], v1[1]); w.w = cvt_pk_bf16(v1[2], v1[3]);
                    *(u32x4*)(rowp + bj * HALF) = w; } }
        if (ACT == 0 && KMS && t == 1) {
#pragma unroll
            for (int bj = 0; bj < 2; ++bj)
#pragma unroll
                for (int n = 0; n < 2; ++n)
#pragma unroll
                    for (int e = 0; e < 4; ++e) { float q = ks[bj][n][e];
#pragma unroll
                        for (int o = 1; o < 16; o <<= 1) q += __shfl_xor(q, o);
                        const int col = colt + bj * HALF + wc * 32 + 8 * fq + 4 * n + e;
                        if (fr == 0) atomicAdd(KMS + ((((size_t)(u.pm >> 5) * 16 + (col >> 6)) * 32 + (u.pm & 31)) * 64 + (col & 63)), q * (1.0f / 256.0f)); }
        }
        if (ACT == 0 && NRM && t < 2) {
#pragma unroll
            for (int bj = 0; bj < 2; ++bj) { float q = mx[bj];
#pragma unroll
                for (int o = 1; o < 16; o <<= 1) q = __builtin_fmaxf(q, __shfl_xor(q, o));
                const int col = colt + bj * HALF + wc * 32;
                if (lane == 0) atomicMax(NRM + (((t * 2 + (u.pm >> 5)) * 16 + (col >> 6)) * 2 + ((col >> 5) & 1)), __float_as_uint(q)); }
        }
    }
};
template <bool LAST> struct EpiRes {
    static constexpr bool PERM = true, AFTER_DRAIN = false;
    float* out; bf16_t* HB; float* SSQ; int ldc;
    __device__ __forceinline__ void operator()(const f32x4 (&acc)[2][2][4][2], const Unit& u, int wr, int wc, int fr, int fq) const {
        const int col0 = u.pn * BM + wc * 32 + 8 * fq;
#pragma unroll
        for (int ai = 0; ai < 2; ++ai)
#pragma unroll
            for (int m = 0; m < 4; ++m) { const int row = u.pm * BM + ai * HALF + wr * 64 + m * 16 + fr; const size_t off = (size_t)row * ldc + col0; float s = 0.f;
#pragma unroll
                for (int bj = 0; bj < 2; ++bj) { const size_t o2 = off + bj * HALF; const u32x4 hb = *(const u32x4*)(HB + o2);
                    f32x4 h0 = acc[ai][bj][m][0], h1 = acc[ai][bj][m][1];
                    h0[0] += __builtin_bit_cast(float, hb.x << 16); h0[1] += __builtin_bit_cast(float, hb.x & 0xffff0000u); h0[2] += __builtin_bit_cast(float, hb.y << 16); h0[3] += __builtin_bit_cast(float, hb.y & 0xffff0000u);
                    h1[0] += __builtin_bit_cast(float, hb.z << 16); h1[1] += __builtin_bit_cast(float, hb.z & 0xffff0000u); h1[2] += __builtin_bit_cast(float, hb.w << 16); h1[3] += __builtin_bit_cast(float, hb.w & 0xffff0000u);
                    if (LAST) { *(f32x4*)(out + o2) = h0; *(f32x4*)(out + o2 + 4) = h1; }
                    else { u32x4 w; w.x = cvt_pk_bf16(h0[0], h0[1]); w.y = cvt_pk_bf16(h0[2], h0[3]); w.z = cvt_pk_bf16(h1[0], h1[1]); w.w = cvt_pk_bf16(h1[2], h1[3]); *(u32x4*)(HB + o2) = w; }
                    s += ((h0[0] * h0[0] + h0[1] * h0[1]) + (h0[2] * h0[2] + h0[3] * h0[3])) + ((h1[0] * h1[0] + h1[1] * h1[1]) + (h1[2] * h1[2] + h1[3] * h1[3])); }
                s += __shfl_xor(s, 16); s += __shfl_xor(s, 32);
                if (fq == 0) SSQ[(size_t)row * 16 + u.pn * 4 + wc] = s;
                if (m & 1) asm volatile("" ::: "memory"); }
    }
};
template <class Epi, class Sched, bool ALIGN_EPI = false, bool SP2 = false>
__device__ __forceinline__ void gemm_phase(PG8_LAS unsigned char* lds, const Gemm g, const Sched& S, const Epi& E) {
    int tid_ = threadIdx.x; asm volatile("" : "+v"(tid_));
    const int tid = tid_, wid = __builtin_amdgcn_readfirstlane(tid >> 6), lane = tid & 63, wr = wid >> 2, wc = wid & 3, fr = lane & 15, fq = lane >> 4;
    const int K = g.K, nt = K / BK;
    unsigned voffA[2], voffB[2];
#pragma unroll
    for (int i = 0; i < 2; ++i) { int R, C; stage_rc(tid * 16 + i * 8192, R, C); const int Rb = Epi::PERM ? ((R & ~31) + perm32(R & 31)) : R;
        voffA[i] = (unsigned)(R * K + C) * 2u; voffB[i] = (unsigned)(Rb * K + C) * 2u; }
    const size_t kstep = (size_t)(BK * 2);
    const size_t hstep = (size_t)HALF * K * 2;
    const size_t tstep = 2 * hstep;
    const unsigned ldsw = (unsigned)wid * 1024u;
    const int aoff = lds_byte(wr * 64 + fr, fq * 8), boff = lds_byte(wc * 32 + fr, fq * 8);
#define PG8_SA(b, h) (((b) * 2 + (h)) * HTB)
#define PG8_SB(b, h) ((4 + (b) * 2 + (h)) * HTB)
#define PG8_STAGE(bufoff, gbase, voff) do { _Pragma("unroll") for (int _i = 0; _i < 2; ++_i) \
        __builtin_amdgcn_global_load_lds((const unsigned*)((const char*)(gbase) + (voff)[_i]), (PG8_LAS unsigned*)(lds + (bufoff) + ldsw + _i * 8192), 16, 0, 0); } while (0)
#define PG8_LDA(dst, b, h) do { _Pragma("unroll") for (int m = 0; m < 4; ++m) _Pragma("unroll") for (int k = 0; k < 2; ++k) dst[m][k] = *(const PG8_LAS bf16x8*)(lds + PG8_SA(b, h) + aoff + m * 2048 + k * 1024); } while (0)
#define PG8_LDB(dst, b, h) do { _Pragma("unroll") for (int n = 0; n < 2; ++n) _Pragma("unroll") for (int k = 0; k < 2; ++k) dst[n][k] = *(const PG8_LAS bf16x8*)(lds + PG8_SB(b, h) + boff + n * 2048 + k * 1024); } while (0)
#define PG8_MMA(ai, bj, At, Bt) do { __builtin_amdgcn_s_setprio(1); _Pragma("unroll") for (int m = 0; m < 4; ++m) _Pragma("unroll") for (int n = 0; n < 2; ++n) _Pragma("unroll") for (int k = 0; k < 2; ++k) \
        acc[ai][bj][m][n] = __builtin_amdgcn_mfma_f32_16x16x32_bf16(Bt[n][k], At[m][k], acc[ai][bj][m][n], 0, 0, 0); __builtin_amdgcn_s_setprio(0); } while (0)
#define PG8_WAIT_V(n) asm volatile("s_waitcnt vmcnt(" #n ")" ::: "memory")
#define PG8_WAIT_L(n) asm volatile("s_waitcnt lgkmcnt(" #n ")" ::: "memory")
#define PG8_BAR __builtin_amdgcn_s_barrier()
#define PG8_SCHED __builtin_amdgcn_sched_barrier(0)
    Unit cur, nxt; int ui = 0;
    if (!S.next(0, cur)) return;
    f32x4 acc[2][2][4][2];
#pragma unroll
    for (int a = 0; a < 2; ++a)
#pragma unroll
        for (int b = 0; b < 2; ++b)
#pragma unroll
            for (int m = 0; m < 4; ++m)
#pragma unroll
                for (int n = 0; n < 2; ++n) acc[a][b][m][n] = (f32x4){0.f, 0.f, 0.f, 0.f};
    bf16x8 At[4][2], B0[2][2], B1[2][2];
    const char* cA = (const char*)g.A + (size_t)cur.pm * tstep; const char* cB = (const char*)g.Bt + (size_t)cur.pn * tstep;
    S.a_ready(cur);
    if constexpr (SP2) {
        PG8_STAGE(PG8_SB(0, 0), cB, voffB); PG8_STAGE(PG8_SB(0, 1), cB + hstep, voffB); PG8_STAGE(PG8_SA(0, 0), cA, voffA); PG8_STAGE(PG8_SA(0, 1), cA + hstep, voffA);
        if (wr == 1) PG8_BAR;
        PG8_WAIT_V(2); PG8_BAR;
        PG8_STAGE(PG8_SB(1, 0), cB + kstep, voffB); PG8_STAGE(PG8_SA(1, 0), cA + kstep, voffA); PG8_STAGE(PG8_SB(1, 1), cB + hstep + kstep, voffB);
        PG8_WAIT_V(6); PG8_BAR;
    } else {
        PG8_STAGE(PG8_SB(0, 0), cB, voffB); PG8_STAGE(PG8_SA(0, 0), cA, voffA); PG8_STAGE(PG8_SB(0, 1), cB + hstep, voffB); PG8_STAGE(PG8_SA(0, 1), cA + hstep, voffA);
        if (wr == 1) PG8_BAR;
        PG8_WAIT_V(4); PG8_BAR;
        PG8_STAGE(PG8_SB(1, 0), cB + kstep, voffB); PG8_STAGE(PG8_SA(1, 0), cA + kstep, voffA); PG8_STAGE(PG8_SB(1, 1), cB + hstep + kstep, voffB);
        PG8_WAIT_V(6); PG8_BAR;
    }
    for (;;) {
        const bool has_next = S.next(ui + 1, nxt);
        const char* nA = has_next ? (const char*)g.A + (size_t)nxt.pm * tstep : cA; const char* nB = has_next ? (const char*)g.Bt + (size_t)nxt.pn * tstep : cB;
        for (int t = 0; t < nt; t += 2) {
            const bool last = (t == nt - 2);
            const char* a1 = cA + (size_t)(t + 1) * kstep;
            const char* a2 = last ? nA : cA + (size_t)(t + 2) * kstep; const char* b2 = last ? nB : cB + (size_t)(t + 2) * kstep;
            const char* a3 = a2 + kstep; const char* b3 = b2 + kstep;
            if (last && has_next) S.a_ready(nxt);
            if constexpr (SP2) {
            PG8_LDB(B0, 0, 0); PG8_LDB(B1, 0, 1); PG8_SCHED; PG8_LDA(At, 0, 0); PG8_STAGE(PG8_SA(1, 1), a1 + hstep, voffA);
            PG8_WAIT_V(8); PG8_WAIT_L(0); PG8_BAR; PG8_MMA(0, 0, At, B0); PG8_MMA(0, 1, At, B1); PG8_BAR; PG8_SCHED;
            PG8_LDA(At, 0, 1); PG8_STAGE(PG8_SB(0, 0), b2, voffB); PG8_STAGE(PG8_SB(0, 1), b2 + hstep, voffB); PG8_STAGE(PG8_SA(0, 0), a2, voffA);
            PG8_WAIT_V(8); PG8_WAIT_L(0); PG8_BAR; PG8_MMA(1, 0, At, B0); PG8_MMA(1, 1, At, B1); PG8_BAR; PG8_SCHED;
            PG8_LDB(B0, 1, 0); PG8_LDB(B1, 1, 1); PG8_SCHED; PG8_LDA(At, 1, 0); PG8_STAGE(PG8_SA(0, 1), a2 + hstep, voffA);
            PG8_WAIT_V(8); PG8_WAIT_L(0); PG8_BAR; PG8_MMA(0, 0, At, B0); PG8_MMA(0, 1, At, B1); PG8_BAR; PG8_SCHED;
            PG8_LDA(At, 1, 1); PG8_STAGE(PG8_SB(1, 0), b3, voffB); PG8_STAGE(PG8_SB(1, 1), b3 + hstep, voffB); PG8_STAGE(PG8_SA(1, 0), a3, voffA);
            PG8_WAIT_V(8); PG8_WAIT_L(0); PG8_BAR; PG8_MMA(1, 0, At, B0); PG8_MMA(1, 1, At, B1); PG8_BAR; PG8_SCHED;
            } else {
            PG8_LDB(B0, 0, 0); PG8_SCHED; PG8_LDA(At, 0, 0); PG8_STAGE(PG8_SA(1, 1), a1 + hstep, voffA);
            PG8_WAIT_L(8); PG8_BAR; PG8_WAIT_L(0); PG8_MMA(0, 0, At, B0); PG8_BAR; PG8_SCHED;
            PG8_LDB(B1, 0, 1); PG8_STAGE(PG8_SB(0, 0), b2, voffB);
            PG8_BAR; PG8_WAIT_L(0); PG8_MMA(0, 1, At, B1); PG8_BAR;
            PG8_LDA(At, 0, 1); PG8_STAGE(PG8_SA(0, 0), a2, voffA);
            PG8_BAR; PG8_WAIT_L(0); PG8_MMA(1, 0, At, B0); PG8_BAR; PG8_SCHED;
            PG8_STAGE(PG8_SB(0, 1), b2 + hstep, voffB);
            PG8_WAIT_V(6); PG8_BAR; PG8_MMA(1, 1, At, B1); PG8_BAR;
            PG8_LDB(B0, 1, 0); PG8_SCHED; PG8_LDA(At, 1, 0); PG8_STAGE(PG8_SA(0, 1), a2 + hstep, voffA);
            PG8_WAIT_L(8); PG8_BAR; PG8_WAIT_L(0); PG8_MMA(0, 0, At, B0); PG8_BAR; PG8_SCHED;
            PG8_LDB(B1, 1, 1); PG8_STAGE(PG8_SB(1, 0), b3, voffB);
            PG8_BAR; PG8_WAIT_L(0); PG8_MMA(0, 1, At, B1); PG8_BAR;
            PG8_LDA(At, 1, 1); PG8_STAGE(PG8_SA(1, 0), a3, voffA);
            PG8_BAR; PG8_WAIT_L(0); PG8_MMA(1, 0, At, B0); PG8_BAR; PG8_SCHED;
            PG8_STAGE(PG8_SB(1, 1), b3 + hstep, voffB);
            PG8_WAIT_V(6); PG8_BAR; PG8_MMA(1, 1, At, B1); PG8_BAR;
            }
        }
        if constexpr (ALIGN_EPI) { if (wr == 0) PG8_BAR; }
        if constexpr (!Epi::AFTER_DRAIN) { E(acc, cur, wr, wc, fr, fq); S.done(cur); }
        if (!has_next) break;
#pragma unroll
        for (int a = 0; a < 2; ++a)
#pragma unroll
            for (int b = 0; b < 2; ++b)
#pragma unroll
                for (int m = 0; m < 4; ++m)
#pragma unroll
                    for (int n = 0; n < 2; ++n) acc[a][b][m][n] = (f32x4){0.f, 0.f, 0.f, 0.f};
        cur = nxt; cA = nA; cB = nB; ++ui;
        if constexpr (ALIGN_EPI) { if (wr == 1) PG8_BAR; }
    }
    PG8_WAIT_V(0);
    if constexpr (!ALIGN_EPI) { if (wr == 0) PG8_BAR; }
    PG8_BAR;
    if constexpr (Epi::AFTER_DRAIN) { E.fused(acc, cur, wr, wc, fr, fq, lds, wid, lane); S.done(cur); }
#undef PG8_SA
#undef PG8_SB
#undef PG8_STAGE
#undef PG8_LDA
#undef PG8_LDB
#undef PG8_MMA
#undef PG8_WAIT_V
#undef PG8_WAIT_L
#undef PG8_BAR
#undef PG8_SCHED
}
}

#ifndef PG8_SP2
#define PG8_SP2 true
#endif
#ifndef PG8_ALIGN
#define PG8_ALIGN true
#endif
#define GAS __attribute__((address_space(1)))
#define LAS __attribute__((address_space(3)))
typedef unsigned short bf16;
typedef unsigned v4u __attribute__((ext_vector_type(4)));
typedef float f32x4 __attribute__((ext_vector_type(4)));
typedef short bf16x8 __attribute__((ext_vector_type(8)));
typedef GAS unsigned gu32;
typedef GAS unsigned long long gu64;
#define RLX_AGENT __ATOMIC_RELAXED, __HIP_MEMORY_SCOPE_AGENT
#define LDS_WAIT() asm volatile("s_waitcnt lgkmcnt(0)" ::: "memory")
#define VM_WAIT() asm volatile("s_waitcnt vmcnt(0)" ::: "memory")
__device__ __forceinline__ unsigned long long rt() { return __builtin_amdgcn_s_memrealtime(); }
__device__ __forceinline__ unsigned f2bf(float f) { unsigned u = __builtin_bit_cast(unsigned, f); return (u + 0x7fffu + ((u >> 16) & 1u)) >> 16; }
__device__ __forceinline__ unsigned pk2(float lo, float hi) { return f2bf(lo) | (f2bf(hi) << 16); }

#define XB_TMO      128
#define XB_XCNT(j)  (256  + 64 * (j))
#define XB_XSUB(j)  (1280 + 64 * (j))
#define XB_XGEN(j)  (2304 + 64 * (j))
#define XB_TOP      3328
#define XB_TOPGEN   3392
#define XCD_BAR_WORDS 3456
#define XB_SPIN_CAP (1u << 18)

__device__ __forceinline__ unsigned xb_ld(unsigned* p)              { return __hip_atomic_load(p, __ATOMIC_RELAXED, __HIP_MEMORY_SCOPE_AGENT); }
__device__ __forceinline__ unsigned xb_add(unsigned* p, unsigned v) { return __hip_atomic_fetch_add(p, v, __ATOMIC_RELAXED, __HIP_MEMORY_SCOPE_AGENT); }
__device__ __forceinline__ unsigned xb_xcc_id() { return (unsigned)__builtin_amdgcn_s_getreg((3 << 11) | 20) & 0xFu; }
#define XB_SPIN(cond, bar) do { unsigned _sp = 0; while (cond) { __builtin_amdgcn_s_sleep(1); \
    if ((++_sp & 255u) == 0u) { if (xb_ld(&(bar)[XB_TMO])) break; if (_sp > XB_SPIN_CAP) { atomicAdd(&(bar)[XB_TMO], 1u); break; } } } } while (0)

struct XcdBarrier {
    unsigned* bar; unsigned x;
    volatile LAS unsigned* st;
};

__device__ __forceinline__ XcdBarrier xcd_barrier_post(unsigned* bar, volatile LAS unsigned* st) {
    XcdBarrier b; b.bar = bar; b.x = xb_xcc_id(); b.st = st;
    if (threadIdx.x == 0) (void)xb_add(&bar[XB_XCNT(b.x)], 1u);
    return b;
}
__device__ __forceinline__ void xcd_barrier_complete(unsigned* bar, unsigned x, unsigned& nloc, unsigned& nx) {
    const unsigned G = gridDim.x * gridDim.y * gridDim.z;
    unsigned sum, cnt, mine, sp = 0u;
    for (;;) {
        sum = 0u; cnt = 0u; mine = 0u;
#pragma unroll
        for (unsigned j = 0; j < 16; ++j) { const unsigned c = xb_ld(&bar[XB_XCNT(j)]); sum += c; cnt += (c > 0u) ? 1u : 0u; mine = (j == x) ? c : mine; }
        if (sum == G) break;
        __builtin_amdgcn_s_sleep(1);
        if ((++sp & 255u) == 0u) { if (xb_ld(&bar[XB_TMO])) break; if (sp > XB_SPIN_CAP) { atomicAdd(&bar[XB_TMO], 1u); break; } }
    }
    nloc = mine > 0u ? mine : 1u; nx = cnt > 0u ? cnt : 1u;
}

__device__ __forceinline__ void xcd_barrier(const XcdBarrier& b) {
    asm volatile("s_waitcnt vmcnt(0)" ::: "memory");
    __syncthreads();
    if (threadIdx.x == 0) {
        unsigned* bar = b.bar; unsigned bx_ = b.x; asm volatile("" : "+s"(bx_));
        __builtin_amdgcn_s_waitcnt(0);
        unsigned nloc = b.st[0], nx = b.st[1];
        if (nloc == 0u) { xcd_barrier_complete(bar, bx_, nloc, nx); b.st[0] = nloc; b.st[1] = nx; }
        const unsigned old = xb_add(&bar[XB_XSUB(bx_)], 1u);
        const unsigned gen = old / nloc;
        if (old + 1u == (gen + 1u) * nloc) {
            __builtin_amdgcn_fence(__ATOMIC_RELEASE, "agent");
            asm volatile("s_waitcnt vmcnt(0)" ::: "memory");
            const unsigned og = xb_add(&bar[XB_TOP], 1u);
            const unsigned tg = og / nx;
            if (og + 1u == (tg + 1u) * nx) xb_add(&bar[XB_TOPGEN], 1u);
            else XB_SPIN(xb_ld(&bar[XB_TOPGEN]) == tg, bar);
            __builtin_amdgcn_fence(__ATOMIC_ACQUIRE, "agent");
            xb_add(&bar[XB_XGEN(bx_)], 1u);
            asm volatile("s_waitcnt vmcnt(0)" ::: "memory");
        } else {
            XB_SPIN(xb_ld(&bar[XB_XGEN(bx_)]) == gen, bar);
            __builtin_amdgcn_fence(__ATOMIC_ACQUIRE, "agent");
            asm volatile("s_waitcnt vmcnt(0)" ::: "memory");
        }
    }
    __syncthreads();
}

namespace attn {
typedef unsigned short bf16;
using bf16x8 = __attribute__((ext_vector_type(8))) short;
using s16x4 = __attribute__((ext_vector_type(4))) short;
using f32x16 = __attribute__((ext_vector_type(16))) float;
using u32x4 = __attribute__((ext_vector_type(4))) unsigned;
typedef __attribute__((address_space(3))) const char* lds_cptr;
typedef __attribute__((address_space(3))) char* lds_ptr;
typedef short v4i16_t __attribute__((ext_vector_type(4)));
constexpr int DM = 1024, SEQ = 8192, KVBLK = 64;
constexpr int KSLOT = 8192;
constexpr float THR = 8.0f;
template <int DV, int AH> struct Lay {
    static constexpr int VSLOT = DV * 128, NKSLOT = AH + 1, NVSLOT = AH + 3, LDS_K = 0, LDS_V = NKSLOT * KSLOT, LDS_WS = LDS_V + NVSLOT * VSLOT, OSTW = 32 * DV * 2,
        LDS_OST = LDS_V  , BYTES = LDS_WS + 8 * 256;
    static_assert(8 * OSTW <= NVSLOT * VSLOT, "O stages fit inside the V ring");
};
#define AT_SBAR() __builtin_amdgcn_sched_barrier(0)
#define AT_WAIT_BAR(N) asm volatile("s_waitcnt vmcnt(" #N ") lgkmcnt(0)\n\ts_barrier" ::: "memory")
__device__ __forceinline__ void wait_bar_n(int n) {
    switch (n) {
        case 0: AT_WAIT_BAR(0); break; case 1: AT_WAIT_BAR(1); break; case 2: AT_WAIT_BAR(2); break; case 3: AT_WAIT_BAR(3); break;
        case 4: AT_WAIT_BAR(4); break; case 5: AT_WAIT_BAR(5); break; case 6: AT_WAIT_BAR(6); break; case 7: AT_WAIT_BAR(7); break;
        case 8: AT_WAIT_BAR(8); break; case 9: AT_WAIT_BAR(9); break; case 10: AT_WAIT_BAR(10); break; case 11: AT_WAIT_BAR(11); break;
        case 12: AT_WAIT_BAR(12); break; case 13: AT_WAIT_BAR(13); break; case 14: AT_WAIT_BAR(14); break; default: AT_WAIT_BAR(15); break;
    }
}
__device__ __forceinline__ int crow(int r, int hi) { return (r & 3) + 8 * (r >> 2) + 4 * hi; }
__device__ __forceinline__ unsigned f2bf_u(float f) { unsigned u = __builtin_bit_cast(unsigned, f); return (u + 0x7fffu + ((u >> 16) & 1u)) >> 16; }
__device__ __forceinline__ float bf2f_u(unsigned h) { return __builtin_bit_cast(float, h << 16); }
__device__ __forceinline__ void glds16(const void* gsrc, unsigned lds_dst) { unsigned keep;
    asm volatile("s_mov_b32 %0, m0\n\ts_mov_b32 m0, %2\n\ts_nop 0\n\tglobal_load_lds_dwordx4 %1, off\n\ts_mov_b32 m0, %0" : "=&s"(keep) : "v"(gsrc), "s"(lds_dst) : "memory"); }
typedef float f32x2_t __attribute__((ext_vector_type(2))); typedef __bf16 bf16x2_t __attribute__((ext_vector_type(2)));
__device__ __forceinline__ unsigned cvtpk_s(float lo, float hi) { f32x2_t v = {lo, hi}; bf16x2_t b = __builtin_convertvector(v, bf16x2_t); return __builtin_bit_cast(unsigned, b); }
__device__ __forceinline__ s16x4 vtr(lds_cptr p) { return __builtin_bit_cast(s16x4, __builtin_amdgcn_ds_read_tr16_b64_v4i16((__attribute__((address_space(3))) v4i16_t*)p)); }
#define AT_MX3(a, b, c) __builtin_fmaxf(__builtin_fmaxf((a), (b)), (c))
#define AT_MFMA(a, b, c) __builtin_amdgcn_mfma_f32_32x32x16_bf16(a, b, c, 0, 0, 0)
__device__ __forceinline__ float rowmax(const f32x16& p0, const f32x16& p1) {
    float a = AT_MX3(p0[0], p0[1], p1[0]), b = AT_MX3(p0[2], p0[3], p1[1]); a = AT_MX3(a, p1[2], p1[3]);
#pragma unroll
    for (int r = 4; r < 16; r += 4) { a = AT_MX3(a, p0[r], p0[r + 1]); b = AT_MX3(b, p0[r + 2], p0[r + 3]); a = AT_MX3(a, p1[r], p1[r + 1]); b = AT_MX3(b, p1[r + 2], p1[r + 3]); }
    float m = __builtin_fmaxf(a, b); auto rr = __builtin_amdgcn_permlane32_swap(__float_as_uint(m), __float_as_uint(m), false, false);
    return __builtin_fmaxf(__uint_as_float(rr[0]), __uint_as_float(rr[1])); }
__device__ __forceinline__ void cmask(f32x16& p0, f32x16& p1, int jb, int qrel, int hi) {
    const int lim = qrel - 64 * jb - 4 * hi;
#pragma unroll
    for (int r = 0; r < 16; ++r) { const int kv = (r & 3) + 8 * (r >> 2); if (kv > lim) p0[r] = -INFINITY; if (kv + 32 > lim) p1[r] = -INFINITY; } }

template <int DV, bool MOBA, int AH, bool FIXED>
__device__ __forceinline__ void sweep(char* shm, const bf16* Qw, const bf16* __restrict__ Kh, const bf16* __restrict__ Vh, int qb, int kt_min, float slope2, float mfix, unsigned sel, f32x16 (&o)[DV / 32], f32x16& lsum) {
    typedef Lay<DV, AH> L;
    constexpr int NPV = DV / 64, NPT = 1 + NPV;
    int tid_ = threadIdx.x; asm volatile("" : "+v"(tid_));
    const int tid = tid_, lane = tid & 63, r32 = lane & 31, hi = lane >> 5; const int wid = __builtin_amdgcn_readfirstlane(tid >> 6);
    const unsigned lds0 = (unsigned)(uintptr_t)shm;
    const lds_ptr shm3 = (lds_ptr)shm;
    __attribute__((address_space(3))) float* wsf = (__attribute__((address_space(3))) float*)(shm3 + L::LDS_WS) + wid * 64;
    const int NT = 4 * qb + 4 - kt_min;
    const bf16* ksrc = Kh + (long)lane * DM + wid * 8;
    const bf16* vsrc0 = Vh + (long)(16 * (wid & 3) + (lane >> 2)) * DM + (wid >> 2) * 32 + (lane & 3) * 8;
    const unsigned kdst = lds0 + L::LDS_K + wid * 1024, vdst = lds0 + L::LDS_V + wid * 1024;
#define AT_KT(i) (MOBA ? ((i) < 4 ? 4 * qb + (i) : (i) - 4 + kt_min) : (i) + kt_min)
#define AT_DMA(i, ksl, vsl) do { if ((i) >= NT) break; const long kt_ = AT_KT(i); glds16(ksrc + kt_ * KVBLK * DM, (unsigned)__builtin_amdgcn_readfirstlane(kdst + (ksl) * KSLOT)); \
        glds16(vsrc0 + kt_ * KVBLK * DM, (unsigned)__builtin_amdgcn_readfirstlane(vdst + (vsl) * L::VSLOT)); \
        if (NPV == 2) glds16(vsrc0 + kt_ * KVBLK * DM + 64, (unsigned)__builtin_amdgcn_readfirstlane(vdst + (vsl) * L::VSLOT + 8192)); } while (0)
#define AT_VRD(g_, d_) do { _Pragma("unroll") for (int ks = 0; ks < 4; ++ks) { vl[g_][ks] = vtr(vp + (d_) * 4096 + ks * 1024); vh[g_][ks] = vtr(vp + (d_) * 4096 + ks * 1024 + 512); } } while (0)
    bf16x8 qr[4];
#pragma unroll
    for (int d0 = 0; d0 < 4; ++d0) qr[d0] = *reinterpret_cast<const bf16x8*>(&Qw[(long)r32 * DM + d0 * 16 + hi * 8]);
    { _Pragma("unroll") for (int a = 0; a < AH; ++a) AT_DMA(a, a, a); }
    const lds_cptr kp0 = (lds_cptr)shm3 + L::LDS_K + hi * 1024 + r32 * 16;
    const lds_cptr vp0 = (lds_cptr)shm3 + L::LDS_V + ((lane >> 4) & 1) * 32 + (lane & 3) * 8 + (4 * hi + ((lane & 15) >> 2)) * 64;
    const unsigned sw = (unsigned)__builtin_amdgcn_readfirstlane((int)(f2bf_u(slope2) | (f2bf_u(slope2 - bf2f_u(f2bf_u(slope2))) << 16)));
    const unsigned hmask = hi == 0 ? 0xffffffffu : 0u;
    const unsigned off0w = (f2bf_u((float)r32) * 0x10001u) & hmask, off1w = (f2bf_u((float)(32 + r32)) * 0x10001u) & hmask;
    unsigned qz = 0u;
    if (FIXED) { const float mrow = mfix + slope2 * (float)(wid * 32 + r32);
                 const unsigned nh = f2bf_u(-mrow), nl = f2bf_u(-mrow - bf2f_u(nh)); qz = (nh | (nl << 16)) & hmask; }
    float mhat = 0.f;
    constexpr bool KPRE = (DV == 64);
    constexpr bool MSUM = (DV == 64);
    float l_reg = 0.f;
    lsum = f32x16{};
    const u32x4 ones4 = {0x3f803f80u, 0x3f803f80u, 0x3f803f80u, 0x3f803f80u};
#pragma unroll
    for (int d = 0; d < DV / 32; ++d) o[d] = f32x16{};
    const int qrel = wid * 32 + r32;
    int slot = 0, vslot = 0;
    constexpr int ND = DV / 32, NMF = 4 * ND, NEXP = 32 / NMF, NVS = AH + 3, PFD = (DV == 64 ? 8 : 6);
    u32x4 pwA[4] = {{0u, 0u, 0u, 0u}, {0u, 0u, 0u, 0u}, {0u, 0u, 0u, 0u}, {0u, 0u, 0u, 0u}}, pwB[4];
    u32x4 a0 = {off0w, 0u, 0x3f803f80u & hmask, 0u}, a1 = {off1w, 0u, 0x3f803f80u & hmask, 0u}, qv = {sw & hmask, sw & hmask, qz, 0u};
    const bool late = !KPRE && wid >= 4;
#define AT_PIN(x) asm volatile("" : "+v"(x))
#define AT_CE(e) ((e) < 16 ? c0[(e) & 15] : c1[(e) & 15])
#define AT_VOFF(g) (((g) >> 2) * 4096 + ((g) & 3) * 1024)
    f32x16 c0, c1; bool resc = false;
    bf16x8 kf[8];
#define AT_KRD(j_, SL_) do { const lds_cptr kp_ = kp0 + (SL_) * KSLOT; kf[2 * (j_)] = *(const __attribute__((address_space(3))) bf16x8*)(kp_ + (j_) * 2048); kf[2 * (j_) + 1] = *(const __attribute__((address_space(3))) bf16x8*)(kp_ + (j_) * 2048 + 512); } while (0)
#define AT_PHA(T_) do { \
        if (!KPRE) { \
            _Pragma("unroll") for (int j = 0; j < 4; ++j) AT_KRD(j, slot); \
            AT_SBAR(); } \
        const int kt = AT_KT(T_); \
        const int jb = MOBA ? ((T_) < 4 ? (T_) : -1) : ((T_) - (NT - 4)); \
        { const unsigned tb = __float_as_uint((float)(64 * (kt - 4 * qb))) >> 16; \
          if (DV == 128) { a0 = (u32x4){off0w, 0u, 0x3f803f80u & hmask, 0u}; a1 = (u32x4){off1w, 0u, 0x3f803f80u & hmask, 0u}; qv = (u32x4){sw & hmask, sw & hmask, qz, 0u}; }     \
          a0.y = (tb * 0x10001u) & hmask; a1.y = a0.y; \
          qv.z = qz; \
          if (MOBA) { if (hi == 0 && (T_) >= 4 && !((sel >> (kt >> 2)) & 1u)) qv.z = 0x0000f14au; } \
          c0 = AT_MFMA(__builtin_bit_cast(bf16x8, a0), __builtin_bit_cast(bf16x8, qv), f32x16{}); c1 = AT_MFMA(__builtin_bit_cast(bf16x8, a1), __builtin_bit_cast(bf16x8, qv), f32x16{}); \
          _Pragma("unroll") for (int j = 0; j < 4; ++j) { c0 = AT_MFMA(kf[2 * j], qr[j], c0); c1 = AT_MFMA(kf[2 * j + 1], qr[j], c1); } } \
        if (jb >= 0) { asm volatile("" ::: "memory"); cmask(c0, c1, jb, qrel, hi); } \
        resc = false; \
        if (!FIXED) { const float rm = rowmax(c0, c1); const bool first = ((T_) == 0); \
          if (first || __any(rm > THR)) { \
              const float dl = first ? rm : __builtin_fmaxf(rm, 0.f); const float mnew = mhat + dl; \
              const unsigned nh = f2bf_u(-mnew), nl = f2bf_u(-mnew - bf2f_u(nh)); const float meff = -(bf2f_u(nh) + bf2f_u(nl)); \
              const float dle = meff - mhat; mhat = meff; qz = (nh | (nl << 16)) & hmask; \
              _Pragma("unroll") for (int r = 0; r < 16; ++r) { c0[r] -= dle; c1[r] -= dle; } \
              if (!first) { const float f = __builtin_amdgcn_exp2f(-dle); if (!MSUM) l_reg *= f; if (hi == 0) wsf[r32] = f; resc = true; } } } \
    } while (0)
#define AT_PHB(VS_, PIN_, POUT_, TN_) do { \
        float sacc = 0.f; \
        const lds_cptr vp = vp0 + (VS_) * L::VSLOT; \
        s16x4 vl[NMF], vh[NMF]; \
        _Pragma("unroll") for (int g = 0; g < PFD; ++g) { vl[g] = vtr(vp + AT_VOFF(g)); vh[g] = vtr(vp + AT_VOFF(g) + 512); } \
        AT_SBAR(); \
        _Pragma("unroll") for (int g = 0; g < NMF; ++g) { \
            if (g + PFD < NMF) { vl[g + PFD] = vtr(vp + AT_VOFF(g + PFD)); vh[g + PFD] = vtr(vp + AT_VOFF(g + PFD) + 512); } \
            { const bf16x8 vf = (bf16x8){vl[g][0], vl[g][1], vl[g][2], vl[g][3], vh[g][0], vh[g][1], vh[g][2], vh[g][3]}; \
              o[g >> 2] = AT_MFMA(__builtin_bit_cast(bf16x8, PIN_[g & 3]), vf, o[g >> 2]); } \
            if (KPRE && g < 4) AT_KRD(g, (slot == AH ? 0 : slot + 1));                                     \
            if (g == (KPRE ? 5 : 9)) { const int s2 = slot == 0 ? AH : slot - 1; int v2 = vslot + AH; v2 = v2 >= NVS ? v2 - NVS : v2; AT_DMA(TN_, s2, v2); }     \
            if (MSUM && (g & (ND - 1)) == ND - 1 && (g / ND) < 4) lsum = AT_MFMA(__builtin_bit_cast(bf16x8, PIN_[g / ND]), __builtin_bit_cast(bf16x8, ones4), lsum); \
            _Pragma("unroll") for (int x = 0; x < NEXP; x += 2) { const int e = g * NEXP + x; \
                const float p0 = __builtin_amdgcn_exp2f(AT_CE(e)), p1 = __builtin_amdgcn_exp2f(AT_CE(e + 1)); \
                if (!MSUM) { sacc += p0; sacc += p1; } POUT_[e >> 3][(e & 7) >> 1] = cvtpk_s(p0, p1); } \
            if (!MSUM) AT_PIN(sacc); AT_PIN(POUT_[(g * NEXP) >> 3]); \
            AT_SBAR(); } \
        if (resc) { \
            asm volatile("s_waitcnt lgkmcnt(0)" ::: "memory"); \
            _Pragma("unroll") for (int r = 0; r < 16; ++r) { const float f_ = wsf[crow(r, hi)]; if (MSUM) lsum[r] *= f_; _Pragma("unroll") for (int d = 0; d < ND; ++d) o[d][r] *= f_; } } \
        if (!MSUM) l_reg += sacc; \
    } while (0)
#define AT_STEP_END(T_) do { { int na = NT - (KPRE ? 3 : 2) - (T_); na = na < 0 ? 0 : (na > AH - (KPRE ? 2 : 1) ? AH - (KPRE ? 2 : 1) : na); wait_bar_n(na * NPT); }     \
        slot = slot == AH ? 0 : slot + 1; vslot = vslot == NVS - 1 ? 0 : vslot + 1; } while (0)
    wait_bar_n(((NT < AH ? NT : AH) - (KPRE ? 2 : 1)) * NPT);
    asm volatile("s_waitcnt vmcnt(0)" ::: "memory");
    asm volatile("" : "+v"(qr[0]), "+v"(qr[1]), "+v"(qr[2]), "+v"(qr[3]));
    if (KPRE) { _Pragma("unroll") for (int j = 0; j < 4; ++j) AT_KRD(j, 0); }
    int vlast; bool inA;
#define AT_VPREV1 (vslot == 0 ? NVS - 1 : vslot - 1)
#define AT_VPREV2 (vslot < 2 ? vslot + NVS - 2 : vslot - 2)
    if (!late) {
        int i = 0;
        for (; i + 1 < NT; i += 2) {
            AT_PHA(i);     AT_PHB(i == 0 ? 0 : AT_VPREV1, pwA, pwB, i + AH); AT_STEP_END(i);
            AT_PHA(i + 1); AT_PHB(AT_VPREV1, pwB, pwA, i + 1 + AH);      AT_STEP_END(i + 1);
        }
        inA = true;
        if (i < NT) { AT_PHA(i); AT_PHB(AT_VPREV1, pwA, pwB, i + AH); AT_STEP_END(i); inA = false; }
        vlast = AT_VPREV1;
    } else {
        { const int s2 = slot == 0 ? AH : slot - 1; int v2 = vslot + AH; v2 = v2 >= NVS ? v2 - NVS : v2; AT_DMA(AH, s2, v2); }
        AT_PHA(0); AT_STEP_END(0);
        int i = 1;
        for (; i + 1 < NT; i += 2) {
            AT_PHB(i == 1 ? 0 : AT_VPREV2, pwA, pwB, i + AH); AT_PHA(i);     AT_STEP_END(i);
            AT_PHB(AT_VPREV2, pwB, pwA, i + 1 + AH);      AT_PHA(i + 1); AT_STEP_END(i + 1);
        }
        inA = true;
        if (i < NT) { AT_PHB(i == 1 ? 0 : AT_VPREV2, pwA, pwB, i + AH); AT_PHA(i); AT_STEP_END(i); inA = false; }
        if (inA) { AT_PHB(AT_VPREV2, pwA, pwB, NT); inA = false; } else { AT_PHB(AT_VPREV2, pwB, pwA, NT); inA = true; }
        vlast = AT_VPREV1;
    }
    if (!inA) {
#pragma unroll
        for (int k = 0; k < 4; ++k) pwA[k] = pwB[k];
    }
    { const lds_cptr vp = vp0 + vlast * L::VSLOT; s16x4 vl[2][4], vh[2][4];
      AT_VRD(0, 0); AT_SBAR();
#pragma unroll
      for (int d = 0; d < ND; ++d) {
          if (d + 1 < ND) AT_VRD((d + 1) & 1, d + 1);
          AT_SBAR();
#pragma unroll
          for (int ks = 0; ks < 4; ++ks) { const bf16x8 vf = (bf16x8){vl[d & 1][ks][0], vl[d & 1][ks][1], vl[d & 1][ks][2], vl[d & 1][ks][3], vh[d & 1][ks][0], vh[d & 1][ks][1], vh[d & 1][ks][2], vh[d & 1][ks][3]};
              o[d] = AT_MFMA(__builtin_bit_cast(bf16x8, pwA[ks]), vf, o[d]); }
          AT_SBAR(); }
      if (MSUM) {
#pragma unroll
          for (int ks = 0; ks < 4; ++ks) lsum = AT_MFMA(__builtin_bit_cast(bf16x8, pwA[ks]), __builtin_bit_cast(bf16x8, ones4), lsum); } }
    if (!MSUM) {
        auto rr = __builtin_amdgcn_permlane32_swap(__float_as_uint(l_reg), __float_as_uint(l_reg), false, false); const float lt = __uint_as_float(rr[0]) + __uint_as_float(rr[1]);
        if (hi == 0) wsf[32 + r32] = lt;
        asm volatile("s_waitcnt lgkmcnt(0)" ::: "memory");
#pragma unroll
        for (int r = 0; r < 16; ++r) lsum[r] = wsf[32 + crow(r, hi)];
    }
    AT_WAIT_BAR(0);
#undef AT_PIN
#undef AT_CE
#undef AT_VOFF
#undef AT_PHA
#undef AT_PHB
#undef AT_STEP_END
#undef AT_KRD
#undef AT_VPREV1
#undef AT_VPREV2
#undef AT_KT
#undef AT_DMA
#undef AT_VRD
}

__device__ __forceinline__ int window_kt_min(const unsigned* nrm, int b, int chunk, int q0, float slope2, float& Bout) {
    const float nq = __uint_as_float(nrm[((0 * 2 + b) * 16 + chunk) * 2]) + __uint_as_float(nrm[((0 * 2 + b) * 16 + chunk) * 2 + 1]);
    const float nk = __uint_as_float(nrm[((1 * 2 + b) * 16 + chunk) * 2]) + __uint_as_float(nrm[((1 * 2 + b) * 16 + chunk) * 2 + 1]);
    const float B = sqrtf(nq * nk) * 1.01f; Bout = B;
    const float W = (2.0f * B + 160.0f) / slope2;
    const int wkeys = W < 1.0e6f ? (int)W : 1000000;
    const int d = q0 - wkeys;
    return d > 0 ? (d >> 6) : 0;
}
__device__ __forceinline__ void diff_item(char* shm, int b, int h, int qb, int m, const bf16* Q, const bf16* K, const bf16* V, bf16* O, float lam, const unsigned* nrm, unsigned* flag, unsigned* tmo) {
    typedef Lay<128, 2> L;
    int tid_ = threadIdx.x; asm volatile("" : "+v"(tid_));
    const int tid = tid_; const int wid = __builtin_amdgcn_readfirstlane(tid >> 6);
    const long rowbase = (long)b * SEQ; const int q0 = qb * 256;
    const float slope2 = __builtin_amdgcn_exp2f(-(float)(h + 1)) * 1.4426950408889634f;
    lam = __uint_as_float((unsigned)__builtin_amdgcn_readfirstlane((int)__float_as_uint(lam)));
    const lds_ptr shm3 = (lds_ptr)shm;
    __attribute__((address_space(3))) float* wsf = (__attribute__((address_space(3))) float*)(shm3 + L::LDS_WS) + wid * 64;
    __attribute__((address_space(3))) bf16* stg = (__attribute__((address_space(3))) bf16*)(shm3 + L::LDS_OST + wid * L::OSTW);
    f32x16 o[4], lsum;
    float Bq; const int kt_min = __builtin_amdgcn_readfirstlane(window_kt_min(nrm, b, 2 * h + m, q0, slope2, Bq));
    Bq = __uint_as_float((unsigned)__builtin_amdgcn_readfirstlane((int)__float_as_uint(Bq)));
    if (Bq <= 40.0f) sweep<128, false, 2, true>(shm, Q + (rowbase + q0 + wid * 32) * DM + h * 128 + m * 64, K + rowbase * DM + h * 128 + m * 64, V + rowbase * DM + h * 128, qb, kt_min, slope2, Bq, 0u, o, lsum);
    else sweep<128, false, 2, false>(shm, Q + (rowbase + q0 + wid * 32) * DM + h * 128 + m * 64, K + rowbase * DM + h * 128 + m * 64, V + rowbase * DM + h * 128, qb, kt_min, slope2, Bq, 0u, o, lsum);
    int lane_e = tid & 63; asm volatile("" : "+v"(lane_e));
    const int lane = lane_e, r32 = lane & 31, hi = lane >> 5;
    bf16* Ow = O + (rowbase + q0 + wid * 32) * DM + h * 128;
    float rli[16];
#pragma unroll
    for (int r = 0; r < 16; ++r) rli[r] = (m == 0 ? 1.0f : lam) * __builtin_amdgcn_rcpf(lsum[r]);
    if (m == 0) {
#pragma unroll
        for (int r = 0; r < 16; ++r)
#pragma unroll
            for (int d = 0; d < 4; ++d) stg[crow(r, hi) * 128 + d * 32 + r32] = (bf16)f2bf_u(o[d][r] * rli[r]);
        asm volatile("s_waitcnt lgkmcnt(0)" ::: "memory");
#pragma unroll
        for (int i = 0; i < 8; ++i) { const int row = i * 4 + (lane >> 4), ch = lane & 15; const u32x4 v = *(const __attribute__((address_space(3))) u32x4*)(stg + row * 128 + ch * 8); *(u32x4*)(Ow + (long)row * DM + ch * 8) = v; }
        asm volatile("s_waitcnt vmcnt(0)" ::: "memory");
        __syncthreads();
        if (tid == 0) { __builtin_amdgcn_fence(__ATOMIC_RELEASE, "agent"); asm volatile("s_waitcnt vmcnt(0)" ::: "memory"); __hip_atomic_store(flag, 1u, __ATOMIC_RELAXED, __HIP_MEMORY_SCOPE_AGENT); }
    } else {
        if (tid == 0) {
            unsigned sp = 0u;
            while (__hip_atomic_load(flag, __ATOMIC_RELAXED, __HIP_MEMORY_SCOPE_AGENT) == 0u) { __builtin_amdgcn_s_sleep(8); if (++sp > (1u << 22)) { __hip_atomic_store(tmo, 1u, __ATOMIC_RELAXED, __HIP_MEMORY_SCOPE_AGENT); break; } }
            __builtin_amdgcn_fence(__ATOMIC_ACQUIRE, "agent");
            asm volatile("s_waitcnt vmcnt(0)" ::: "memory");
        }
        __syncthreads();
#pragma unroll
        for (int i = 0; i < 8; ++i) { const int row = i * 4 + (lane >> 4), ch = lane & 15; const u32x4 v = *(const u32x4*)(Ow + (long)row * DM + ch * 8); *(__attribute__((address_space(3))) u32x4*)(stg + row * 128 + ch * 8) = v; }
        asm volatile("s_waitcnt vmcnt(0) lgkmcnt(0)" ::: "memory");
        float ss[16];
#pragma unroll
        for (int r = 0; r < 16; ++r) { float sq = 0.f;
#pragma unroll
            for (int d = 0; d < 4; ++d) { const float v = bf2f_u(stg[crow(r, hi) * 128 + d * 32 + r32]) - o[d][r] * rli[r]; o[d][r] = v; sq = __builtin_fmaf(v, v, sq); }
            ss[r] = sq; }
#pragma unroll
        for (int r = 0; r < 16; ++r) {
#pragma unroll
            for (int off = 1; off < 32; off <<= 1) ss[r] += __shfl_xor(ss[r], off);
            ss[r] = 1.0f / sqrtf(ss[r] * (1.0f / 128.0f) + 1e-6f); }
#pragma unroll
        for (int r = 0; r < 16; ++r)
#pragma unroll
            for (int d = 0; d < 4; ++d) stg[crow(r, hi) * 128 + d * 32 + r32] = (bf16)f2bf_u(o[d][r] * ss[r]);
        asm volatile("s_waitcnt lgkmcnt(0)" ::: "memory");
#pragma unroll
        for (int i = 0; i < 8; ++i) { const int row = i * 4 + (lane >> 4), ch = lane & 15; const u32x4 v = *(const __attribute__((address_space(3))) u32x4*)(stg + row * 128 + ch * 8); *(u32x4*)(Ow + (long)row * DM + ch * 8) = v; }
    }
}
__device__ __forceinline__ void moba_unit(char* shm, int b, int h, int qb, const bf16* Q, const bf16* K, const bf16* V, bf16* O, const float* KM, const unsigned* nrm) {
    typedef Lay<64, 4> L;
    int tid_ = threadIdx.x; asm volatile("" : "+v"(tid_));
    const int tid = tid_, lane = tid & 63, r32 = lane & 31, hi = lane >> 5; const int wid = __builtin_amdgcn_readfirstlane(tid >> 6);
    const long rowbase = (long)b * SEQ; const int q0 = qb * 256;
    const float slope2 = __builtin_amdgcn_exp2f(-0.5f * (float)(h + 1)) * 1.4426950408889634f;
    const lds_ptr shm3 = (lds_ptr)shm;
    __attribute__((address_space(3))) float* wsf = (__attribute__((address_space(3))) float*)(shm3 + L::LDS_WS) + wid * 64;
    __attribute__((address_space(3))) bf16* stg = (__attribute__((address_space(3))) bf16*)(shm3 + L::LDS_OST + wid * L::OSTW);
    const bf16* Qw = Q + (rowbase + q0 + wid * 32) * DM + h * 64;
    unsigned sel = 0u;
    if (qb > 0) {
        f32x16 g = f32x16{};
        const float* km = KM + (((long)b * 16 + h) * 32 + r32) * 64 + hi * 8;
#pragma unroll
        for (int d0 = 0; d0 < 4; ++d0) {
            const bf16x8 qf = *reinterpret_cast<const bf16x8*>(&Qw[(long)r32 * DM + d0 * 16 + hi * 8]);
            const float4 x0 = *(const float4*)(km + d0 * 16), x1 = *(const float4*)(km + d0 * 16 + 4);
            const float xs[8] = {x0.x, x0.y, x0.z, x0.w, x1.x, x1.y, x1.z, x1.w};
            unsigned hw[8], lw[8];
#pragma unroll
            for (int e = 0; e < 8; ++e) { hw[e] = f2bf_u(xs[e]); lw[e] = f2bf_u(xs[e] - bf2f_u(hw[e])); }
            const u32x4 ah = {hw[0] | (hw[1] << 16), hw[2] | (hw[3] << 16), hw[4] | (hw[5] << 16), hw[6] | (hw[7] << 16)};
            const u32x4 al = {lw[0] | (lw[1] << 16), lw[2] | (lw[3] << 16), lw[4] | (lw[5] << 16), lw[6] | (lw[7] << 16)};
            g = AT_MFMA(__builtin_bit_cast(bf16x8, ah), qf, g); g = AT_MFMA(__builtin_bit_cast(bf16x8, al), qf, g);
        }
        float g0[16], g1[16];
#pragma unroll
        for (int r = 0; r < 16; ++r) { auto rr = __builtin_amdgcn_permlane32_swap(__float_as_uint(g[r]), __float_as_uint(g[r]), false, false); g0[r] = __uint_as_float(rr[0]); g1[r] = __uint_as_float(rr[1]); }
        float b0 = -INFINITY, b1 = -INFINITY, b2 = -INFINITY; int i0 = 0, i1 = 0, i2 = 0;
#pragma unroll
        for (int n = 0; n < 32; ++n) {
            const int rn = 4 * (n >> 3) + (n & 3);
            float v = ((n >> 2) & 1) ? g1[rn] : g0[rn];
            if (n >= qb) v = -INFINITY;
            if (v > b0) { b2 = b1; i2 = i1; b1 = b0; i1 = i0; b0 = v; i0 = n; }
            else if (v > b1) { b2 = b1; i2 = i1; b1 = v; i1 = n; }
            else if (v > b2) { b2 = v; i2 = n; }
        }
        if (b0 > -INFINITY) sel |= 1u << i0;
        if (b1 > -INFINITY) sel |= 1u << i1;
        if (b2 > -INFINITY) sel |= 1u << i2;
    }
    f32x16 o[2], lsum;
    float Bq; const int kt_min = __builtin_amdgcn_readfirstlane(window_kt_min(nrm, b, h, q0, slope2, Bq));
    Bq = __uint_as_float((unsigned)__builtin_amdgcn_readfirstlane((int)__float_as_uint(Bq)));
    if (Bq <= 40.0f) sweep<64, true, 4, true>(shm, Qw, K + rowbase * DM + h * 64, V + rowbase * DM + h * 64, qb, kt_min, slope2, Bq, sel, o, lsum);
    else sweep<64, true, 4, false>(shm, Qw, K + rowbase * DM + h * 64, V + rowbase * DM + h * 64, qb, kt_min, slope2, Bq, sel, o, lsum);
    int lane_e = lane; asm volatile("" : "+v"(lane_e));
    { const int lane = lane_e, r32 = lane & 31, hi = lane >> 5;
#pragma unroll
    for (int r = 0; r < 16; ++r) { const float rl = __builtin_amdgcn_rcpf(lsum[r]);
#pragma unroll
        for (int d = 0; d < 2; ++d) stg[crow(r, hi) * 64 + d * 32 + r32] = (bf16)f2bf_u(o[d][r] * rl); }
    asm volatile("s_waitcnt lgkmcnt(0)" ::: "memory");
    bf16* Ow = O + (rowbase + q0 + wid * 32) * DM + h * 64;
#pragma unroll
    for (int i = 0; i < 4; ++i) { const int row = i * 8 + (lane >> 3), ch = lane & 7; const u32x4 v = *(const __attribute__((address_space(3))) u32x4*)(stg + row * 64 + ch * 8); *(u32x4*)(Ow + (long)row * DM + ch * 8) = v; }
    }
}
#undef AT_SBAR
#undef AT_WAIT_BAR
#undef AT_MX3
#undef AT_MFMA
}

constexpr int NWAVES = 8;
constexpr int RING_OFF = 0, RING_BYTES = 131072;
constexpr int LDSCTL_OFF = RING_BYTES, MISC_OFF = LDSCTL_OFF + 320;
constexpr int LDS_BYTES = RING_BYTES + 1024;
static_assert(attn::Lay<128, 2>::BYTES <= RING_BYTES && attn::Lay<64, 4>::BYTES <= RING_BYTES && LDS_BYTES <= 163840, "LDS budget");
static_assert(MISC_OFF + 128 <= LDS_BYTES, "LDS map");

struct Frame {
    LAS unsigned char* lds; volatile LAS unsigned* MISC; gu32* ctl;
    int tid, lane, wave, vcu, G;
};
__device__ __forceinline__ float wave_sum(float v) {
#pragma unroll
    for (int o = 1; o < 64; o <<= 1) v += __shfl_xor(v, o);
    return v;
}
__device__ __forceinline__ float bf2f(unsigned h) { return __builtin_bit_cast(float, h << 16); }

__device__ __forceinline__ void p0_transpose_item(const float* W, int K, int N, bf16* WT, LAS float* scr, int item, int lane, const float* gk, int gmask, float cmul, int qcols, float qscale) {
    const int nblk = N / 32, kb = item / nblk, nb = item % nblk, k0 = 64 * kb, n0 = 32 * nb;
    const float cs = cmul * ((n0 < qcols) ? qscale : 1.0f);
#pragma unroll 8
    for (int i = 0; i < 32; ++i) { const int kk = 2 * i + (lane >> 5); const float g = gk ? gk[(k0 + kk) & gmask] : 1.0f; scr[kk * 33 + (lane & 31)] = W[(size_t)(k0 + kk) * N + n0 + (lane & 31)] * (g * cs); }
    LDS_WAIT(); asm volatile("" ::: "memory");
    const int c = lane & 7;
#pragma unroll
    for (int j = 0; j < 4; ++j) { const int n = (lane >> 3) + 8 * j; const LAS float* s = scr + (8 * c) * 33 + n;
        v4u o; o.x = pk2(s[0 * 33], s[1 * 33]); o.y = pk2(s[2 * 33], s[3 * 33]); o.z = pk2(s[4 * 33], s[5 * 33]); o.w = pk2(s[6 * 33], s[7 * 33]);
        *(GAS v4u*)(WT + (size_t)(n0 + n) * K + k0 + 8 * c) = o; }
    LDS_WAIT(); asm volatile("" ::: "memory");
}
__device__ __forceinline__ void p0_x_row2(const float* xrow, bf16* hrow, float* ssq, int lane) {
    f32x4 v[2][4];
#pragma unroll
    for (int r = 0; r < 2; ++r)
#pragma unroll
        for (int j = 0; j < 4; ++j) v[r][j] = ((const GAS f32x4*)(xrow + (size_t)r * D) + lane)[64 * j];
#pragma unroll
    for (int r = 0; r < 2; ++r) { GAS unsigned long long* h8 = (GAS unsigned long long*)(hrow + (size_t)r * D) + lane; float s[4];
#pragma unroll
        for (int j = 0; j < 4; ++j) { h8[64 * j] = (unsigned long long)pk2(v[r][j].x, v[r][j].y) | ((unsigned long long)pk2(v[r][j].z, v[r][j].w) << 32);
            s[j] = wave_sum((v[r][j].x * v[r][j].x + v[r][j].y * v[r][j].y) + (v[r][j].z * v[r][j].z + v[r][j].w * v[r][j].w)); }
        if (lane < 16) { const int j = lane >> 2; const float sj = j == 0 ? s[0] : j == 1 ? s[1] : j == 2 ? s[2] : s[3]; ssq[r * 16 + lane] = (lane & 3) == 0 ? sj : 0.f; } }
}
__device__ __forceinline__ void final_row(const bf16* hrow, float* orow, const float* ssq, const float* g, int lane) {
    const float rs = pg8::row_rstd16(ssq, 0);
#pragma unroll
    for (int j = 0; j < 2; ++j) {
        const v4u hb = *((const GAS v4u*)(hrow + 512 * j) + lane);
        const GAS f32x4* gr = (const GAS f32x4*)(g + 512 * j) + 2 * lane; GAS f32x4* orr = (GAS f32x4*)(orow + 512 * j) + 2 * lane;
        f32x4 a = {bf2f(hb.x & 0xffffu), bf2f(hb.x >> 16), bf2f(hb.y & 0xffffu), bf2f(hb.y >> 16)}, b = {bf2f(hb.z & 0xffffu), bf2f(hb.z >> 16), bf2f(hb.w & 0xffffu), bf2f(hb.w >> 16)};
        orr[0] = a * rs * gr[0]; orr[1] = b * rs * gr[1];
    }
}

#define REP_QKV 1
#define REP_DIFF 1
#define REP_MOBA 1
#define REP_FF1 1
#define REP_PRO 1
#define REP_BAR 1
struct Args { const float* in[10]; float* out; unsigned char* ws; };
__global__ void __launch_bounds__(NWAVES * 64, 2) fwd_kernel(Args args) {
    extern __shared__ __attribute__((aligned(16))) unsigned char lds[];
    Frame F;
    F.lds = (LAS unsigned char*)lds;
    F.MISC = (volatile LAS unsigned*)(F.lds + MISC_OFF);
    F.tid = threadIdx.x; F.lane = F.tid & 63; F.wave = __builtin_amdgcn_readfirstlane(F.tid >> 6);
    F.G = gridDim.x; { const int bx = blockIdx.x; F.vcu = (F.G % 8 == 0) ? (bx % 8) * (F.G / 8) + bx / 8 : bx; }
    unsigned char* ws = args.ws;
    F.ctl = (gu32*)(ws + WS_CTL);
#define PTRS() \
    unsigned long long z_ = 0ull; asm volatile("" : "+s"(z_)); unsigned char* wsl = args.ws + z_; float* out = args.out + z_;     \
    bf16* WIN = (bf16*)(wsl + WS_WIN); bf16* WOUT = (bf16*)(wsl + WS_WOUT); bf16* WFF1 = (bf16*)(wsl + WS_WFF1); bf16* WFF2 = (bf16*)(wsl + WS_WFF2); \
    float* SSQ = (float*)(wsl + WS_SSQ); float* KM = (float*)(wsl + WS_KMEAN); \
    bf16* HB = (bf16*)(wsl + WS_HB); bf16* Qb = (bf16*)(wsl + WS_Q); bf16* Kb = (bf16*)(wsl + WS_K); bf16* Vb = (bf16*)(wsl + WS_V); bf16* Ob = (bf16*)(wsl + WS_O); \
    bf16* ACT = (bf16*)(wsl + WS_ACT); \
    (void)WIN; (void)WOUT; (void)WFF1; (void)WFF2; (void)SSQ; (void)KM; (void)HB; (void)Qb; (void)Kb; (void)Vb; (void)Ob; (void)ACT; (void)out
    for (int u = F.tid; u < (LDS_BYTES - LDSCTL_OFF) / 4; u += NWAVES * 64) ((LAS unsigned*)(F.lds + LDSCTL_OFF))[u] = 0u;
    __syncthreads();
    XcdBarrier bar = xcd_barrier_post((unsigned*)(F.ctl + CW_BAR), F.MISC + 8);
#define GRID_BAR() do { for (int rb_ = 0; rb_ < REP_BAR; ++rb_) xcd_barrier(bar); } while (0)
    const int gw = F.vcu * NWAVES + F.wave, NGW = F.G * NWAVES;

    {
        PTRS();
        const float* x = args.in[0]; const float* attn_norm = args.in[1]; const float* w_in = args.in[2]; const float* w_out = args.in[3];
        const float* diff_subln = args.in[5]; const float* mlp_norm = args.in[6]; const float* w_ff1 = args.in[7]; const float* w_ff2 = args.in[8];
        int ln = threadIdx.x & 63; asm volatile("" : "+v"(ln));
        LAS float* scr = (LAS float*)(F.lds + RING_OFF + F.wave * 16384);
        constexpr int I_IN = (D / 64) * (NQKV / 32), I_OUT = (D / 64) * (D / 32), I_F1 = (D / 64) * (FF / 32), I_F2 = (FF / 64) * (D / 32);
        constexpr int PER_L = I_IN + I_OUT + I_F1 + I_F2;
        for (int rp_ = 0; rp_ < REP_PRO; ++rp_) {
        for (int it = gw; it < 2 * PER_L; it += NGW) {
            const int l = it / PER_L; int r = it % PER_L;
            if (r < I_IN) { p0_transpose_item(w_in + (size_t)l * D * NQKV, D, NQKV, WIN + (size_t)l * NQKV * D, scr, r, ln, attn_norm + l * D, D - 1, 1.0f, D, QSCALE); continue; } r -= I_IN;
            if (r < I_OUT) { p0_transpose_item(w_out + (size_t)l * D * D, D, D, WOUT + (size_t)l * D * D, scr, r, ln, l == 0 ? diff_subln : nullptr, 127, l == 0 ? 0.8f : 1.0f, 0, 1.0f); continue; } r -= I_OUT;
            if (r < I_F1) { p0_transpose_item(w_ff1 + (size_t)l * D * FF, D, FF, WFF1 + (size_t)l * FF * D, scr, r, ln, mlp_norm + l * D, D - 1, 1.0f, 0, 1.0f); continue; } r -= I_F1;
            p0_transpose_item(w_ff2 + (size_t)l * FF * D, FF, D, WFF2 + (size_t)l * D * FF, scr, r, ln, nullptr, 0, 1.0f, 0, 1.0f);
        }
        for (int m = 2 * gw; m < M; m += 2 * NGW) p0_x_row2(x + (size_t)m * D, HB + (size_t)m * D, SSQ + (size_t)m * 16, ln);
        }
    }
    GRID_BAR();

#pragma unroll 1
    for (int l = 0; l < 2; ++l) {
        {
            PTRS();
            pg8::Gemm g{HB, WIN + (size_t)l * NQKV * D, M, NQKV, D}; pg8::StaticOrder S; S.init(M, NQKV, F.G, (int)blockIdx.x);
            pg8::EpiScaleBf16<0> E{Qb, D, SSQ, D, (size_t)M * D, l == 1 ? (float*)(F.ctl + CW_KMS) : nullptr, (unsigned*)(F.ctl + CW_NRM + l * 256)};
            for (int rep = 0; rep < REP_QKV; ++rep)
            pg8::gemm_phase<pg8::EpiScaleBf16<0>, pg8::StaticOrder, PG8_ALIGN, PG8_SP2>(F.lds + RING_OFF, g, S, E);
        }
        GRID_BAR();
        if (l == 0) {
            PTRS();
            const float* lp = args.in[4];
            int lnl = threadIdx.x & 63; asm volatile("" : "+v"(lnl));
            const float la = wave_sum(lp[lnl] * lp[64 + lnl]), lc = wave_sum(lp[128 + lnl] * lp[192 + lnl]);
            const float lam = expf(la) - expf(lc) + 0.2f;
            for (int rep = 0; rep < REP_DIFF; ++rep)
            for (;;) {
                if (F.tid == 0) F.MISC[16] = __hip_atomic_fetch_add(F.ctl + CW_QUEUE + 64 * rep, 1u, RLX_AGENT);
                __syncthreads();
                const int i = (int)F.MISC[16];
                __syncthreads();
                if (i >= 1024) break;
                const int u = i >> 1, bh = u & 15, qb = 31 - (u >> 4);
                attn::diff_item((char*)lds + RING_OFF, bh >> 3, bh & 7, qb, i & 1, Qb, Kb, Vb, Ob, lam, (const unsigned*)(F.ctl + CW_NRM), (unsigned*)(F.ctl + CW_DFLAG + rep * 512 + u), (unsigned*)(F.ctl + CW_BAR) + XB_TMO);
            }
        } else {
            PTRS();
            const float* KMf = (const float*)(F.ctl + CW_KMS);
            for (int rep = 0; rep < REP_MOBA; ++rep)
            for (;;) {
                if (F.tid == 0) F.MISC[16] = __hip_atomic_fetch_add(F.ctl + CW_QUEUE + 64 * (4 + rep), 1u, RLX_AGENT);
                __syncthreads();
                const int i = (int)F.MISC[16];
                __syncthreads();
                if (i >= 1024) break;
                const int bh = i & 31, qb = 31 - (i >> 5);
                attn::moba_unit((char*)lds + RING_OFF, bh >> 4, bh & 15, qb, Qb, Kb, Vb, Ob, KMf, (const unsigned*)(F.ctl + CW_NRM + 256));
            }
        }
        GRID_BAR();
        {
            PTRS();
            pg8::Gemm g{Ob, WOUT + (size_t)l * D * D, M, D, D}; pg8::StaticOrder S; S.init(M, D, F.G, (int)blockIdx.x);
            pg8::EpiRes<false> E{out, HB, SSQ, D};
            pg8::gemm_phase<pg8::EpiRes<false>, pg8::StaticOrder, PG8_ALIGN, PG8_SP2>(F.lds + RING_OFF, g, S, E);
        }
        GRID_BAR();
        {
            PTRS();
            pg8::Gemm g{HB, WFF1 + (size_t)l * FF * D, M, FF, D}; pg8::StaticOrder S; S.init(M, FF, F.G, (int)blockIdx.x);
            pg8::EpiScaleBf16<1> E{ACT, FF, SSQ, 0, 0, nullptr, nullptr};
            for (int rep = 0; rep < REP_FF1; ++rep)
            pg8::gemm_phase<pg8::EpiScaleBf16<1>, pg8::StaticOrder, PG8_ALIGN, PG8_SP2>(F.lds + RING_OFF, g, S, E);
        }
        GRID_BAR();
        {
            PTRS();
            pg8::Gemm g{ACT, WFF2 + (size_t)l * D * FF, M, D, FF}; pg8::StaticOrder S; S.init(M, D, F.G, (int)blockIdx.x);
            pg8::EpiRes<false> E{out, HB, SSQ, D}; pg8::gemm_phase<pg8::EpiRes<false>, pg8::StaticOrder, PG8_ALIGN, PG8_SP2>(F.lds + RING_OFF, g, S, E);
        }
        GRID_BAR();
    }
    PTRS(); const float* final_norm = args.in[9]; int lnf = threadIdx.x & 63; asm volatile("" : "+v"(lnf));
    for (int m = gw; m < M; m += NGW) final_row(HB + (size_t)m * D, out + (size_t)m * D, SSQ + (size_t)m * 16, final_norm, lnf);
    if (xb_ld((unsigned*)(F.ctl + CW_BAR) + XB_TMO) != 0u && blockIdx.x == 0) { const float qn = __builtin_nanf(""); for (int i = F.tid; i < 4096; i += NWAVES * 64) out[i] = qn; }
}

extern "C" void kernel_launch(void* const* d_in, const int* in_sizes, int n_in, void* d_out, int out_size, void* d_ws, size_t ws_size, hipStream_t stream) {
    static int grid = 0;
    if (grid == 0) {
        if (n_in != 10 || in_sizes[0] != M * D || out_size != M * D || ws_size < WS_END) { fprintf(stderr, "kernel_launch: unexpected shapes (n_in %d out %d ws %zu); nothing launched\n", n_in, out_size, ws_size); grid = -1; return; }
        int dev = 0, cus = 0, per_cu = 0;
        if (hipGetDevice(&dev) != hipSuccess || hipDeviceGetAttribute(&cus, hipDeviceAttributeMultiprocessorCount, dev) != hipSuccess) { fprintf(stderr, "kernel_launch: device query failed\n"); grid = -1; return; }
        if (hipFuncSetAttribute((const void*)fwd_kernel, hipFuncAttributeMaxDynamicSharedMemorySize, LDS_BYTES) != hipSuccess) { fprintf(stderr, "kernel_launch: hipFuncSetAttribute failed\n"); grid = -1; return; }
        if (hipOccupancyMaxActiveBlocksPerMultiprocessor(&per_cu, (const void*)fwd_kernel, NWAVES * 64, LDS_BYTES) != hipSuccess || per_cu < 1) { fprintf(stderr, "kernel_launch: occupancy query reports %d workgroups per CU\n", per_cu); per_cu = 1; }
        (void)hipGetLastError();
        grid = cus;
    }
    if (grid < 0) return;
    if (hipMemsetAsync((char*)d_ws + WS_CTL, 0, CTL_ZERO_BYTES, stream) != hipSuccess) { fprintf(stderr, "kernel_launch: hipMemsetAsync failed\n"); return; }
    Args a{};
    for (int i = 0; i < 10; ++i) a.in[i] = (const float*)d_in[i];
    a.out = (float*)d_out; a.ws = (unsigned char*)d_ws;
    hipLaunchKernelGGL(fwd_kernel, dim3(grid), dim3(NWAVES * 64), LDS_BYTES, stream, a);
    const hipError_t le = hipPeekAtLastError();
    if (le != hipSuccess) fprintf(stderr, "kernel_launch: launch failed: %s\n", hipGetErrorName(le));
}
```
